# Optimizing an MI355X kernel written in HIP

```python
import math
import jax, jax.numpy as jnp
from jax import lax
import numpy as np

D_MODEL = 1024
BATCH = 4
SEQ = 4096
DEPTH = 2

GRID_W = 64
CTX_LEN = 256
EPS = 1e-6
F32 = jnp.float32
HEAD_DIM = 64
ROPE_BASE = 10000.0

WA_HEADS = 4
WA_KV_HEADS = 2
WA_WINDOW = 128
WA_BLOCK = 128
NA_HEADS = 4
NA_MAX_KH = 8
NA_KW = 16
NA_QBW = 16
NA_KBW = NA_QBW + NA_KW
SSM_HEADS = 8
SSM_HEAD_DIM = 64
SSM_INNER = SSM_HEADS * SSM_HEAD_DIM
SSM_GROUPS = 2
SSM_STATE = 128
SSM_CONV = 7
SSM_CHUNK = 128
D_FF = ((8 * D_MODEL + 3 * 256 - 1) // (3 * 256)) * 256

QA_COLS = WA_HEADS * HEAD_DIM
QB_COLS = NA_HEADS * HEAD_DIM
Z_COLS = SSM_INNER
Q_SIDE = QA_COLS + QB_COLS + Z_COLS
KA_COLS = WA_KV_HEADS * HEAD_DIM
KB_COLS = NA_HEADS * HEAD_DIM
XBC_COLS = SSM_INNER + 2 * SSM_GROUPS * SSM_STATE
DT_COLS = 2 * SSM_HEADS
IN_COLS = Q_SIDE + 2 * KA_COLS + 2 * KB_COLS + XBC_COLS + DT_COLS
MIX_WIDTH = QA_COLS + QB_COLS + SSM_INNER

kernel_name = 'hymba_style_window_natten_ssd_prefix_dit'


def rms_norm(x, g):
    xf = x.astype(F32)
    y = xf * lax.rsqrt(jnp.mean(xf * xf, axis=-1, keepdims=True) + EPS)
    return (y * g.astype(F32)).astype(x.dtype)


def modulate(h, shift, scale):
    return h * (1 + scale) + shift


def split_cols(p, sizes):
    out, off = [], 0
    for s in sizes:
        out.append(p[..., off:off + s])
        off += s
    return out


def rope_2d(x, rows, cols):
    d = x.shape[-1]
    half = d // 2
    quarter = half // 2
    inv_freq = ROPE_BASE ** (-jnp.arange(quarter, dtype=F32) / quarter)
    xf = x.astype(F32)

    def rot(xp, pos):
        ang = pos.astype(F32)[:, None] * inv_freq[None, :]
        cos = jnp.cos(ang)[None, :, None, :]
        sin = jnp.sin(ang)[None, :, None, :]
        x1, x2 = xp[..., :quarter], xp[..., quarter:]
        return jnp.concatenate([x1 * cos - x2 * sin, x2 * cos + x1 * sin], axis=-1)

    return jnp.concatenate([rot(xf[..., :half], rows), rot(xf[..., half:], cols)], axis=-1).astype(x.dtype)


def window_attention(q, k, v, k_ctx, v_ctx, sink):
    b, L, H, d = q.shape
    G = k.shape[2]
    rep = H // G
    blk = WA_BLOCK
    nb = L // blk
    Lc = k_ctx.shape[1]
    scale = d ** -0.5
    qb = q.reshape(b, nb, blk, G, rep, d)

    def band(t):
        tp = jnp.pad(t, ((0, 0), (blk, blk), (0, 0), (0, 0))).reshape(b, nb + 2, blk, G, d)
        return jnp.concatenate([tp[:, 0:nb], tp[:, 1:nb + 1], tp[:, 2:nb + 2]], axis=2)

    kb, vb = band(k), band(v)
    qpos = jnp.arange(nb)[:, None] * blk + jnp.arange(blk)[None, :]
    kpos = (jnp.arange(nb)[:, None] - 1) * blk + jnp.arange(3 * blk)[None, :]
    mask = ((jnp.abs(qpos[:, :, None] - kpos[:, None, :]) <= WA_WINDOW)
            & (kpos[:, None, :] >= 0) & (kpos[:, None, :] < L))
    s_loc = jnp.einsum('bnqgrd,bnkgd->bngrqk', qb, kb).astype(F32) * scale
    s_loc = jnp.where(mask[None, :, None, None], s_loc, -jnp.inf)
    s_ctx = jnp.einsum('bnqgrd,bcgd->bngrqc', qb, k_ctx).astype(F32) * scale
    s_sink = jnp.broadcast_to(sink.astype(F32).reshape(G, rep)[None, None, :, :, None, None],
                              s_loc.shape[:-1] + (1,))
    p = jax.nn.softmax(jnp.concatenate([s_loc, s_ctx, s_sink], axis=-1), axis=-1).astype(v.dtype)
    nk = 3 * blk
    o = (jnp.einsum('bngrqk,bnkgd->bnqgrd', p[..., :nk], vb)
         + jnp.einsum('bngrqc,bcgd->bnqgrd', p[..., nk:nk + Lc], v_ctx))
    return o.reshape(b, L, H * d)


def context_attention(q, k, v, sink):
    b, Lc, H, d = q.shape
    G = k.shape[2]
    rep = H // G
    qg = q.reshape(b, Lc, G, rep, d)
    s = jnp.einsum('bqgrd,bkgd->bgrqk', qg, k).astype(F32) * d ** -0.5
    if sink is not None:
        s_sink = jnp.broadcast_to(sink.astype(F32).reshape(G, rep)[None, :, :, None, None], s.shape[:-1] + (1,))
        s = jnp.concatenate([s, s_sink], axis=-1)
    p = jax.nn.softmax(s, axis=-1)[..., :Lc].astype(v.dtype)
    o = jnp.einsum('bgrqk,bkgd->bqgrd', p, v)
    return o.reshape(b, Lc, H * d)


def neighbourhood_attention(q, k, v, k_ctx, v_ctx, rpb, grid_rows):
    b, L, H, d = q.shape
    kh = min(NA_MAX_KH, grid_rows)
    ncb = GRID_W // NA_QBW
    scale = d ** -0.5
    r = jnp.arange(grid_rows)
    row_idx = jnp.clip(r - kh // 2, 0, grid_rows - kh)[:, None] + jnp.arange(kh)[None, :]
    cb = jnp.arange(ncb)
    col_idx = jnp.clip(cb * NA_QBW - NA_KW // 2, 0, GRID_W - NA_KBW)[:, None] + jnp.arange(NA_KBW)[None, :]
    qcol = cb[:, None] * NA_QBW + jnp.arange(NA_QBW)[None, :]
    cstart = jnp.clip(qcol - NA_KW // 2, 0, GRID_W - NA_KW)
    cmask = (col_idx[:, None, :] >= cstart[:, :, None]) & (col_idx[:, None, :] < cstart[:, :, None] + NA_KW)
    dy = row_idx - r[:, None] + (NA_MAX_KH - 1)
    dx = jnp.clip(col_idx[:, None, :] - qcol[:, :, None], -(NA_KW - 1), NA_KW - 1) + (NA_KW - 1)
    bias = rpb.astype(F32)[:, dy[:, None, None, :, None], dx[None, :, :, None, :]]
    bias = jnp.moveaxis(bias, 0, 2)
    qg = q.reshape(b, grid_rows, ncb, NA_QBW, H, d)
    kg = k.reshape(b, grid_rows, GRID_W, H, d)
    vg = v.reshape(b, grid_rows, GRID_W, H, d)
    ri = row_idx[:, None, :, None]
    ci = col_idx[None, :, None, :]
    kwin = kg[:, ri, ci]
    vwin = vg[:, ri, ci]
    s = jnp.einsum('brcqhd,brcyxhd->brchqyx', qg, kwin).astype(F32) * scale + bias[None]
    s = jnp.where(cmask[None, None, :, None, :, None, :], s, -jnp.inf)
    nloc = kh * NA_KBW
    s = s.reshape(b, grid_rows, ncb, H, NA_QBW, nloc)
    s_ctx = jnp.einsum('brcqhd,bkhd->brchqk', qg, k_ctx).astype(F32) * scale
    p = jax.nn.softmax(jnp.concatenate([s, s_ctx], axis=-1), axis=-1).astype(v.dtype)
    p_loc = p[..., :nloc].reshape(b, grid_rows, ncb, H, NA_QBW, kh, NA_KBW)
    o = (jnp.einsum('brchqyx,brcyxhd->brcqhd', p_loc, vwin)
         + jnp.einsum('brchqk,bkhd->brcqhd', p[..., nloc:], v_ctx))
    return o.reshape(b, L, H * d)


def depthwise_conv(x, w, bias):
    k = w.shape[0]
    y = lax.conv_general_dilated(x, w[:, None, :].astype(x.dtype), window_strides=(1,),
                                 padding=[(k // 2, k // 2)], dimension_numbers=('NWC', 'WIO', 'NWC'),
                                 feature_group_count=x.shape[-1])
    return y + bias


def ssm_prepare(xbc_raw, dt_raw, conv_w, conv_b, dt_bias):
    xbc = jax.nn.silu(depthwise_conv(xbc_raw, conv_w, conv_b))
    xs, bm, cm = split_cols(xbc, (SSM_INNER, SSM_GROUPS * SSM_STATE, SSM_GROUPS * SSM_STATE))
    b, L = xs.shape[:2]
    rep = SSM_HEADS // SSM_GROUPS
    xs = xs.reshape(b, L, SSM_HEADS, SSM_HEAD_DIM)
    bm = jnp.repeat(bm.reshape(b, L, SSM_GROUPS, SSM_STATE), rep, axis=2)
    cm = jnp.repeat(cm.reshape(b, L, SSM_GROUPS, SSM_STATE), rep, axis=2)
    dt = jax.nn.softplus(dt_raw.astype(F32) + dt_bias.astype(F32).reshape(2 * SSM_HEADS))
    return xs, bm, cm, dt.reshape(b, L, 2, SSM_HEADS)


def ssd_scan(x, dt, A, Bm, Cm, h0, with_output):
    b, L, H, P = x.shape
    N = Bm.shape[-1]
    Q = SSM_CHUNK
    nc = L // Q
    xc = x.astype(F32).reshape(b, nc, Q, H, P)
    dtc = dt.astype(F32).reshape(b, nc, Q, H)
    bc = Bm.astype(F32).reshape(b, nc, Q, H, N)
    cc = Cm.astype(F32).reshape(b, nc, Q, H, N)
    acum = jnp.cumsum(dtc * A, axis=2)
    decay_to_end = jnp.exp(acum[:, :, -1:, :] - acum)
    states = jnp.einsum('bcjhn,bcjh,bcjhp->bchpn', bc, decay_to_end * dtc, xc)
    chunk_decay = jnp.exp(acum[:, :, -1, :])

    def step(h, inp):
        st, dec = inp
        return h * dec[:, :, None, None] + st, h

    h_final, h_enter = lax.scan(step, h0, (jnp.moveaxis(states, 1, 0), jnp.moveaxis(chunk_decay, 1, 0)))
    if not with_output:
        return h_final
    h_enter = jnp.moveaxis(h_enter, 0, 1)
    seg = acum[:, :, :, None, :] - acum[:, :, None, :, :]
    lower = jnp.tril(jnp.ones((Q, Q), dtype=bool))
    decay_ij = jnp.exp(jnp.where(lower[None, None, :, :, None], seg, -jnp.inf))
    w = jnp.einsum('bcihn,bcjhn->bcijh', cc, bc) * decay_ij * dtc[:, :, None, :, :]
    y = (jnp.einsum('bcijh,bcjhp->bcihp', w, xc)
         + jnp.einsum('bcihn,bchpn->bcihp', cc, h_enter) * jnp.exp(acum)[..., None])
    return y.reshape(b, L, H, P), h_final


def ssd_bidir(xs, bm, cm, dt, A, h0_f, h0_b, with_output):
    rev = lambda t: jnp.flip(t, axis=1)
    fwd = ssd_scan(xs, dt[:, :, 0], A[0], bm, cm, h0_f, with_output)
    bwd = ssd_scan(rev(xs), rev(dt[:, :, 1]), A[1], rev(bm), rev(cm), h0_b, with_output)
    if not with_output:
        return fwd, bwd
    (y_f, h_f), (y_b, h_b) = fwd, bwd
    return y_f + rev(y_b), h_f, h_b


def ssm_output(y, xs, z, d_skip, g):
    b, L = y.shape[:2]
    y = y + d_skip.astype(F32)[:, None] * xs.astype(F32)
    y = y.reshape(b, L, SSM_INNER) * jax.nn.silu(z.astype(F32))
    return rms_norm(y, g).astype(z.dtype)


def swiglu(h, w_in, w_out):
    gate, up = jnp.split(h @ w_in, 2, axis=-1)
    return (jax.nn.silu(gate) * up) @ w_out


def hybrid_layer(xl, xc, sc, scc, rows, cols, grid_rows, w_mod, b_mod, g_mix, w_in, wa_sink, na_rpb,
                 conv_w, conv_b, dt_bias, a_log, d_skip, ssm_g, w_out, g_ffn, w_ffn_in, w_ffn_out, ctx_out):
    D = D_MODEL
    b, L, _ = xl.shape
    Lc = xc.shape[1]
    hd = HEAD_DIM
    mod_l = sc @ w_mod + b_mod
    sh1, sc1, gt1, sh2, sc2, gt2 = [m[:, None, :] for m in jnp.split(mod_l, 6, axis=-1)]
    n_ctx_mod = 6 if ctx_out else 2
    mods_c = jnp.split(scc @ w_mod[:, :n_ctx_mod * D] + b_mod[:n_ctx_mod * D], n_ctx_mod)

    hl = modulate(rms_norm(xl, g_mix), sh1, sc1)
    hc = modulate(rms_norm(xc, g_mix), mods_c[0], mods_c[1])
    kv_sizes = (KA_COLS, KA_COLS, KB_COLS, KB_COLS, XBC_COLS, DT_COLS)
    qa, qb, z, ka, va, kb, vb, xbc, dtr = split_cols(hl @ w_in, (QA_COLS, QB_COLS, Z_COLS) + kv_sizes)
    if ctx_out:
        qa_c, qb_c, z_c, ka_c, va_c, kb_c, vb_c, xbc_c, dtr_c = split_cols(hc @ w_in, (QA_COLS, QB_COLS, Z_COLS) + kv_sizes)
    else:
        ka_c, va_c, kb_c, vb_c, xbc_c, dtr_c = split_cols(hc @ w_in[:, Q_SIDE:], kv_sizes)

    ka_c = ka_c.reshape(b, Lc, WA_KV_HEADS, hd)
    va_c = va_c.reshape(b, Lc, WA_KV_HEADS, hd)
    o_a = window_attention(rope_2d(qa.reshape(b, L, WA_HEADS, hd), rows, cols),
                           rope_2d(ka.reshape(b, L, WA_KV_HEADS, hd), rows, cols),
                           va.reshape(b, L, WA_KV_HEADS, hd), ka_c, va_c, wa_sink)
    kb_c = kb_c.reshape(b, Lc, NA_HEADS, hd)
    vb_c = vb_c.reshape(b, Lc, NA_HEADS, hd)
    o_b = neighbourhood_attention(qb.reshape(b, L, NA_HEADS, hd), kb.reshape(b, L, NA_HEADS, hd),
                                  vb.reshape(b, L, NA_HEADS, hd), kb_c, vb_c, na_rpb, grid_rows)
    A = -jnp.exp(a_log.astype(F32))
    xs_c, bm_c, cm_c, dt_c = ssm_prepare(xbc_c, dtr_c, conv_w, conv_b, dt_bias)
    h0 = jnp.zeros((b, SSM_HEADS, SSM_HEAD_DIM, SSM_STATE), F32)
    if ctx_out:
        y_c, h_f, h_b = ssd_bidir(xs_c, bm_c, cm_c, dt_c, A, h0, h0, True)
    else:
        h_f, h_b = ssd_bidir(xs_c, bm_c, cm_c, dt_c, A, h0, h0, False)
    xs, bm, cm, dt = ssm_prepare(xbc, dtr, conv_w, conv_b, dt_bias)
    y_l, _, _ = ssd_bidir(xs, bm, cm, dt, A, h_f, h_b, True)
    o_c = ssm_output(y_l, xs, z, d_skip, ssm_g)

    mix = jnp.concatenate([o_a, o_b, o_c.astype(o_a.dtype)], axis=-1) @ w_out
    xl = xl + gt1 * mix
    xl = xl + gt2 * swiglu(modulate(rms_norm(xl, g_ffn), sh2, sc2), w_ffn_in, w_ffn_out)
    if not ctx_out:
        return xl, None

    o_ac = context_attention(qa_c.reshape(b, Lc, WA_HEADS, hd), ka_c, va_c, wa_sink)
    o_bc = context_attention(qb_c.reshape(b, Lc, NA_HEADS, hd), kb_c, vb_c, None)
    o_cc = ssm_output(y_c, xs_c, z_c, d_skip, ssm_g)
    mix_c = jnp.concatenate([o_ac, o_bc, o_cc.astype(o_ac.dtype)], axis=-1) @ w_out
    xc = xc + mods_c[2] * mix_c
    xc = xc + mods_c[5] * swiglu(modulate(rms_norm(xc, g_ffn), mods_c[3], mods_c[4]), w_ffn_in, w_ffn_out)
    return xl, xc


def setup_inputs(seed: int = 0) -> dict:
    key = jax.random.key(seed)
    ks = jax.random.split(key, 24)
    nrm = jax.random.normal
    D = D_MODEL
    dt0 = jnp.exp(jax.random.uniform(ks[12], (DEPTH, 2, SSM_HEADS), minval=math.log(1e-3), maxval=math.log(0.1)))
    return {
        'x': nrm(ks[0], (BATCH, SEQ, D), F32),
        'c': nrm(ks[1], (BATCH, D), F32),
        'ctx': nrm(ks[2], (BATCH, CTX_LEN, D), F32),
        'c_ctx': nrm(ks[3], (D,), F32),
        'w_mod': nrm(ks[4], (DEPTH, D, 6 * D), F32) * (0.5 * D ** -0.5),
        'b_mod': nrm(ks[5], (DEPTH, 6 * D), F32) * 0.01,
        'g_mix': 1.0 + 0.05 * nrm(ks[6], (DEPTH, D), F32),
        'w_in': nrm(ks[7], (DEPTH, D, IN_COLS), F32) * D ** -0.5,
        'wa_sink': nrm(ks[8], (DEPTH, WA_HEADS), F32) * 0.5,
        'na_rpb': nrm(ks[9], (DEPTH, NA_HEADS, 2 * NA_MAX_KH - 1, 2 * NA_KW - 1), F32) * 0.1,
        'ssm_conv_w': nrm(ks[10], (DEPTH, SSM_CONV, XBC_COLS), F32) * SSM_CONV ** -0.5,
        'ssm_conv_b': nrm(ks[11], (DEPTH, XBC_COLS), F32) * 0.01,
        'ssm_dt_bias': dt0 + jnp.log(-jnp.expm1(-dt0)),
        'ssm_a_log': jnp.log(jax.random.uniform(ks[13], (DEPTH, 2, SSM_HEADS), minval=1.0, maxval=16.0)),
        'ssm_d': 1.0 + 0.1 * nrm(ks[14], (DEPTH, SSM_HEADS), F32),
        'ssm_norm_g': 1.0 + 0.05 * nrm(ks[15], (DEPTH, SSM_INNER), F32),
        'w_out': nrm(ks[16], (DEPTH, MIX_WIDTH, D), F32) * MIX_WIDTH ** -0.5,
        'g_ffn': 1.0 + 0.05 * nrm(ks[17], (DEPTH, D), F32),
        'w_ffn_in': nrm(ks[18], (DEPTH, D, 2 * D_FF), F32) * D ** -0.5,
        'w_ffn_out': nrm(ks[19], (DEPTH, D_FF, D), F32) * D_FF ** -0.5,
        'g_final': 1.0 + 0.05 * nrm(ks[20], (D,), F32),
    }


def reference(x, c, ctx, c_ctx, w_mod, b_mod, g_mix, w_in, wa_sink, na_rpb, ssm_conv_w, ssm_conv_b,
              ssm_dt_bias, ssm_a_log, ssm_d, ssm_norm_g, w_out, g_ffn, w_ffn_in, w_ffn_out, g_final):
    L = x.shape[1]
    grid_rows = L // GRID_W
    t = jnp.arange(L)
    rows, cols = t // GRID_W, t % GRID_W
    sc = jax.nn.silu(c)
    scc = jax.nn.silu(c_ctx)
    xl, xc = x, ctx
    for i in range(DEPTH):
        xl, xc = hybrid_layer(xl, xc, sc, scc, rows, cols, grid_rows, w_mod[i], b_mod[i], g_mix[i], w_in[i],
                              wa_sink[i], na_rpb[i], ssm_conv_w[i], ssm_conv_b[i], ssm_dt_bias[i], ssm_a_log[i],
                              ssm_d[i], ssm_norm_g[i], w_out[i], g_ffn[i], w_ffn_in[i], w_ffn_out[i],
                              ctx_out=(i < DEPTH - 1))
    return rms_norm(xl, g_final)
```

```cpp
#include <hip/hip_runtime.h>
#include <hip/hip_cooperative_groups.h>
#include <cstdio>
#include <cstdint>
namespace cg = cooperative_groups;

#ifndef LAUNCH_PER_PHASE
#define LAUNCH_PER_PHASE 0
#endif

typedef unsigned short bf16_t;
typedef short bf16x8 __attribute__((ext_vector_type(8)));
typedef float f32x4 __attribute__((ext_vector_type(4)));
typedef unsigned u32x4 __attribute__((ext_vector_type(4)));
typedef unsigned u32x2 __attribute__((ext_vector_type(2)));
#define DEVI __device__ __forceinline__

constexpr int T = 16384, TC = 1024, TT = T + TC;
constexpr int PW = 2816;
constexpr int NPH = 20;
constexpr float EPSN = 1e-6f;

constexpr size_t SZ_WIN = (size_t)2944 * 1024 * 2, SZ_WOUT = (size_t)1024 * 1024 * 2, SZ_WFI = (size_t)5632 * 1024 * 2, SZ_WFO = (size_t)1024 * 2816 * 2;
constexpr size_t OFF_WIN = 0;
constexpr size_t OFF_WOUT = OFF_WIN + SZ_WIN;
constexpr size_t OFF_WFI = OFF_WOUT + SZ_WOUT;
constexpr size_t OFF_WFO = OFF_WFI + SZ_WFI;
constexpr size_t OFF_H = OFF_WFO + SZ_WFO;
constexpr size_t OFF_PROJ = OFF_H + (size_t)TT * 1024 * 2;
constexpr size_t OFF_VT = OFF_PROJ + (size_t)TT * PW * 2;
constexpr size_t OFF_DT = OFF_VT + (size_t)384 * TT * 2;
constexpr size_t OFF_XC = OFF_DT + (size_t)TT * 16 * 4;
constexpr size_t OFF_MODS = OFF_XC + (size_t)TC * 1024 * 4;
constexpr size_t SZ_MODS = (size_t)2 * 5 * 6144 * 4;
constexpr size_t OFF_BAR = OFF_MODS + SZ_MODS;
constexpr size_t SZ_BAR = 3456 * 4;
constexpr size_t OFF_SSQ = OFF_BAR + SZ_BAR;
constexpr size_t OFF_ST = OFF_SSQ + (size_t)TT * 4;
constexpr size_t OFF_CD = OFF_ST + (size_t)64 * 34 * 8192 * 2;
constexpr size_t OFF_ROPE = OFF_CD + (size_t)64 * 34 * 4;
constexpr size_t OFF_XN = OFF_ROPE + 2 * 1024 * 4;
constexpr size_t OFF_XTX = OFF_XN + (size_t)TT * 512 * 2;
constexpr size_t OFF_XTB = OFF_XTX + (size_t)512 * TT * 2;
constexpr size_t WS_END = OFF_XTB + (size_t)256 * TT * 2;
static_assert(WS_END <= (size_t)256 * 1024 * 1024, "workspace map exceeds 256 MiB");

struct Params {
  const float *x, *c, *ctx, *c_ctx, *w_mod, *b_mod, *g_mix, *w_in, *wa_sink, *na_rpb, *conv_w, *conv_b, *dt_bias, *a_log, *ssm_d, *ssm_g, *w_out, *g_ffn, *w_ffn_in, *w_ffn_out, *g_final;
  float* out; unsigned char* ws; int ph_lo, ph_hi;
};

constexpr int HSTR = 73728, SMEM_BYTES = 2 * HSTR;
__shared__ __attribute__((aligned(16))) unsigned char smem[SMEM_BYTES];
#define NOINL __device__ __forceinline__

typedef __bf16 bf16x2_t __attribute__((ext_vector_type(2)));
typedef float f32x2_t __attribute__((ext_vector_type(2)));
DEVI unsigned cvt_pk(float lo, float hi) { f32x2_t v = {lo, hi}; bf16x2_t b = __builtin_convertvector(v, bf16x2_t); return __builtin_bit_cast(unsigned, b); }
DEVI float bflo(unsigned u) { return __uint_as_float(u << 16); }
DEVI float bfhi(unsigned u) { return __uint_as_float(u & 0xffff0000u); }
DEVI float bf2f(bf16_t h) { return __uint_as_float((unsigned)h << 16); }
DEVI float silu_f(float v) { return v * __builtin_amdgcn_rcpf(1.f + __expf(-v)); }
DEVI float softplus_f(float v) { const float e = __expf(v); return v > 20.f ? v : (e < 1e-3f ? e * (1.f - 0.5f * e) : __logf(1.f + e)); }
DEVI float wave_sum(float v) {
#pragma unroll
  for (int o = 32; o > 0; o >>= 1) v += __shfl_xor(v, o);
  return v;
}
DEVI float wave_incl_scan(float v, int lane) {
#pragma unroll
  for (int o = 1; o < 64; o <<= 1) { const float u = __shfl_up(v, o); if (lane >= o) v += u; }
  return v;
}
DEVI f32x4 mfma16(bf16x8 a, bf16x8 b, f32x4 c) { return __builtin_amdgcn_mfma_f32_16x16x32_bf16(a, b, c, 0, 0, 0); }
DEVI bf16x8 as_bf16x8(u32x4 v) { union { u32x4 u; bf16x8 b; } x; x.u = v; return x.b; }

DEVI u32x4 scale8(u32x4 v, float s) {
  u32x4 o;
  o.x = cvt_pk(bflo(v.x) * s, bfhi(v.x) * s); o.y = cvt_pk(bflo(v.y) * s, bfhi(v.y) * s);
  o.z = cvt_pk(bflo(v.z) * s, bfhi(v.z) * s); o.w = cvt_pk(bflo(v.w) * s, bfhi(v.w) * s);
  return o;
}
DEVI int tid_opq() { int t; asm volatile("v_mov_b32 %0, %1" : "=v"(t) : "v"((int)(threadIdx.x & 255))); return t; }
DEVI int half_id() { return __builtin_amdgcn_readfirstlane((int)(threadIdx.x >> 8)); }
#define VB (blockIdx.x * 2 + half_id())
#define VG (gridDim.x * 2)
DEVI int ufy(int v) { return __builtin_amdgcn_readfirstlane(v); }

NOINL void prep_phase(const Params& P, int wl, bool full) {
  unsigned char* const smh = smem + half_id() * HSTR;
  float* tile = (float*)smh;
  const int t = tid_opq();
  constexpr int I_IN = 46 * 16, I_OUT = 16 * 16, I_FI = 88 * 16, I_FO = 16 * 44, I_L = I_IN + I_OUT + I_FI + I_FO;
  constexpr int I_MOD = 2 * 16 * 24;
  const int total = I_L + (full ? I_MOD + 1 : 0);
  for (int it = VB; it < total; it += VG) {
    if (it < I_L) {
      const int l = wl; int r = it;
      const float* W; bf16_t* Wt; int K, N, kind, nt_, kt_;
      if (r < I_IN) { kind = 0; W = P.w_in + (size_t)l * 1024 * 2832; N = 2832; K = 1024; Wt = (bf16_t*)(P.ws + OFF_WIN); nt_ = r / 16; kt_ = r % 16; }
      else if (r < I_IN + I_OUT) { r -= I_IN; kind = 1; W = P.w_out + (size_t)l * 1024 * 1024; N = 1024; K = 1024; Wt = (bf16_t*)(P.ws + OFF_WOUT); nt_ = r / 16; kt_ = r % 16; }
      else if (r < I_IN + I_OUT + I_FI) { r -= I_IN + I_OUT; kind = 2; W = P.w_ffn_in + (size_t)l * 1024 * 5632; N = 5632; K = 1024; Wt = (bf16_t*)(P.ws + OFF_WFI); nt_ = r / 16; kt_ = r % 16; }
      else { r -= I_IN + I_OUT + I_FI; kind = 3; W = P.w_ffn_out + (size_t)l * 2816 * 1024; N = 1024; K = 2816; Wt = (bf16_t*)(P.ws + OFF_WFO); nt_ = r / 44; kt_ = r % 44; }
      {
        const int n4 = (t & 15) * 4, np = nt_ * 64 + n4;
        int col;
        if (kind == 0) col = np < 2832 ? np : -1;
        else if (kind == 2) { const int qq = np >> 5, rr = np & 31; col = rr < 16 ? 16 * qq + rr : 2816 + 16 * qq + rr - 16; }
        else col = np;
#pragma unroll
        for (int i = 0; i < 4; ++i) {
          const int kk = i * 16 + (t >> 4);
          f32x4 v = (f32x4){0.f, 0.f, 0.f, 0.f};
          const int ksrc = kind == 1 ? ((kt_ * 64 + kk + 512) & 1023) : (kt_ * 64 + kk);
          if (col >= 0) v = *(const f32x4*)(W + (size_t)ksrc * N + col);
          tile[kk * 65 + n4] = v[0]; tile[kk * 65 + n4 + 1] = v[1]; tile[kk * 65 + n4 + 2] = v[2]; tile[kk * 65 + n4 + 3] = v[3];
        }
      }
      __syncthreads();
      {
        const int n = t >> 2, kc = (t & 3) * 16;
        u32x4 o0, o1;
        o0.x = cvt_pk(tile[(kc + 0) * 65 + n], tile[(kc + 1) * 65 + n]); o0.y = cvt_pk(tile[(kc + 2) * 65 + n], tile[(kc + 3) * 65 + n]);
        o0.z = cvt_pk(tile[(kc + 4) * 65 + n], tile[(kc + 5) * 65 + n]); o0.w = cvt_pk(tile[(kc + 6) * 65 + n], tile[(kc + 7) * 65 + n]);
        o1.x = cvt_pk(tile[(kc + 8) * 65 + n], tile[(kc + 9) * 65 + n]); o1.y = cvt_pk(tile[(kc + 10) * 65 + n], tile[(kc + 11) * 65 + n]);
        o1.z = cvt_pk(tile[(kc + 12) * 65 + n], tile[(kc + 13) * 65 + n]); o1.w = cvt_pk(tile[(kc + 14) * 65 + n], tile[(kc + 15) * 65 + n]);
        bf16_t* dst = Wt + (size_t)(nt_ * 64 + n) * K + kt_ * 64 + kc;
        *(u32x4*)dst = o0; *(u32x4*)(dst + 8) = o1;
      }
      __syncthreads();
    } else if (it < I_L + I_MOD) {
      const int m = it - I_L; const int l = m / 384, rem = m % 384, kc = rem / 24, cb = rem % 24;
      float* sv = (float*)smh;
      for (int e = t; e < 320; e += 256) { const int r = e >> 6, k = kc * 64 + (e & 63); const float v = r < 4 ? P.c[r * 1024 + k] : P.c_ctx[k]; sv[e] = v / (1.f + __expf(-v)); }
      __syncthreads();
      const int n = cb * 256 + t;
      float a0 = 0.f, a1 = 0.f, a2 = 0.f, a3 = 0.f, a4 = 0.f;
      const float* wp = P.w_mod + ((size_t)l * 1024 + kc * 64) * 6144 + n;
#pragma unroll 8
      for (int kk = 0; kk < 64; ++kk) { const float w = wp[(size_t)kk * 6144]; a0 += sv[kk] * w; a1 += sv[64 + kk] * w; a2 += sv[128 + kk] * w; a3 += sv[192 + kk] * w; a4 += sv[256 + kk] * w; }
      if (kc == 0) { const float bb = P.b_mod[l * 6144 + n]; a0 += bb; a1 += bb; a2 += bb; a3 += bb; a4 += bb; }
      float* md = (float*)(P.ws + OFF_MODS) + (size_t)l * 5 * 6144 + n;
      atomicAdd(md, a0); atomicAdd(md + 6144, a1); atomicAdd(md + 2 * 6144, a2); atomicAdd(md + 3 * 6144, a3); atomicAdd(md + 4 * 6144, a4);
      __syncthreads();
    } else {
      float* rc = (float*)(P.ws + OFF_ROPE);
      for (int e = t; e < 1024; e += 256) { const int pos = e >> 4, i = e & 15; const float inv = __builtin_amdgcn_exp2f(-(float)i * (13.287712379549449f / 16.f)); float xr = (float)pos * inv * 0.15915494309189535f; xr -= floorf(xr); rc[e] = __builtin_amdgcn_cosf(xr); rc[1024 + e] = __builtin_amdgcn_sinf(xr); }
    }
  }
}

NOINL void norm_phase(const Params& P, int layer, int which) {
  const float* src_lat = (layer == 0 && which == 0) ? P.x : P.out; const float* src_ctx = (layer == 0 && which == 0) ? P.ctx : (const float*)(P.ws + OFF_XC);
  const int M = (which == 0 || layer == 0) ? TT : T;
  const int t_ = tid_opq(); const int lane = t_ & 63, wv = t_ >> 6;
  const int gw = VB * 4 + wv, nw = VG * 4;
  const float* g = (which == 0 ? P.g_mix : P.g_ffn) + layer * 1024;
  bf16_t* H = (bf16_t*)(P.ws + OFF_H);
  float* ssq = (float*)(P.ws + OFF_SSQ);
  for (int row = gw; row < M; row += nw) {
    const float* xr = row < T ? src_lat + (size_t)row * 1024 : src_ctx + (size_t)(row - T) * 1024;
    const int mr = row < T ? (row >> 12) : 4;
    const float* md = (const float*)(P.ws + OFF_MODS) + (size_t)(layer * 5 + mr) * 6144 + which * 3072;
    f32x4 v[4]; float s = 0.f;
#pragma unroll
    for (int j = 0; j < 4; ++j) { v[j] = *(const f32x4*)(xr + 4 * (lane + 64 * j)); s += v[j][0] * v[j][0] + v[j][1] * v[j][1] + v[j][2] * v[j][2] + v[j][3] * v[j][3]; }
    s = wave_sum(s);
    const float rstd = rsqrtf(s * (1.f / 1024.f) + EPSN);
#pragma unroll
    for (int j = 0; j < 4; ++j) {
      const int k = 4 * (lane + 64 * j);
      const f32x4 gg = *(const f32x4*)(g + k), sh = *(const f32x4*)(md + k), sc = *(const f32x4*)(md + 1024 + k);
      f32x4 h;
#pragma unroll
      for (int e = 0; e < 4; ++e) h[e] = v[j][e] * rstd * gg[e] * (1.f + sc[e]) + sh[e];
      u32x2 o; o.x = cvt_pk(h[0], h[1]); o.y = cvt_pk(h[2], h[3]);
      *(u32x2*)(H + (size_t)row * 1024 + k) = o;
    }
    if (which == 0 && lane == 0) ssq[row] = 0.f;
  }
}

NOINL void final_norm_phase(const Params& P) {
  const int t_ = tid_opq(); const int lane = t_ & 63, wv = t_ >> 6;
  const int gw = VB * 4 + wv, nw = VG * 4;
  for (int row = gw; row < T; row += nw) {
    float* xr = P.out + (size_t)row * 1024;
    f32x4 v[4]; float s = 0.f;
#pragma unroll
    for (int j = 0; j < 4; ++j) { v[j] = *(const f32x4*)(xr + 4 * (lane + 64 * j)); s += v[j][0] * v[j][0] + v[j][1] * v[j][1] + v[j][2] * v[j][2] + v[j][3] * v[j][3]; }
    s = wave_sum(s);
    const float rstd = rsqrtf(s * (1.f / 1024.f) + EPSN);
#pragma unroll
    for (int j = 0; j < 4; ++j) {
      const int k = 4 * (lane + 64 * j);
      const f32x4 gg = *(const f32x4*)(P.g_final + k);
      f32x4 h;
#pragma unroll
      for (int e = 0; e < 4; ++e) h[e] = v[j][e] * rstd * gg[e];
      *(f32x4*)(xr + k) = h;
    }
  }
}

namespace pg8 {
#define PG8_LAS __attribute__((address_space(3)))
typedef unsigned short bf16_t;
typedef short bf16x8 __attribute__((ext_vector_type(8)));
typedef float f32x4 __attribute__((ext_vector_type(4)));
typedef unsigned u32x4 __attribute__((ext_vector_type(4)));
constexpr int BM = 256, BK = 64, HALF = 128, HTB = HALF * BK * 2  , STAGE_BYTES = 8 * HTB, NXCD = 8, WGM = 8;

__host__ __device__ __forceinline__ int lds_byte(int r, int c) { const int st = (r >> 4) * 2 + (c >> 5), rr = r & 15, cc = c & 31, ob = rr * 64 + cc * 2; return st * 1024 + (ob ^ (((ob >> 9) & 1) << 5)); }
__host__ __device__ __forceinline__ void stage_rc(int b, int& R, int& C) { const int st = b / 1024, sb = b % 1024, swz = sb ^ (((sb >> 9) & 1) << 5); R = (st >> 1) * 16 + swz / 64; C = (st & 1) * 32 + (swz % 64) / 2; }
__host__ __device__ __forceinline__ int perm32(int rho) { const int n = rho >> 4, i = rho & 15; return 8 * (i >> 2) + 4 * n + (i & 3); }

struct Unit { int pm, pn; };
struct Gemm { const bf16_t* A; const bf16_t* Bt; int M, N, K; };

struct StaticOrder {
    int nM, nN, nwg, G, c;
    __host__ __device__ void init(int M, int N, int G_, int c_) { nM = M / BM; nN = N / BM; nwg = nM * nN; G = G_; c = c_; }
    __host__ __device__ bool next(int i, Unit& u) const {
        const long L = (long)i * G + c; if (L >= nwg) return false;
        int wgid = (int)L; { const int q = nwg / NXCD, r = nwg % NXCD, xcd = wgid % NXCD, off = wgid / NXCD; wgid = (xcd < r ? xcd * (q + 1) : r * (q + 1) + (xcd - r) * q) + off; }
        const int nig = WGM * nN, gid = wgid / nig, fm = gid * WGM, gsz = (nM - fm) < WGM ? (nM - fm) : WGM;
        u.pm = fm + ((wgid % nig) % gsz); u.pn = (wgid % nig) / gsz; return true;
    }
    __device__ __forceinline__ void a_ready(const Unit&) const {}
    __device__ __forceinline__ void done(const Unit&) const {}
};

template <class Epi, class Sched, bool ALIGN_EPI = false, bool SP2 = false>
__device__ __forceinline__ void gemm_phase(PG8_LAS unsigned char* lds, const Gemm g, const Sched& S, const Epi& E) {
    int tid_; asm volatile("v_mov_b32 %0, %1" : "=v"(tid_) : "v"((int)threadIdx.x)); const int tid = tid_, wid = __builtin_amdgcn_readfirstlane(tid >> 6), lane = tid & 63, wr = wid >> 2, wc = wid & 3, fr = lane & 15, fq = lane >> 4;
    const int K = g.K, nt = K / BK;
    unsigned voffA[2], voffB[2];
#pragma unroll
    for (int i = 0; i < 2; ++i) { int R, C; stage_rc(tid * 16 + i * 8192, R, C); const int Rb = Epi::PERM ? ((R & ~31) + perm32(R & 31)) : R;
        voffA[i] = (unsigned)(R * K + C) * 2u; voffB[i] = (unsigned)(Rb * K + C) * 2u; }
    const size_t kstep = (size_t)(BK * 2);
    const size_t hstep = (size_t)HALF * K * 2;
    const size_t tstep = 2 * hstep;
    const unsigned ldsw = (unsigned)wid * 1024u;
    const int aoff = lds_byte(wr * 64 + fr, fq * 8), boff = lds_byte(wc * 32 + fr, fq * 8);
#define PG8_SA(b, h) (((b) * 2 + (h)) * HTB)
#define PG8_SB(b, h) ((4 + (b) * 2 + (h)) * HTB)
#define PG8_STAGE(bufoff, gbase, voff) do { _Pragma("unroll") for (int _i = 0; _i < 2; ++_i) \
        __builtin_amdgcn_global_load_lds((const unsigned*)((const char*)(gbase) + (voff)[_i]), (PG8_LAS unsigned*)(lds + (bufoff) + ldsw + _i * 8192), 16, 0, 0); } while (0)
#define PG8_LDA(dst, b, h) do { _Pragma("unroll") for (int m = 0; m < 4; ++m) _Pragma("unroll") for (int k = 0; k < 2; ++k) dst[m][k] = *(const PG8_LAS bf16x8*)(lds + PG8_SA(b, h) + aoff + m * 2048 + k * 1024); } while (0)
#define PG8_LDB(dst, b, h) do { _Pragma("unroll") for (int n = 0; n < 2; ++n) _Pragma("unroll") for (int k = 0; k < 2; ++k) dst[n][k] = *(const PG8_LAS bf16x8*)(lds + PG8_SB(b, h) + boff + n * 2048 + k * 1024); } while (0)
#define PG8_MMA(ai, bj, At, Bt) do { __builtin_amdgcn_s_setprio(1); _Pragma("unroll") for (int m = 0; m < 4; ++m) _Pragma("unroll") for (int n = 0; n < 2; ++n) _Pragma("unroll") for (int k = 0; k < 2; ++k) \
        acc[ai][bj][m][n] = __builtin_amdgcn_mfma_f32_16x16x32_bf16(Bt[n][k], At[m][k], acc[ai][bj][m][n], 0, 0, 0); __builtin_amdgcn_s_setprio(0); } while (0)
#define PG8_WAIT_V(n) asm volatile("s_waitcnt vmcnt(" #n ")" ::: "memory")
#define PG8_WAIT_L(n) asm volatile("s_waitcnt lgkmcnt(" #n ")" ::: "memory")
#define PG8_BAR __builtin_amdgcn_s_barrier()
#define PG8_SCHED __builtin_amdgcn_sched_barrier(0)
    Unit cur, nxt; int ui = 0;
    if (!S.next(0, cur)) return;
    f32x4 acc[2][2][4][2];
#pragma unroll
    for (int a = 0; a < 2; ++a)
#pragma unroll
        for (int b = 0; b < 2; ++b)
#pragma unroll
            for (int m = 0; m < 4; ++m)
#pragma unroll
                for (int n = 0; n < 2; ++n) acc[a][b][m][n] = (f32x4){0.f, 0.f, 0.f, 0.f};
    bf16x8 At[4][2], B0[2][2], B1[2][2];
    const char* cA = (const char*)g.A + (size_t)cur.pm * tstep; const char* cB = (const char*)g.Bt + (size_t)cur.pn * tstep;
    S.a_ready(cur);
    if constexpr (SP2) {
        PG8_STAGE(PG8_SB(0, 0), cB, voffB); PG8_STAGE(PG8_SB(0, 1), cB + hstep, voffB); PG8_STAGE(PG8_SA(0, 0), cA, voffA); PG8_STAGE(PG8_SA(0, 1), cA + hstep, voffA);
        if (wr == 1) PG8_BAR;
        PG8_WAIT_V(2); PG8_BAR;
        PG8_STAGE(PG8_SB(1, 0), cB + kstep, voffB); PG8_STAGE(PG8_SA(1, 0), cA + kstep, voffA); PG8_STAGE(PG8_SB(1, 1), cB + hstep + kstep, voffB);
        PG8_WAIT_V(6); PG8_BAR;
    } else {
        PG8_STAGE(PG8_SB(0, 0), cB, voffB); PG8_STAGE(PG8_SA(0, 0), cA, voffA); PG8_STAGE(PG8_SB(0, 1), cB + hstep, voffB); PG8_STAGE(PG8_SA(0, 1), cA + hstep, voffA);
        if (wr == 1) PG8_BAR;
        PG8_WAIT_V(4); PG8_BAR;
        PG8_STAGE(PG8_SB(1, 0), cB + kstep, voffB); PG8_STAGE(PG8_SA(1, 0), cA + kstep, voffA); PG8_STAGE(PG8_SB(1, 1), cB + hstep + kstep, voffB);
        PG8_WAIT_V(6); PG8_BAR;
    }
    for (;;) {
        const bool has_next = S.next(ui + 1, nxt);
        const char* nA = has_next ? (const char*)g.A + (size_t)nxt.pm * tstep : cA; const char* nB = has_next ? (const char*)g.Bt + (size_t)nxt.pn * tstep : cB;
        for (int t = 0; t < nt; t += 2) {
            if constexpr (Epi::MIDSCALE) { if (t == 8) E.midscale(acc, cur, wr, fr); }
            const bool last = (t == nt - 2);
            const char* a1 = cA + (size_t)(t + 1) * kstep;
            const char* a2 = last ? nA : cA + (size_t)(t + 2) * kstep; const char* b2 = last ? nB : cB + (size_t)(t + 2) * kstep;
            const char* a3 = a2 + kstep; const char* b3 = b2 + kstep;
            if (last && has_next) S.a_ready(nxt);
            if constexpr (SP2) {
            PG8_LDB(B0, 0, 0); PG8_LDB(B1, 0, 1); PG8_SCHED; PG8_LDA(At, 0, 0); PG8_STAGE(PG8_SA(1, 1), a1 + hstep, voffA);
            PG8_WAIT_V(8); PG8_WAIT_L(0); PG8_BAR; PG8_MMA(0, 0, At, B0); PG8_MMA(0, 1, At, B1); PG8_BAR; PG8_SCHED;
            PG8_LDA(At, 0, 1); PG8_STAGE(PG8_SB(0, 0), b2, voffB); PG8_STAGE(PG8_SB(0, 1), b2 + hstep, voffB); PG8_STAGE(PG8_SA(0, 0), a2, voffA);
            PG8_WAIT_V(8); PG8_WAIT_L(0); PG8_BAR; PG8_MMA(1, 0, At, B0); PG8_MMA(1, 1, At, B1); PG8_BAR; PG8_SCHED;
            PG8_LDB(B0, 1, 0); PG8_LDB(B1, 1, 1); PG8_SCHED; PG8_LDA(At, 1, 0); PG8_STAGE(PG8_SA(0, 1), a2 + hstep, voffA);
            PG8_WAIT_V(8); PG8_WAIT_L(0); PG8_BAR; PG8_MMA(0, 0, At, B0); PG8_MMA(0, 1, At, B1); PG8_BAR; PG8_SCHED;
            PG8_LDA(At, 1, 1); PG8_STAGE(PG8_SB(1, 0), b3, voffB); PG8_STAGE(PG8_SB(1, 1), b3 + hstep, voffB); PG8_STAGE(PG8_SA(1, 0), a3, voffA);
            PG8_WAIT_V(8); PG8_WAIT_L(0); PG8_BAR; PG8_MMA(1, 0, At, B0); PG8_MMA(1, 1, At, B1); PG8_BAR; PG8_SCHED;
            } else {
            PG8_LDB(B0, 0, 0); PG8_SCHED; PG8_LDA(At, 0, 0); PG8_STAGE(PG8_SA(1, 1), a1 + hstep, voffA);
            PG8_WAIT_L(8); PG8_BAR; PG8_WAIT_L(0); PG8_MMA(0, 0, At, B0); PG8_BAR; PG8_SCHED;
            PG8_LDB(B1, 0, 1); PG8_STAGE(PG8_SB(0, 0), b2, voffB);
            PG8_BAR; PG8_WAIT_L(0); PG8_MMA(0, 1, At, B1); PG8_BAR;
            PG8_LDA(At, 0, 1); PG8_STAGE(PG8_SA(0, 0), a2, voffA);
            PG8_BAR; PG8_WAIT_L(0); PG8_MMA(1, 0, At, B0); PG8_BAR; PG8_SCHED;
            PG8_STAGE(PG8_SB(0, 1), b2 + hstep, voffB);
            PG8_WAIT_V(6); PG8_BAR; PG8_MMA(1, 1, At, B1); PG8_BAR;
            PG8_LDB(B0, 1, 0); PG8_SCHED; PG8_LDA(At, 1, 0); PG8_STAGE(PG8_SA(0, 1), a2 + hstep, voffA);
            PG8_WAIT_L(8); PG8_BAR; PG8_WAIT_L(0); PG8_MMA(0, 0, At, B0); PG8_BAR; PG8_SCHED;
            PG8_LDB(B1, 1, 1); PG8_STAGE(PG8_SB(1, 0), b3, voffB);
            PG8_BAR; PG8_WAIT_L(0); PG8_MMA(0, 1, At, B1); PG8_BAR;
            PG8_LDA(At, 1, 1); PG8_STAGE(PG8_SA(1, 0), a3, voffA);
            PG8_BAR; PG8_WAIT_L(0); PG8_MMA(1, 0, At, B0); PG8_BAR; PG8_SCHED;
            PG8_STAGE(PG8_SB(1, 1), b3 + hstep, voffB);
            PG8_WAIT_V(6); PG8_BAR; PG8_MMA(1, 1, At, B1); PG8_BAR;
            }
        }
        if constexpr (ALIGN_EPI) { if (wr == 0) PG8_BAR; }
        if constexpr (!Epi::AFTER_DRAIN) { E(acc, cur, wr, wc, fr, fq); S.done(cur); }
        if (!has_next) break;
#pragma unroll
        for (int a = 0; a < 2; ++a)
#pragma unroll
            for (int b = 0; b < 2; ++b)
#pragma unroll
                for (int m = 0; m < 4; ++m)
#pragma unroll
                    for (int n = 0; n < 2; ++n) acc[a][b][m][n] = (f32x4){0.f, 0.f, 0.f, 0.f};
        cur = nxt; cA = nA; cB = nB; ++ui;
        if constexpr (ALIGN_EPI) { if (wr == 1) PG8_BAR; }
    }
    PG8_WAIT_V(0);
    if constexpr (!ALIGN_EPI) { if (wr == 0) PG8_BAR; }
    PG8_BAR;
    if constexpr (Epi::AFTER_DRAIN) { E.fused(acc, cur, wr, wc, fr, fq, lds, wid, lane); S.done(cur); }
#undef PG8_SA
#undef PG8_SB
#undef PG8_STAGE
#undef PG8_LDA
#undef PG8_LDB
#undef PG8_MMA
#undef PG8_WAIT_V
#undef PG8_WAIT_L
#undef PG8_BAR
#undef PG8_SCHED
}
}

struct EpiInProj {
  static constexpr bool PERM = false, AFTER_DRAIN = false, MIDSCALE = false;
  unsigned char* ws;
  DEVI void operator()(const f32x4 (&acc)[2][2][4][2], const pg8::Unit& u, int wr, int wc, int fr, int fq) const {
    bf16_t* PROJ = (bf16_t*)(ws + OFF_PROJ); bf16_t* VT = (bf16_t*)(ws + OFF_VT); const float* rc = (const float*)(ws + OFF_ROPE);
    const int rowb = u.pm * 256 + wr * 64 + fr;
#pragma unroll
    for (int bj = 0; bj < 2; ++bj) {
      const int cb = u.pn * 256 + bj * 128;
      const bool isv = (cb == 1152) || (cb == 1536) || (cb == 1664);
      const bool do_rope = (cb < 256) || (cb == 1024);
      const float qs = cb < 512 ? 0.125f : 1.f;
      const int vchb = (cb == 1152 ? 0 : 128 + (cb - 1536)) + 32 * wc + 4 * fq;
#pragma unroll
      for (int ai = 0; ai < 2; ++ai)
#pragma unroll
        for (int m = 0; m < 4; ++m) {
          const int row = rowb + 128 * ai + 16 * m;
          f32x4 v0 = acc[ai][bj][m][0], v1 = acc[ai][bj][m][1];
          if (isv) {
#pragma unroll
            for (int e = 0; e < 4; ++e) { VT[(unsigned)((vchb + e) * TT + row)] = (bf16_t)(cvt_pk(v0[e], 0.f) & 0xffffu); VT[(unsigned)((vchb + 16 + e) * TT + row)] = (bf16_t)(cvt_pk(v1[e], 0.f) & 0xffffu); }
          } else {
            if (do_rope && row < T) {
              const int pos = row & 4095, pp = (wc & 1) ? (pos & 63) : (pos >> 6);
              const f32x4 cs = *(const f32x4*)(rc + pp * 16 + 4 * fq), sn = *(const f32x4*)(rc + 1024 + pp * 16 + 4 * fq);
#pragma unroll
              for (int e = 0; e < 4; ++e) { const float x1 = v0[e], x2 = v1[e]; v0[e] = x1 * cs[e] - x2 * sn[e]; v1[e] = x2 * cs[e] + x1 * sn[e]; }
            }
            u32x2 o0, o1; o0.x = cvt_pk(v0[0] * qs, v0[1] * qs); o0.y = cvt_pk(v0[2] * qs, v0[3] * qs); o1.x = cvt_pk(v1[0] * qs, v1[1] * qs); o1.y = cvt_pk(v1[2] * qs, v1[3] * qs);
            bf16_t* dst = PROJ + (unsigned)(row * PW + cb + 32 * wc + 4 * fq);
            *(u32x2*)dst = o0; *(u32x2*)(dst + 16) = o1;
          }
        }
    }
  }
};
struct EpiSwiglu {
  static constexpr bool PERM = false, AFTER_DRAIN = false, MIDSCALE = false;
  unsigned char* ws;
  DEVI void operator()(const f32x4 (&acc)[2][2][4][2], const pg8::Unit& u, int wr, int wc, int fr, int fq) const {
    bf16_t* G = (bf16_t*)(ws + OFF_PROJ);
    const int rowb = u.pm * 256 + wr * 64 + fr;
#pragma unroll
    for (int bj = 0; bj < 2; ++bj)
#pragma unroll
      for (int ai = 0; ai < 2; ++ai)
#pragma unroll
        for (int m = 0; m < 4; ++m) {
          const int row = rowb + 128 * ai + 16 * m;
          float o[4];
#pragma unroll
          for (int e = 0; e < 4; ++e) o[e] = silu_f(acc[ai][bj][m][0][e]) * acc[ai][bj][m][1][e];
          u32x2 ov; ov.x = cvt_pk(o[0], o[1]); ov.y = cvt_pk(o[2], o[3]);
          *(u32x2*)(G + (unsigned)(row * 2816 + u.pn * 128 + bj * 64 + wc * 16 + 4 * fq)) = ov;
        }
  }
};
template <bool MID>
struct EpiResid {
  static constexpr bool PERM = false, AFTER_DRAIN = false, MIDSCALE = MID;
  unsigned char* ws; const float* rin_lat; const float* rin_ctx; float* rout_lat; float* rout_ctx; int layer, gate_idx;
  DEVI void midscale(f32x4 (&acc)[2][2][4][2], const pg8::Unit& u, int wr, int fr) const {
    const float* ssq = (const float*)(ws + OFF_SSQ) + u.pm * 256 + wr * 64 + fr;
#pragma unroll
    for (int ai = 0; ai < 2; ++ai)
#pragma unroll
      for (int m = 0; m < 4; ++m) {
        const float rs = rsqrtf(ssq[128 * ai + 16 * m] * (1.f / 512.f) + EPSN);
#pragma unroll
        for (int bj = 0; bj < 2; ++bj) { acc[ai][bj][m][0] = acc[ai][bj][m][0] * rs; acc[ai][bj][m][1] = acc[ai][bj][m][1] * rs; }
      }
  }
  DEVI void operator()(const f32x4 (&acc)[2][2][4][2], const pg8::Unit& u, int wr, int wc, int fr, int fq) const {
    const bool lat = u.pm < T / 256;
    const int mr = lat ? (u.pm >> 4) : 4;
    const float* gpb = (const float*)(ws + OFF_MODS) + (size_t)(layer * 5 + mr) * 6144 + gate_idx * 1024;
    const float* rinb = lat ? rin_lat : rin_ctx; float* routb = lat ? rout_lat : rout_ctx;
    const int col0 = u.pn * 256 + wc * 32 + 4 * fq;
    const unsigned off0 = (unsigned)(((lat ? u.pm : u.pm - T / 256) * 256 + wr * 64 + fr) * 1024 + col0);
#pragma unroll
    for (int bj = 0; bj < 2; ++bj)
#pragma unroll
      for (int n = 0; n < 2; ++n) {
        const f32x4 gv = *(const f32x4*)(gpb + col0 + 128 * bj + 16 * n);
#pragma unroll
        for (int ai = 0; ai < 2; ++ai)
#pragma unroll
          for (int m = 0; m < 4; ++m) {
            const unsigned off = off0 + (unsigned)((128 * ai + 16 * m) * 1024 + 128 * bj + 16 * n);
            const f32x4 rv = *(const f32x4*)(rinb + off);
            f32x4 o;
#pragma unroll
            for (int e = 0; e < 4; ++e) o[e] = rv[e] + gv[e] * acc[ai][bj][m][n][e];
            *(f32x4*)(routb + off) = o;
          }
      }
  }
};
constexpr int MODE_INPROJ = 0, MODE_RESID = 1, MODE_SWIGLU = 2;
template <int MODE, bool ASCALE>
DEVI void gemm_phase(const Params& P, int layer) {
  constexpr int K = (MODE == MODE_RESID && !ASCALE) ? 2816 : 1024;
  constexpr int N = MODE == MODE_INPROJ ? 2816 : (MODE == MODE_SWIGLU ? 5632 : 1024);
  const int M = (MODE == MODE_INPROJ || layer == 0) ? TT : T;
  const bf16_t* A = (const bf16_t*)(P.ws + ((MODE == MODE_RESID && !ASCALE) ? OFF_PROJ : OFF_H));
  const bf16_t* Wt = (const bf16_t*)(P.ws + (MODE == MODE_INPROJ ? OFF_WIN : MODE == MODE_SWIGLU ? OFF_WFI : ASCALE ? OFF_WOUT : OFF_WFO));
  pg8::Gemm g{A, Wt, M, N, K}; pg8::StaticOrder S; S.init(M, N, (int)gridDim.x, (int)blockIdx.x);
  PG8_LAS unsigned char* lds = (PG8_LAS unsigned char*)smem;
  if constexpr (MODE == MODE_INPROJ) {
    EpiInProj E{P.ws};
    pg8::gemm_phase<EpiInProj, pg8::StaticOrder, true, true>(lds, g, S, E);
    const int lane = threadIdx.x & 63, r = lane & 15, q = lane >> 4;
    const bf16_t* Wd = Wt + (size_t)(2816 + r) * 1024 + 8 * q;
    float* DTb = (float*)(P.ws + OFF_DT);
    for (int tile = blockIdx.x * 8 + (threadIdx.x >> 6); tile < TT / 16; tile += gridDim.x * 8) {
      const bf16_t* Ar = A + (size_t)(16 * tile + r) * 1024 + 8 * q;
      f32x4 acc = (f32x4){0.f, 0.f, 0.f, 0.f};
#pragma unroll 8
      for (int s2 = 0; s2 < 32; ++s2) acc = mfma16(*(const bf16x8*)(Ar + 32 * s2), *(const bf16x8*)(Wd + 32 * s2), acc);
#pragma unroll
      for (int e = 0; e < 4; ++e) DTb[(size_t)(16 * tile + 4 * q + e) * 16 + r] = acc[e];
    }
  } else if constexpr (MODE == MODE_SWIGLU) {
    EpiSwiglu E{P.ws};
    pg8::gemm_phase<EpiSwiglu, pg8::StaticOrder, true, true>(lds, g, S, E);
  } else {
    float* XCp = (float*)(P.ws + OFF_XC);
    EpiResid<ASCALE> E{P.ws, (ASCALE && layer == 0) ? P.x : P.out, (ASCALE && layer == 0) ? P.ctx : XCp, P.out, XCp, layer, ASCALE ? 2 : 5};
    pg8::gemm_phase<EpiResid<ASCALE>, pg8::StaticOrder, true, true>(lds, g, S, E);
  }
}

template <int KIND>
NOINL void attn_item(const Params& P, int layer, int b, int i1, int i2, int isctx_) {
  unsigned char* const smh = smem + half_id() * HSTR;
  const bool isctx = isctx_ != 0;
  constexpr int NQT = (KIND == 1) ? 1 : 2;
  const int t = tid_opq(), lane = t & 63, w = t >> 6, r = lane & 15, q = lane >> 4, r7 = r & 7;
  const bf16_t* PROJ = (const bf16_t*)(P.ws + OFF_PROJ);
  const bf16_t* VT = (const bf16_t*)(P.ws + OFF_VT);
  bf16_t* MIX = (bf16_t*)(P.ws + OFF_H);
  constexpr bool DBL = (KIND == 1);
  constexpr int VSTR = DBL ? 272 : 136;
  constexpr int VOFF = DBL ? 16384 : 8192, BUFSZ = DBL ? 33792 : 16896;
  float* rpb = (float*)(smh + 2 * BUFSZ);
  const int col0 = w == 0 ? 0 : (w == 1 ? 8 : (w == 2 ? 24 : 32));
  int qrow[NQT]; int qcol, kcol, vch, ocol, ntile; bool has_sink = false; float sinkv = 0.f;
  int r0g = 0;
  if (KIND == 0 && !isctx) {
    const int n = i1, head = i2;
#pragma unroll
    for (int qt = 0; qt < NQT; ++qt) qrow[qt] = b * 4096 + 128 * n + 32 * w + 16 * qt + r;
    qcol = head * 64; kcol = 1024 + (head >> 1) * 64; vch = (head >> 1) * 64; ocol = 512 + head * 64; ntile = 10; has_sink = true; sinkv = P.wa_sink[layer * 4 + head];
  } else if (KIND == 1) {
    const int gr = i1, h = i2;
    qrow[0] = b * 4096 + gr * 64 + 16 * w + r;
    qcol = 256 + 64 * h; kcol = 1280 + 64 * h; vch = 128 + 64 * h; ocol = 768 + 64 * h; ntile = 8;
    r0g = gr - 4 < 0 ? 0 : (gr - 4 > 56 ? 56 : gr - 4);
    __syncthreads();
    for (int e = t; e < 465; e += 256) rpb[e] = P.na_rpb[(size_t)(layer * 4 + h) * 465 + e];
  } else {
    const int qb = i1, hh = i2;
#pragma unroll
    for (int qt = 0; qt < NQT; ++qt) qrow[qt] = T + b * 256 + 128 * qb + 32 * w + 16 * qt + r;
    ntile = 4;
    if (hh < 4) { qcol = hh * 64; kcol = 1024 + (hh >> 1) * 64; vch = (hh >> 1) * 64; ocol = 512 + hh * 64; has_sink = true; sinkv = P.wa_sink[layer * 4 + hh]; }
    else { const int h = hh - 4; qcol = 256 + 64 * h; kcol = 1280 + 64 * h; vch = 128 + 64 * h; ocol = 768 + 64 * h; }
  }
  bf16x8 qf[NQT][2];
#pragma unroll
  for (int qt = 0; qt < NQT; ++qt)
#pragma unroll
    for (int s = 0; s < 2; ++s) qf[qt][s] = *(const bf16x8*)(PROJ + (size_t)qrow[qt] * PW + qcol + 32 * s + 8 * q);
  f32x4 o[4][NQT]; float mrun[NQT], lrun[NQT];
#pragma unroll
  for (int qt = 0; qt < NQT; ++qt) { mrun[qt] = -1e30f; lrun[qt] = 0.f;
#pragma unroll
    for (int dt = 0; dt < 4; ++dt) o[dt][qt] = (f32x4){0.f, 0.f, 0.f, 0.f}; }

  const int skip = (KIND == 0 && !isctx && i1 == 0) ? 2 : 0;
  const int nvalid = ntile - skip - ((KIND == 0 && !isctx && i1 == 31) ? 2 : 0);
  const int skey = t >> 2, sc0 = (t & 3) * 2;
  u32x4 pk0, pk1, pv0, pv1, pk2, pk3, pv2, pv3;
#define KV_ROW0(IDX, TI, KROW0) const int TI = (IDX) < 4 ? (IDX) : (IDX) + skip; \
    const int KROW0 = TI < 4 ? T + b * 256 + 64 * TI : (KIND == 1 ? b * 4096 + (r0g + 2 * (TI - 4)) * 64 : b * 4096 + 128 * (i1 - 1) + 64 * (TI - 4));
#define KV_LOAD(IDX) { KV_ROW0(IDX, ti_, kr0_) \
    const bf16_t* kp = PROJ + (size_t)(kr0_ + skey) * PW + kcol + sc0 * 8; pk0 = *(const u32x4*)kp; pk1 = *(const u32x4*)(kp + 8); \
    const bf16_t* vp = VT + (size_t)(vch + skey) * TT + kr0_ + sc0 * 8; pv0 = *(const u32x4*)vp; pv1 = *(const u32x4*)(vp + 8); \
    if (DBL && ti_ >= 4) { pk2 = *(const u32x4*)(kp + 64 * PW); pk3 = *(const u32x4*)(kp + 64 * PW + 8); pv2 = *(const u32x4*)(vp + 64); pv3 = *(const u32x4*)(vp + 72); } }
#define KV_STORE(IDX) { KV_ROW0(IDX, tis_, krs_) (void)krs_; unsigned char* Kw = smh + ((IDX) & 1) * BUFSZ; unsigned char* Vw = Kw + VOFF; \
    *(u32x4*)(Kw + skey * 128 + ((sc0 ^ (skey & 7)) << 4)) = pk0; *(u32x4*)(Kw + skey * 128 + (((sc0 + 1) ^ (skey & 7)) << 4)) = pk1; \
    u32x2* dst = (u32x2*)(Vw + skey * VSTR + sc0 * 16); \
    dst[0] = (u32x2){pv0.x, pv0.y}; dst[1] = (u32x2){pv0.z, pv0.w}; dst[2] = (u32x2){pv1.x, pv1.y}; dst[3] = (u32x2){pv1.z, pv1.w}; \
    if (DBL && tis_ >= 4) { \
      *(u32x4*)(Kw + (skey + 64) * 128 + ((sc0 ^ (skey & 7)) << 4)) = pk2; *(u32x4*)(Kw + (skey + 64) * 128 + (((sc0 + 1) ^ (skey & 7)) << 4)) = pk3; \
      u32x2* dst2 = (u32x2*)(Vw + skey * VSTR + 128 + sc0 * 16); \
      dst2[0] = (u32x2){pv2.x, pv2.y}; dst2[1] = (u32x2){pv2.z, pv2.w}; dst2[2] = (u32x2){pv3.x, pv3.y}; dst2[3] = (u32x2){pv3.z, pv3.w}; } }
  __syncthreads();
  KV_LOAD(0);
  KV_STORE(0);
  if (nvalid > 1) KV_LOAD(1);
  __syncthreads();
#pragma unroll 1
  for (int idx = 0; idx < nvalid; ++idx) {
    KV_ROW0(idx, ti, krow0)
    (void)krow0;
    const int kbase = 128 * (i1 - 1) + 64 * (ti - 4); const int kr = r0g + 2 * (ti - 4);
    const bool local2 = DBL && ti >= 4;
    const unsigned char* Ks = smh + (idx & 1) * BUFSZ; const unsigned char* Vs = Ks + VOFF;
    f32x4 sc[4][NQT];
#pragma unroll
    for (int kt = 0; kt < 4; ++kt) {
      const int krow = (local2 ? (kt >> 1) * 64 + col0 + 16 * (kt & 1) : 16 * kt) + r;
      const bf16x8 kf0 = *(const bf16x8*)(Ks + krow * 128 + ((q ^ r7) << 4));
      const bf16x8 kf1 = *(const bf16x8*)(Ks + krow * 128 + (((4 + q) ^ r7) << 4));
#pragma unroll
      for (int qt = 0; qt < NQT; ++qt) { sc[kt][qt] = mfma16(kf0, qf[qt][0], (f32x4){0.f, 0.f, 0.f, 0.f}); sc[kt][qt] = mfma16(kf1, qf[qt][1], sc[kt][qt]); }
    }
    if (ti >= 4) {
      if (KIND == 0) {
#pragma unroll
        for (int qt = 0; qt < NQT; ++qt) { const int qpos = 128 * i1 + 32 * w + 16 * qt + r;
#pragma unroll
          for (int kt = 0; kt < 4; ++kt)
#pragma unroll
            for (int e = 0; e < 4; ++e) { const int d = qpos - (kbase + 16 * kt + 4 * q + e); if (d > 128 || d < -128) sc[kt][qt][e] = -1e30f; } }
      } else if (KIND == 1) {
        const int qc = 16 * w + r; const int cs = qc - 8 < 0 ? 0 : (qc - 8 > 48 ? 48 : qc - 8);
#pragma unroll
        for (int kt = 0; kt < 4; ++kt) {
          const int dy = kr + (kt >> 1) - i1 + 7;
#pragma unroll
          for (int e = 0; e < 4; ++e) { const int kc = col0 + 16 * (kt & 1) + 4 * q + e; const bool ok = (kc >= cs) && (kc < cs + 16);
            int dx = kc - qc + 15; dx = dx < 0 ? 0 : (dx > 30 ? 30 : dx);
            sc[kt][0][e] = ok ? sc[kt][0][e] + rpb[dy * 31 + dx] : -1e30f; }
        }
      }
    }
    bf16x8 pf[2][NQT];
#pragma unroll
    for (int qt = 0; qt < NQT; ++qt) {
      float mx = -1e30f;
#pragma unroll
      for (int kt = 0; kt < 4; ++kt)
#pragma unroll
        for (int e = 0; e < 4; ++e) mx = fmaxf(mx, sc[kt][qt][e]);
      mx = fmaxf(mx, __shfl_xor(mx, 16)); mx = fmaxf(mx, __shfl_xor(mx, 32));
      const float mn = fmaxf(mrun[qt], mx); const float alpha = __expf(mrun[qt] - mn); mrun[qt] = mn;
      float ls = 0.f;
#pragma unroll
      for (int kt = 0; kt < 4; ++kt)
#pragma unroll
        for (int e = 0; e < 4; ++e) { const float p = __expf(sc[kt][qt][e] - mn); sc[kt][qt][e] = p; ls += p; }
      lrun[qt] = lrun[qt] * alpha + ls;
#pragma unroll
      for (int dt = 0; dt < 4; ++dt) o[dt][qt] = o[dt][qt] * alpha;
#pragma unroll
      for (int s = 0; s < 2; ++s) {
        u32x4 pk; pk.x = cvt_pk(sc[2 * s][qt][0], sc[2 * s][qt][1]); pk.y = cvt_pk(sc[2 * s][qt][2], sc[2 * s][qt][3]);
        pk.z = cvt_pk(sc[2 * s + 1][qt][0], sc[2 * s + 1][qt][1]); pk.w = cvt_pk(sc[2 * s + 1][qt][2], sc[2 * s + 1][qt][3]);
        pf[s][qt] = as_bf16x8(pk);
      }
    }
#pragma unroll
    for (int s = 0; s < 2; ++s)
#pragma unroll
      for (int dt = 0; dt < 4; ++dt) {
        const int vkb = local2 ? 64 * s + col0 : 32 * s;
        const u32x2 lo = *(const u32x2*)(Vs + (16 * dt + r) * VSTR + (vkb + 4 * q) * 2);
        const u32x2 hi = *(const u32x2*)(Vs + (16 * dt + r) * VSTR + (vkb + 16 + 4 * q) * 2);
        const bf16x8 vf = as_bf16x8((u32x4){lo.x, lo.y, hi.x, hi.y});
#pragma unroll
        for (int qt = 0; qt < NQT; ++qt) o[dt][qt] = mfma16(vf, pf[s][qt], o[dt][qt]);
      }
    if (idx + 1 < nvalid) KV_STORE(idx + 1);
    __syncthreads();
    if (idx + 2 < nvalid) KV_LOAD(idx + 2);
  }
#pragma unroll
  for (int qt = 0; qt < NQT; ++qt) {
    float l = lrun[qt]; l += __shfl_xor(l, 16); l += __shfl_xor(l, 32);
    float mf = mrun[qt]; float scale;
    if (has_sink) { const float m2 = fmaxf(mf, sinkv); const float a = __expf(mf - m2); l = l * a + __expf(sinkv - m2); scale = a / l; }
    else scale = 1.f / l;
#pragma unroll
    for (int dt = 0; dt < 4; ++dt) {
      u32x2 ov; ov.x = cvt_pk(o[dt][qt][0] * scale, o[dt][qt][1] * scale); ov.y = cvt_pk(o[dt][qt][2] * scale, o[dt][qt][3] * scale);
      *(u32x2*)(MIX + (size_t)qrow[qt] * 1024 + ocol + 16 * dt + 4 * q) = ov;
    }
  }
}

DEVI void ssd_load_raw(unsigned char* raw, const bf16_t* PROJ, int rowbase, int lo, int hi, int col0) {
  for (int e = tid_opq(); e < 134 * 8; e += 256) {
    const int rr = e >> 3, ch = e & 7; const int row = rowbase - 3 + rr;
    u32x4 v = (u32x4){0u, 0u, 0u, 0u};
    if (row >= lo && row < hi) v = *(const u32x4*)(PROJ + (size_t)row * PW + col0 + ch * 8);
    *(u32x4*)(raw + rr * 128 + ch * 16) = v;
  }
}

template <bool TRANSP, bool WEIGHTED>
DEVI void ssd_conv(const unsigned char* raw, const float* cw  , const float* cb, unsigned char* out1, unsigned char* out2, const float* wt1, const float* wt2) {
  const int t_ = tid_opq(); const int c = t_ & 63, tq = t_ >> 6;
  float wj[7];
#pragma unroll
  for (int j = 0; j < 7; ++j) wj[j] = cw[j * 1024 + c];
  const float bias = cb[c];
  const bf16_t* rp = (const bf16_t*)raw + c;
  float w0 = bf2f(rp[(32 * tq + 0) * 64]), w1 = bf2f(rp[(32 * tq + 1) * 64]), w2 = bf2f(rp[(32 * tq + 2) * 64]), w3 = bf2f(rp[(32 * tq + 3) * 64]), w4 = bf2f(rp[(32 * tq + 4) * 64]), w5 = bf2f(rp[(32 * tq + 5) * 64]);
  float hold1[4], hold2[4];
#pragma unroll 1
  for (int tg = 0; tg < 8; ++tg) {
#pragma unroll
    for (int t4 = 0; t4 < 4; ++t4) {
      const int tok = 32 * tq + 4 * tg + t4;
      const float w6 = bf2f(rp[(tok + 6) * 64]);
      float v = bias + wj[0] * w0 + wj[1] * w1 + wj[2] * w2 + wj[3] * w3 + wj[4] * w4 + wj[5] * w5 + wj[6] * w6;
      v = silu_f(v);
      w0 = w1; w1 = w2; w2 = w3; w3 = w4; w4 = w5; w5 = w6;
      if (TRANSP) {
        hold1[t4] = WEIGHTED ? v * wt1[tok] : v;
        if (WEIGHTED) hold2[t4] = v * wt2[tok];
        if (t4 == 3) {
          u32x2 o; o.x = cvt_pk(hold1[0], hold1[1]); o.y = cvt_pk(hold1[2], hold1[3]);
          *(u32x2*)(out1 + c * 272 + (tok - 3) * 2) = o;
          if (WEIGHTED) { u32x2 o2; o2.x = cvt_pk(hold2[0], hold2[1]); o2.y = cvt_pk(hold2[2], hold2[3]); *(u32x2*)(out2 + c * 272 + (tok - 3) * 2) = o2; }
        }
      } else {
        *(bf16_t*)(out1 + tok * 128 + (((c >> 3) ^ (tok & 7)) << 4) + (c & 7) * 2) = (bf16_t)(cvt_pk(v, 0.f) & 0xffffu);
      }
    }
  }
}

constexpr int SM_RAW = 0, SM_X1 = 17152, SM_X2 = 34560, SM_BT = 51968, SM_SMALL = 69376;
constexpr int SM_XT = 17152, SM_BN = 34560, SM_CN = 50944;

NOINL void conv_item(const Params& P, int layer, int b, int cidx, int slab) {
  unsigned char* const smh = smem + half_id() * HSTR;
  const int t = tid_opq(), c = t & 63, tq = t >> 6;
  const bf16_t* PROJ = (const bf16_t*)(P.ws + OFF_PROJ);
  bf16_t* XN = (bf16_t*)(P.ws + OFF_XN);
  int rowbase, lo, hi;
  if (cidx < 2) { lo = T + b * 256; hi = lo + 256; rowbase = lo + cidx * 128; } else { lo = b * 4096; hi = lo + 4096; rowbase = lo + (cidx - 2) * 128; }
  __syncthreads();
  ssd_load_raw(smh + SM_RAW, PROJ, rowbase, lo, hi, 1792 + slab * 64);
  __syncthreads();
  const float* cw = P.conv_w + (size_t)layer * 7 * 1024 + slab * 64 + c;
  float wj[7];
#pragma unroll
  for (int j = 0; j < 7; ++j) wj[j] = cw[j * 1024];
  const float bias = P.conv_b[layer * 1024 + slab * 64 + c];
  const bf16_t* rp = (const bf16_t*)(smh + SM_RAW) + c;
  float w0 = bf2f(rp[(32 * tq + 0) * 64]), w1 = bf2f(rp[(32 * tq + 1) * 64]), w2 = bf2f(rp[(32 * tq + 2) * 64]), w3 = bf2f(rp[(32 * tq + 3) * 64]), w4 = bf2f(rp[(32 * tq + 4) * 64]), w5 = bf2f(rp[(32 * tq + 5) * 64]);
  const bool nat = slab >= 8, tr = slab < 12;
  bf16_t* trp = slab < 8 ? (bf16_t*)(P.ws + OFF_XTX) + (size_t)(slab * 64 + c) * TT : (bf16_t*)(P.ws + OFF_XTB) + (size_t)((slab - 8) * 64 + c) * TT;
#pragma unroll 1
  for (int tg = 0; tg < 4; ++tg) {
    float hold[8];
#pragma unroll
    for (int t8 = 0; t8 < 8; ++t8) {
      const int tok = 32 * tq + 8 * tg + t8;
      const float w6 = bf2f(rp[(tok + 6) * 64]);
      float v = bias + wj[0] * w0 + wj[1] * w1 + wj[2] * w2 + wj[3] * w3 + wj[4] * w4 + wj[5] * w5 + wj[6] * w6;
      v = silu_f(v);
      w0 = w1; w1 = w2; w2 = w3; w3 = w4; w4 = w5; w5 = w6;
      hold[t8] = v;
      if (nat) XN[(size_t)(rowbase + tok) * 512 + (slab - 8) * 64 + c] = (bf16_t)(cvt_pk(v, 0.f) & 0xffffu);
    }
    if (tr) {
      u32x4 o; o.x = cvt_pk(hold[0], hold[1]); o.y = cvt_pk(hold[2], hold[3]); o.z = cvt_pk(hold[4], hold[5]); o.w = cvt_pk(hold[6], hold[7]);
      *(u32x4*)(trp + rowbase + 32 * tq + 8 * tg) = o;
    }
  }
}

NOINL void ssd_state_item(const Params& P, int layer, int b, int cidx, int h) {
  unsigned char* const smh = smem + half_id() * HSTR;
  const int t = tid_opq(), lane = t & 63, w = t >> 6, r = lane & 15, q = lane >> 4;
  const bf16_t* PROJ = (const bf16_t*)(P.ws + OFF_PROJ);
  const float* DTb = (const float*)(P.ws + OFF_DT);
  bf16_t* ST = (bf16_t*)(P.ws + OFF_ST);
  float* CD = (float*)(P.ws + OFF_CD);
  float* sm = (float*)(smh + SM_SMALL);
  int rowbase, lo, hi;
  if (cidx < 2) { lo = T + b * 256; hi = lo + 256; rowbase = lo + cidx * 128; } else { lo = b * 4096; hi = lo + 4096; rowbase = lo + (cidx - 2) * 128; }
  const int g = h >> 2;
  const float Af = -__expf(P.a_log[layer * 16 + h]), Ab = -__expf(P.a_log[layer * 16 + 8 + h]);
  __syncthreads();
  float inf_ = 0.f, inb_ = 0.f, ab_ = 0.f;
  if (t < 128) {
    const float df = softplus_f(DTb[(size_t)(rowbase + t) * 16 + h] + P.dt_bias[layer * 16 + h]);
    const float db = softplus_f(DTb[(size_t)(rowbase + t) * 16 + 8 + h] + P.dt_bias[layer * 16 + 8 + h]);
    sm[256 + t] = df; sm[384 + t] = db;
    ab_ = db * Ab; inf_ = wave_incl_scan(df * Af, lane); inb_ = wave_incl_scan(ab_, lane);
    if (lane == 63) { sm[772 + w] = inf_; sm[774 + w] = inb_; }
  }
  __syncthreads();
  if (t < 128) {
    const float acf = inf_ + (w == 1 ? sm[772] : 0.f), totf = sm[772] + sm[773];
    const float preb = inb_ - ab_ + (w == 1 ? sm[774] : 0.f), totb = sm[774] + sm[775];
    sm[512 + t] = __expf(totf - acf) * sm[256 + t];
    sm[640 + t] = __expf(preb) * sm[384 + t];
    if (t == 0) { const int seq = (b * 8 + h) * 2; CD[seq * 34 + cidx] = __expf(totf); CD[(seq + 1) * 34 + cidx] = __expf(totb); }
  }
  __syncthreads();
  {
    const bf16_t* XTX = (const bf16_t*)(P.ws + OFF_XTX);
#pragma unroll
    for (int k = 0; k < 4; ++k) {
      const int e = t + 256 * k, p = e >> 4, c16 = e & 15;
      const u32x4 v = *(const u32x4*)(XTX + (size_t)(h * 64 + p) * TT + rowbase + c16 * 8);
      const float* wf = sm + 512 + c16 * 8; const float* wb = sm + 640 + c16 * 8;
      u32x4 of, ob;
      of.x = cvt_pk(bflo(v.x) * wf[0], bfhi(v.x) * wf[1]); of.y = cvt_pk(bflo(v.y) * wf[2], bfhi(v.y) * wf[3]); of.z = cvt_pk(bflo(v.z) * wf[4], bfhi(v.z) * wf[5]); of.w = cvt_pk(bflo(v.w) * wf[6], bfhi(v.w) * wf[7]);
      ob.x = cvt_pk(bflo(v.x) * wb[0], bfhi(v.x) * wb[1]); ob.y = cvt_pk(bflo(v.y) * wb[2], bfhi(v.y) * wb[3]); ob.z = cvt_pk(bflo(v.z) * wb[4], bfhi(v.z) * wb[5]); ob.w = cvt_pk(bflo(v.w) * wb[6], bfhi(v.w) * wb[7]);
      *(u32x4*)(smh + SM_X1 + p * 272 + c16 * 16) = of; *(u32x4*)(smh + SM_X2 + p * 272 + c16 * 16) = ob;
    }
  }
#pragma unroll 1
  for (int nh = 0; nh < 2; ++nh) {
    {
      const bf16_t* XTB = (const bf16_t*)(P.ws + OFF_XTB);
#pragma unroll
      for (int k = 0; k < 4; ++k) {
        const int e = t + 256 * k, n = e >> 4, c16 = e & 15;
        *(u32x4*)(smh + SM_BT + n * 272 + c16 * 16) = *(const u32x4*)(XTB + (size_t)(g * 128 + nh * 64 + n) * TT + rowbase + c16 * 8);
      }
    }
    __syncthreads();
    f32x4 acc[4][2];
#pragma unroll
    for (int nt = 0; nt < 4; ++nt) { acc[nt][0] = (f32x4){0.f, 0.f, 0.f, 0.f}; acc[nt][1] = (f32x4){0.f, 0.f, 0.f, 0.f}; }
#pragma unroll
    for (int s = 0; s < 4; ++s) {
      const bf16x8 xf = *(const bf16x8*)(smh + SM_X1 + (16 * w + r) * 272 + (32 * s + 8 * q) * 2);
      const bf16x8 xb = *(const bf16x8*)(smh + SM_X2 + (16 * w + r) * 272 + (32 * s + 8 * q) * 2);
#pragma unroll
      for (int nt = 0; nt < 4; ++nt) {
        const bf16x8 bt = *(const bf16x8*)(smh + SM_BT + (16 * nt + r) * 272 + (32 * s + 8 * q) * 2);
        acc[nt][0] = mfma16(bt, xf, acc[nt][0]); acc[nt][1] = mfma16(bt, xb, acc[nt][1]);
      }
    }
#pragma unroll
    for (int dir = 0; dir < 2; ++dir) {
      bf16_t* sp = ST + ((size_t)(((b * 8 + h) * 2 + dir) * 34 + cidx)) * 8192 + (16 * w + r) * 128 + nh * 64 + 4 * q;
#pragma unroll
      for (int nt = 0; nt < 4; ++nt) { u32x2 ov; ov.x = cvt_pk(acc[nt][dir][0], acc[nt][dir][1]); ov.y = cvt_pk(acc[nt][dir][2], acc[nt][dir][3]); *(u32x2*)(sp + 16 * nt) = ov; }
    }
    __syncthreads();
  }
}

NOINL void ssd_scan_phase(const Params& P) {
  bf16_t* ST = (bf16_t*)(P.ws + OFF_ST);
  const float* CD = (const float*)(P.ws + OFF_CD);
  const int total = 64 * 2048;
  for (int gidx = VB * 256 + tid_opq(); gidx < total; gidx += VG * 256) {
    const int seq = gidx >> 11, e = gidx & 2047, dir = seq & 1;
    bf16_t* base = ST + (size_t)seq * 34 * 8192 + e * 4;
    const float* cd = CD + seq * 34;
    u32x2 v[34];
#pragma unroll
    for (int k = 0; k < 34; ++k) { const int ci = dir == 0 ? k : (k == 0 ? 1 : (k == 1 ? 0 : 35 - k)); v[k] = *(const u32x2*)(base + (size_t)ci * 8192); }
    float h0 = 0.f, h1 = 0.f, h2 = 0.f, h3 = 0.f;
#pragma unroll
    for (int k = 0; k < 34; ++k) {
      const int ci = dir == 0 ? k : (k == 0 ? 1 : (k == 1 ? 0 : 35 - k));
      u32x2 ov; ov.x = cvt_pk(h0, h1); ov.y = cvt_pk(h2, h3);
      *(u32x2*)(base + (size_t)ci * 8192) = ov;
      const float d = cd[ci];
      h0 = h0 * d + bflo(v[k].x); h1 = h1 * d + bfhi(v[k].x); h2 = h2 * d + bflo(v[k].y); h3 = h3 * d + bfhi(v[k].y);
    }
  }
}

NOINL void ssd_out_item(const Params& P, int layer, int b, int cidx, int h, int do_atomic) {
  unsigned char* const smh = smem + half_id() * HSTR;
  const int t = tid_opq(), lane = t & 63, w = t >> 6, r = lane & 15, q = lane >> 4, r7 = r & 7;
  const bf16_t* PROJ = (const bf16_t*)(P.ws + OFF_PROJ);
  const float* DTb = (const float*)(P.ws + OFF_DT);
  const bf16_t* ST = (const bf16_t*)(P.ws + OFF_ST);
  bf16_t* MIX = (bf16_t*)(P.ws + OFF_H);
  float* SSQ = (float*)(P.ws + OFF_SSQ);
  float* sm = (float*)(smh + SM_SMALL);
  int rowbase, lo, hi;
  if (cidx < 2) { lo = T + b * 256; hi = lo + 256; rowbase = lo + cidx * 128; } else { lo = b * 4096; hi = lo + 4096; rowbase = lo + (cidx - 2) * 128; }
  const int g = h >> 2;
  const float Af = -__expf(P.a_log[layer * 16 + h]), Ab = -__expf(P.a_log[layer * 16 + 8 + h]);
  __syncthreads();
  float inf_ = 0.f, inb_ = 0.f, ab_ = 0.f;
  if (t < 128) {
    const float df = softplus_f(DTb[(size_t)(rowbase + t) * 16 + h] + P.dt_bias[layer * 16 + h]);
    const float db = softplus_f(DTb[(size_t)(rowbase + t) * 16 + 8 + h] + P.dt_bias[layer * 16 + 8 + h]);
    sm[256 + t] = df; sm[384 + t] = db;
    ab_ = db * Ab; inf_ = wave_incl_scan(df * Af, lane); inb_ = wave_incl_scan(ab_, lane);
    if (lane == 63) { sm[772 + w] = inf_; sm[774 + w] = inb_; }
  }
  {
    const bf16_t* XTX = (const bf16_t*)(P.ws + OFF_XTX);
#pragma unroll
    for (int k = 0; k < 4; ++k) {
      const int e = t + 256 * k, p = e >> 4, c16 = e & 15;
      *(u32x4*)(smh + SM_XT + p * 272 + c16 * 16) = *(const u32x4*)(XTX + (size_t)(h * 64 + p) * TT + rowbase + c16 * 8);
    }
  }
  __syncthreads();
  if (t < 128) {
    const float acf = inf_ + (w == 1 ? sm[772] : 0.f);
    const float preb = inb_ - ab_ + (w == 1 ? sm[774] : 0.f), totb = sm[774] + sm[775];
    sm[512 + t] = acf; sm[640 + t] = preb;
    if (t == 0) sm[768] = totb;
  }
  __syncthreads();
  f32x4 G[8][2], y[4][2];
#pragma unroll
  for (int jt = 0; jt < 8; ++jt) { G[jt][0] = (f32x4){0.f, 0.f, 0.f, 0.f}; G[jt][1] = (f32x4){0.f, 0.f, 0.f, 0.f}; }
#pragma unroll
  for (int pt = 0; pt < 4; ++pt) { y[pt][0] = (f32x4){0.f, 0.f, 0.f, 0.f}; y[pt][1] = (f32x4){0.f, 0.f, 0.f, 0.f}; }
  float acfi[2], prebi[2], efi[2][2];
#pragma unroll
  for (int it = 0; it < 2; ++it) {
    const int i = 32 * w + 16 * it + r;
    acfi[it] = sm[512 + i]; prebi[it] = sm[640 + i];
    efi[0][it] = __expf(acfi[it]); efi[1][it] = __expf(sm[768] - prebi[it]);
  }
#pragma unroll 1
  for (int nh = 0; nh < 2; ++nh) {
    {
      const bf16_t* XN = (const bf16_t*)(P.ws + OFF_XN);
#pragma unroll
      for (int k = 0; k < 4; ++k) {
        const int e = t + 256 * k, tok = e >> 3, ch = e & 7;
        const bf16_t* src = XN + (size_t)(rowbase + tok) * 512 + g * 128 + nh * 64 + ch * 8;
        *(u32x4*)(smh + SM_BN + tok * 128 + ((ch ^ (tok & 7)) << 4)) = *(const u32x4*)src;
        *(u32x4*)(smh + SM_CN + tok * 128 + ((ch ^ (tok & 7)) << 4)) = *(const u32x4*)(src + 256);
      }
      const int hp_ = t >> 2, hc_ = (t & 3) * 2;
#pragma unroll
      for (int d = 0; d < 2; ++d) {
        const bf16_t* hsrc = ST + ((size_t)(((b * 8 + h) * 2 + d) * 34 + cidx)) * 8192 + hp_ * 128 + nh * 64 + hc_ * 8;
        *(u32x4*)(smh + SM_RAW + d * 8192 + hp_ * 128 + ((hc_ ^ (hp_ & 7)) << 4)) = *(const u32x4*)hsrc;
        *(u32x4*)(smh + SM_RAW + d * 8192 + hp_ * 128 + (((hc_ + 1) ^ (hp_ & 7)) << 4)) = *(const u32x4*)(hsrc + 8);
      }
    }
    __syncthreads();
    bf16x8 cf[2][2];
#pragma unroll
    for (int it = 0; it < 2; ++it)
#pragma unroll
      for (int s = 0; s < 2; ++s) cf[it][s] = *(const bf16x8*)(smh + SM_CN + (32 * w + 16 * it + r) * 128 + (((4 * s + q) ^ r7) << 4));
#pragma unroll
    for (int jt = 0; jt < 8; ++jt)
#pragma unroll
      for (int s = 0; s < 2; ++s) {
        const bf16x8 bfr = *(const bf16x8*)(smh + SM_BN + (16 * jt + r) * 128 + (((4 * s + q) ^ r7) << 4));
        G[jt][0] = mfma16(bfr, cf[0][s], G[jt][0]); G[jt][1] = mfma16(bfr, cf[1][s], G[jt][1]);
      }
#pragma unroll
    for (int d = 0; d < 2; ++d) {
#pragma unroll
      for (int s = 0; s < 2; ++s) {
        union { bf16x8 b; u32x4 u; } c0, c1; c0.b = cf[0][s]; c1.b = cf[1][s];
        const bf16x8 cs0 = as_bf16x8(scale8(c0.u, efi[d][0])), cs1 = as_bf16x8(scale8(c1.u, efi[d][1]));
#pragma unroll
        for (int pt = 0; pt < 4; ++pt) {
          const bf16x8 hf = *(const bf16x8*)(smh + SM_RAW + d * 8192 + (16 * pt + r) * 128 + (((4 * s + q) ^ r7) << 4));
          y[pt][0] = mfma16(hf, cs0, y[pt][0]); y[pt][1] = mfma16(hf, cs1, y[pt][1]);
        }
      }
    }
    __syncthreads();
  }
#pragma unroll
  for (int s = 0; s < 4; ++s) {
    asm volatile("" ::: "memory");
    bf16x8 mf[2];
    const int wu = __builtin_amdgcn_readfirstlane(w);
    if (s < wu) {
      float aj[8], dfj[8];
#pragma unroll
      for (int jj = 0; jj < 8; ++jj) { const int j = 32 * s + (jj < 4 ? 4 * q + jj : 16 + 4 * q + jj - 4); aj[jj] = sm[512 + j]; dfj[jj] = sm[256 + j]; }
#pragma unroll
      for (int it = 0; it < 2; ++it) {
        float mv[8];
#pragma unroll
        for (int jj = 0; jj < 8; ++jj) mv[jj] = G[2 * s + (jj >> 2)][it][jj & 3] * __expf(acfi[it] - aj[jj]) * dfj[jj];
        u32x4 pk; pk.x = cvt_pk(mv[0], mv[1]); pk.y = cvt_pk(mv[2], mv[3]); pk.z = cvt_pk(mv[4], mv[5]); pk.w = cvt_pk(mv[6], mv[7]);
        mf[it] = as_bf16x8(pk);
      }
    } else if (s > wu) {
      float pj[8], dbj[8];
#pragma unroll
      for (int jj = 0; jj < 8; ++jj) { const int j = 32 * s + (jj < 4 ? 4 * q + jj : 16 + 4 * q + jj - 4); pj[jj] = sm[640 + j]; dbj[jj] = sm[384 + j]; }
#pragma unroll
      for (int it = 0; it < 2; ++it) {
        float mv[8];
#pragma unroll
        for (int jj = 0; jj < 8; ++jj) mv[jj] = G[2 * s + (jj >> 2)][it][jj & 3] * __expf(pj[jj] - prebi[it]) * dbj[jj];
        u32x4 pk; pk.x = cvt_pk(mv[0], mv[1]); pk.y = cvt_pk(mv[2], mv[3]); pk.z = cvt_pk(mv[4], mv[5]); pk.w = cvt_pk(mv[6], mv[7]);
        mf[it] = as_bf16x8(pk);
      }
    } else {
    float aj[8], pj[8], dfj[8], dbj[8];
#pragma unroll
    for (int jj = 0; jj < 8; ++jj) { const int j = 32 * s + (jj < 4 ? 4 * q + jj : 16 + 4 * q + jj - 4); aj[jj] = sm[512 + j]; pj[jj] = sm[640 + j]; dfj[jj] = sm[256 + j]; dbj[jj] = sm[384 + j]; }
#pragma unroll
    for (int it = 0; it < 2; ++it) {
      const int i = 32 * w + 16 * it + r;
      float mv[8];
#pragma unroll
      for (int jj = 0; jj < 8; ++jj) {
        const int j = 32 * s + (jj < 4 ? 4 * q + jj : 16 + 4 * q + jj - 4);
        const float gv = G[2 * s + (jj >> 2)][it][jj & 3];
        float m;
        if (j < i) m = gv * __expf(acfi[it] - aj[jj]) * dfj[jj];
        else if (j > i) m = gv * __expf(pj[jj] - prebi[it]) * dbj[jj];
        else m = gv * (dfj[jj] + dbj[jj]);
        mv[jj] = m;
      }
      u32x4 pk; pk.x = cvt_pk(mv[0], mv[1]); pk.y = cvt_pk(mv[2], mv[3]); pk.z = cvt_pk(mv[4], mv[5]); pk.w = cvt_pk(mv[6], mv[7]);
      mf[it] = as_bf16x8(pk);
    }
    }
#pragma unroll
    for (int pt = 0; pt < 4; ++pt) {
      const u32x2 lo2 = *(const u32x2*)(smh + SM_XT + (16 * pt + r) * 272 + (32 * s + 4 * q) * 2);
      const u32x2 hi2 = *(const u32x2*)(smh + SM_XT + (16 * pt + r) * 272 + (32 * s + 16 + 4 * q) * 2);
      const bf16x8 xf = as_bf16x8((u32x4){lo2.x, lo2.y, hi2.x, hi2.y});
      y[pt][0] = mfma16(xf, mf[0], y[pt][0]); y[pt][1] = mfma16(xf, mf[1], y[pt][1]);
    }
  }
  const float dsk = P.ssm_d[layer * 8 + h];
  const bf16_t* XT = (const bf16_t*)(smh + SM_XT);
#pragma unroll
  for (int it = 0; it < 2; ++it) {
    const int i = 32 * w + 16 * it + r; const int row = rowbase + i;
    float ss = 0.f;
#pragma unroll
    for (int pt = 0; pt < 4; ++pt) {
      const int p0 = 16 * pt + 4 * q;
      const u32x2 zz = *(const u32x2*)(PROJ + (size_t)row * PW + 512 + h * 64 + p0);
      const f32x4 gg = *(const f32x4*)(P.ssm_g + layer * 512 + h * 64 + p0);
      const float zv[4] = {bflo(zz.x), bfhi(zz.x), bflo(zz.y), bfhi(zz.y)};
      float ov[4];
#pragma unroll
      for (int e = 0; e < 4; ++e) {
        const float xs = bf2f(XT[(p0 + e) * 136 + i]);
        const float yz = (y[pt][it][e] + dsk * xs) * silu_f(zv[e]);
        ss += yz * yz; ov[e] = yz * gg[e];
      }
      u32x2 o; o.x = cvt_pk(ov[0], ov[1]); o.y = cvt_pk(ov[2], ov[3]);
      *(u32x2*)(MIX + (size_t)row * 1024 + h * 64 + p0) = o;
    }
    ss += __shfl_xor(ss, 16); ss += __shfl_xor(ss, 32);
    if (q == 0 && do_atomic) atomicAdd(SSQ + row, ss);
  }
}

DEVI void mixer1_phase(const Params& P, int layer) {
  const int nA = 512, nV = 4 * 34 * 16, nC = (layer == 0) ? 64 : 0;
  const int total = nA + nV + nC;
#pragma unroll 1
  for (int it = VB; it < total; it += VG) {
    if (it < nA || it >= nA + nV) {
      int b, i1, i2; bool isctx = it >= nA;
      if (!isctx) { b = it >> 7; i1 = (it >> 2) & 31; i2 = it & 3; }
      else { const int e = it - nA - nV; b = e >> 4; i1 = (e >> 3) & 1; i2 = e & 7; }
      attn_item<0>(P, layer, b, i1, i2, isctx ? 1 : 0);
    } else { const int e = it - nA; const int b = e / 544, rem = e % 544; conv_item(P, layer, b, rem >> 4, rem & 15); }
  }
}
DEVI void mixer2_phase(const Params& P, int layer) {
  const int nB = 1024, nS = 4 * 34 * 8;
  const int total = nB + nS;
#pragma unroll 1
  for (int it = VB; it < total; it += VG) {
    if (it < nB) { const int b = it >> 8, gr = (it >> 2) & 63, h = it & 3; attn_item<1>(P, layer, b, gr, h, 0); }
    else { const int e = it - nB; const int b = e / 272, rem = e % 272; ssd_state_item(P, layer, b, rem >> 3, rem & 7); }
  }
}

DEVI void ssd_out_phase(const Params& P, int layer, int do_atomic = 1) {
  const int c0 = (layer == 0) ? 0 : 2;
  const int nc = 34 - c0;
  const int total = 4 * nc * 8;
#pragma unroll 1
  for (int it = VB; it < total; it += VG) {
    const int b = it / (nc * 8), rem = it % (nc * 8);
    ssd_out_item(P, layer, b, c0 + (rem >> 3), rem & 7, do_atomic);
  }
}


#define XB_TMO      128
#define XB_XCNT(j)  (256  + 64 * (j))
#define XB_XSUB(j)  (1280 + 64 * (j))
#define XB_XGEN(j)  (2304 + 64 * (j))
#define XB_TOP      3328
#define XB_TOPGEN   3392
#define XB_SPIN_CAP (1u << 18)
#define LAS __attribute__((address_space(3)))
DEVI unsigned xb_ld(unsigned* p)              { return __hip_atomic_load(p, __ATOMIC_RELAXED, __HIP_MEMORY_SCOPE_AGENT); }
DEVI unsigned xb_add(unsigned* p, unsigned v) { return __hip_atomic_fetch_add(p, v, __ATOMIC_RELAXED, __HIP_MEMORY_SCOPE_AGENT); }
DEVI unsigned xb_xcc_id() { return (unsigned)__builtin_amdgcn_s_getreg((3 << 11) | 20) & 0xFu; }
#define XB_SPIN(cond, bar) do { unsigned _sp = 0; while (cond) { __builtin_amdgcn_s_sleep(1); \
    if ((++_sp & 255u) == 0u) { if (xb_ld(&(bar)[XB_TMO])) break; if (_sp > XB_SPIN_CAP) { atomicAdd(&(bar)[XB_TMO], 1u); break; } } } } while (0)
struct XcdBarrier { unsigned* bar; unsigned x; volatile LAS unsigned* st; };
DEVI XcdBarrier xcd_barrier_post(unsigned* bar, volatile LAS unsigned* st) {
  XcdBarrier b; b.bar = bar; b.x = xb_xcc_id(); b.st = st;
  if (threadIdx.x == 0) (void)xb_add(&bar[XB_XCNT(b.x)], 1u);
  return b;
}
DEVI void xcd_barrier_complete(unsigned* bar, unsigned x, unsigned& nloc, unsigned& nx) {
  const unsigned G = gridDim.x * gridDim.y * gridDim.z;
  unsigned sum, cnt, mine, sp = 0u;
  for (;;) {
    sum = 0u; cnt = 0u; mine = 0u;
#pragma unroll
    for (unsigned j = 0; j < 16; ++j) { const unsigned c = xb_ld(&bar[XB_XCNT(j)]); sum += c; cnt += (c > 0u) ? 1u : 0u; mine = (j == x) ? c : mine; }
    if (sum == G) break;
    __builtin_amdgcn_s_sleep(1);
    if ((++sp & 255u) == 0u) { if (xb_ld(&bar[XB_TMO])) break; if (sp > XB_SPIN_CAP) { atomicAdd(&bar[XB_TMO], 1u); break; } }
  }
  nloc = mine > 0u ? mine : 1u; nx = cnt > 0u ? cnt : 1u;
}
DEVI void xcd_barrier(const XcdBarrier& b) {
  asm volatile("s_waitcnt vmcnt(0)" ::: "memory");
  __syncthreads();
  if (threadIdx.x == 0) {
    unsigned* bar = b.bar;
    __builtin_amdgcn_s_waitcnt(0);
    unsigned nloc = b.st[0], nx = b.st[1];
    if (nloc == 0u) { xcd_barrier_complete(bar, b.x, nloc, nx); b.st[0] = nloc; b.st[1] = nx; }
    const unsigned old = xb_add(&bar[XB_XSUB(b.x)], 1u);
    const unsigned gen = old / nloc;
    if (old + 1u == (gen + 1u) * nloc) {
      __builtin_amdgcn_fence(__ATOMIC_RELEASE, "agent");
      asm volatile("s_waitcnt vmcnt(0)" ::: "memory");
      const unsigned og = xb_add(&bar[XB_TOP], 1u);
      const unsigned tg = og / nx;
      if (og + 1u == (tg + 1u) * nx) xb_add(&bar[XB_TOPGEN], 1u);
      else XB_SPIN(xb_ld(&bar[XB_TOPGEN]) == tg, bar);
      __builtin_amdgcn_fence(__ATOMIC_ACQUIRE, "agent");
      xb_add(&bar[XB_XGEN(b.x)], 1u);
      asm volatile("s_waitcnt vmcnt(0)" ::: "memory");
    } else {
      XB_SPIN(xb_ld(&bar[XB_XGEN(b.x)]) == gen, bar);
      __builtin_amdgcn_fence(__ATOMIC_ACQUIRE, "agent");
      asm volatile("s_waitcnt vmcnt(0)" ::: "memory");
    }
  }
  __syncthreads();
}

__global__ void __launch_bounds__(512, 2) mega_fwd(Params P) {
  cg::grid_group grid = cg::this_grid();
  __shared__ uint4 xb_words;
  if (threadIdx.x == 0) xb_words = make_uint4(0u, 0u, 0u, 0u);
  __syncthreads();
  XcdBarrier xb = xcd_barrier_post((unsigned*)(P.ws + OFF_BAR), (volatile LAS unsigned*)&xb_words);
  if (P.ph_hi > 1000) grid.sync();
#define BAR() xcd_barrier(xb)
#ifndef REP_S
#define REP_S -1
#endif
#define RUN(S_, CALL) { if (REP_S == (S_)) { const int do_at = 0; (void)do_at; CALL; BAR(); } { const int do_at = 1; (void)do_at; CALL; } BAR(); }
#define LAYER(l) \
  RUN(0, (norm_phase(P, l, 0), (l == 1 ? prep_phase(P, 1, false) : (void)0))) \
  RUN(1, (gemm_phase<MODE_INPROJ, false>(P, l))) \
  RUN(2, mixer1_phase(P, l)) \
  RUN(9, mixer2_phase(P, l)) \
  RUN(3, ssd_scan_phase(P)) \
  RUN(4, ssd_out_phase(P, l, do_at)) \
  RUN(5, (gemm_phase<MODE_RESID, true>(P, l))) \
  RUN(6, norm_phase(P, l, 1)) \
  RUN(7, (gemm_phase<MODE_SWIGLU, false>(P, l))) \
  RUN(8, (gemm_phase<MODE_RESID, false>(P, l)))
  prep_phase(P, 0, true); BAR();
  LAYER(0)
  LAYER(1)
  final_norm_phase(P);
}

extern "C" void kernel_launch(void* const* d_in, const int* in_sizes, int n_in, void* d_out, int out_size, void* d_ws, size_t ws_size, hipStream_t stream) {
  static int grid_blocks = 0;
  if (!grid_blocks) {
    int dev = 0, cus = 0, per_cu = 0;
    hipGetDevice(&dev);
    hipDeviceGetAttribute(&cus, hipDeviceAttributeMultiprocessorCount, dev);
    hipOccupancyMaxActiveBlocksPerMultiprocessor(&per_cu, mega_fwd, 512, 0);
    if (per_cu < 1) per_cu = 1;
    if (per_cu > 1) per_cu = 1;
    grid_blocks = cus * per_cu;
    if (ws_size < WS_END) fprintf(stderr, "kernel_launch: workspace too small: %zu < %zu\n", ws_size, (size_t)WS_END);
  }
  Params p{};
  const float** pp = (const float**)&p;
  for (int i = 0; i < 21; ++i) pp[i] = (const float*)d_in[i];
  p.out = (float*)d_out; p.ws = (unsigned char*)d_ws;
  hipMemsetAsync((unsigned char*)d_ws + OFF_MODS, 0, SZ_MODS + SZ_BAR, stream);
#if LAUNCH_PER_PHASE
  for (int ph = 0; ph < NPH; ++ph) {
    p.ph_lo = ph; p.ph_hi = ph + 1;
    hipLaunchKernelGGL(mega_fwd, dim3(grid_blocks), dim3(256), 0, stream, p);
  }
#else
  p.ph_lo = 0; p.ph_hi = NPH;
  void* args[] = {&p};
  hipError_t e = hipLaunchCooperativeKernel((void*)mega_fwd, dim3(grid_blocks), dim3(512), args, 0, stream);
  if (e != hipSuccess) fprintf(stderr, "cooperative launch failed: %s (grid %d)\n", hipGetErrorString(e), grid_blocks);
#endif
}
```

```cpp
#include <hip/hip_runtime.h>
#include <hip/hip_cooperative_groups.h>
#include <cstdio>
#include <cstdint>
namespace cg = cooperative_groups;

#ifndef LAUNCH_PER_PHASE
#define LAUNCH_PER_PHASE 0
#endif

typedef unsigned short bf16_t;
typedef short bf16x8 __attribute__((ext_vector_type(8)));
typedef float f32x4 __attribute__((ext_vector_type(4)));
typedef unsigned u32x4 __attribute__((ext_vector_type(4)));
typedef unsigned u32x2 __attribute__((ext_vector_type(2)));
#define DEVI __device__ __forceinline__

constexpr int T = 16384, TC = 1024, TT = T + TC;
constexpr int PW = 2816;
constexpr int NPH = 20;
constexpr float EPSN = 1e-6f;

constexpr size_t SZ_WIN = (size_t)2944 * 1024 * 2, SZ_WOUT = (size_t)1024 * 1024 * 2, SZ_WFI = (size_t)5632 * 1024 * 2, SZ_WFO = (size_t)1024 * 2816 * 2;
constexpr size_t OFF_WIN = 0;
constexpr size_t OFF_WOUT = OFF_WIN + SZ_WIN;
constexpr size_t OFF_WFI = OFF_WOUT + SZ_WOUT;
constexpr size_t OFF_WFO = OFF_WFI + SZ_WFI;
constexpr size_t OFF_H = OFF_WFO + SZ_WFO;
constexpr size_t OFF_PROJ = OFF_H + (size_t)TT * 1024 * 2;
constexpr size_t OFF_VT = OFF_PROJ + (size_t)TT * PW * 2;
constexpr size_t OFF_DT = OFF_VT + (size_t)384 * TT * 2;
constexpr size_t OFF_XC = OFF_DT + (size_t)TT * 16 * 4;
constexpr size_t OFF_MODS = OFF_XC + (size_t)TC * 1024 * 4;
constexpr size_t SZ_MODS = (size_t)2 * 5 * 6144 * 4;
constexpr size_t OFF_BAR = OFF_MODS + SZ_MODS;
constexpr size_t SZ_BAR = 3456 * 4;
constexpr size_t OFF_SSQ = OFF_BAR + SZ_BAR;
constexpr size_t OFF_ST = OFF_SSQ + (size_t)TT * 4;
constexpr size_t OFF_CD = OFF_ST + (size_t)64 * 34 * 8192 * 2;
constexpr size_t OFF_ROPE = OFF_CD + (size_t)64 * 34 * 4;
constexpr size_t OFF_XN = OFF_ROPE + 2 * 1024 * 4;
constexpr size_t OFF_XTX = OFF_XN + (size_t)TT * 512 * 2;
constexpr size_t OFF_XTB = OFF_XTX + (size_t)512 * TT * 2;
constexpr size_t WS_END = OFF_XTB + (size_t)256 * TT * 2;
static_assert(WS_END <= (size_t)256 * 1024 * 1024, "workspace map exceeds 256 MiB");

struct Params {
  const float *x, *c, *ctx, *c_ctx, *w_mod, *b_mod, *g_mix, *w_in, *wa_sink, *na_rpb, *conv_w, *conv_b, *dt_bias, *a_log, *ssm_d, *ssm_g, *w_out, *g_ffn, *w_ffn_in, *w_ffn_out, *g_final;
  float* out; unsigned char* ws; int ph_lo, ph_hi;
};

constexpr int HSTR = 73728, SMEM_BYTES = 2 * HSTR;
__shared__ __attribute__((aligned(16))) unsigned char smem[SMEM_BYTES];
#define NOINL __device__ __forceinline__

typedef __bf16 bf16x2_t __attribute__((ext_vector_type(2)));
typedef float f32x2_t __attribute__((ext_vector_type(2)));
DEVI unsigned cvt_pk(float lo, float hi) { f32x2_t v = {lo, hi}; bf16x2_t b = __builtin_convertvector(v, bf16x2_t); return __builtin_bit_cast(unsigned, b); }
DEVI float bflo(unsigned u) { return __uint_as_float(u << 16); }
DEVI float bfhi(unsigned u) { return __uint_as_float(u & 0xffff0000u); }
DEVI float bf2f(bf16_t h) { return __uint_as_float((unsigned)h << 16); }
DEVI float silu_f(float v) { return v * __builtin_amdgcn_rcpf(1.f + __expf(-v)); }
DEVI float softplus_f(float v) { const float e = __expf(v); return v > 20.f ? v : (e < 1e-3f ? e * (1.f - 0.5f * e) : __logf(1.f + e)); }
DEVI float wave_sum(float v) {
#pragma unroll
  for (int o = 32; o > 0; o >>= 1) v += __shfl_xor(v, o);
  return v;
}
DEVI float wave_incl_scan(float v, int lane) {
#pragma unroll
  for (int o = 1; o < 64; o <<= 1) { const float u = __shfl_up(v, o); if (lane >= o) v += u; }
  return v;
}
DEVI f32x4 mfma16(bf16x8 a, bf16x8 b, f32x4 c) { return __builtin_amdgcn_mfma_f32_16x16x32_bf16(a, b, c, 0, 0, 0); }
DEVI bf16x8 as_bf16x8(u32x4 v) { union { u32x4 u; bf16x8 b; } x; x.u = v; return x.b; }

DEVI u32x4 scale8(u32x4 v, float s) {
  u32x4 o;
  o.x = cvt_pk(bflo(v.x) * s, bfhi(v.x) * s); o.y = cvt_pk(bflo(v.y) * s, bfhi(v.y) * s);
  o.z = cvt_pk(bflo(v.z) * s, bfhi(v.z) * s); o.w = cvt_pk(bflo(v.w) * s, bfhi(v.w) * s);
  return o;
}
DEVI int tid_opq() { int t; asm volatile("v_mov_b32 %0, %1" : "=v"(t) : "v"((int)(threadIdx.x & 255))); return t; }
DEVI int half_id() { return __builtin_amdgcn_readfirstlane((int)(threadIdx.x >> 8)); }
#define VB (blockIdx.x * 2 + half_id())
#define VG (gridDim.x * 2)
DEVI int ufy(int v) { return __builtin_amdgcn_readfirstlane(v); }

NOINL void prep_phase(const Params& P, int wl, bool full) {
  unsigned char* const smh = smem + half_id() * HSTR;
  float* tile = (float*)smh;
  const int t = tid_opq();
  constexpr int I_IN = 46 * 16, I_OUT = 16 * 16, I_FI = 88 * 16, I_FO = 16 * 44, I_L = I_IN + I_OUT + I_FI + I_FO;
  constexpr int I_MOD = 2 * 16 * 24;
  const int total = I_L + (full ? I_MOD + 1 : 0);
  for (int it = VB; it < total; it += VG) {
    if (it < I_L) {
      const int l = wl; int r = it;
      const float* W; bf16_t* Wt; int K, N, kind, nt_, kt_;
      if (r < I_IN) { kind = 0; W = P.w_in + (size_t)l * 1024 * 2832; N = 2832; K = 1024; Wt = (bf16_t*)(P.ws + OFF_WIN); nt_ = r / 16; kt_ = r % 16; }
      else if (r < I_IN + I_OUT) { r -= I_IN; kind = 1; W = P.w_out + (size_t)l * 1024 * 1024; N = 1024; K = 1024; Wt = (bf16_t*)(P.ws + OFF_WOUT); nt_ = r / 16; kt_ = r % 16; }
      else if (r < I_IN + I_OUT + I_FI) { r -= I_IN + I_OUT; kind = 2; W = P.w_ffn_in + (size_t)l * 1024 * 5632; N = 5632; K = 1024; Wt = (bf16_t*)(P.ws + OFF_WFI); nt_ = r / 16; kt_ = r % 16; }
      else { r -= I_IN + I_OUT + I_FI; kind = 3; W = P.w_ffn_out + (size_t)l * 2816 * 1024; N = 1024; K = 2816; Wt = (bf16_t*)(P.ws + OFF_WFO); nt_ = r / 44; kt_ = r % 44; }
      {
        const int n4 = (t & 15) * 4, np = nt_ * 64 + n4;
        int col;
        if (kind == 0) col = np < 2832 ? np : -1;
        else if (kind == 2) { const int qq = np >> 5, rr = np & 31; col = rr < 16 ? 16 * qq + rr : 2816 + 16 * qq + rr - 16; }
        else col = np;
#pragma unroll
        for (int i = 0; i < 4; ++i) {
          const int kk = i * 16 + (t >> 4);
          f32x4 v = (f32x4){0.f, 0.f, 0.f, 0.f};
          const int ksrc = kind == 1 ? ((kt_ * 64 + kk + 512) & 1023) : (kt_ * 64 + kk);
          if (col >= 0) v = *(const f32x4*)(W + (size_t)ksrc * N + col);
          tile[kk * 65 + n4] = v[0]; tile[kk * 65 + n4 + 1] = v[1]; tile[kk * 65 + n4 + 2] = v[2]; tile[kk * 65 + n4 + 3] = v[3];
        }
      }
      __syncthreads();
      {
        const int n = t >> 2, kc = (t & 3) * 16;
        u32x4 o0, o1;
        o0.x = cvt_pk(tile[(kc + 0) * 65 + n], tile[(kc + 1) * 65 + n]); o0.y = cvt_pk(tile[(kc + 2) * 65 + n], tile[(kc + 3) * 65 + n]);
        o0.z = cvt_pk(tile[(kc + 4) * 65 + n], tile[(kc + 5) * 65 + n]); o0.w = cvt_pk(tile[(kc + 6) * 65 + n], tile[(kc + 7) * 65 + n]);
        o1.x = cvt_pk(tile[(kc + 8) * 65 + n], tile[(kc + 9) * 65 + n]); o1.y = cvt_pk(tile[(kc + 10) * 65 + n], tile[(kc + 11) * 65 + n]);
        o1.z = cvt_pk(tile[(kc + 12) * 65 + n], tile[(kc + 13) * 65 + n]); o1.w = cvt_pk(tile[(kc + 14) * 65 + n], tile[(kc + 15) * 65 + n]);
        bf16_t* dst = Wt + (size_t)(nt_ * 64 + n) * K + kt_ * 64 + kc;
        *(u32x4*)dst = o0; *(u32x4*)(dst + 8) = o1;
      }
      __syncthreads();
    } else if (it < I_L + I_MOD) {
      const int m = it - I_L; const int l = m / 384, rem = m % 384, kc = rem / 24, cb = rem % 24;
      float* sv = (float*)smh;
      for (int e = t; e < 320; e += 256) { const int r = e >> 6, k = kc * 64 + (e & 63); const float v = r < 4 ? P.c[r * 1024 + k] : P.c_ctx[k]; sv[e] = v / (1.f + __expf(-v)); }
      __syncthreads();
      const int n = cb * 256 + t;
      float a0 = 0.f, a1 = 0.f, a2 = 0.f, a3 = 0.f, a4 = 0.f;
      const float* wp = P.w_mod + ((size_t)l * 1024 + kc * 64) * 6144 + n;
#pragma unroll 8
      for (int kk = 0; kk < 64; ++kk) { const float w = wp[(size_t)kk * 6144]; a0 += sv[kk] * w; a1 += sv[64 + kk] * w; a2 += sv[128 + kk] * w; a3 += sv[192 + kk] * w; a4 += sv[256 + kk] * w; }
      if (kc == 0) { const float bb = P.b_mod[l * 6144 + n]; a0 += bb; a1 += bb; a2 += bb; a3 += bb; a4 += bb; }
      float* md = (float*)(P.ws + OFF_MODS) + (size_t)l * 5 * 6144 + n;
      atomicAdd(md, a0); atomicAdd(md + 6144, a1); atomicAdd(md + 2 * 6144, a2); atomicAdd(md + 3 * 6144, a3); atomicAdd(md + 4 * 6144, a4);
      __syncthreads();
    } else {
      float* rc = (float*)(P.ws + OFF_ROPE);
      for (int e = t; e < 1024; e += 256) { const int pos = e >> 4, i = e & 15; const float inv = __builtin_amdgcn_exp2f(-(float)i * (13.287712379549449f / 16.f)); float xr = (float)pos * inv * 0.15915494309189535f; xr -= floorf(xr); rc[e] = __builtin_amdgcn_cosf(xr); rc[1024 + e] = __builtin_amdgcn_sinf(xr); }
    }
  }
}

NOINL void norm_phase(const Params& P, int layer, int which) {
  const float* src_lat = (layer == 0 && which == 0) ? P.x : P.out; const float* src_ctx = (layer == 0 && which == 0) ? P.ctx : (const float*)(P.ws + OFF_XC);
  const int M = (which == 0 || layer == 0) ? TT : T;
  const int t_ = tid_opq(); const int lane = t_ & 63, wv = t_ >> 6;
  const int gw = VB * 4 + wv, nw = VG * 4;
  const float* g = (which == 0 ? P.g_mix : P.g_ffn) + layer * 1024;
  bf16_t* H = (bf16_t*)(P.ws + OFF_H);
  float* ssq = (float*)(P.ws + OFF_SSQ);
  for (int row = gw; row < M; row += nw) {
    const float* xr = row < T ? src_lat + (size_t)row * 1024 : src_ctx + (size_t)(row - T) * 1024;
    const int mr = row < T ? (row >> 12) : 4;
    const float* md = (const float*)(P.ws + OFF_MODS) + (size_t)(layer * 5 + mr) * 6144 + which * 3072;
    f32x4 v[4]; float s = 0.f;
#pragma unroll
    for (int j = 0; j < 4; ++j) { v[j] = *(const f32x4*)(xr + 4 * (lane + 64 * j)); s += v[j][0] * v[j][0] + v[j][1] * v[j][1] + v[j][2] * v[j][2] + v[j][3] * v[j][3]; }
    s = wave_sum(s);
    const float rstd = rsqrtf(s * (1.f / 1024.f) + EPSN);
#pragma unroll
    for (int j = 0; j < 4; ++j) {
      const int k = 4 * (lane + 64 * j);
      const f32x4 gg = *(const f32x4*)(g + k), sh = *(const f32x4*)(md + k), sc = *(const f32x4*)(md + 1024 + k);
      f32x4 h;
#pragma unroll
      for (int e = 0; e < 4; ++e) h[e] = v[j][e] * rstd * gg[e] * (1.f + sc[e]) + sh[e];
      u32x2 o; o.x = cvt_pk(h[0], h[1]); o.y = cvt_pk(h[2], h[3]);
      *(u32x2*)(H + (size_t)row * 1024 + k) = o;
    }
    if (which == 0 && lane == 0) ssq[row] = 0.f;
  }
}

NOINL void final_norm_phase(const Params& P) {
  const int t_ = tid_opq(); const int lane = t_ & 63, wv = t_ >> 6;
  const int gw = VB * 4 + wv, nw = VG * 4;
  for (int row = gw; row < T; row += nw) {
    float* xr = P.out + (size_t)row * 1024;
    f32x4 v[4]; float s = 0.f;
#pragma unroll
    for (int j = 0; j < 4; ++j) { v[j] = *(const f32x4*)(xr + 4 * (lane + 64 * j)); s += v[j][0] * v[j][0] + v[j][1] * v[j][1] + v[j][2] * v[j][2] + v[j][3] * v[j][3]; }
    s = wave_sum(s);
    const float rstd = rsqrtf(s * (1.f / 1024.f) + EPSN);
#pragma unroll
    for (int j = 0; j < 4; ++j) {
      const int k = 4 * (lane + 64 * j);
      const f32x4 gg = *(const f32x4*)(P.g_final + k);
      f32x4 h;
#pragma unroll
      for (int e = 0; e < 4; ++e) h[e] = v[j][e] * rstd * gg[e];
      *(f32x4*)(xr + k) = h;
    }
  }
}

namespace pg8 {
#define PG8_LAS __attribute__((address_space(3)))
typedef unsigned short bf16_t;
typedef short bf16x8 __attribute__((ext_vector_type(8)));
typedef float f32x4 __attribute__((ext_vector_type(4)));
typedef unsigned u32x4 __attribute__((ext_vector_type(4)));
constexpr int BM = 256, BK = 64, HALF = 128, HTB = HALF * BK * 2  , STAGE_BYTES = 8 * HTB, NXCD = 8, WGM = 8;

__host__ __device__ __forceinline__ int lds_byte(int r, int c) { const int st = (r >> 4) * 2 + (c >> 5), rr = r & 15, cc = c & 31, ob = rr * 64 + cc * 2; return st * 1024 + (ob ^ (((ob >> 9) & 1) << 5)); }
__host__ __device__ __forceinline__ void stage_rc(int b, int& R, int& C) { const int st = b / 1024, sb = b % 1024, swz = sb ^ (((sb >> 9) & 1) << 5); R = (st >> 1) * 16 + swz / 64; C = (st & 1) * 32 + (swz % 64) / 2; }
__host__ __device__ __forceinline__ int perm32(int rho) { const int n = rho >> 4, i = rho & 15; return 8 * (i >> 2) + 4 * n + (i & 3); }

struct Unit { int pm, pn; };
struct Gemm { const bf16_t* A; const bf16_t* Bt; int M, N, K; };

struct StaticOrder {
    int nM, nN, nwg, G, c;
    __host__ __device__ void init(int M, int N, int G_, int c_) { nM = M / BM; nN = N / BM; nwg = nM * nN; G = G_; c = c_; }
    __host__ __device__ bool next(int i, Unit& u) const {
        const long L = (long)i * G + c; if (L >= nwg) return false;
        int wgid = (int)L; { const int q = nwg / NXCD, r = nwg % NXCD, xcd = wgid % NXCD, off = wgid / NXCD; wgid = (xcd < r ? xcd * (q + 1) : r * (q + 1) + (xcd - r) * q) + off; }
        const int nig = WGM * nN, gid = wgid / nig, fm = gid * WGM, gsz = (nM - fm) < WGM ? (nM - fm) : WGM;
        u.pm = fm + ((wgid % nig) % gsz); u.pn = (wgid % nig) / gsz; return true;
    }
    __device__ __forceinline__ void a_ready(const Unit&) const {}
    __device__ __forceinline__ void done(const Unit&) const {}
};

template <class Epi, class Sched, bool ALIGN_EPI = false, bool SP2 = false>
__device__ __forceinline__ void gemm_phase(PG8_LAS unsigned char* lds, const Gemm g, const Sched& S, const Epi& E) {
    int tid_; asm volatile("v_mov_b32 %0, %1" : "=v"(tid_) : "v"((int)threadIdx.x)); const int tid = tid_, wid = __builtin_amdgcn_readfirstlane(tid >> 6), lane = tid & 63, wr = wid >> 2, wc = wid & 3, fr = lane & 15, fq = lane >> 4;
    const int K = g.K, nt = K / BK;
    unsigned voffA[2], voffB[2];
#pragma unroll
    for (int i = 0; i < 2; ++i) { int R, C; stage_rc(tid * 16 + i * 8192, R, C); const int Rb = Epi::PERM ? ((R & ~31) + perm32(R & 31)) : R;
        voffA[i] = (unsigned)(R * K + C) * 2u; voffB[i] = (unsigned)(Rb * K + C) * 2u; }
    const size_t kstep = (size_t)(BK * 2);
    const size_t hstep = (size_t)HALF * K * 2;
    const size_t tstep = 2 * hstep;
    const unsigned ldsw = (unsigned)wid * 1024u;
    const int aoff = lds_byte(wr * 64 + fr, fq * 8), boff = lds_byte(wc * 32 + fr, fq * 8);
#define PG8_SA(b, h) (((b) * 2 + (h)) * HTB)
#define PG8_SB(b, h) ((4 + (b) * 2 + (h)) * HTB)
#define PG8_STAGE(bufoff, gbase, voff) do { _Pragma("unroll") for (int _i = 0; _i < 2; ++_i) \
        __builtin_amdgcn_global_load_lds((const unsigned*)((const char*)(gbase) + (voff)[_i]), (PG8_LAS unsigned*)(lds + (bufoff) + ldsw + _i * 8192), 16, 0, 0); } while (0)
#define PG8_LDA(dst, b, h) do { _Pragma("unroll") for (int m = 0; m < 4; ++m) _Pragma("unroll") for (int k = 0; k < 2; ++k) dst[m][k] = *(const PG8_LAS bf16x8*)(lds + PG8_SA(b, h) + aoff + m * 2048 + k * 1024); } while (0)
#define PG8_LDB(dst, b, h) do { _Pragma("unroll") for (int n = 0; n < 2; ++n) _Pragma("unroll") for (int k = 0; k < 2; ++k) dst[n][k] = *(const PG8_LAS bf16x8*)(lds + PG8_SB(b, h) + boff + n * 2048 + k * 1024); } while (0)
#define PG8_MMA(ai, bj, At, Bt) do { __builtin_amdgcn_s_setprio(1); _Pragma("unroll") for (int m = 0; m < 4; ++m) _Pragma("unroll") for (int n = 0; n < 2; ++n) _Pragma("unroll") for (int k = 0; k < 2; ++k) \
        acc[ai][bj][m][n] = __builtin_amdgcn_mfma_f32_16x16x32_bf16(Bt[n][k], At[m][k], acc[ai][bj][m][n], 0, 0, 0); __builtin_amdgcn_s_setprio(0); } while (0)
#define PG8_WAIT_V(n) asm volatile("s_waitcnt vmcnt(" #n ")" ::: "memory")
#define PG8_WAIT_L(n) asm volatile("s_waitcnt lgkmcnt(" #n ")" ::: "memory")
#define PG8_BAR __builtin_amdgcn_s_barrier()
#define PG8_SCHED __builtin_amdgcn_sched_barrier(0)
    Unit cur, nxt; int ui = 0;
    if (!S.next(0, cur)) return;
    f32x4 acc[2][2][4][2];
#pragma unroll
    for (int a = 0; a < 2; ++a)
#pragma unroll
        for (int b = 0; b < 2; ++b)
#pragma unroll
            for (int m = 0; m < 4; ++m)
#pragma unroll
                for (int n = 0; n < 2; ++n) acc[a][b][m][n] = (f32x4){0.f, 0.f, 0.f, 0.f};
    bf16x8 At[4][2], B0[2][2], B1[2][2];
    const char* cA = (const char*)g.A + (size_t)cur.pm * tstep; const char* cB = (const char*)g.Bt + (size_t)cur.pn * tstep;
    S.a_ready(cur);
    if constexpr (SP2) {
        PG8_STAGE(PG8_SB(0, 0), cB, voffB); PG8_STAGE(PG8_SB(0, 1), cB + hstep, voffB); PG8_STAGE(PG8_SA(0, 0), cA, voffA); PG8_STAGE(PG8_SA(0, 1), cA + hstep, voffA);
        if (wr == 1) PG8_BAR;
        PG8_WAIT_V(2); PG8_BAR;
        PG8_STAGE(PG8_SB(1, 0), cB + kstep, voffB); PG8_STAGE(PG8_SA(1, 0), cA + kstep, voffA); PG8_STAGE(PG8_SB(1, 1), cB + hstep + kstep, voffB);
        PG8_WAIT_V(6); PG8_BAR;
    } else {
        PG8_STAGE(PG8_SB(0, 0), cB, voffB); PG8_STAGE(PG8_SA(0, 0), cA, voffA); PG8_STAGE(PG8_SB(0, 1), cB + hstep, voffB); PG8_STAGE(PG8_SA(0, 1), cA + hstep, voffA);
        if (wr == 1) PG8_BAR;
        PG8_WAIT_V(4); PG8_BAR;
        PG8_STAGE(PG8_SB(1, 0), cB + kstep, voffB); PG8_STAGE(PG8_SA(1, 0), cA + kstep, voffA); PG8_STAGE(PG8_SB(1, 1), cB + hstep + kstep, voffB);
        PG8_WAIT_V(6); PG8_BAR;
    }
    for (;;) {
        const bool has_next = S.next(ui + 1, nxt);
        const char* nA = has_next ? (const char*)g.A + (size_t)nxt.pm * tstep : cA; const char* nB = has_next ? (const char*)g.Bt + (size_t)nxt.pn * tstep : cB;
        for (int t = 0; t < nt; t += 2) {
            if constexpr (Epi::MIDSCALE) { if (t == 8) E.midscale(acc, cur, wr, fr); }
            const bool last = (t == nt - 2);
            const char* a1 = cA + (size_t)(t + 1) * kstep;
            const char* a2 = last ? nA : cA + (size_t)(t + 2) * kstep; const char* b2 = last ? nB : cB + (size_t)(t + 2) * kstep;
            const char* a3 = a2 + kstep; const char* b3 = b2 + kstep;
            if (last && has_next) S.a_ready(nxt);
            if constexpr (SP2) {
            PG8_LDB(B0, 0, 0); PG8_LDB(B1, 0, 1); PG8_SCHED; PG8_LDA(At, 0, 0); PG8_STAGE(PG8_SA(1, 1), a1 + hstep, voffA);
            PG8_WAIT_V(8); PG8_WAIT_L(0); PG8_BAR; PG8_MMA(0, 0, At, B0); PG8_MMA(0, 1, At, B1); PG8_BAR; PG8_SCHED;
            PG8_LDA(At, 0, 1); PG8_STAGE(PG8_SB(0, 0), b2, voffB); PG8_STAGE(PG8_SB(0, 1), b2 + hstep, voffB); PG8_STAGE(PG8_SA(0, 0), a2, voffA);
            PG8_WAIT_V(8); PG8_WAIT_L(0); PG8_BAR; PG8_MMA(1, 0, At, B0); PG8_MMA(1, 1, At, B1); PG8_BAR; PG8_SCHED;
            PG8_LDB(B0, 1, 0); PG8_LDB(B1, 1, 1); PG8_SCHED; PG8_LDA(At, 1, 0); PG8_STAGE(PG8_SA(0, 1), a2 + hstep, voffA);
            PG8_WAIT_V(8); PG8_WAIT_L(0); PG8_BAR; PG8_MMA(0, 0, At, B0); PG8_MMA(0, 1, At, B1); PG8_BAR; PG8_SCHED;
            PG8_LDA(At, 1, 1); PG8_STAGE(PG8_SB(1, 0), b3, voffB); PG8_STAGE(PG8_SB(1, 1), b3 + hstep, voffB); PG8_STAGE(PG8_SA(1, 0), a3, voffA);
            PG8_WAIT_V(8); PG8_WAIT_L(0); PG8_BAR; PG8_MMA(1, 0, At, B0); PG8_MMA(1, 1, At, B1); PG8_BAR; PG8_SCHED;
            } else {
            PG8_LDB(B0, 0, 0); PG8_SCHED; PG8_LDA(At, 0, 0); PG8_STAGE(PG8_SA(1, 1), a1 + hstep, voffA);
            PG8_WAIT_L(8); PG8_BAR; PG8_WAIT_L(0); PG8_MMA(0, 0, At, B0); PG8_BAR; PG8_SCHED;
            PG8_LDB(B1, 0, 1); PG8_STAGE(PG8_SB(0, 0), b2, voffB);
            PG8_BAR; PG8_WAIT_L(0); PG8_MMA(0, 1, At, B1); PG8_BAR;
            PG8_LDA(At, 0, 1); PG8_STAGE(PG8_SA(0, 0), a2, voffA);
            PG8_BAR; PG8_WAIT_L(0); PG8_MMA(1, 0, At, B0); PG8_BAR; PG8_SCHED;
            PG8_STAGE(PG8_SB(0, 1), b2 + hstep, voffB);
            PG8_WAIT_V(6); PG8_BAR; PG8_MMA(1, 1, At, B1); PG8_BAR;
            PG8_LDB(B0, 1, 0); PG8_SCHED; PG8_LDA(At, 1, 0); PG8_STAGE(PG8_SA(0, 1), a2 + hstep, voffA);
            PG8_WAIT_L(8); PG8_BAR; PG8_WAIT_L(0); PG8_MMA(0, 0, At, B0); PG8_BAR; PG8_SCHED;
            PG8_LDB(B1, 1, 1); PG8_STAGE(PG8_SB(1, 0), b3, voffB);
            PG8_BAR; PG8_WAIT_L(0); PG8_MMA(0, 1, At, B1); PG8_BAR;
            PG8_LDA(At, 1, 1); PG8_STAGE(PG8_SA(1, 0), a3, voffA);
            PG8_BAR; PG8_WAIT_L(0); PG8_MMA(1, 0, At, B0); PG8_BAR; PG8_SCHED;
            PG8_STAGE(PG8_SB(1, 1), b3 + hstep, voffB);
            PG8_WAIT_V(6); PG8_BAR; PG8_MMA(1, 1, At, B1); PG8_BAR;
            }
        }
        if constexpr (ALIGN_EPI) { if (wr == 0) PG8_BAR; }
        if constexpr (!Epi::AFTER_DRAIN) { E(acc, cur, wr, wc, fr, fq); S.done(cur); }
        if (!has_next) break;
#pragma unroll
        for (int a = 0; a < 2; ++a)
#pragma unroll
            for (int b = 0; b < 2; ++b)
#pragma unroll
                for (int m = 0; m < 4; ++m)
#pragma unroll
                    for (int n = 0; n < 2; ++n) acc[a][b][m][n] = (f32x4){0.f, 0.f, 0.f, 0.f};
        cur = nxt; cA = nA; cB = nB; ++ui;
        if constexpr (ALIGN_EPI) { if (wr == 1) PG8_BAR; }
    }
    PG8_WAIT_V(0);
    if constexpr (!ALIGN_EPI) { if (wr == 0) PG8_BAR; }
    PG8_BAR;
    if constexpr (Epi::AFTER_DRAIN) { E.fused(acc, cur, wr, wc, fr, fq, lds, wid, lane); S.done(cur); }
#undef PG8_SA
#undef PG8_SB
#undef PG8_STAGE
#undef PG8_LDA
#undef PG8_LDB
#undef PG8_MMA
#undef PG8_WAIT_V
#undef PG8_WAIT_L
#undef PG8_BAR
#undef PG8_SCHED
}
}

struct EpiInProj {
  static constexpr bool PERM = false, AFTER_DRAIN = false, MIDSCALE = false;
  unsigned char* ws;
  DEVI void operator()(const f32x4 (&acc)[2][2][4][2], const pg8::Unit& u, int wr, int wc, int fr, int fq) const {
    bf16_t* PROJ = (bf16_t*)(ws + OFF_PROJ); bf16_t* VT = (bf16_t*)(ws + OFF_VT); const float* rc = (const float*)(ws + OFF_ROPE);
    const int rowb = u.pm * 256 + wr * 64 + fr;
#pragma unroll
    for (int bj = 0; bj < 2; ++bj) {
      const int cb = u.pn * 256 + bj * 128;
      const bool isv = (cb == 1152) || (cb == 1536) || (cb == 1664);
      const bool do_rope = (cb < 256) || (cb == 1024);
      const float qs = cb < 512 ? 0.125f : 1.f;
      const int vchb = (cb == 1152 ? 0 : 128 + (cb - 1536)) + 32 * wc + 4 * fq;
#pragma unroll
      for (int ai = 0; ai < 2; ++ai)
#pragma unroll
        for (int m = 0; m < 4; ++m) {
          const int row = rowb + 128 * ai + 16 * m;
          f32x4 v0 = acc[ai][bj][m][0], v1 = acc[ai][bj][m][1];
          if (isv) {
#pragma unroll
            for (int e = 0; e < 4; ++e) { VT[(unsigned)((vchb + e) * TT + row)] = (bf16_t)(cvt_pk(v0[e], 0.f) & 0xffffu); VT[(unsigned)((vchb + 16 + e) * TT + row)] = (bf16_t)(cvt_pk(v1[e], 0.f) & 0xffffu); }
          } else {
            if (do_rope && row < T) {
              const int pos = row & 4095, pp = (wc & 1) ? (pos & 63) : (pos >> 6);
              const f32x4 cs = *(const f32x4*)(rc + pp * 16 + 4 * fq), sn = *(const f32x4*)(rc + 1024 + pp * 16 + 4 * fq);
#pragma unroll
              for (int e = 0; e < 4; ++e) { const float x1 = v0[e], x2 = v1[e]; v0[e] = x1 * cs[e] - x2 * sn[e]; v1[e] = x2 * cs[e] + x1 * sn[e]; }
            }
            u32x2 o0, o1; o0.x = cvt_pk(v0[0] * qs, v0[1] * qs); o0.y = cvt_pk(v0[2] * qs, v0[3] * qs); o1.x = cvt_pk(v1[0] * qs, v1[1] * qs); o1.y = cvt_pk(v1[2] * qs, v1[3] * qs);
            bf16_t* dst = PROJ + (unsigned)(row * PW + cb + 32 * wc + 4 * fq);
            *(u32x2*)dst = o0; *(u32x2*)(dst + 16) = o1;
          }
        }
    }
  }
};
struct EpiSwiglu {
  static constexpr bool PERM = false, AFTER_DRAIN = false, MIDSCALE = false;
  unsigned char* ws;
  DEVI void operator()(const f32x4 (&acc)[2][2][4][2], const pg8::Unit& u, int wr, int wc, int fr, int fq) const {
    bf16_t* G = (bf16_t*)(ws + OFF_PROJ);
    const int rowb = u.pm * 256 + wr * 64 + fr;
#pragma unroll
    for (int bj = 0; bj < 2; ++bj)
#pragma unroll
      for (int ai = 0; ai < 2; ++ai)
#pragma unroll
        for (int m = 0; m < 4; ++m) {
          const int row = rowb + 128 * ai + 16 * m;
          float o[4];
#pragma unroll
          for (int e = 0; e < 4; ++e) o[e] = silu_f(acc[ai][bj][m][0][e]) * acc[ai][bj][m][1][e];
          u32x2 ov; ov.x = cvt_pk(o[0], o[1]); ov.y = cvt_pk(o[2], o[3]);
          *(u32x2*)(G + (unsigned)(row * 2816 + u.pn * 128 + bj * 64 + wc * 16 + 4 * fq)) = ov;
        }
  }
};
template <bool MID>
struct EpiResid {
  static constexpr bool PERM = false, AFTER_DRAIN = false, MIDSCALE = MID;
  unsigned char* ws; const float* rin_lat; const float* rin_ctx; float* rout_lat; float* rout_ctx; int layer, gate_idx;
  DEVI void midscale(f32x4 (&acc)[2][2][4][2], const pg8::Unit& u, int wr, int fr) const {
    const float* ssq = (const float*)(ws + OFF_SSQ) + u.pm * 256 + wr * 64 + fr;
#pragma unroll
    for (int ai = 0; ai < 2; ++ai)
#pragma unroll
      for (int m = 0; m < 4; ++m) {
        const float rs = rsqrtf(ssq[128 * ai + 16 * m] * (1.f / 512.f) + EPSN);
#pragma unroll
        for (int bj = 0; bj < 2; ++bj) { acc[ai][bj][m][0] = acc[ai][bj][m][0] * rs; acc[ai][bj][m][1] = acc[ai][bj][m][1] * rs; }
      }
  }
  DEVI void operator()(const f32x4 (&acc)[2][2][4][2], const pg8::Unit& u, int wr, int wc, int fr, int fq) const {
    const bool lat = u.pm < T / 256;
    const int mr = lat ? (u.pm >> 4) : 4;
    const float* gpb = (const float*)(ws + OFF_MODS) + (size_t)(layer * 5 + mr) * 6144 + gate_idx * 1024;
    const float* rinb = lat ? rin_lat : rin_ctx; float* routb = lat ? rout_lat : rout_ctx;
    const int col0 = u.pn * 256 + wc * 32 + 4 * fq;
    const unsigned off0 = (unsigned)(((lat ? u.pm : u.pm - T / 256) * 256 + wr * 64 + fr) * 1024 + col0);
#pragma unroll
    for (int bj = 0; bj < 2; ++bj)
#pragma unroll
      for (int n = 0; n < 2; ++n) {
        const f32x4 gv = *(const f32x4*)(gpb + col0 + 128 * bj + 16 * n);
#pragma unroll
        for (int ai = 0; ai < 2; ++ai)
#pragma unroll
          for (int m = 0; m < 4; ++m) {
            const unsigned off = off0 + (unsigned)((128 * ai + 16 * m) * 1024 + 128 * bj + 16 * n);
            const f32x4 rv = *(const f32x4*)(rinb + off);
            f32x4 o;
#pragma unroll
            for (int e = 0; e < 4; ++e) o[e] = rv[e] + gv[e] * acc[ai][bj][m][n][e];
            *(f32x4*)(routb + off) = o;
          }
      }
  }
};
constexpr int MODE_INPROJ = 0, MODE_RESID = 1, MODE_SWIGLU = 2;
template <int MODE, bool ASCALE>
DEVI void gemm_phase(const Params& P, int layer) {
  constexpr int K = (MODE == MODE_RESID && !ASCALE) ? 2816 : 1024;
  constexpr int N = MODE == MODE_INPROJ ? 2816 : (MODE == MODE_SWIGLU ? 5632 : 1024);
  const int M = (MODE == MODE_INPROJ || (layer == 0 && MODE != MODE_RESID)) ? TT : T;
  const bf16_t* A = (const bf16_t*)(P.ws + ((MODE == MODE_RESID && !ASCALE) ? OFF_PROJ : OFF_H));
  const bf16_t* Wt = (const bf16_t*)(P.ws + (MODE == MODE_INPROJ ? OFF_WIN : MODE == MODE_SWIGLU ? OFF_WFI : ASCALE ? OFF_WOUT : OFF_WFO));
  pg8::Gemm g{A, Wt, M, N, K}; pg8::StaticOrder S; S.init(M, N, (int)gridDim.x, (int)blockIdx.x);
  PG8_LAS unsigned char* lds = (PG8_LAS unsigned char*)smem;
  if constexpr (MODE == MODE_INPROJ) {
    EpiInProj E{P.ws};
    pg8::gemm_phase<EpiInProj, pg8::StaticOrder, true, true>(lds, g, S, E);
    const int lane = threadIdx.x & 63, r = lane & 15, q = lane >> 4;
    const bf16_t* Wd = Wt + (size_t)(2816 + r) * 1024 + 8 * q;
    float* DTb = (float*)(P.ws + OFF_DT);
    for (int tile = blockIdx.x * 8 + (threadIdx.x >> 6); tile < TT / 16; tile += gridDim.x * 8) {
      const bf16_t* Ar = A + (size_t)(16 * tile + r) * 1024 + 8 * q;
      f32x4 acc = (f32x4){0.f, 0.f, 0.f, 0.f};
#pragma unroll 8
      for (int s2 = 0; s2 < 32; ++s2) acc = mfma16(*(const bf16x8*)(Ar + 32 * s2), *(const bf16x8*)(Wd + 32 * s2), acc);
#pragma unroll
      for (int e = 0; e < 4; ++e) DTb[(size_t)(16 * tile + 4 * q + e) * 16 + r] = acc[e];
    }
  } else if constexpr (MODE == MODE_SWIGLU) {
    EpiSwiglu E{P.ws};
    pg8::gemm_phase<EpiSwiglu, pg8::StaticOrder, true, true>(lds, g, S, E);
  } else {
    float* XCp = (float*)(P.ws + OFF_XC);
    EpiResid<ASCALE> E{P.ws, (ASCALE && layer == 0) ? P.x : P.out, (ASCALE && layer == 0) ? P.ctx : XCp, P.out, XCp, layer, ASCALE ? 2 : 5};
    pg8::gemm_phase<EpiResid<ASCALE>, pg8::StaticOrder, true, true>(lds, g, S, E);
    if (layer == 0) {
      const int lane = threadIdx.x & 63, r = lane & 15, q = lane >> 4, w8 = threadIdx.x >> 6;
      const float* gpb = (const float*)(P.ws + OFF_MODS) + (size_t)(layer * 5 + 4) * 6144 + (ASCALE ? 2 : 5) * 1024;
      const float* rinb = ASCALE ? P.ctx : XCp;
      const float* ssq = (const float*)(P.ws + OFF_SSQ) + T;
      constexpr int PER = K / 32 / 8;
      float* part = (float*)smem;
      for (int tl = blockIdx.x; tl < 256; tl += gridDim.x) {
        const int r0 = (tl >> 4) * 64, n0 = (tl & 15) * 64;
        const bf16_t* Ar = A + (size_t)(T + r0 + r) * K + w8 * PER * 32 + 8 * q;
        const bf16_t* Br = Wt + (size_t)(n0 + r) * K + w8 * PER * 32 + 8 * q;
        f32x4 acc[4][4];
#pragma unroll
        for (int i = 0; i < 4; ++i)
#pragma unroll
          for (int j = 0; j < 4; ++j) acc[i][j] = (f32x4){0.f, 0.f, 0.f, 0.f};
#pragma unroll 2
        for (int s2 = 0; s2 < PER; ++s2) {
          bf16x8 af[4], bfr[4];
#pragma unroll
          for (int i = 0; i < 4; ++i) { af[i] = *(const bf16x8*)(Ar + (size_t)(16 * i) * K + 32 * s2); bfr[i] = *(const bf16x8*)(Br + (size_t)(16 * i) * K + 32 * s2); }
#pragma unroll
          for (int i = 0; i < 4; ++i)
#pragma unroll
            for (int j = 0; j < 4; ++j) acc[i][j] = mfma16(af[i], bfr[j], acc[i][j]);
        }
        const bool sc = ASCALE && w8 < 4;
#pragma unroll
        for (int i = 0; i < 4; ++i)
#pragma unroll
          for (int e = 0; e < 4; ++e) {
            const float rs = sc ? rsqrtf(ssq[r0 + 16 * i + 4 * q + e] * (1.f / 512.f) + EPSN) : 1.f;
#pragma unroll
            for (int j = 0; j < 4; ++j) part[w8 * 4096 + (16 * i + 4 * q + e) * 64 + 16 * j + r] = acc[i][j][e] * rs;
          }
        __syncthreads();
#pragma unroll
        for (int k = 0; k < 8; ++k) {
          const int o = (int)threadIdx.x + 512 * k, row = o >> 6, col = o & 63;
          float sum = 0.f;
#pragma unroll
          for (int pw = 0; pw < 8; ++pw) sum += part[pw * 4096 + o];
          const unsigned off = (unsigned)((r0 + row) * 1024 + n0 + col);
          XCp[off] = rinb[off] + gpb[n0 + col] * sum;
        }
        __syncthreads();
      }
    }
  }
}

template <int KIND>
NOINL void attn_item(const Params& P, int layer, int b, int i1, int i2, int isctx_) {
  unsigned char* const smh = smem + half_id() * HSTR;
  const bool isctx = isctx_ != 0;
  constexpr int NQT = (KIND == 1) ? 1 : 2;
  const int t = tid_opq(), lane = t & 63, w = t >> 6, r = lane & 15, q = lane >> 4, r7 = r & 7;
  const bf16_t* PROJ = (const bf16_t*)(P.ws + OFF_PROJ);
  const bf16_t* VT = (const bf16_t*)(P.ws + OFF_VT);
  bf16_t* MIX = (bf16_t*)(P.ws + OFF_H);
  constexpr bool DBL = (KIND == 1);
  constexpr int VSTR = DBL ? 272 : 136;
  unsigned char* Ks = smh; unsigned char* Vs = smh + (DBL ? 16384 : 8192); float* rpb = (float*)(smh + 33792);
  const int col0 = w == 0 ? 0 : (w == 1 ? 8 : (w == 2 ? 24 : 32));
  int qrow[NQT]; int qcol, kcol, vch, ocol, ntile; bool has_sink = false; float sinkv = 0.f;
  int r0g = 0;
  if (KIND == 0 && !isctx) {
    const int n = i1, head = i2;
#pragma unroll
    for (int qt = 0; qt < NQT; ++qt) qrow[qt] = b * 4096 + 128 * n + 32 * w + 16 * qt + r;
    qcol = head * 64; kcol = 1024 + (head >> 1) * 64; vch = (head >> 1) * 64; ocol = 512 + head * 64; ntile = 10; has_sink = true; sinkv = P.wa_sink[layer * 4 + head];
  } else if (KIND == 1) {
    const int gr = i1, h = i2;
    qrow[0] = b * 4096 + gr * 64 + 16 * w + r;
    qcol = 256 + 64 * h; kcol = 1280 + 64 * h; vch = 128 + 64 * h; ocol = 768 + 64 * h; ntile = 8;
    r0g = gr - 4 < 0 ? 0 : (gr - 4 > 56 ? 56 : gr - 4);
    __syncthreads();
    for (int e = t; e < 465; e += 256) rpb[e] = P.na_rpb[(size_t)(layer * 4 + h) * 465 + e];
  } else {
    const int qb = i1, hh = i2;
#pragma unroll
    for (int qt = 0; qt < NQT; ++qt) qrow[qt] = T + b * 256 + 128 * qb + 32 * w + 16 * qt + r;
    ntile = 4;
    if (hh < 4) { qcol = hh * 64; kcol = 1024 + (hh >> 1) * 64; vch = (hh >> 1) * 64; ocol = 512 + hh * 64; has_sink = true; sinkv = P.wa_sink[layer * 4 + hh]; }
    else { const int h = hh - 4; qcol = 256 + 64 * h; kcol = 1280 + 64 * h; vch = 128 + 64 * h; ocol = 768 + 64 * h; }
  }
  bf16x8 qf[NQT][2];
#pragma unroll
  for (int qt = 0; qt < NQT; ++qt)
#pragma unroll
    for (int s = 0; s < 2; ++s) qf[qt][s] = *(const bf16x8*)(PROJ + (size_t)qrow[qt] * PW + qcol + 32 * s + 8 * q);
  f32x4 o[4][NQT]; float mrun[NQT], lrun[NQT];
#pragma unroll
  for (int qt = 0; qt < NQT; ++qt) { mrun[qt] = -1e30f; lrun[qt] = 0.f;
#pragma unroll
    for (int dt = 0; dt < 4; ++dt) o[dt][qt] = (f32x4){0.f, 0.f, 0.f, 0.f}; }

  const int skip = (KIND == 0 && !isctx && i1 == 0) ? 2 : 0;
  const int nvalid = ntile - skip - ((KIND == 0 && !isctx && i1 == 31) ? 2 : 0);
  const int skey = t >> 2, sc0 = (t & 3) * 2;
  u32x4 pk0, pk1, pv0, pv1, pk2, pk3, pv2, pv3;
#define KV_ROW0(IDX, TI, KROW0) const int TI = (IDX) < 4 ? (IDX) : (IDX) + skip; \
    const int KROW0 = TI < 4 ? T + b * 256 + 64 * TI : (KIND == 1 ? b * 4096 + (r0g + 2 * (TI - 4)) * 64 : b * 4096 + 128 * (i1 - 1) + 64 * (TI - 4));
#define KV_LOAD(IDX) { KV_ROW0(IDX, ti_, kr0_) \
    const bf16_t* kp = PROJ + (size_t)(kr0_ + skey) * PW + kcol + sc0 * 8; pk0 = *(const u32x4*)kp; pk1 = *(const u32x4*)(kp + 8); \
    const bf16_t* vp = VT + (size_t)(vch + skey) * TT + kr0_ + sc0 * 8; pv0 = *(const u32x4*)vp; pv1 = *(const u32x4*)(vp + 8); \
    if (DBL && ti_ >= 4) { pk2 = *(const u32x4*)(kp + 64 * PW); pk3 = *(const u32x4*)(kp + 64 * PW + 8); pv2 = *(const u32x4*)(vp + 64); pv3 = *(const u32x4*)(vp + 72); } }
  KV_LOAD(0);
#pragma unroll 1
  for (int idx = 0; idx < nvalid; ++idx) {
    KV_ROW0(idx, ti, krow0)
    (void)krow0;
    const int kbase = 128 * (i1 - 1) + 64 * (ti - 4); const int kr = r0g + 2 * (ti - 4);
    const bool local2 = DBL && ti >= 4;
    __syncthreads();
    {
      *(u32x4*)(Ks + skey * 128 + ((sc0 ^ (skey & 7)) << 4)) = pk0; *(u32x4*)(Ks + skey * 128 + (((sc0 + 1) ^ (skey & 7)) << 4)) = pk1;
      u32x2* dst = (u32x2*)(Vs + skey * VSTR + sc0 * 16);
      dst[0] = (u32x2){pv0.x, pv0.y}; dst[1] = (u32x2){pv0.z, pv0.w}; dst[2] = (u32x2){pv1.x, pv1.y}; dst[3] = (u32x2){pv1.z, pv1.w};
      if (local2) {
        *(u32x4*)(Ks + (skey + 64) * 128 + ((sc0 ^ (skey & 7)) << 4)) = pk2; *(u32x4*)(Ks + (skey + 64) * 128 + (((sc0 + 1) ^ (skey & 7)) << 4)) = pk3;
        u32x2* dst2 = (u32x2*)(Vs + skey * VSTR + 128 + sc0 * 16);
        dst2[0] = (u32x2){pv2.x, pv2.y}; dst2[1] = (u32x2){pv2.z, pv2.w}; dst2[2] = (u32x2){pv3.x, pv3.y}; dst2[3] = (u32x2){pv3.z, pv3.w};
      }
    }
    __syncthreads();
    if (idx + 1 < nvalid) KV_LOAD(idx + 1);
    f32x4 sc[4][NQT];
#pragma unroll
    for (int kt = 0; kt < 4; ++kt) {
      const int krow = (local2 ? (kt >> 1) * 64 + col0 + 16 * (kt & 1) : 16 * kt) + r;
      const bf16x8 kf0 = *(const bf16x8*)(Ks + krow * 128 + ((q ^ r7) << 4));
      const bf16x8 kf1 = *(const bf16x8*)(Ks + krow * 128 + (((4 + q) ^ r7) << 4));
#pragma unroll
      for (int qt = 0; qt < NQT; ++qt) { sc[kt][qt] = mfma16(kf0, qf[qt][0], (f32x4){0.f, 0.f, 0.f, 0.f}); sc[kt][qt] = mfma16(kf1, qf[qt][1], sc[kt][qt]); }
    }
    if (ti >= 4) {
      if (KIND == 0) {
#pragma unroll
        for (int qt = 0; qt < NQT; ++qt) { const int qpos = 128 * i1 + 32 * w + 16 * qt + r;
#pragma unroll
          for (int kt = 0; kt < 4; ++kt)
#pragma unroll
            for (int e = 0; e < 4; ++e) { const int d = qpos - (kbase + 16 * kt + 4 * q + e); if (d > 128 || d < -128) sc[kt][qt][e] = -1e30f; } }
      } else if (KIND == 1) {
        const int qc = 16 * w + r; const int cs = qc - 8 < 0 ? 0 : (qc - 8 > 48 ? 48 : qc - 8);
#pragma unroll
        for (int kt = 0; kt < 4; ++kt) {
          const int dy = kr + (kt >> 1) - i1 + 7;
#pragma unroll
          for (int e = 0; e < 4; ++e) { const int kc = col0 + 16 * (kt & 1) + 4 * q + e; const bool ok = (kc >= cs) && (kc < cs + 16);
            int dx = kc - qc + 15; dx = dx < 0 ? 0 : (dx > 30 ? 30 : dx);
            sc[kt][0][e] = ok ? sc[kt][0][e] + rpb[dy * 31 + dx] : -1e30f; }
        }
      }
    }
    bf16x8 pf[2][NQT];
#pragma unroll
    for (int qt = 0; qt < NQT; ++qt) {
      float mx = -1e30f;
#pragma unroll
      for (int kt = 0; kt < 4; ++kt)
#pragma unroll
        for (int e = 0; e < 4; ++e) mx = fmaxf(mx, sc[kt][qt][e]);
      mx = fmaxf(mx, __shfl_xor(mx, 16)); mx = fmaxf(mx, __shfl_xor(mx, 32));
      const float mn = fmaxf(mrun[qt], mx); const float alpha = __expf(mrun[qt] - mn); mrun[qt] = mn;
      float ls = 0.f;
#pragma unroll
      for (int kt = 0; kt < 4; ++kt)
#pragma unroll
        for (int e = 0; e < 4; ++e) { const float p = __expf(sc[kt][qt][e] - mn); sc[kt][qt][e] = p; ls += p; }
      lrun[qt] = lrun[qt] * alpha + ls;
#pragma unroll
      for (int dt = 0; dt < 4; ++dt) o[dt][qt] = o[dt][qt] * alpha;
#pragma unroll
      for (int s = 0; s < 2; ++s) {
        u32x4 pk; pk.x = cvt_pk(sc[2 * s][qt][0], sc[2 * s][qt][1]); pk.y = cvt_pk(sc[2 * s][qt][2], sc[2 * s][qt][3]);
        pk.z = cvt_pk(sc[2 * s + 1][qt][0], sc[2 * s + 1][qt][1]); pk.w = cvt_pk(sc[2 * s + 1][qt][2], sc[2 * s + 1][qt][3]);
        pf[s][qt] = as_bf16x8(pk);
      }
    }
#pragma unroll
    for (int s = 0; s < 2; ++s)
#pragma unroll
      for (int dt = 0; dt < 4; ++dt) {
        const int vkb = local2 ? 64 * s + col0 : 32 * s;
        const u32x2 lo = *(const u32x2*)(Vs + (16 * dt + r) * VSTR + (vkb + 4 * q) * 2);
        const u32x2 hi = *(const u32x2*)(Vs + (16 * dt + r) * VSTR + (vkb + 16 + 4 * q) * 2);
        const bf16x8 vf = as_bf16x8((u32x4){lo.x, lo.y, hi.x, hi.y});
#pragma unroll
        for (int qt = 0; qt < NQT; ++qt) o[dt][qt] = mfma16(vf, pf[s][qt], o[dt][qt]);
      }
  }
#pragma unroll
  for (int qt = 0; qt < NQT; ++qt) {
    float l = lrun[qt]; l += __shfl_xor(l, 16); l += __shfl_xor(l, 32);
    float mf = mrun[qt]; float scale;
    if (has_sink) { const float m2 = fmaxf(mf, sinkv); const float a = __expf(mf - m2); l = l * a + __expf(sinkv - m2); scale = a / l; }
    else scale = 1.f / l;
#pragma unroll
    for (int dt = 0; dt < 4; ++dt) {
      u32x2 ov; ov.x = cvt_pk(o[dt][qt][0] * scale, o[dt][qt][1] * scale); ov.y = cvt_pk(o[dt][qt][2] * scale, o[dt][qt][3] * scale);
      *(u32x2*)(MIX + (size_t)qrow[qt] * 1024 + ocol + 16 * dt + 4 * q) = ov;
    }
  }
}

DEVI void ssd_load_raw(unsigned char* raw, const bf16_t* PROJ, int rowbase, int lo, int hi, int col0) {
  for (int e = tid_opq(); e < 134 * 8; e += 256) {
    const int rr = e >> 3, ch = e & 7; const int row = rowbase - 3 + rr;
    u32x4 v = (u32x4){0u, 0u, 0u, 0u};
    if (row >= lo && row < hi) v = *(const u32x4*)(PROJ + (size_t)row * PW + col0 + ch * 8);
    *(u32x4*)(raw + rr * 128 + ch * 16) = v;
  }
}

template <bool TRANSP, bool WEIGHTED>
DEVI void ssd_conv(const unsigned char* raw, const float* cw  , const float* cb, unsigned char* out1, unsigned char* out2, const float* wt1, const float* wt2) {
  const int t_ = tid_opq(); const int c = t_ & 63, tq = t_ >> 6;
  float wj[7];
#pragma unroll
  for (int j = 0; j < 7; ++j) wj[j] = cw[j * 1024 + c];
  const float bias = cb[c];
  const bf16_t* rp = (const bf16_t*)raw + c;
  float w0 = bf2f(rp[(32 * tq + 0) * 64]), w1 = bf2f(rp[(32 * tq + 1) * 64]), w2 = bf2f(rp[(32 * tq + 2) * 64]), w3 = bf2f(rp[(32 * tq + 3) * 64]), w4 = bf2f(rp[(32 * tq + 4) * 64]), w5 = bf2f(rp[(32 * tq + 5) * 64]);
  float hold1[4], hold2[4];
#pragma unroll 1
  for (int tg = 0; tg < 8; ++tg) {
#pragma unroll
    for (int t4 = 0; t4 < 4; ++t4) {
      const int tok = 32 * tq + 4 * tg + t4;
      const float w6 = bf2f(rp[(tok + 6) * 64]);
      float v = bias + wj[0] * w0 + wj[1] * w1 + wj[2] * w2 + wj[3] * w3 + wj[4] * w4 + wj[5] * w5 + wj[6] * w6;
      v = silu_f(v);
      w0 = w1; w1 = w2; w2 = w3; w3 = w4; w4 = w5; w5 = w6;
      if (TRANSP) {
        hold1[t4] = WEIGHTED ? v * wt1[tok] : v;
        if (WEIGHTED) hold2[t4] = v * wt2[tok];
        if (t4 == 3) {
          u32x2 o; o.x = cvt_pk(hold1[0], hold1[1]); o.y = cvt_pk(hold1[2], hold1[3]);
          *(u32x2*)(out1 + c * 272 + (tok - 3) * 2) = o;
          if (WEIGHTED) { u32x2 o2; o2.x = cvt_pk(hold2[0], hold2[1]); o2.y = cvt_pk(hold2[2], hold2[3]); *(u32x2*)(out2 + c * 272 + (tok - 3) * 2) = o2; }
        }
      } else {
        *(bf16_t*)(out1 + tok * 128 + (((c >> 3) ^ (tok & 7)) << 4) + (c & 7) * 2) = (bf16_t)(cvt_pk(v, 0.f) & 0xffffu);
      }
    }
  }
}

constexpr int SM_RAW = 0, SM_X1 = 17152, SM_X2 = 34560, SM_BT = 51968, SM_SMALL = 69376;
constexpr int SM_XT = 17152, SM_BN = 34560, SM_CN = 50944;

NOINL void conv_item(const Params& P, int layer, int b, int cidx, int slab) {
  unsigned char* const smh = smem + half_id() * HSTR;
  const int t = tid_opq(), c = t & 63, tq = t >> 6;
  const bf16_t* PROJ = (const bf16_t*)(P.ws + OFF_PROJ);
  bf16_t* XN = (bf16_t*)(P.ws + OFF_XN);
  int rowbase, lo, hi;
  if (cidx < 2) { lo = T + b * 256; hi = lo + 256; rowbase = lo + cidx * 128; } else { lo = b * 4096; hi = lo + 4096; rowbase = lo + (cidx - 2) * 128; }
  __syncthreads();
  ssd_load_raw(smh + SM_RAW, PROJ, rowbase, lo, hi, 1792 + slab * 64);
  __syncthreads();
  const float* cw = P.conv_w + (size_t)layer * 7 * 1024 + slab * 64 + c;
  float wj[7];
#pragma unroll
  for (int j = 0; j < 7; ++j) wj[j] = cw[j * 1024];
  const float bias = P.conv_b[layer * 1024 + slab * 64 + c];
  const bf16_t* rp = (const bf16_t*)(smh + SM_RAW) + c;
  float w0 = bf2f(rp[(32 * tq + 0) * 64]), w1 = bf2f(rp[(32 * tq + 1) * 64]), w2 = bf2f(rp[(32 * tq + 2) * 64]), w3 = bf2f(rp[(32 * tq + 3) * 64]), w4 = bf2f(rp[(32 * tq + 4) * 64]), w5 = bf2f(rp[(32 * tq + 5) * 64]);
  const bool nat = slab >= 8, tr = slab < 12;
  bf16_t* trp = slab < 8 ? (bf16_t*)(P.ws + OFF_XTX) + (size_t)(slab * 64 + c) * TT : (bf16_t*)(P.ws + OFF_XTB) + (size_t)((slab - 8) * 64 + c) * TT;
#pragma unroll 1
  for (int tg = 0; tg < 4; ++tg) {
    float hold[8];
#pragma unroll
    for (int t8 = 0; t8 < 8; ++t8) {
      const int tok = 32 * tq + 8 * tg + t8;
      const float w6 = bf2f(rp[(tok + 6) * 64]);
      float v = bias + wj[0] * w0 + wj[1] * w1 + wj[2] * w2 + wj[3] * w3 + wj[4] * w4 + wj[5] * w5 + wj[6] * w6;
      v = silu_f(v);
      w0 = w1; w1 = w2; w2 = w3; w3 = w4; w4 = w5; w5 = w6;
      hold[t8] = v;
      if (nat) XN[(size_t)(rowbase + tok) * 512 + (slab - 8) * 64 + c] = (bf16_t)(cvt_pk(v, 0.f) & 0xffffu);
    }
    if (tr) {
      u32x4 o; o.x = cvt_pk(hold[0], hold[1]); o.y = cvt_pk(hold[2], hold[3]); o.z = cvt_pk(hold[4], hold[5]); o.w = cvt_pk(hold[6], hold[7]);
      *(u32x4*)(trp + rowbase + 32 * tq + 8 * tg) = o;
    }
  }
}

NOINL void ssd_state_item(const Params& P, int layer, int b, int cidx, int h) {
  unsigned char* const smh = smem + half_id() * HSTR;
  const int t = tid_opq(), lane = t & 63, w = t >> 6, r = lane & 15, q = lane >> 4;
  const bf16_t* PROJ = (const bf16_t*)(P.ws + OFF_PROJ);
  const float* DTb = (const float*)(P.ws + OFF_DT);
  bf16_t* ST = (bf16_t*)(P.ws + OFF_ST);
  float* CD = (float*)(P.ws + OFF_CD);
  float* sm = (float*)(smh + SM_SMALL);
  int rowbase, lo, hi;
  if (cidx < 2) { lo = T + b * 256; hi = lo + 256; rowbase = lo + cidx * 128; } else { lo = b * 4096; hi = lo + 4096; rowbase = lo + (cidx - 2) * 128; }
  const int g = h >> 2;
  const float Af = -__expf(P.a_log[layer * 16 + h]), Ab = -__expf(P.a_log[layer * 16 + 8 + h]);
  __syncthreads();
  float inf_ = 0.f, inb_ = 0.f, ab_ = 0.f;
  if (t < 128) {
    const float df = softplus_f(DTb[(size_t)(rowbase + t) * 16 + h] + P.dt_bias[layer * 16 + h]);
    const float db = softplus_f(DTb[(size_t)(rowbase + t) * 16 + 8 + h] + P.dt_bias[layer * 16 + 8 + h]);
    sm[256 + t] = df; sm[384 + t] = db;
    ab_ = db * Ab; inf_ = wave_incl_scan(df * Af, lane); inb_ = wave_incl_scan(ab_, lane);
    if (lane == 63) { sm[772 + w] = inf_; sm[774 + w] = inb_; }
  }
  __syncthreads();
  if (t < 128) {
    const float acf = inf_ + (w == 1 ? sm[772] : 0.f), totf = sm[772] + sm[773];
    const float preb = inb_ - ab_ + (w == 1 ? sm[774] : 0.f), totb = sm[774] + sm[775];
    sm[512 + t] = __expf(totf - acf) * sm[256 + t];
    sm[640 + t] = __expf(preb) * sm[384 + t];
    if (t == 0) { const int seq = (b * 8 + h) * 2; CD[seq * 34 + cidx] = __expf(totf); CD[(seq + 1) * 34 + cidx] = __expf(totb); }
  }
  __syncthreads();
  {
    const bf16_t* XTX = (const bf16_t*)(P.ws + OFF_XTX);
#pragma unroll
    for (int k = 0; k < 4; ++k) {
      const int e = t + 256 * k, p = e >> 4, c16 = e & 15;
      const u32x4 v = *(const u32x4*)(XTX + (size_t)(h * 64 + p) * TT + rowbase + c16 * 8);
      const float* wf = sm + 512 + c16 * 8; const float* wb = sm + 640 + c16 * 8;
      u32x4 of, ob;
      of.x = cvt_pk(bflo(v.x) * wf[0], bfhi(v.x) * wf[1]); of.y = cvt_pk(bflo(v.y) * wf[2], bfhi(v.y) * wf[3]); of.z = cvt_pk(bflo(v.z) * wf[4], bfhi(v.z) * wf[5]); of.w = cvt_pk(bflo(v.w) * wf[6], bfhi(v.w) * wf[7]);
      ob.x = cvt_pk(bflo(v.x) * wb[0], bfhi(v.x) * wb[1]); ob.y = cvt_pk(bflo(v.y) * wb[2], bfhi(v.y) * wb[3]); ob.z = cvt_pk(bflo(v.z) * wb[4], bfhi(v.z) * wb[5]); ob.w = cvt_pk(bflo(v.w) * wb[6], bfhi(v.w) * wb[7]);
      *(u32x4*)(smh + SM_X1 + p * 272 + c16 * 16) = of; *(u32x4*)(smh + SM_X2 + p * 272 + c16 * 16) = ob;
    }
  }
#pragma unroll 1
  for (int nh = 0; nh < 2; ++nh) {
    {
      const bf16_t* XTB = (const bf16_t*)(P.ws + OFF_XTB);
#pragma unroll
      for (int k = 0; k < 4; ++k) {
        const int e = t + 256 * k, n = e >> 4, c16 = e & 15;
        *(u32x4*)(smh + SM_BT + n * 272 + c16 * 16) = *(const u32x4*)(XTB + (size_t)(g * 128 + nh * 64 + n) * TT + rowbase + c16 * 8);
      }
    }
    __syncthreads();
    f32x4 acc[4][2];
#pragma unroll
    for (int nt = 0; nt < 4; ++nt) { acc[nt][0] = (f32x4){0.f, 0.f, 0.f, 0.f}; acc[nt][1] = (f32x4){0.f, 0.f, 0.f, 0.f}; }
#pragma unroll
    for (int s = 0; s < 4; ++s) {
      const bf16x8 xf = *(const bf16x8*)(smh + SM_X1 + (16 * w + r) * 272 + (32 * s + 8 * q) * 2);
      const bf16x8 xb = *(const bf16x8*)(smh + SM_X2 + (16 * w + r) * 272 + (32 * s + 8 * q) * 2);
#pragma unroll
      for (int nt = 0; nt < 4; ++nt) {
        const bf16x8 bt = *(const bf16x8*)(smh + SM_BT + (16 * nt + r) * 272 + (32 * s + 8 * q) * 2);
        acc[nt][0] = mfma16(bt, xf, acc[nt][0]); acc[nt][1] = mfma16(bt, xb, acc[nt][1]);
      }
    }
#pragma unroll
    for (int dir = 0; dir < 2; ++dir) {
      bf16_t* sp = ST + ((size_t)(((b * 8 + h) * 2 + dir) * 34 + cidx)) * 8192 + (16 * w + r) * 128 + nh * 64 + 4 * q;
#pragma unroll
      for (int nt = 0; nt < 4; ++nt) { u32x2 ov; ov.x = cvt_pk(acc[nt][dir][0], acc[nt][dir][1]); ov.y = cvt_pk(acc[nt][dir][2], acc[nt][dir][3]); *(u32x2*)(sp + 16 * nt) = ov; }
    }
    __syncthreads();
  }
}

NOINL void ssd_scan_phase(const Params& P) {
  bf16_t* ST = (bf16_t*)(P.ws + OFF_ST);
  const float* CD = (const float*)(P.ws + OFF_CD);
  const int total = 64 * 2048;
  for (int gidx = VB * 256 + tid_opq(); gidx < total; gidx += VG * 256) {
    const int seq = gidx >> 11, e = gidx & 2047, dir = seq & 1;
    bf16_t* base = ST + (size_t)seq * 34 * 8192 + e * 4;
    const float* cd = CD + seq * 34;
    u32x2 v[34];
#pragma unroll
    for (int k = 0; k < 34; ++k) { const int ci = dir == 0 ? k : (k == 0 ? 1 : (k == 1 ? 0 : 35 - k)); v[k] = *(const u32x2*)(base + (size_t)ci * 8192); }
    float h0 = 0.f, h1 = 0.f, h2 = 0.f, h3 = 0.f;
#pragma unroll
    for (int k = 0; k < 34; ++k) {
      const int ci = dir == 0 ? k : (k == 0 ? 1 : (k == 1 ? 0 : 35 - k));
      u32x2 ov; ov.x = cvt_pk(h0, h1); ov.y = cvt_pk(h2, h3);
      *(u32x2*)(base + (size_t)ci * 8192) = ov;
      const float d = cd[ci];
      h0 = h0 * d + bflo(v[k].x); h1 = h1 * d + bfhi(v[k].x); h2 = h2 * d + bflo(v[k].y); h3 = h3 * d + bfhi(v[k].y);
    }
  }
}

NOINL void ssd_out_item(const Params& P, int layer, int b, int cidx, int h, int do_atomic) {
  unsigned char* const smh = smem + half_id() * HSTR;
  const int t = tid_opq(), lane = t & 63, w = t >> 6, r = lane & 15, q = lane >> 4, r7 = r & 7;
  const bf16_t* PROJ = (const bf16_t*)(P.ws + OFF_PROJ);
  const float* DTb = (const float*)(P.ws + OFF_DT);
  const bf16_t* ST = (const bf16_t*)(P.ws + OFF_ST);
  bf16_t* MIX = (bf16_t*)(P.ws + OFF_H);
  float* SSQ = (float*)(P.ws + OFF_SSQ);
  float* sm = (float*)(smh + SM_SMALL);
  int rowbase, lo, hi;
  if (cidx < 2) { lo = T + b * 256; hi = lo + 256; rowbase = lo + cidx * 128; } else { lo = b * 4096; hi = lo + 4096; rowbase = lo + (cidx - 2) * 128; }
  const int g = h >> 2;
  const float Af = -__expf(P.a_log[layer * 16 + h]), Ab = -__expf(P.a_log[layer * 16 + 8 + h]);
  __syncthreads();
  float inf_ = 0.f, inb_ = 0.f, ab_ = 0.f;
  if (t < 128) {
    const float df = softplus_f(DTb[(size_t)(rowbase + t) * 16 + h] + P.dt_bias[layer * 16 + h]);
    const float db = softplus_f(DTb[(size_t)(rowbase + t) * 16 + 8 + h] + P.dt_bias[layer * 16 + 8 + h]);
    sm[256 + t] = df; sm[384 + t] = db;
    ab_ = db * Ab; inf_ = wave_incl_scan(df * Af, lane); inb_ = wave_incl_scan(ab_, lane);
    if (lane == 63) { sm[772 + w] = inf_; sm[774 + w] = inb_; }
  }
  {
    const bf16_t* XTX = (const bf16_t*)(P.ws + OFF_XTX);
#pragma unroll
    for (int k = 0; k < 4; ++k) {
      const int e = t + 256 * k, p = e >> 4, c16 = e & 15;
      *(u32x4*)(smh + SM_XT + p * 272 + c16 * 16) = *(const u32x4*)(XTX + (size_t)(h * 64 + p) * TT + rowbase + c16 * 8);
    }
  }
  __syncthreads();
  if (t < 128) {
    const float acf = inf_ + (w == 1 ? sm[772] : 0.f);
    const float preb = inb_ - ab_ + (w == 1 ? sm[774] : 0.f), totb = sm[774] + sm[775];
    sm[512 + t] = acf; sm[640 + t] = preb;
    if (t == 0) sm[768] = totb;
  }
  __syncthreads();
  f32x4 G[8][2], y[4][2];
#pragma unroll
  for (int jt = 0; jt < 8; ++jt) { G[jt][0] = (f32x4){0.f, 0.f, 0.f, 0.f}; G[jt][1] = (f32x4){0.f, 0.f, 0.f, 0.f}; }
#pragma unroll
  for (int pt = 0; pt < 4; ++pt) { y[pt][0] = (f32x4){0.f, 0.f, 0.f, 0.f}; y[pt][1] = (f32x4){0.f, 0.f, 0.f, 0.f}; }
  float acfi[2], prebi[2], efi[2][2];
#pragma unroll
  for (int it = 0; it < 2; ++it) {
    const int i = 32 * w + 16 * it + r;
    acfi[it] = sm[512 + i]; prebi[it] = sm[640 + i];
    efi[0][it] = __expf(acfi[it]); efi[1][it] = __expf(sm[768] - prebi[it]);
  }
#pragma unroll 1
  for (int nh = 0; nh < 2; ++nh) {
    {
      const bf16_t* XN = (const bf16_t*)(P.ws + OFF_XN);
#pragma unroll
      for (int k = 0; k < 4; ++k) {
        const int e = t + 256 * k, tok = e >> 3, ch = e & 7;
        const bf16_t* src = XN + (size_t)(rowbase + tok) * 512 + g * 128 + nh * 64 + ch * 8;
        *(u32x4*)(smh + SM_BN + tok * 128 + ((ch ^ (tok & 7)) << 4)) = *(const u32x4*)src;
        *(u32x4*)(smh + SM_CN + tok * 128 + ((ch ^ (tok & 7)) << 4)) = *(const u32x4*)(src + 256);
      }
      const int hp_ = t >> 2, hc_ = (t & 3) * 2;
#pragma unroll
      for (int d = 0; d < 2; ++d) {
        const bf16_t* hsrc = ST + ((size_t)(((b * 8 + h) * 2 + d) * 34 + cidx)) * 8192 + hp_ * 128 + nh * 64 + hc_ * 8;
        *(u32x4*)(smh + SM_RAW + d * 8192 + hp_ * 128 + ((hc_ ^ (hp_ & 7)) << 4)) = *(const u32x4*)hsrc;
        *(u32x4*)(smh + SM_RAW + d * 8192 + hp_ * 128 + (((hc_ + 1) ^ (hp_ & 7)) << 4)) = *(const u32x4*)(hsrc + 8);
      }
    }
    __syncthreads();
    bf16x8 cf[2][2];
#pragma unroll
    for (int it = 0; it < 2; ++it)
#pragma unroll
      for (int s = 0; s < 2; ++s) cf[it][s] = *(const bf16x8*)(smh + SM_CN + (32 * w + 16 * it + r) * 128 + (((4 * s + q) ^ r7) << 4));
#pragma unroll
    for (int jt = 0; jt < 8; ++jt)
#pragma unroll
      for (int s = 0; s < 2; ++s) {
        const bf16x8 bfr = *(const bf16x8*)(smh + SM_BN + (16 * jt + r) * 128 + (((4 * s + q) ^ r7) << 4));
        G[jt][0] = mfma16(bfr, cf[0][s], G[jt][0]); G[jt][1] = mfma16(bfr, cf[1][s], G[jt][1]);
      }
#pragma unroll
    for (int d = 0; d < 2; ++d) {
#pragma unroll
      for (int s = 0; s < 2; ++s) {
        union { bf16x8 b; u32x4 u; } c0, c1; c0.b = cf[0][s]; c1.b = cf[1][s];
        const bf16x8 cs0 = as_bf16x8(scale8(c0.u, efi[d][0])), cs1 = as_bf16x8(scale8(c1.u, efi[d][1]));
#pragma unroll
        for (int pt = 0; pt < 4; ++pt) {
          const bf16x8 hf = *(const bf16x8*)(smh + SM_RAW + d * 8192 + (16 * pt + r) * 128 + (((4 * s + q) ^ r7) << 4));
          y[pt][0] = mfma16(hf, cs0, y[pt][0]); y[pt][1] = mfma16(hf, cs1, y[pt][1]);
        }
      }
    }
    __syncthreads();
  }
#pragma unroll
  for (int s = 0; s < 4; ++s) {
    asm volatile("" ::: "memory");
    bf16x8 mf[2];
    const int wu = __builtin_amdgcn_readfirstlane(w);
    if (s < wu) {
      float aj[8], dfj[8];
#pragma unroll
      for (int jj = 0; jj < 8; ++jj) { const int j = 32 * s + (jj < 4 ? 4 * q + jj : 16 + 4 * q + jj - 4); aj[jj] = sm[512 + j]; dfj[jj] = sm[256 + j]; }
#pragma unroll
      for (int it = 0; it < 2; ++it) {
        float mv[8];
#pragma unroll
        for (int jj = 0; jj < 8; ++jj) mv[jj] = G[2 * s + (jj >> 2)][it][jj & 3] * __expf(acfi[it] - aj[jj]) * dfj[jj];
        u32x4 pk; pk.x = cvt_pk(mv[0], mv[1]); pk.y = cvt_pk(mv[2], mv[3]); pk.z = cvt_pk(mv[4], mv[5]); pk.w = cvt_pk(mv[6], mv[7]);
        mf[it] = as_bf16x8(pk);
      }
    } else if (s > wu) {
      float pj[8], dbj[8];
#pragma unroll
      for (int jj = 0; jj < 8; ++jj) { const int j = 32 * s + (jj < 4 ? 4 * q + jj : 16 + 4 * q + jj - 4); pj[jj] = sm[640 + j]; dbj[jj] = sm[384 + j]; }
#pragma unroll
      for (int it = 0; it < 2; ++it) {
        float mv[8];
#pragma unroll
        for (int jj = 0; jj < 8; ++jj) mv[jj] = G[2 * s + (jj >> 2)][it][jj & 3] * __expf(pj[jj] - prebi[it]) * dbj[jj];
        u32x4 pk; pk.x = cvt_pk(mv[0], mv[1]); pk.y = cvt_pk(mv[2], mv[3]); pk.z = cvt_pk(mv[4], mv[5]); pk.w = cvt_pk(mv[6], mv[7]);
        mf[it] = as_bf16x8(pk);
      }
    } else {
    float aj[8], pj[8], dfj[8], dbj[8];
#pragma unroll
    for (int jj = 0; jj < 8; ++jj) { const int j = 32 * s + (jj < 4 ? 4 * q + jj : 16 + 4 * q + jj - 4); aj[jj] = sm[512 + j]; pj[jj] = sm[640 + j]; dfj[jj] = sm[256 + j]; dbj[jj] = sm[384 + j]; }
#pragma unroll
    for (int it = 0; it < 2; ++it) {
      const int i = 32 * w + 16 * it + r;
      float mv[8];
#pragma unroll
      for (int jj = 0; jj < 8; ++jj) {
        const int j = 32 * s + (jj < 4 ? 4 * q + jj : 16 + 4 * q + jj - 4);
        const float gv = G[2 * s + (jj >> 2)][it][jj & 3];
        float m;
        if (j < i) m = gv * __expf(acfi[it] - aj[jj]) * dfj[jj];
        else if (j > i) m = gv * __expf(pj[jj] - prebi[it]) * dbj[jj];
        else m = gv * (dfj[jj] + dbj[jj]);
        mv[jj] = m;
      }
      u32x4 pk; pk.x = cvt_pk(mv[0], mv[1]); pk.y = cvt_pk(mv[2], mv[3]); pk.z = cvt_pk(mv[4], mv[5]); pk.w = cvt_pk(mv[6], mv[7]);
      mf[it] = as_bf16x8(pk);
    }
    }
#pragma unroll
    for (int pt = 0; pt < 4; ++pt) {
      const u32x2 lo2 = *(const u32x2*)(smh + SM_XT + (16 * pt + r) * 272 + (32 * s + 4 * q) * 2);
      const u32x2 hi2 = *(const u32x2*)(smh + SM_XT + (16 * pt + r) * 272 + (32 * s + 16 + 4 * q) * 2);
      const bf16x8 xf = as_bf16x8((u32x4){lo2.x, lo2.y, hi2.x, hi2.y});
      y[pt][0] = mfma16(xf, mf[0], y[pt][0]); y[pt][1] = mfma16(xf, mf[1], y[pt][1]);
    }
  }
  const float dsk = P.ssm_d[layer * 8 + h];
  const bf16_t* XT = (const bf16_t*)(smh + SM_XT);
#pragma unroll
  for (int it = 0; it < 2; ++it) {
    const int i = 32 * w + 16 * it + r; const int row = rowbase + i;
    float ss = 0.f;
#pragma unroll
    for (int pt = 0; pt < 4; ++pt) {
      const int p0 = 16 * pt + 4 * q;
      const u32x2 zz = *(const u32x2*)(PROJ + (size_t)row * PW + 512 + h * 64 + p0);
      const f32x4 gg = *(const f32x4*)(P.ssm_g + layer * 512 + h * 64 + p0);
      const float zv[4] = {bflo(zz.x), bfhi(zz.x), bflo(zz.y), bfhi(zz.y)};
      float ov[4];
#pragma unroll
      for (int e = 0; e < 4; ++e) {
        const float xs = bf2f(XT[(p0 + e) * 136 + i]);
        const float yz = (y[pt][it][e] + dsk * xs) * silu_f(zv[e]);
        ss += yz * yz; ov[e] = yz * gg[e];
      }
      u32x2 o; o.x = cvt_pk(ov[0], ov[1]); o.y = cvt_pk(ov[2], ov[3]);
      *(u32x2*)(MIX + (size_t)row * 1024 + h * 64 + p0) = o;
    }
    ss += __shfl_xor(ss, 16); ss += __shfl_xor(ss, 32);
    if (q == 0 && do_atomic) atomicAdd(SSQ + row, ss);
  }
}

DEVI void mixer1_phase(const Params& P, int layer) {
  const int nA = 512, nV = 4 * 34 * 16, nC = (layer == 0) ? 64 : 0;
  const int total = nA + nV + nC;
#pragma unroll 1
  for (int it = VB; it < total; it += VG) {
    if (it < nA || it >= nA + nV) {
      int b, i1, i2; bool isctx = it >= nA;
      if (!isctx) { b = it >> 7; i1 = (it >> 2) & 31; i2 = it & 3; }
      else { const int e = it - nA - nV; b = e >> 4; i1 = (e >> 3) & 1; i2 = e & 7; }
      attn_item<0>(P, layer, b, i1, i2, isctx ? 1 : 0);
    } else { const int e = it - nA; const int b = e / 544, rem = e % 544; conv_item(P, layer, b, rem >> 4, rem & 15); }
  }
}
DEVI void mixer2_phase(const Params& P, int layer) {
  const int nB = 1024, nS = 4 * 34 * 8;
  const int total = nB + nS;
#pragma unroll 1
  for (int it = VB; it < total; it += VG) {
    if (it < nB) { const int b = it >> 8, gr = (it >> 2) & 63, h = it & 3; attn_item<1>(P, layer, b, gr, h, 0); }
    else { const int e = it - nB; const int b = e / 272, rem = e % 272; ssd_state_item(P, layer, b, rem >> 3, rem & 7); }
  }
}

DEVI void ssd_out_phase(const Params& P, int layer, int do_atomic = 1) {
  const int c0 = (layer == 0) ? 0 : 2;
  const int nc = 34 - c0;
  const int total = 4 * nc * 8;
#pragma unroll 1
  for (int it = VB; it < total; it += VG) {
    const int b = it / (nc * 8), rem = it % (nc * 8);
    ssd_out_item(P, layer, b, c0 + (rem >> 3), rem & 7, do_atomic);
  }
}


#define XB_TMO      128
#define XB_XCNT(j)  (256  + 64 * (j))
#define XB_XSUB(j)  (1280 + 64 * (j))
#define XB_XGEN(j)  (2304 + 64 * (j))
#define XB_TOP      3328
#define XB_TOPGEN   3392
#define XB_SPIN_CAP (1u << 18)
#define LAS __attribute__((address_space(3)))
DEVI unsigned xb_ld(unsigned* p)              { return __hip_atomic_load(p, __ATOMIC_RELAXED, __HIP_MEMORY_SCOPE_AGENT); }
DEVI unsigned xb_add(unsigned* p, unsigned v) { return __hip_atomic_fetch_add(p, v, __ATOMIC_RELAXED, __HIP_MEMORY_SCOPE_AGENT); }
DEVI unsigned xb_xcc_id() { return (unsigned)__builtin_amdgcn_s_getreg((3 << 11) | 20) & 0xFu; }
#define XB_SPIN(cond, bar) do { unsigned _sp = 0; while (cond) { __builtin_amdgcn_s_sleep(1); \
    if ((++_sp & 255u) == 0u) { if (xb_ld(&(bar)[XB_TMO])) break; if (_sp > XB_SPIN_CAP) { atomicAdd(&(bar)[XB_TMO], 1u); break; } } } } while (0)
struct XcdBarrier { unsigned* bar; unsigned x; volatile LAS unsigned* st; };
DEVI XcdBarrier xcd_barrier_post(unsigned* bar, volatile LAS unsigned* st) {
  XcdBarrier b; b.bar = bar; b.x = xb_xcc_id(); b.st = st;
  if (threadIdx.x == 0) (void)xb_add(&bar[XB_XCNT(b.x)], 1u);
  return b;
}
DEVI void xcd_barrier_complete(unsigned* bar, unsigned x, unsigned& nloc, unsigned& nx) {
  const unsigned G = gridDim.x * gridDim.y * gridDim.z;
  unsigned sum, cnt, mine, sp = 0u;
  for (;;) {
    sum = 0u; cnt = 0u; mine = 0u;
#pragma unroll
    for (unsigned j = 0; j < 16; ++j) { const unsigned c = xb_ld(&bar[XB_XCNT(j)]); sum += c; cnt += (c > 0u) ? 1u : 0u; mine = (j == x) ? c : mine; }
    if (sum == G) break;
    __builtin_amdgcn_s_sleep(1);
    if ((++sp & 255u) == 0u) { if (xb_ld(&bar[XB_TMO])) break; if (sp > XB_SPIN_CAP) { atomicAdd(&bar[XB_TMO], 1u); break; } }
  }
  nloc = mine > 0u ? mine : 1u; nx = cnt > 0u ? cnt : 1u;
}
DEVI void xcd_barrier(const XcdBarrier& b) {
  asm volatile("s_waitcnt vmcnt(0)" ::: "memory");
  __syncthreads();
  if (threadIdx.x == 0) {
    unsigned* bar = b.bar;
    __builtin_amdgcn_s_waitcnt(0);
    unsigned nloc = b.st[0], nx = b.st[1];
    if (nloc == 0u) { xcd_barrier_complete(bar, b.x, nloc, nx); b.st[0] = nloc; b.st[1] = nx; }
    const unsigned old = xb_add(&bar[XB_XSUB(b.x)], 1u);
    const unsigned gen = old / nloc;
    if (old + 1u == (gen + 1u) * nloc) {
      __builtin_amdgcn_fence(__ATOMIC_RELEASE, "agent");
      asm volatile("s_waitcnt vmcnt(0)" ::: "memory");
      const unsigned og = xb_add(&bar[XB_TOP], 1u);
      const unsigned tg = og / nx;
      if (og + 1u == (tg + 1u) * nx) xb_add(&bar[XB_TOPGEN], 1u);
      else XB_SPIN(xb_ld(&bar[XB_TOPGEN]) == tg, bar);
      __builtin_amdgcn_fence(__ATOMIC_ACQUIRE, "agent");
      xb_add(&bar[XB_XGEN(b.x)], 1u);
      asm volatile("s_waitcnt vmcnt(0)" ::: "memory");
    } else {
      XB_SPIN(xb_ld(&bar[XB_XGEN(b.x)]) == gen, bar);
      __builtin_amdgcn_fence(__ATOMIC_ACQUIRE, "agent");
      asm volatile("s_waitcnt vmcnt(0)" ::: "memory");
    }
  }
  __syncthreads();
}

__global__ void __launch_bounds__(512, 2) mega_fwd(Params P) {
  cg::grid_group grid = cg::this_grid();
  __shared__ uint4 xb_words;
  if (threadIdx.x == 0) xb_words = make_uint4(0u, 0u, 0u, 0u);
  __syncthreads();
  XcdBarrier xb = xcd_barrier_post((unsigned*)(P.ws + OFF_BAR), (volatile LAS unsigned*)&xb_words);
  if (P.ph_hi > 1000) grid.sync();
#define BAR() xcd_barrier(xb)
#ifndef REP_S
#define REP_S -1
#endif
#define RUN(S_, CALL) { if (REP_S == (S_)) { const int do_at = 0; (void)do_at; CALL; BAR(); } { const int do_at = 1; (void)do_at; CALL; } BAR(); }
#define LAYER(l) \
  RUN(0, (norm_phase(P, l, 0), (l == 1 ? prep_phase(P, 1, false) : (void)0))) \
  RUN(1, (gemm_phase<MODE_INPROJ, false>(P, l))) \
  RUN(2, mixer1_phase(P, l)) \
  RUN(9, mixer2_phase(P, l)) \
  RUN(3, ssd_scan_phase(P)) \
  RUN(4, ssd_out_phase(P, l, do_at)) \
  RUN(5, (gemm_phase<MODE_RESID, true>(P, l))) \
  RUN(6, norm_phase(P, l, 1)) \
  RUN(7, (gemm_phase<MODE_SWIGLU, false>(P, l))) \
  RUN(8, (gemm_phase<MODE_RESID, false>(P, l)))
  prep_phase(P, 0, true); BAR();
  LAYER(0)
  LAYER(1)
  final_norm_phase(P);
}

extern "C" void kernel_launch(void* const* d_in, const int* in_sizes, int n_in, void* d_out, int out_size, void* d_ws, size_t ws_size, hipStream_t stream) {
  static int grid_blocks = 0;
  if (!grid_blocks) {
    int dev = 0, cus = 0, per_cu = 0;
    hipGetDevice(&dev);
    hipDeviceGetAttribute(&cus, hipDeviceAttributeMultiprocessorCount, dev);
    hipOccupancyMaxActiveBlocksPerMultiprocessor(&per_cu, mega_fwd, 512, 0);
    if (per_cu < 1) per_cu = 1;
    if (per_cu > 1) per_cu = 1;
    grid_blocks = cus * per_cu;
    if (ws_size < WS_END) fprintf(stderr, "kernel_launch: workspace too small: %zu < %zu\n", ws_size, (size_t)WS_END);
  }
  Params p{};
  const float** pp = (const float**)&p;
  for (int i = 0; i < 21; ++i) pp[i] = (const float*)d_in[i];
  p.out = (float*)d_out; p.ws = (unsigned char*)d_ws;
  hipMemsetAsync((unsigned char*)d_ws + OFF_MODS, 0, SZ_MODS + SZ_BAR, stream);
#if LAUNCH_PER_PHASE
  for (int ph = 0; ph < NPH; ++ph) {
    p.ph_lo = ph; p.ph_hi = ph + 1;
    hipLaunchKernelGGL(mega_fwd, dim3(grid_blocks), dim3(256), 0, stream, p);
  }
#else
  p.ph_lo = 0; p.ph_hi = NPH;
  void* args[] = {&p};
  hipError_t e = hipLaunchCooperativeKernel((void*)mega_fwd, dim3(grid_blocks), dim3(512), args, 0, stream);
  if (e != hipSuccess) fprintf(stderr, "cooperative launch failed: %s (grid %d)\n", hipGetErrorString(e), grid_blocks);
#endif
}
```

```cpp
#include <hip/hip_runtime.h>
#include <hip/hip_cooperative_groups.h>
#include <cstdio>
#include <cstdint>
namespace cg = cooperative_groups;

#ifndef LAUNCH_PER_PHASE
#define LAUNCH_PER_PHASE 0
#endif

typedef unsigned short bf16_t;
typedef short bf16x8 __attribute__((ext_vector_type(8)));
typedef float f32x4 __attribute__((ext_vector_type(4)));
typedef unsigned u32x4 __attribute__((ext_vector_type(4)));
typedef unsigned u32x2 __attribute__((ext_vector_type(2)));
#define DEVI __device__ __forceinline__

constexpr int T = 16384, TC = 1024, TT = T + TC;
constexpr int PW = 2816;
constexpr int NPH = 20;
constexpr float EPSN = 1e-6f;

constexpr size_t SZ_WIN = (size_t)2944 * 1024 * 2, SZ_WOUT = (size_t)1024 * 1024 * 2, SZ_WFI = (size_t)5632 * 1024 * 2, SZ_WFO = (size_t)1024 * 2816 * 2;
constexpr size_t OFF_WIN = 0;
constexpr size_t OFF_WOUT = OFF_WIN + SZ_WIN;
constexpr size_t OFF_WFI = OFF_WOUT + SZ_WOUT;
constexpr size_t OFF_WFO = OFF_WFI + SZ_WFI;
constexpr size_t OFF_H = OFF_WFO + SZ_WFO;
constexpr size_t OFF_PROJ = OFF_H + (size_t)TT * 1024 * 2;
constexpr size_t OFF_VT = OFF_PROJ + (size_t)TT * PW * 2;
constexpr size_t OFF_DT = OFF_VT + (size_t)384 * TT * 2;
constexpr size_t OFF_XC = OFF_DT + (size_t)TT * 16 * 4;
constexpr size_t OFF_MODS = OFF_XC + (size_t)TC * 1024 * 4;
constexpr size_t SZ_MODS = (size_t)2 * 5 * 6144 * 4;
constexpr size_t OFF_BAR = OFF_MODS + SZ_MODS;
constexpr size_t SZ_BAR = 3456 * 4;
constexpr size_t OFF_SSQ = OFF_BAR + SZ_BAR;
constexpr size_t OFF_ST = OFF_SSQ + (size_t)TT * 4;
constexpr size_t OFF_CD = OFF_ST + (size_t)64 * 34 * 8192 * 2;
constexpr size_t OFF_ROPE = OFF_CD + (size_t)64 * 34 * 4;
constexpr size_t OFF_XN = OFF_ROPE + 2 * 1024 * 4;
constexpr size_t OFF_XTX = OFF_XN + (size_t)TT * 512 * 2;
constexpr size_t OFF_XTB = OFF_XTX + (size_t)512 * TT * 2;
constexpr size_t WS_END = OFF_XTB + (size_t)256 * TT * 2;
static_assert(WS_END <= (size_t)256 * 1024 * 1024, "workspace map exceeds 256 MiB");

struct Params {
  const float *x, *c, *ctx, *c_ctx, *w_mod, *b_mod, *g_mix, *w_in, *wa_sink, *na_rpb, *conv_w, *conv_b, *dt_bias, *a_log, *ssm_d, *ssm_g, *w_out, *g_ffn, *w_ffn_in, *w_ffn_out, *g_final;
  float* out; unsigned char* ws; int ph_lo, ph_hi;
};

constexpr int HSTR = 73728, SMEM_BYTES = 2 * HSTR;
__shared__ __attribute__((aligned(16))) unsigned char smem[SMEM_BYTES];
#define NOINL __device__ __forceinline__

typedef __bf16 bf16x2_t __attribute__((ext_vector_type(2)));
typedef float f32x2_t __attribute__((ext_vector_type(2)));
DEVI unsigned cvt_pk(float lo, float hi) { f32x2_t v = {lo, hi}; bf16x2_t b = __builtin_convertvector(v, bf16x2_t); return __builtin_bit_cast(unsigned, b); }
DEVI float bflo(unsigned u) { return __uint_as_float(u << 16); }
DEVI float bfhi(unsigned u) { return __uint_as_float(u & 0xffff0000u); }
DEVI float bf2f(bf16_t h) { return __uint_as_float((unsigned)h << 16); }
DEVI float silu_f(float v) { return v * __builtin_amdgcn_rcpf(1.f + __expf(-v)); }
DEVI float softplus_f(float v) { const float e = __expf(v); return v > 20.f ? v : (e < 1e-3f ? e * (1.f - 0.5f * e) : __logf(1.f + e)); }
DEVI float wave_sum(float v) {
#pragma unroll
  for (int o = 32; o > 0; o >>= 1) v += __shfl_xor(v, o);
  return v;
}
DEVI float wave_incl_scan(float v, int lane) {
#pragma unroll
  for (int o = 1; o < 64; o <<= 1) { const float u = __shfl_up(v, o); if (lane >= o) v += u; }
  return v;
}
DEVI f32x4 mfma16(bf16x8 a, bf16x8 b, f32x4 c) { return __builtin_amdgcn_mfma_f32_16x16x32_bf16(a, b, c, 0, 0, 0); }
DEVI bf16x8 as_bf16x8(u32x4 v) { union { u32x4 u; bf16x8 b; } x; x.u = v; return x.b; }

DEVI u32x4 scale8(u32x4 v, float s) {
  u32x4 o;
  o.x = cvt_pk(bflo(v.x) * s, bfhi(v.x) * s); o.y = cvt_pk(bflo(v.y) * s, bfhi(v.y) * s);
  o.z = cvt_pk(bflo(v.z) * s, bfhi(v.z) * s); o.w = cvt_pk(bflo(v.w) * s, bfhi(v.w) * s);
  return o;
}
DEVI int tid_opq() { int t; asm volatile("v_mov_b32 %0, %1" : "=v"(t) : "v"((int)(threadIdx.x & 255))); return t; }
DEVI int half_id() { return __builtin_amdgcn_readfirstlane((int)(threadIdx.x >> 8)); }
#define VB (blockIdx.x * 2 + half_id())
#define VG (gridDim.x * 2)
DEVI int ufy(int v) { return __builtin_amdgcn_readfirstlane(v); }

NOINL void prep_phase(const Params& P, int wl, bool full) {
  unsigned char* const smh = smem + half_id() * HSTR;
  float* tile = (float*)smh;
  const int t = tid_opq();
  constexpr int I_IN = 46 * 16, I_OUT = 16 * 16, I_FI = 88 * 16, I_FO = 16 * 44, I_L = I_IN + I_OUT + I_FI + I_FO;
  constexpr int I_MOD = 2 * 16 * 24;
  const int total = I_L + (full ? I_MOD + 1 : 0);
  for (int it = VB; it < total; it += VG) {
    if (it < I_L) {
      const int l = wl; int r = it;
      const float* W; bf16_t* Wt; int K, N, kind, nt_, kt_;
      if (r < I_IN) { kind = 0; W = P.w_in + (size_t)l * 1024 * 2832; N = 2832; K = 1024; Wt = (bf16_t*)(P.ws + OFF_WIN); nt_ = r / 16; kt_ = r % 16; }
      else if (r < I_IN + I_OUT) { r -= I_IN; kind = 1; W = P.w_out + (size_t)l * 1024 * 1024; N = 1024; K = 1024; Wt = (bf16_t*)(P.ws + OFF_WOUT); nt_ = r / 16; kt_ = r % 16; }
      else if (r < I_IN + I_OUT + I_FI) { r -= I_IN + I_OUT; kind = 2; W = P.w_ffn_in + (size_t)l * 1024 * 5632; N = 5632; K = 1024; Wt = (bf16_t*)(P.ws + OFF_WFI); nt_ = r / 16; kt_ = r % 16; }
      else { r -= I_IN + I_OUT + I_FI; kind = 3; W = P.w_ffn_out + (size_t)l * 2816 * 1024; N = 1024; K = 2816; Wt = (bf16_t*)(P.ws + OFF_WFO); nt_ = r / 44; kt_ = r % 44; }
      {
        const int n4 = (t & 15) * 4, np = nt_ * 64 + n4;
        int col;
        if (kind == 0) col = np < 2832 ? np : -1;
        else if (kind == 2) { const int qq = np >> 5, rr = np & 31; col = rr < 16 ? 16 * qq + rr : 2816 + 16 * qq + rr - 16; }
        else col = np;
#pragma unroll
        for (int i = 0; i < 4; ++i) {
          const int kk = i * 16 + (t >> 4);
          f32x4 v = (f32x4){0.f, 0.f, 0.f, 0.f};
          const int ksrc = kind == 1 ? ((kt_ * 64 + kk + 512) & 1023) : (kt_ * 64 + kk);
          if (col >= 0) v = *(const f32x4*)(W + (size_t)ksrc * N + col);
          tile[kk * 65 + n4] = v[0]; tile[kk * 65 + n4 + 1] = v[1]; tile[kk * 65 + n4 + 2] = v[2]; tile[kk * 65 + n4 + 3] = v[3];
        }
      }
      __syncthreads();
      {
        const int n = t >> 2, kc = (t & 3) * 16;
        u32x4 o0, o1;
        o0.x = cvt_pk(tile[(kc + 0) * 65 + n], tile[(kc + 1) * 65 + n]); o0.y = cvt_pk(tile[(kc + 2) * 65 + n], tile[(kc + 3) * 65 + n]);
        o0.z = cvt_pk(tile[(kc + 4) * 65 + n], tile[(kc + 5) * 65 + n]); o0.w = cvt_pk(tile[(kc + 6) * 65 + n], tile[(kc + 7) * 65 + n]);
        o1.x = cvt_pk(tile[(kc + 8) * 65 + n], tile[(kc + 9) * 65 + n]); o1.y = cvt_pk(tile[(kc + 10) * 65 + n], tile[(kc + 11) * 65 + n]);
        o1.z = cvt_pk(tile[(kc + 12) * 65 + n], tile[(kc + 13) * 65 + n]); o1.w = cvt_pk(tile[(kc + 14) * 65 + n], tile[(kc + 15) * 65 + n]);
        bf16_t* dst = Wt + (size_t)(nt_ * 64 + n) * K + kt_ * 64 + kc;
        *(u32x4*)dst = o0; *(u32x4*)(dst + 8) = o1;
      }
      __syncthreads();
    } else if (it < I_L + I_MOD) {
      const int m = it - I_L; const int l = m / 384, rem = m % 384, kc = rem / 24, cb = rem % 24;
      float* sv = (float*)smh;
      for (int e = t; e < 320; e += 256) { const int r = e >> 6, k = kc * 64 + (e & 63); const float v = r < 4 ? P.c[r * 1024 + k] : P.c_ctx[k]; sv[e] = v / (1.f + __expf(-v)); }
      __syncthreads();
      const int n = cb * 256 + t;
      float a0 = 0.f, a1 = 0.f, a2 = 0.f, a3 = 0.f, a4 = 0.f;
      const float* wp = P.w_mod + ((size_t)l * 1024 + kc * 64) * 6144 + n;
#pragma unroll 8
      for (int kk = 0; kk < 64; ++kk) { const float w = wp[(size_t)kk * 6144]; a0 += sv[kk] * w; a1 += sv[64 + kk] * w; a2 += sv[128 + kk] * w; a3 += sv[192 + kk] * w; a4 += sv[256 + kk] * w; }
      if (kc == 0) { const float bb = P.b_mod[l * 6144 + n]; a0 += bb; a1 += bb; a2 += bb; a3 += bb; a4 += bb; }
      float* md = (float*)(P.ws + OFF_MODS) + (size_t)l * 5 * 6144 + n;
      atomicAdd(md, a0); atomicAdd(md + 6144, a1); atomicAdd(md + 2 * 6144, a2); atomicAdd(md + 3 * 6144, a3); atomicAdd(md + 4 * 6144, a4);
      __syncthreads();
    } else {
      float* rc = (float*)(P.ws + OFF_ROPE);
      for (int e = t; e < 1024; e += 256) { const int pos = e >> 4, i = e & 15; const float inv = __builtin_amdgcn_exp2f(-(float)i * (13.287712379549449f / 16.f)); float xr = (float)pos * inv * 0.15915494309189535f; xr -= floorf(xr); rc[e] = __builtin_amdgcn_cosf(xr); rc[1024 + e] = __builtin_amdgcn_sinf(xr); }
    }
  }
}

NOINL void norm_phase(const Params& P, int layer, int which) {
  const float* src_lat = (layer == 0 && which == 0) ? P.x : P.out; const float* src_ctx = (layer == 0 && which == 0) ? P.ctx : (const float*)(P.ws + OFF_XC);
  const int M = (which == 0 || layer == 0) ? TT : T;
  const int t_ = tid_opq(); const int lane = t_ & 63, wv = t_ >> 6;
  const int gw = VB * 4 + wv, nw = VG * 4;
  const float* g = (which == 0 ? P.g_mix : P.g_ffn) + layer * 1024;
  bf16_t* H = (bf16_t*)(P.ws + OFF_H);
  float* ssq = (float*)(P.ws + OFF_SSQ);
  for (int row = gw; row < M; row += nw) {
    const float* xr = row < T ? src_lat + (size_t)row * 1024 : src_ctx + (size_t)(row - T) * 1024;
    const int mr = row < T ? (row >> 12) : 4;
    const float* md = (const float*)(P.ws + OFF_MODS) + (size_t)(layer * 5 + mr) * 6144 + which * 3072;
    f32x4 v[4]; float s = 0.f;
#pragma unroll
    for (int j = 0; j < 4; ++j) { v[j] = *(const f32x4*)(xr + 4 * (lane + 64 * j)); s += v[j][0] * v[j][0] + v[j][1] * v[j][1] + v[j][2] * v[j][2] + v[j][3] * v[j][3]; }
    s = wave_sum(s);
    const float rstd = rsqrtf(s * (1.f / 1024.f) + EPSN);
    f32x4 ggv[4], shv[4], scv[4];
#pragma unroll
    for (int j = 0; j < 4; ++j) { const int k = 4 * (lane + 64 * j); ggv[j] = *(const f32x4*)(g + k); shv[j] = *(const f32x4*)(md + k); scv[j] = *(const f32x4*)(md + 1024 + k); }
#pragma unroll
    for (int j = 0; j < 4; ++j) {
      const int k = 4 * (lane + 64 * j);
      const f32x4 gg = ggv[j], sh = shv[j], sc = scv[j];
      f32x4 h;
#pragma unroll
      for (int e = 0; e < 4; ++e) h[e] = v[j][e] * rstd * gg[e] * (1.f + sc[e]) + sh[e];
      u32x2 o; o.x = cvt_pk(h[0], h[1]); o.y = cvt_pk(h[2], h[3]);
      *(u32x2*)(H + (size_t)row * 1024 + k) = o;
    }
    if (which == 0 && lane == 0) ssq[row] = 0.f;
  }
}

NOINL void final_norm_phase(const Params& P) {
  const int t_ = tid_opq(); const int lane = t_ & 63, wv = t_ >> 6;
  const int gw = VB * 4 + wv, nw = VG * 4;
  for (int row = gw; row < T; row += nw) {
    float* xr = P.out + (size_t)row * 1024;
    f32x4 v[4]; float s = 0.f;
#pragma unroll
    for (int j = 0; j < 4; ++j) { v[j] = *(const f32x4*)(xr + 4 * (lane + 64 * j)); s += v[j][0] * v[j][0] + v[j][1] * v[j][1] + v[j][2] * v[j][2] + v[j][3] * v[j][3]; }
    s = wave_sum(s);
    const float rstd = rsqrtf(s * (1.f / 1024.f) + EPSN);
#pragma unroll
    for (int j = 0; j < 4; ++j) {
      const int k = 4 * (lane + 64 * j);
      const f32x4 gg = *(const f32x4*)(P.g_final + k);
      f32x4 h;
#pragma unroll
      for (int e = 0; e < 4; ++e) h[e] = v[j][e] * rstd * gg[e];
      *(f32x4*)(xr + k) = h;
    }
  }
}

namespace pg8 {
#define PG8_LAS __attribute__((address_space(3)))
typedef unsigned short bf16_t;
typedef short bf16x8 __attribute__((ext_vector_type(8)));
typedef float f32x4 __attribute__((ext_vector_type(4)));
typedef unsigned u32x4 __attribute__((ext_vector_type(4)));
constexpr int BM = 256, BK = 64, HALF = 128, HTB = HALF * BK * 2  , STAGE_BYTES = 8 * HTB, NXCD = 8, WGM = 8;

__host__ __device__ __forceinline__ int lds_byte(int r, int c) { const int st = (r >> 4) * 2 + (c >> 5), rr = r & 15, cc = c & 31, ob = rr * 64 + cc * 2; return st * 1024 + (ob ^ (((ob >> 9) & 1) << 5)); }
__host__ __device__ __forceinline__ void stage_rc(int b, int& R, int& C) { const int st = b / 1024, sb = b % 1024, swz = sb ^ (((sb >> 9) & 1) << 5); R = (st >> 1) * 16 + swz / 64; C = (st & 1) * 32 + (swz % 64) / 2; }
__host__ __device__ __forceinline__ int perm32(int rho) { const int n = rho >> 4, i = rho & 15; return 8 * (i >> 2) + 4 * n + (i & 3); }

struct Unit { int pm, pn; };
struct Gemm { const bf16_t* A; const bf16_t* Bt; int M, N, K; };

struct StaticOrder {
    int nM, nN, nwg, G, c;
    __host__ __device__ void init(int M, int N, int G_, int c_) { nM = M / BM; nN = N / BM; nwg = nM * nN; G = G_; c = c_; }
    __host__ __device__ bool next(int i, Unit& u) const {
        const long L = (long)i * G + c; if (L >= nwg) return false;
        int wgid = (int)L; { const int q = nwg / NXCD, r = nwg % NXCD, xcd = wgid % NXCD, off = wgid / NXCD; wgid = (xcd < r ? xcd * (q + 1) : r * (q + 1) + (xcd - r) * q) + off; }
        const int nig = WGM * nN, gid = wgid / nig, fm = gid * WGM, gsz = (nM - fm) < WGM ? (nM - fm) : WGM;
        u.pm = fm + ((wgid % nig) % gsz); u.pn = (wgid % nig) / gsz; return true;
    }
    __device__ __forceinline__ void a_ready(const Unit&) const {}
    __device__ __forceinline__ void done(const Unit&) const {}
};

template <class Epi, class Sched, bool ALIGN_EPI = false, bool SP2 = false>
__device__ __forceinline__ void gemm_phase(PG8_LAS unsigned char* lds, const Gemm g, const Sched& S, const Epi& E) {
    int tid_; asm volatile("v_mov_b32 %0, %1" : "=v"(tid_) : "v"((int)threadIdx.x)); const int tid = tid_, wid = __builtin_amdgcn_readfirstlane(tid >> 6), lane = tid & 63, wr = wid >> 2, wc = wid & 3, fr = lane & 15, fq = lane >> 4;
    const int K = g.K, nt = K / BK;
    unsigned voffA[2], voffB[2];
#pragma unroll
    for (int i = 0; i < 2; ++i) { int R, C; stage_rc(tid * 16 + i * 8192, R, C); const int Rb = Epi::PERM ? ((R & ~31) + perm32(R & 31)) : R;
        voffA[i] = (unsigned)(R * K + C) * 2u; voffB[i] = (unsigned)(Rb * K + C) * 2u; }
    const size_t kstep = (size_t)(BK * 2);
    const size_t hstep = (size_t)HALF * K * 2;
    const size_t tstep = 2 * hstep;
    const unsigned ldsw = (unsigned)wid * 1024u;
    const int aoff = lds_byte(wr * 64 + fr, fq * 8), boff = lds_byte(wc * 32 + fr, fq * 8);
#define PG8_SA(b, h) (((b) * 2 + (h)) * HTB)
#define PG8_SB(b, h) ((4 + (b) * 2 + (h)) * HTB)
#define PG8_STAGE(bufoff, gbase, voff) do { _Pragma("unroll") for (int _i = 0; _i < 2; ++_i) \
        __builtin_amdgcn_global_load_lds((const unsigned*)((const char*)(gbase) + (voff)[_i]), (PG8_LAS unsigned*)(lds + (bufoff) + ldsw + _i * 8192), 16, 0, 0); } while (0)
#define PG8_LDA(dst, b, h) do { _Pragma("unroll") for (int m = 0; m < 4; ++m) _Pragma("unroll") for (int k = 0; k < 2; ++k) dst[m][k] = *(const PG8_LAS bf16x8*)(lds + PG8_SA(b, h) + aoff + m * 2048 + k * 1024); } while (0)
#define PG8_LDB(dst, b, h) do { _Pragma("unroll") for (int n = 0; n < 2; ++n) _Pragma("unroll") for (int k = 0; k < 2; ++k) dst[n][k] = *(const PG8_LAS bf16x8*)(lds + PG8_SB(b, h) + boff + n * 2048 + k * 1024); } while (0)
#define PG8_MMA(ai, bj, At, Bt) do { __builtin_amdgcn_s_setprio(1); _Pragma("unroll") for (int m = 0; m < 4; ++m) _Pragma("unroll") for (int n = 0; n < 2; ++n) _Pragma("unroll") for (int k = 0; k < 2; ++k) \
        acc[ai][bj][m][n] = __builtin_amdgcn_mfma_f32_16x16x32_bf16(Bt[n][k], At[m][k], acc[ai][bj][m][n], 0, 0, 0); __builtin_amdgcn_s_setprio(0); } while (0)
#define PG8_WAIT_V(n) asm volatile("s_waitcnt vmcnt(" #n ")" ::: "memory")
#define PG8_WAIT_L(n) asm volatile("s_waitcnt lgkmcnt(" #n ")" ::: "memory")
#define PG8_BAR __builtin_amdgcn_s_barrier()
#define PG8_SCHED __builtin_amdgcn_sched_barrier(0)
    Unit cur, nxt; int ui = 0;
    if (!S.next(0, cur)) return;
    f32x4 acc[2][2][4][2];
#pragma unroll
    for (int a = 0; a < 2; ++a)
#pragma unroll
        for (int b = 0; b < 2; ++b)
#pragma unroll
            for (int m = 0; m < 4; ++m)
#pragma unroll
                for (int n = 0; n < 2; ++n) acc[a][b][m][n] = (f32x4){0.f, 0.f, 0.f, 0.f};
    bf16x8 At[4][2], B0[2][2], B1[2][2];
    const char* cA = (const char*)g.A + (size_t)cur.pm * tstep; const char* cB = (const char*)g.Bt + (size_t)cur.pn * tstep;
    S.a_ready(cur);
    if constexpr (SP2) {
        PG8_STAGE(PG8_SB(0, 0), cB, voffB); PG8_STAGE(PG8_SB(0, 1), cB + hstep, voffB); PG8_STAGE(PG8_SA(0, 0), cA, voffA); PG8_STAGE(PG8_SA(0, 1), cA + hstep, voffA);
        if (wr == 1) PG8_BAR;
        PG8_WAIT_V(2); PG8_BAR;
        PG8_STAGE(PG8_SB(1, 0), cB + kstep, voffB); PG8_STAGE(PG8_SA(1, 0), cA + kstep, voffA); PG8_STAGE(PG8_SB(1, 1), cB + hstep + kstep, voffB);
        PG8_WAIT_V(6); PG8_BAR;
    } else {
        PG8_STAGE(PG8_SB(0, 0), cB, voffB); PG8_STAGE(PG8_SA(0, 0), cA, voffA); PG8_STAGE(PG8_SB(0, 1), cB + hstep, voffB); PG8_STAGE(PG8_SA(0, 1), cA + hstep, voffA);
        if (wr == 1) PG8_BAR;
        PG8_WAIT_V(4); PG8_BAR;
        PG8_STAGE(PG8_SB(1, 0), cB + kstep, voffB); PG8_STAGE(PG8_SA(1, 0), cA + kstep, voffA); PG8_STAGE(PG8_SB(1, 1), cB + hstep + kstep, voffB);
        PG8_WAIT_V(6); PG8_BAR;
    }
    for (;;) {
        const bool has_next = S.next(ui + 1, nxt);
        const char* nA = has_next ? (const char*)g.A + (size_t)nxt.pm * tstep : cA; const char* nB = has_next ? (const char*)g.Bt + (size_t)nxt.pn * tstep : cB;
        for (int t = 0; t < nt; t += 2) {
            if constexpr (Epi::MIDSCALE) { if (t == 8) E.midscale(acc, cur, wr, fr); }
            const bool last = (t == nt - 2);
            const char* a1 = cA + (size_t)(t + 1) * kstep;
            const char* a2 = last ? nA : cA + (size_t)(t + 2) * kstep; const char* b2 = last ? nB : cB + (size_t)(t + 2) * kstep;
            const char* a3 = a2 + kstep; const char* b3 = b2 + kstep;
            if (last && has_next) S.a_ready(nxt);
            if constexpr (SP2) {
            PG8_LDB(B0, 0, 0); PG8_LDB(B1, 0, 1); PG8_SCHED; PG8_LDA(At, 0, 0); PG8_STAGE(PG8_SA(1, 1), a1 + hstep, voffA);
            PG8_WAIT_V(8); PG8_WAIT_L(0); PG8_BAR; PG8_MMA(0, 0, At, B0); PG8_MMA(0, 1, At, B1); PG8_BAR; PG8_SCHED;
            PG8_LDA(At, 0, 1); PG8_STAGE(PG8_SB(0, 0), b2, voffB); PG8_STAGE(PG8_SB(0, 1), b2 + hstep, voffB); PG8_STAGE(PG8_SA(0, 0), a2, voffA);
            PG8_WAIT_V(8); PG8_WAIT_L(0); PG8_BAR; PG8_MMA(1, 0, At, B0); PG8_MMA(1, 1, At, B1); PG8_BAR; PG8_SCHED;
            PG8_LDB(B0, 1, 0); PG8_LDB(B1, 1, 1); PG8_SCHED; PG8_LDA(At, 1, 0); PG8_STAGE(PG8_SA(0, 1), a2 + hstep, voffA);
            PG8_WAIT_V(8); PG8_WAIT_L(0); PG8_BAR; PG8_MMA(0, 0, At, B0); PG8_MMA(0, 1, At, B1); PG8_BAR; PG8_SCHED;
            PG8_LDA(At, 1, 1); PG8_STAGE(PG8_SB(1, 0), b3, voffB); PG8_STAGE(PG8_SB(1, 1), b3 + hstep, voffB); PG8_STAGE(PG8_SA(1, 0), a3, voffA);
            PG8_WAIT_V(8); PG8_WAIT_L(0); PG8_BAR; PG8_MMA(1, 0, At, B0); PG8_MMA(1, 1, At, B1); PG8_BAR; PG8_SCHED;
            } else {
            PG8_LDB(B0, 0, 0); PG8_SCHED; PG8_LDA(At, 0, 0); PG8_STAGE(PG8_SA(1, 1), a1 + hstep, voffA);
            PG8_WAIT_L(8); PG8_BAR; PG8_WAIT_L(0); PG8_MMA(0, 0, At, B0); PG8_BAR; PG8_SCHED;
            PG8_LDB(B1, 0, 1); PG8_STAGE(PG8_SB(0, 0), b2, voffB);
            PG8_BAR; PG8_WAIT_L(0); PG8_MMA(0, 1, At, B1); PG8_BAR;
            PG8_LDA(At, 0, 1); PG8_STAGE(PG8_SA(0, 0), a2, voffA);
            PG8_BAR; PG8_WAIT_L(0); PG8_MMA(1, 0, At, B0); PG8_BAR; PG8_SCHED;
            PG8_STAGE(PG8_SB(0, 1), b2 + hstep, voffB);
            PG8_WAIT_V(6); PG8_BAR; PG8_MMA(1, 1, At, B1); PG8_BAR;
            PG8_LDB(B0, 1, 0); PG8_SCHED; PG8_LDA(At, 1, 0); PG8_STAGE(PG8_SA(0, 1), a2 + hstep, voffA);
            PG8_WAIT_L(8); PG8_BAR; PG8_WAIT_L(0); PG8_MMA(0, 0, At, B0); PG8_BAR; PG8_SCHED;
            PG8_LDB(B1, 1, 1); PG8_STAGE(PG8_SB(1, 0), b3, voffB);
            PG8_BAR; PG8_WAIT_L(0); PG8_MMA(0, 1, At, B1); PG8_BAR;
            PG8_LDA(At, 1, 1); PG8_STAGE(PG8_SA(1, 0), a3, voffA);
            PG8_BAR; PG8_WAIT_L(0); PG8_MMA(1, 0, At, B0); PG8_BAR; PG8_SCHED;
            PG8_STAGE(PG8_SB(1, 1), b3 + hstep, voffB);
            PG8_WAIT_V(6); PG8_BAR; PG8_MMA(1, 1, At, B1); PG8_BAR;
            }
        }
        if constexpr (ALIGN_EPI) { if (wr == 0) PG8_BAR; }
        if constexpr (!Epi::AFTER_DRAIN) { E(acc, cur, wr, wc, fr, fq); S.done(cur); }
        if (!has_next) break;
#pragma unroll
        for (int a = 0; a < 2; ++a)
#pragma unroll
            for (int b = 0; b < 2; ++b)
#pragma unroll
                for (int m = 0; m < 4; ++m)
#pragma unroll
                    for (int n = 0; n < 2; ++n) acc[a][b][m][n] = (f32x4){0.f, 0.f, 0.f, 0.f};
        cur = nxt; cA = nA; cB = nB; ++ui;
        if constexpr (ALIGN_EPI) { if (wr == 1) PG8_BAR; }
    }
    PG8_WAIT_V(0);
    if constexpr (!ALIGN_EPI) { if (wr == 0) PG8_BAR; }
    PG8_BAR;
    if constexpr (Epi::AFTER_DRAIN) { E.fused(acc, cur, wr, wc, fr, fq, lds, wid, lane); S.done(cur); }
#undef PG8_SA
#undef PG8_SB
#undef PG8_STAGE
#undef PG8_LDA
#undef PG8_LDB
#undef PG8_MMA
#undef PG8_WAIT_V
#undef PG8_WAIT_L
#undef PG8_BAR
#undef PG8_SCHED
}
}

struct EpiInProj {
  static constexpr bool PERM = false, AFTER_DRAIN = false, MIDSCALE = false;
  unsigned char* ws;
  DEVI void operator()(const f32x4 (&acc)[2][2][4][2], const pg8::Unit& u, int wr, int wc, int fr, int fq) const {
    bf16_t* PROJ = (bf16_t*)(ws + OFF_PROJ); bf16_t* VT = (bf16_t*)(ws + OFF_VT); const float* rc = (const float*)(ws + OFF_ROPE);
    const int rowb = u.pm * 256 + wr * 64 + fr;
#pragma unroll
    for (int bj = 0; bj < 2; ++bj) {
      const int cb = u.pn * 256 + bj * 128;
      const bool isv = (cb == 1152) || (cb == 1536) || (cb == 1664);
      const bool do_rope = (cb < 256) || (cb == 1024);
      const float qs = cb < 512 ? 0.125f : 1.f;
      const int vchb = (cb == 1152 ? 0 : 128 + (cb - 1536)) + 32 * wc + 4 * fq;
#pragma unroll
      for (int ai = 0; ai < 2; ++ai)
#pragma unroll
        for (int m = 0; m < 4; ++m) {
          const int row = rowb + 128 * ai + 16 * m;
          f32x4 v0 = acc[ai][bj][m][0], v1 = acc[ai][bj][m][1];
          if (isv) {
#pragma unroll
            for (int e = 0; e < 4; ++e) { VT[(unsigned)((vchb + e) * TT + row)] = (bf16_t)(cvt_pk(v0[e], 0.f) & 0xffffu); VT[(unsigned)((vchb + 16 + e) * TT + row)] = (bf16_t)(cvt_pk(v1[e], 0.f) & 0xffffu); }
          } else {
            if (do_rope && row < T) {
              const int pos = row & 4095, pp = (wc & 1) ? (pos & 63) : (pos >> 6);
              const f32x4 cs = *(const f32x4*)(rc + pp * 16 + 4 * fq), sn = *(const f32x4*)(rc + 1024 + pp * 16 + 4 * fq);
#pragma unroll
              for (int e = 0; e < 4; ++e) { const float x1 = v0[e], x2 = v1[e]; v0[e] = x1 * cs[e] - x2 * sn[e]; v1[e] = x2 * cs[e] + x1 * sn[e]; }
            }
            u32x2 o0, o1; o0.x = cvt_pk(v0[0] * qs, v0[1] * qs); o0.y = cvt_pk(v0[2] * qs, v0[3] * qs); o1.x = cvt_pk(v1[0] * qs, v1[1] * qs); o1.y = cvt_pk(v1[2] * qs, v1[3] * qs);
            bf16_t* dst = PROJ + (unsigned)(row * PW + cb + 32 * wc + 4 * fq);
            *(u32x2*)dst = o0; *(u32x2*)(dst + 16) = o1;
          }
        }
    }
  }
};
struct EpiSwiglu {
  static constexpr bool PERM = false, AFTER_DRAIN = false, MIDSCALE = false;
  unsigned char* ws;
  DEVI void operator()(const f32x4 (&acc)[2][2][4][2], const pg8::Unit& u, int wr, int wc, int fr, int fq) const {
    bf16_t* G = (bf16_t*)(ws + OFF_PROJ);
    const int rowb = u.pm * 256 + wr * 64 + fr;
#pragma unroll
    for (int bj = 0; bj < 2; ++bj)
#pragma unroll
      for (int ai = 0; ai < 2; ++ai)
#pragma unroll
        for (int m = 0; m < 4; ++m) {
          const int row = rowb + 128 * ai + 16 * m;
          float o[4];
#pragma unroll
          for (int e = 0; e < 4; ++e) o[e] = silu_f(acc[ai][bj][m][0][e]) * acc[ai][bj][m][1][e];
          u32x2 ov; ov.x = cvt_pk(o[0], o[1]); ov.y = cvt_pk(o[2], o[3]);
          *(u32x2*)(G + (unsigned)(row * 2816 + u.pn * 128 + bj * 64 + wc * 16 + 4 * fq)) = ov;
        }
  }
};
template <bool MID>
struct EpiResid {
  static constexpr bool PERM = false, AFTER_DRAIN = false, MIDSCALE = MID;
  unsigned char* ws; const float* rin_lat; const float* rin_ctx; float* rout_lat; float* rout_ctx; int layer, gate_idx;
  DEVI void midscale(f32x4 (&acc)[2][2][4][2], const pg8::Unit& u, int wr, int fr) const {
    const float* ssq = (const float*)(ws + OFF_SSQ) + u.pm * 256 + wr * 64 + fr;
    float sq[8];
#pragma unroll
    for (int k = 0; k < 8; ++k) sq[k] = ssq[128 * (k >> 2) + 16 * (k & 3)];
#pragma unroll
    for (int ai = 0; ai < 2; ++ai)
#pragma unroll
      for (int m = 0; m < 4; ++m) {
        const float rs = rsqrtf(sq[ai * 4 + m] * (1.f / 512.f) + EPSN);
#pragma unroll
        for (int bj = 0; bj < 2; ++bj) { acc[ai][bj][m][0] = acc[ai][bj][m][0] * rs; acc[ai][bj][m][1] = acc[ai][bj][m][1] * rs; }
      }
  }
  DEVI void operator()(const f32x4 (&acc)[2][2][4][2], const pg8::Unit& u, int wr, int wc, int fr, int fq) const {
    const bool lat = u.pm < T / 256;
    const int mr = lat ? (u.pm >> 4) : 4;
    const float* gpb = (const float*)(ws + OFF_MODS) + (size_t)(layer * 5 + mr) * 6144 + gate_idx * 1024;
    const float* rinb = lat ? rin_lat : rin_ctx; float* routb = lat ? rout_lat : rout_ctx;
    const int col0 = u.pn * 256 + wc * 32 + 4 * fq;
    const unsigned off0 = (unsigned)(((lat ? u.pm : u.pm - T / 256) * 256 + wr * 64 + fr) * 1024 + col0);
#pragma unroll
    for (int bj = 0; bj < 2; ++bj)
#pragma unroll
      for (int n = 0; n < 2; ++n) {
        const f32x4 gv = *(const f32x4*)(gpb + col0 + 128 * bj + 16 * n);
        f32x4 rv[8];
#pragma unroll
        for (int k = 0; k < 8; ++k) rv[k] = *(const f32x4*)(rinb + off0 + (unsigned)((128 * (k >> 2) + 16 * (k & 3)) * 1024 + 128 * bj + 16 * n));
#pragma unroll
        for (int ai = 0; ai < 2; ++ai)
#pragma unroll
          for (int m = 0; m < 4; ++m) {
            const unsigned off = off0 + (unsigned)((128 * ai + 16 * m) * 1024 + 128 * bj + 16 * n);
            f32x4 o;
#pragma unroll
            for (int e = 0; e < 4; ++e) o[e] = rv[ai * 4 + m][e] + gv[e] * acc[ai][bj][m][n][e];
            *(f32x4*)(routb + off) = o;
          }
      }
  }
};
constexpr int MODE_INPROJ = 0, MODE_RESID = 1, MODE_SWIGLU = 2;
template <int MODE, bool ASCALE>
DEVI void gemm_phase(const Params& P, int layer) {
  constexpr int K = (MODE == MODE_RESID && !ASCALE) ? 2816 : 1024;
  constexpr int N = MODE == MODE_INPROJ ? 2816 : (MODE == MODE_SWIGLU ? 5632 : 1024);
  const int M = (MODE == MODE_INPROJ || (layer == 0 && MODE != MODE_RESID)) ? TT : T;
  const bf16_t* A = (const bf16_t*)(P.ws + ((MODE == MODE_RESID && !ASCALE) ? OFF_PROJ : OFF_H));
  const bf16_t* Wt = (const bf16_t*)(P.ws + (MODE == MODE_INPROJ ? OFF_WIN : MODE == MODE_SWIGLU ? OFF_WFI : ASCALE ? OFF_WOUT : OFF_WFO));
  pg8::Gemm g{A, Wt, M, N, K}; pg8::StaticOrder S; S.init(M, N, (int)gridDim.x, (int)blockIdx.x);
  PG8_LAS unsigned char* lds = (PG8_LAS unsigned char*)smem;
  if constexpr (MODE == MODE_INPROJ) {
    EpiInProj E{P.ws};
    pg8::gemm_phase<EpiInProj, pg8::StaticOrder, true, true>(lds, g, S, E);
    const int lane = threadIdx.x & 63, r = lane & 15, q = lane >> 4;
    const bf16_t* Wd = Wt + (size_t)(2816 + r) * 1024 + 8 * q;
    float* DTb = (float*)(P.ws + OFF_DT);
    for (int tile = blockIdx.x * 8 + (threadIdx.x >> 6); tile < TT / 16; tile += gridDim.x * 8) {
      const bf16_t* Ar = A + (size_t)(16 * tile + r) * 1024 + 8 * q;
      f32x4 acc = (f32x4){0.f, 0.f, 0.f, 0.f};
#pragma unroll 8
      for (int s2 = 0; s2 < 32; ++s2) acc = mfma16(*(const bf16x8*)(Ar + 32 * s2), *(const bf16x8*)(Wd + 32 * s2), acc);
#pragma unroll
      for (int e = 0; e < 4; ++e) DTb[(size_t)(16 * tile + 4 * q + e) * 16 + r] = acc[e];
    }
  } else if constexpr (MODE == MODE_SWIGLU) {
    EpiSwiglu E{P.ws};
    pg8::gemm_phase<EpiSwiglu, pg8::StaticOrder, true, true>(lds, g, S, E);
  } else {
    float* XCp = (float*)(P.ws + OFF_XC);
    EpiResid<ASCALE> E{P.ws, (ASCALE && layer == 0) ? P.x : P.out, (ASCALE && layer == 0) ? P.ctx : XCp, P.out, XCp, layer, ASCALE ? 2 : 5};
    pg8::gemm_phase<EpiResid<ASCALE>, pg8::StaticOrder, true, true>(lds, g, S, E);
    if (layer == 0) {
      const int lane = threadIdx.x & 63, r = lane & 15, q = lane >> 4, w8 = threadIdx.x >> 6;
      const float* gpb = (const float*)(P.ws + OFF_MODS) + (size_t)(layer * 5 + 4) * 6144 + (ASCALE ? 2 : 5) * 1024;
      const float* rinb = ASCALE ? P.ctx : XCp;
      const float* ssq = (const float*)(P.ws + OFF_SSQ) + T;
      constexpr int PER = K / 32 / 8;
      float* part = (float*)smem;
      for (int tl = blockIdx.x; tl < 256; tl += gridDim.x) {
        const int r0 = (tl >> 4) * 64, n0 = (tl & 15) * 64;
        const bf16_t* Ar = A + (size_t)(T + r0 + r) * K + w8 * PER * 32 + 8 * q;
        const bf16_t* Br = Wt + (size_t)(n0 + r) * K + w8 * PER * 32 + 8 * q;
        f32x4 acc[4][4];
#pragma unroll
        for (int i = 0; i < 4; ++i)
#pragma unroll
          for (int j = 0; j < 4; ++j) acc[i][j] = (f32x4){0.f, 0.f, 0.f, 0.f};
#pragma unroll 2
        for (int s2 = 0; s2 < PER; ++s2) {
          bf16x8 af[4], bfr[4];
#pragma unroll
          for (int i = 0; i < 4; ++i) { af[i] = *(const bf16x8*)(Ar + (size_t)(16 * i) * K + 32 * s2); bfr[i] = *(const bf16x8*)(Br + (size_t)(16 * i) * K + 32 * s2); }
#pragma unroll
          for (int i = 0; i < 4; ++i)
#pragma unroll
            for (int j = 0; j < 4; ++j) acc[i][j] = mfma16(af[i], bfr[j], acc[i][j]);
        }
        const bool sc = ASCALE && w8 < 4;
        float sqv[16];
#pragma unroll
        for (int k = 0; k < 16; ++k) sqv[k] = ssq[r0 + 16 * (k >> 2) + 4 * q + (k & 3)];
#pragma unroll
        for (int i = 0; i < 4; ++i)
#pragma unroll
          for (int e = 0; e < 4; ++e) {
            const float rs = sc ? rsqrtf(sqv[i * 4 + e] * (1.f / 512.f) + EPSN) : 1.f;
#pragma unroll
            for (int j = 0; j < 4; ++j) part[w8 * 4096 + (16 * i + 4 * q + e) * 64 + 16 * j + r] = acc[i][j][e] * rs;
          }
        __syncthreads();
        float rres[8], gres[8];
#pragma unroll
        for (int k = 0; k < 8; ++k) { const int o = (int)threadIdx.x + 512 * k; rres[k] = rinb[(unsigned)((r0 + (o >> 6)) * 1024 + n0 + (o & 63))]; gres[k] = gpb[n0 + (o & 63)]; }
#pragma unroll
        for (int k = 0; k < 8; ++k) {
          const int o = (int)threadIdx.x + 512 * k, row = o >> 6, col = o & 63;
          float sum = 0.f;
#pragma unroll
          for (int pw = 0; pw < 8; ++pw) sum += part[pw * 4096 + o];
          XCp[(unsigned)((r0 + row) * 1024 + n0 + col)] = rres[k] + gres[k] * sum;
        }
        __syncthreads();
      }
    }
  }
}

template <int KIND>
NOINL void attn_item(const Params& P, int layer, int b, int i1, int i2, int isctx_) {
  unsigned char* const smh = smem + half_id() * HSTR;
  const bool isctx = isctx_ != 0;
  constexpr int NQT = (KIND == 1) ? 1 : 2;
  const int t = tid_opq(), lane = t & 63, w = t >> 6, r = lane & 15, q = lane >> 4, r7 = r & 7;
  const bf16_t* PROJ = (const bf16_t*)(P.ws + OFF_PROJ);
  const bf16_t* VT = (const bf16_t*)(P.ws + OFF_VT);
  bf16_t* MIX = (bf16_t*)(P.ws + OFF_H);
  constexpr bool DBL = (KIND == 1);
  constexpr int VSTR = DBL ? 272 : 136;
  unsigned char* Ks = smh; unsigned char* Vs = smh + (DBL ? 16384 : 8192); float* rpb = (float*)(smh + 33792);
  const int col0 = w == 0 ? 0 : (w == 1 ? 8 : (w == 2 ? 24 : 32));
  int qrow[NQT]; int qcol, kcol, vch, ocol, ntile; bool has_sink = false; float sinkv = 0.f;
  int r0g = 0;
  if (KIND == 0 && !isctx) {
    const int n = i1, head = i2;
#pragma unroll
    for (int qt = 0; qt < NQT; ++qt) qrow[qt] = b * 4096 + 128 * n + 32 * w + 16 * qt + r;
    qcol = head * 64; kcol = 1024 + (head >> 1) * 64; vch = (head >> 1) * 64; ocol = 512 + head * 64; ntile = 10; has_sink = true; sinkv = P.wa_sink[layer * 4 + head];
  } else if (KIND == 1) {
    const int gr = i1, h = i2;
    qrow[0] = b * 4096 + gr * 64 + 16 * w + r;
    qcol = 256 + 64 * h; kcol = 1280 + 64 * h; vch = 128 + 64 * h; ocol = 768 + 64 * h; ntile = 8;
    r0g = gr - 4 < 0 ? 0 : (gr - 4 > 56 ? 56 : gr - 4);
    __syncthreads();
    for (int e = t; e < 465; e += 256) rpb[e] = P.na_rpb[(size_t)(layer * 4 + h) * 465 + e];
  } else {
    const int qb = i1, hh = i2;
#pragma unroll
    for (int qt = 0; qt < NQT; ++qt) qrow[qt] = T + b * 256 + 128 * qb + 32 * w + 16 * qt + r;
    ntile = 4;
    if (hh < 4) { qcol = hh * 64; kcol = 1024 + (hh >> 1) * 64; vch = (hh >> 1) * 64; ocol = 512 + hh * 64; has_sink = true; sinkv = P.wa_sink[layer * 4 + hh]; }
    else { const int h = hh - 4; qcol = 256 + 64 * h; kcol = 1280 + 64 * h; vch = 128 + 64 * h; ocol = 768 + 64 * h; }
  }
  bf16x8 qf[NQT][2];
#pragma unroll
  for (int qt = 0; qt < NQT; ++qt)
#pragma unroll
    for (int s = 0; s < 2; ++s) qf[qt][s] = *(const bf16x8*)(PROJ + (size_t)qrow[qt] * PW + qcol + 32 * s + 8 * q);
  f32x4 o[4][NQT]; float mrun[NQT], lrun[NQT];
#pragma unroll
  for (int qt = 0; qt < NQT; ++qt) { mrun[qt] = -1e30f; lrun[qt] = 0.f;
#pragma unroll
    for (int dt = 0; dt < 4; ++dt) o[dt][qt] = (f32x4){0.f, 0.f, 0.f, 0.f}; }

  const int skip = (KIND == 0 && !isctx && i1 == 0) ? 2 : 0;
  const int nvalid = ntile - skip - ((KIND == 0 && !isctx && i1 == 31) ? 2 : 0);
  const int skey = t >> 2, sc0 = (t & 3) * 2;
  u32x4 pk0, pk1, pv0, pv1, pk2, pk3, pv2, pv3;
#define KV_ROW0(IDX, TI, KROW0) const int TI = (IDX) < 4 ? (IDX) : (IDX) + skip; \
    const int KROW0 = TI < 4 ? T + b * 256 + 64 * TI : (KIND == 1 ? b * 4096 + (r0g + 2 * (TI - 4)) * 64 : b * 4096 + 128 * (i1 - 1) + 64 * (TI - 4));
#define KV_LOAD(IDX) { KV_ROW0(IDX, ti_, kr0_) \
    const bf16_t* kp = PROJ + (size_t)(kr0_ + skey) * PW + kcol + sc0 * 8; pk0 = *(const u32x4*)kp; pk1 = *(const u32x4*)(kp + 8); \
    const bf16_t* vp = VT + (size_t)(vch + skey) * TT + kr0_ + sc0 * 8; pv0 = *(const u32x4*)vp; pv1 = *(const u32x4*)(vp + 8); \
    if (DBL && ti_ >= 4) { pk2 = *(const u32x4*)(kp + 64 * PW); pk3 = *(const u32x4*)(kp + 64 * PW + 8); pv2 = *(const u32x4*)(vp + 64); pv3 = *(const u32x4*)(vp + 72); } }
  KV_LOAD(0);
#pragma unroll 1
  for (int idx = 0; idx < nvalid; ++idx) {
    KV_ROW0(idx, ti, krow0)
    (void)krow0;
    const int kbase = 128 * (i1 - 1) + 64 * (ti - 4); const int kr = r0g + 2 * (ti - 4);
    const bool local2 = DBL && ti >= 4;
    __syncthreads();
    {
      *(u32x4*)(Ks + skey * 128 + ((sc0 ^ (skey & 7)) << 4)) = pk0; *(u32x4*)(Ks + skey * 128 + (((sc0 + 1) ^ (skey & 7)) << 4)) = pk1;
      u32x2* dst = (u32x2*)(Vs + skey * VSTR + sc0 * 16);
      dst[0] = (u32x2){pv0.x, pv0.y}; dst[1] = (u32x2){pv0.z, pv0.w}; dst[2] = (u32x2){pv1.x, pv1.y}; dst[3] = (u32x2){pv1.z, pv1.w};
      if (local2) {
        *(u32x4*)(Ks + (skey + 64) * 128 + ((sc0 ^ (skey & 7)) << 4)) = pk2; *(u32x4*)(Ks + (skey + 64) * 128 + (((sc0 + 1) ^ (skey & 7)) << 4)) = pk3;
        u32x2* dst2 = (u32x2*)(Vs + skey * VSTR + 128 + sc0 * 16);
        dst2[0] = (u32x2){pv2.x, pv2.y}; dst2[1] = (u32x2){pv2.z, pv2.w}; dst2[2] = (u32x2){pv3.x, pv3.y}; dst2[3] = (u32x2){pv3.z, pv3.w};
      }
    }
    __syncthreads();
    if (idx + 1 < nvalid) KV_LOAD(idx + 1);
    f32x4 sc[4][NQT];
#pragma unroll
    for (int kt = 0; kt < 4; ++kt) {
      const int krow = (local2 ? (kt >> 1) * 64 + col0 + 16 * (kt & 1) : 16 * kt) + r;
      const bf16x8 kf0 = *(const bf16x8*)(Ks + krow * 128 + ((q ^ r7) << 4));
      const bf16x8 kf1 = *(const bf16x8*)(Ks + krow * 128 + (((4 + q) ^ r7) << 4));
#pragma unroll
      for (int qt = 0; qt < NQT; ++qt) { sc[kt][qt] = mfma16(kf0, qf[qt][0], (f32x4){0.f, 0.f, 0.f, 0.f}); sc[kt][qt] = mfma16(kf1, qf[qt][1], sc[kt][qt]); }
    }
    if (ti >= 4) {
      if (KIND == 0) {
#pragma unroll
        for (int qt = 0; qt < NQT; ++qt) { const int qpos = 128 * i1 + 32 * w + 16 * qt + r;
#pragma unroll
          for (int kt = 0; kt < 4; ++kt)
#pragma unroll
            for (int e = 0; e < 4; ++e) { const int d = qpos - (kbase + 16 * kt + 4 * q + e); if (d > 128 || d < -128) sc[kt][qt][e] = -1e30f; } }
      } else if (KIND == 1) {
        const int qc = 16 * w + r; const int cs = qc - 8 < 0 ? 0 : (qc - 8 > 48 ? 48 : qc - 8);
#pragma unroll
        for (int kt = 0; kt < 4; ++kt) {
          const int dy = kr + (kt >> 1) - i1 + 7;
#pragma unroll
          for (int e = 0; e < 4; ++e) { const int kc = col0 + 16 * (kt & 1) + 4 * q + e; const bool ok = (kc >= cs) && (kc < cs + 16);
            int dx = kc - qc + 15; dx = dx < 0 ? 0 : (dx > 30 ? 30 : dx);
            sc[kt][0][e] = ok ? sc[kt][0][e] + rpb[dy * 31 + dx] : -1e30f; }
        }
      }
    }
    bf16x8 pf[2][NQT];
#pragma unroll
    for (int qt = 0; qt < NQT; ++qt) {
      float mx = -1e30f;
#pragma unroll
      for (int kt = 0; kt < 4; ++kt)
#pragma unroll
        for (int e = 0; e < 4; ++e) mx = fmaxf(mx, sc[kt][qt][e]);
      mx = fmaxf(mx, __shfl_xor(mx, 16)); mx = fmaxf(mx, __shfl_xor(mx, 32));
      const float mn = fmaxf(mrun[qt], mx); const float alpha = __expf(mrun[qt] - mn); mrun[qt] = mn;
      float ls = 0.f;
#pragma unroll
      for (int kt = 0; kt < 4; ++kt)
#pragma unroll
        for (int e = 0; e < 4; ++e) { const float p = __expf(sc[kt][qt][e] - mn); sc[kt][qt][e] = p; ls += p; }
      lrun[qt] = lrun[qt] * alpha + ls;
#pragma unroll
      for (int dt = 0; dt < 4; ++dt) o[dt][qt] = o[dt][qt] * alpha;
#pragma unroll
      for (int s = 0; s < 2; ++s) {
        u32x4 pk; pk.x = cvt_pk(sc[2 * s][qt][0], sc[2 * s][qt][1]); pk.y = cvt_pk(sc[2 * s][qt][2], sc[2 * s][qt][3]);
        pk.z = cvt_pk(sc[2 * s + 1][qt][0], sc[2 * s + 1][qt][1]); pk.w = cvt_pk(sc[2 * s + 1][qt][2], sc[2 * s + 1][qt][3]);
        pf[s][qt] = as_bf16x8(pk);
      }
    }
#pragma unroll
    for (int s = 0; s < 2; ++s)
#pragma unroll
      for (int dt = 0; dt < 4; ++dt) {
        const int vkb = local2 ? 64 * s + col0 : 32 * s;
        const u32x2 lo = *(const u32x2*)(Vs + (16 * dt + r) * VSTR + (vkb + 4 * q) * 2);
        const u32x2 hi = *(const u32x2*)(Vs + (16 * dt + r) * VSTR + (vkb + 16 + 4 * q) * 2);
        const bf16x8 vf = as_bf16x8((u32x4){lo.x, lo.y, hi.x, hi.y});
#pragma unroll
        for (int qt = 0; qt < NQT; ++qt) o[dt][qt] = mfma16(vf, pf[s][qt], o[dt][qt]);
      }
  }
#pragma unroll
  for (int qt = 0; qt < NQT; ++qt) {
    float l = lrun[qt]; l += __shfl_xor(l, 16); l += __shfl_xor(l, 32);
    float mf = mrun[qt]; float scale;
    if (has_sink) { const float m2 = fmaxf(mf, sinkv); const float a = __expf(mf - m2); l = l * a + __expf(sinkv - m2); scale = a / l; }
    else scale = 1.f / l;
#pragma unroll
    for (int dt = 0; dt < 4; ++dt) {
      u32x2 ov; ov.x = cvt_pk(o[dt][qt][0] * scale, o[dt][qt][1] * scale); ov.y = cvt_pk(o[dt][qt][2] * scale, o[dt][qt][3] * scale);
      *(u32x2*)(MIX + (size_t)qrow[qt] * 1024 + ocol + 16 * dt + 4 * q) = ov;
    }
  }
}

DEVI void ssd_load_raw(unsigned char* raw, const bf16_t* PROJ, int rowbase, int lo, int hi, int col0) {
  for (int e = tid_opq(); e < 134 * 8; e += 256) {
    const int rr = e >> 3, ch = e & 7; const int row = rowbase - 3 + rr;
    u32x4 v = (u32x4){0u, 0u, 0u, 0u};
    if (row >= lo && row < hi) v = *(const u32x4*)(PROJ + (size_t)row * PW + col0 + ch * 8);
    *(u32x4*)(raw + rr * 128 + ch * 16) = v;
  }
}

template <bool TRANSP, bool WEIGHTED>
DEVI void ssd_conv(const unsigned char* raw, const float* cw  , const float* cb, unsigned char* out1, unsigned char* out2, const float* wt1, const float* wt2) {
  const int t_ = tid_opq(); const int c = t_ & 63, tq = t_ >> 6;
  float wj[7];
#pragma unroll
  for (int j = 0; j < 7; ++j) wj[j] = cw[j * 1024 + c];
  const float bias = cb[c];
  const bf16_t* rp = (const bf16_t*)raw + c;
  float w0 = bf2f(rp[(32 * tq + 0) * 64]), w1 = bf2f(rp[(32 * tq + 1) * 64]), w2 = bf2f(rp[(32 * tq + 2) * 64]), w3 = bf2f(rp[(32 * tq + 3) * 64]), w4 = bf2f(rp[(32 * tq + 4) * 64]), w5 = bf2f(rp[(32 * tq + 5) * 64]);
  float hold1[4], hold2[4];
#pragma unroll 1
  for (int tg = 0; tg < 8; ++tg) {
#pragma unroll
    for (int t4 = 0; t4 < 4; ++t4) {
      const int tok = 32 * tq + 4 * tg + t4;
      const float w6 = bf2f(rp[(tok + 6) * 64]);
      float v = bias + wj[0] * w0 + wj[1] * w1 + wj[2] * w2 + wj[3] * w3 + wj[4] * w4 + wj[5] * w5 + wj[6] * w6;
      v = silu_f(v);
      w0 = w1; w1 = w2; w2 = w3; w3 = w4; w4 = w5; w5 = w6;
      if (TRANSP) {
        hold1[t4] = WEIGHTED ? v * wt1[tok] : v;
        if (WEIGHTED) hold2[t4] = v * wt2[tok];
        if (t4 == 3) {
          u32x2 o; o.x = cvt_pk(hold1[0], hold1[1]); o.y = cvt_pk(hold1[2], hold1[3]);
          *(u32x2*)(out1 + c * 272 + (tok - 3) * 2) = o;
          if (WEIGHTED) { u32x2 o2; o2.x = cvt_pk(hold2[0], hold2[1]); o2.y = cvt_pk(hold2[2], hold2[3]); *(u32x2*)(out2 + c * 272 + (tok - 3) * 2) = o2; }
        }
      } else {
        *(bf16_t*)(out1 + tok * 128 + (((c >> 3) ^ (tok & 7)) << 4) + (c & 7) * 2) = (bf16_t)(cvt_pk(v, 0.f) & 0xffffu);
      }
    }
  }
}

constexpr int SM_RAW = 0, SM_X1 = 17152, SM_X2 = 34560, SM_BT = 51968, SM_SMALL = 69376;
constexpr int SM_XT = 17152, SM_BN = 34560, SM_CN = 50944;

NOINL void conv_item(const Params& P, int layer, int b, int cidx, int slab) {
  unsigned char* const smh = smem + half_id() * HSTR;
  const int t = tid_opq(), c = t & 63, tq = t >> 6;
  const bf16_t* PROJ = (const bf16_t*)(P.ws + OFF_PROJ);
  bf16_t* XN = (bf16_t*)(P.ws + OFF_XN);
  int rowbase, lo, hi;
  if (cidx < 2) { lo = T + b * 256; hi = lo + 256; rowbase = lo + cidx * 128; } else { lo = b * 4096; hi = lo + 4096; rowbase = lo + (cidx - 2) * 128; }
  __syncthreads();
  ssd_load_raw(smh + SM_RAW, PROJ, rowbase, lo, hi, 1792 + slab * 64);
  __syncthreads();
  const float* cw = P.conv_w + (size_t)layer * 7 * 1024 + slab * 64 + c;
  float wj[7];
#pragma unroll
  for (int j = 0; j < 7; ++j) wj[j] = cw[j * 1024];
  const float bias = P.conv_b[layer * 1024 + slab * 64 + c];
  const bf16_t* rp = (const bf16_t*)(smh + SM_RAW) + c;
  float w0 = bf2f(rp[(32 * tq + 0) * 64]), w1 = bf2f(rp[(32 * tq + 1) * 64]), w2 = bf2f(rp[(32 * tq + 2) * 64]), w3 = bf2f(rp[(32 * tq + 3) * 64]), w4 = bf2f(rp[(32 * tq + 4) * 64]), w5 = bf2f(rp[(32 * tq + 5) * 64]);
  const bool nat = slab >= 8, tr = slab < 12;
  bf16_t* trp = slab < 8 ? (bf16_t*)(P.ws + OFF_XTX) + (size_t)(slab * 64 + c) * TT : (bf16_t*)(P.ws + OFF_XTB) + (size_t)((slab - 8) * 64 + c) * TT;
#pragma unroll 1
  for (int tg = 0; tg < 4; ++tg) {
    float hold[8];
#pragma unroll
    for (int t8 = 0; t8 < 8; ++t8) {
      const int tok = 32 * tq + 8 * tg + t8;
      const float w6 = bf2f(rp[(tok + 6) * 64]);
      float v = bias + wj[0] * w0 + wj[1] * w1 + wj[2] * w2 + wj[3] * w3 + wj[4] * w4 + wj[5] * w5 + wj[6] * w6;
      v = silu_f(v);
      w0 = w1; w1 = w2; w2 = w3; w3 = w4; w4 = w5; w5 = w6;
      hold[t8] = v;
      if (nat) XN[(size_t)(rowbase + tok) * 512 + (slab - 8) * 64 + c] = (bf16_t)(cvt_pk(v, 0.f) & 0xffffu);
    }
    if (tr) {
      u32x4 o; o.x = cvt_pk(hold[0], hold[1]); o.y = cvt_pk(hold[2], hold[3]); o.z = cvt_pk(hold[4], hold[5]); o.w = cvt_pk(hold[6], hold[7]);
      *(u32x4*)(trp + rowbase + 32 * tq + 8 * tg) = o;
    }
  }
}

NOINL void ssd_state_item(const Params& P, int layer, int b, int cidx, int h) {
  unsigned char* const smh = smem + half_id() * HSTR;
  const int t = tid_opq(), lane = t & 63, w = t >> 6, r = lane & 15, q = lane >> 4;
  const bf16_t* PROJ = (const bf16_t*)(P.ws + OFF_PROJ);
  const float* DTb = (const float*)(P.ws + OFF_DT);
  bf16_t* ST = (bf16_t*)(P.ws + OFF_ST);
  float* CD = (float*)(P.ws + OFF_CD);
  float* sm = (float*)(smh + SM_SMALL);
  int rowbase, lo, hi;
  if (cidx < 2) { lo = T + b * 256; hi = lo + 256; rowbase = lo + cidx * 128; } else { lo = b * 4096; hi = lo + 4096; rowbase = lo + (cidx - 2) * 128; }
  const int g = h >> 2;
  const float Af = -__expf(P.a_log[layer * 16 + h]), Ab = -__expf(P.a_log[layer * 16 + 8 + h]);
  __syncthreads();
  float inf_ = 0.f, inb_ = 0.f, ab_ = 0.f;
  if (t < 128) {
    const float df = softplus_f(DTb[(size_t)(rowbase + t) * 16 + h] + P.dt_bias[layer * 16 + h]);
    const float db = softplus_f(DTb[(size_t)(rowbase + t) * 16 + 8 + h] + P.dt_bias[layer * 16 + 8 + h]);
    sm[256 + t] = df; sm[384 + t] = db;
    ab_ = db * Ab; inf_ = wave_incl_scan(df * Af, lane); inb_ = wave_incl_scan(ab_, lane);
    if (lane == 63) { sm[772 + w] = inf_; sm[774 + w] = inb_; }
  }
  __syncthreads();
  if (t < 128) {
    const float acf = inf_ + (w == 1 ? sm[772] : 0.f), totf = sm[772] + sm[773];
    const float preb = inb_ - ab_ + (w == 1 ? sm[774] : 0.f), totb = sm[774] + sm[775];
    sm[512 + t] = __expf(totf - acf) * sm[256 + t];
    sm[640 + t] = __expf(preb) * sm[384 + t];
    if (t == 0) { const int seq = (b * 8 + h) * 2; CD[seq * 34 + cidx] = __expf(totf); CD[(seq + 1) * 34 + cidx] = __expf(totb); }
  }
  __syncthreads();
  {
    const bf16_t* XTX = (const bf16_t*)(P.ws + OFF_XTX);
#pragma unroll
    for (int k = 0; k < 4; ++k) {
      const int e = t + 256 * k, p = e >> 4, c16 = e & 15;
      const u32x4 v = *(const u32x4*)(XTX + (size_t)(h * 64 + p) * TT + rowbase + c16 * 8);
      const float* wf = sm + 512 + c16 * 8; const float* wb = sm + 640 + c16 * 8;
      u32x4 of, ob;
      of.x = cvt_pk(bflo(v.x) * wf[0], bfhi(v.x) * wf[1]); of.y = cvt_pk(bflo(v.y) * wf[2], bfhi(v.y) * wf[3]); of.z = cvt_pk(bflo(v.z) * wf[4], bfhi(v.z) * wf[5]); of.w = cvt_pk(bflo(v.w) * wf[6], bfhi(v.w) * wf[7]);
      ob.x = cvt_pk(bflo(v.x) * wb[0], bfhi(v.x) * wb[1]); ob.y = cvt_pk(bflo(v.y) * wb[2], bfhi(v.y) * wb[3]); ob.z = cvt_pk(bflo(v.z) * wb[4], bfhi(v.z) * wb[5]); ob.w = cvt_pk(bflo(v.w) * wb[6], bfhi(v.w) * wb[7]);
      *(u32x4*)(smh + SM_X1 + p * 272 + c16 * 16) = of; *(u32x4*)(smh + SM_X2 + p * 272 + c16 * 16) = ob;
    }
  }
#pragma unroll 1
  for (int nh = 0; nh < 2; ++nh) {
    {
      const bf16_t* XTB = (const bf16_t*)(P.ws + OFF_XTB);
#pragma unroll
      for (int k = 0; k < 4; ++k) {
        const int e = t + 256 * k, n = e >> 4, c16 = e & 15;
        *(u32x4*)(smh + SM_BT + n * 272 + c16 * 16) = *(const u32x4*)(XTB + (size_t)(g * 128 + nh * 64 + n) * TT + rowbase + c16 * 8);
      }
    }
    __syncthreads();
    f32x4 acc[4][2];
#pragma unroll
    for (int nt = 0; nt < 4; ++nt) { acc[nt][0] = (f32x4){0.f, 0.f, 0.f, 0.f}; acc[nt][1] = (f32x4){0.f, 0.f, 0.f, 0.f}; }
#pragma unroll
    for (int s = 0; s < 4; ++s) {
      const bf16x8 xf = *(const bf16x8*)(smh + SM_X1 + (16 * w + r) * 272 + (32 * s + 8 * q) * 2);
      const bf16x8 xb = *(const bf16x8*)(smh + SM_X2 + (16 * w + r) * 272 + (32 * s + 8 * q) * 2);
#pragma unroll
      for (int nt = 0; nt < 4; ++nt) {
        const bf16x8 bt = *(const bf16x8*)(smh + SM_BT + (16 * nt + r) * 272 + (32 * s + 8 * q) * 2);
        acc[nt][0] = mfma16(bt, xf, acc[nt][0]); acc[nt][1] = mfma16(bt, xb, acc[nt][1]);
      }
    }
#pragma unroll
    for (int dir = 0; dir < 2; ++dir) {
      bf16_t* sp = ST + ((size_t)(((b * 8 + h) * 2 + dir) * 34 + cidx)) * 8192 + (16 * w + r) * 128 + nh * 64 + 4 * q;
#pragma unroll
      for (int nt = 0; nt < 4; ++nt) { u32x2 ov; ov.x = cvt_pk(acc[nt][dir][0], acc[nt][dir][1]); ov.y = cvt_pk(acc[nt][dir][2], acc[nt][dir][3]); *(u32x2*)(sp + 16 * nt) = ov; }
    }
    __syncthreads();
  }
}

NOINL void ssd_scan_phase(const Params& P) {
  bf16_t* ST = (bf16_t*)(P.ws + OFF_ST);
  const float* CD = (const float*)(P.ws + OFF_CD);
  const int total = 64 * 2048;
  for (int gidx = VB * 256 + tid_opq(); gidx < total; gidx += VG * 256) {
    const int seq = gidx >> 11, e = gidx & 2047, dir = seq & 1;
    bf16_t* base = ST + (size_t)seq * 34 * 8192 + e * 4;
    const float* cd = CD + seq * 34;
    u32x2 v[34];
#pragma unroll
    for (int k = 0; k < 34; ++k) { const int ci = dir == 0 ? k : (k == 0 ? 1 : (k == 1 ? 0 : 35 - k)); v[k] = *(const u32x2*)(base + (size_t)ci * 8192); }
    float dk[34];
#pragma unroll
    for (int k = 0; k < 34; ++k) { const int ci = dir == 0 ? k : (k == 0 ? 1 : (k == 1 ? 0 : 35 - k)); dk[k] = cd[ci]; }
    float h0 = 0.f, h1 = 0.f, h2 = 0.f, h3 = 0.f;
#pragma unroll
    for (int k = 0; k < 34; ++k) {
      const int ci = dir == 0 ? k : (k == 0 ? 1 : (k == 1 ? 0 : 35 - k));
      u32x2 ov; ov.x = cvt_pk(h0, h1); ov.y = cvt_pk(h2, h3);
      *(u32x2*)(base + (size_t)ci * 8192) = ov;
      const float d = dk[k];
      h0 = h0 * d + bflo(v[k].x); h1 = h1 * d + bfhi(v[k].x); h2 = h2 * d + bflo(v[k].y); h3 = h3 * d + bfhi(v[k].y);
    }
  }
}

NOINL void ssd_out_item(const Params& P, int layer, int b, int cidx, int h, int do_atomic) {
  unsigned char* const smh = smem + half_id() * HSTR;
  const int t = tid_opq(), lane = t & 63, w = t >> 6, r = lane & 15, q = lane >> 4, r7 = r & 7;
  const bf16_t* PROJ = (const bf16_t*)(P.ws + OFF_PROJ);
  const float* DTb = (const float*)(P.ws + OFF_DT);
  const bf16_t* ST = (const bf16_t*)(P.ws + OFF_ST);
  bf16_t* MIX = (bf16_t*)(P.ws + OFF_H);
  float* SSQ = (float*)(P.ws + OFF_SSQ);
  float* sm = (float*)(smh + SM_SMALL);
  int rowbase, lo, hi;
  if (cidx < 2) { lo = T + b * 256; hi = lo + 256; rowbase = lo + cidx * 128; } else { lo = b * 4096; hi = lo + 4096; rowbase = lo + (cidx - 2) * 128; }
  const int g = h >> 2;
  const float Af = -__expf(P.a_log[layer * 16 + h]), Ab = -__expf(P.a_log[layer * 16 + 8 + h]);
  __syncthreads();
  float inf_ = 0.f, inb_ = 0.f, ab_ = 0.f;
  if (t < 128) {
    const float df = softplus_f(DTb[(size_t)(rowbase + t) * 16 + h] + P.dt_bias[layer * 16 + h]);
    const float db = softplus_f(DTb[(size_t)(rowbase + t) * 16 + 8 + h] + P.dt_bias[layer * 16 + 8 + h]);
    sm[256 + t] = df; sm[384 + t] = db;
    ab_ = db * Ab; inf_ = wave_incl_scan(df * Af, lane); inb_ = wave_incl_scan(ab_, lane);
    if (lane == 63) { sm[772 + w] = inf_; sm[774 + w] = inb_; }
  }
  {
    const bf16_t* XTX = (const bf16_t*)(P.ws + OFF_XTX);
#pragma unroll
    for (int k = 0; k < 4; ++k) {
      const int e = t + 256 * k, p = e >> 4, c16 = e & 15;
      *(u32x4*)(smh + SM_XT + p * 272 + c16 * 16) = *(const u32x4*)(XTX + (size_t)(h * 64 + p) * TT + rowbase + c16 * 8);
    }
  }
  __syncthreads();
  if (t < 128) {
    const float acf = inf_ + (w == 1 ? sm[772] : 0.f);
    const float preb = inb_ - ab_ + (w == 1 ? sm[774] : 0.f), totb = sm[774] + sm[775];
    sm[512 + t] = acf; sm[640 + t] = preb;
    if (t == 0) sm[768] = totb;
  }
  __syncthreads();
  f32x4 G[8][2], y[4][2];
#pragma unroll
  for (int jt = 0; jt < 8; ++jt) { G[jt][0] = (f32x4){0.f, 0.f, 0.f, 0.f}; G[jt][1] = (f32x4){0.f, 0.f, 0.f, 0.f}; }
#pragma unroll
  for (int pt = 0; pt < 4; ++pt) { y[pt][0] = (f32x4){0.f, 0.f, 0.f, 0.f}; y[pt][1] = (f32x4){0.f, 0.f, 0.f, 0.f}; }
  float acfi[2], prebi[2], efi[2][2];
#pragma unroll
  for (int it = 0; it < 2; ++it) {
    const int i = 32 * w + 16 * it + r;
    acfi[it] = sm[512 + i]; prebi[it] = sm[640 + i];
    efi[0][it] = __expf(acfi[it]); efi[1][it] = __expf(sm[768] - prebi[it]);
  }
#pragma unroll 1
  for (int nh = 0; nh < 2; ++nh) {
    {
      const bf16_t* XN = (const bf16_t*)(P.ws + OFF_XN);
#pragma unroll
      for (int k = 0; k < 4; ++k) {
        const int e = t + 256 * k, tok = e >> 3, ch = e & 7;
        const bf16_t* src = XN + (size_t)(rowbase + tok) * 512 + g * 128 + nh * 64 + ch * 8;
        *(u32x4*)(smh + SM_BN + tok * 128 + ((ch ^ (tok & 7)) << 4)) = *(const u32x4*)src;
        *(u32x4*)(smh + SM_CN + tok * 128 + ((ch ^ (tok & 7)) << 4)) = *(const u32x4*)(src + 256);
      }
      const int hp_ = t >> 2, hc_ = (t & 3) * 2;
#pragma unroll
      for (int d = 0; d < 2; ++d) {
        const bf16_t* hsrc = ST + ((size_t)(((b * 8 + h) * 2 + d) * 34 + cidx)) * 8192 + hp_ * 128 + nh * 64 + hc_ * 8;
        *(u32x4*)(smh + SM_RAW + d * 8192 + hp_ * 128 + ((hc_ ^ (hp_ & 7)) << 4)) = *(const u32x4*)hsrc;
        *(u32x4*)(smh + SM_RAW + d * 8192 + hp_ * 128 + (((hc_ + 1) ^ (hp_ & 7)) << 4)) = *(const u32x4*)(hsrc + 8);
      }
    }
    __syncthreads();
    bf16x8 cf[2][2];
#pragma unroll
    for (int it = 0; it < 2; ++it)
#pragma unroll
      for (int s = 0; s < 2; ++s) cf[it][s] = *(const bf16x8*)(smh + SM_CN + (32 * w + 16 * it + r) * 128 + (((4 * s + q) ^ r7) << 4));
#pragma unroll
    for (int jt = 0; jt < 8; ++jt)
#pragma unroll
      for (int s = 0; s < 2; ++s) {
        const bf16x8 bfr = *(const bf16x8*)(smh + SM_BN + (16 * jt + r) * 128 + (((4 * s + q) ^ r7) << 4));
        G[jt][0] = mfma16(bfr, cf[0][s], G[jt][0]); G[jt][1] = mfma16(bfr, cf[1][s], G[jt][1]);
      }
#pragma unroll
    for (int d = 0; d < 2; ++d) {
#pragma unroll
      for (int s = 0; s < 2; ++s) {
        union { bf16x8 b; u32x4 u; } c0, c1; c0.b = cf[0][s]; c1.b = cf[1][s];
        const bf16x8 cs0 = as_bf16x8(scale8(c0.u, efi[d][0])), cs1 = as_bf16x8(scale8(c1.u, efi[d][1]));
#pragma unroll
        for (int pt = 0; pt < 4; ++pt) {
          const bf16x8 hf = *(const bf16x8*)(smh + SM_RAW + d * 8192 + (16 * pt + r) * 128 + (((4 * s + q) ^ r7) << 4));
          y[pt][0] = mfma16(hf, cs0, y[pt][0]); y[pt][1] = mfma16(hf, cs1, y[pt][1]);
        }
      }
    }
    __syncthreads();
  }
#pragma unroll
  for (int s = 0; s < 4; ++s) {
    asm volatile("" ::: "memory");
    bf16x8 mf[2];
    const int wu = __builtin_amdgcn_readfirstlane(w);
    if (s < wu) {
      float aj[8], dfj[8];
#pragma unroll
      for (int jj = 0; jj < 8; ++jj) { const int j = 32 * s + (jj < 4 ? 4 * q + jj : 16 + 4 * q + jj - 4); aj[jj] = sm[512 + j]; dfj[jj] = sm[256 + j]; }
#pragma unroll
      for (int it = 0; it < 2; ++it) {
        float mv[8];
#pragma unroll
        for (int jj = 0; jj < 8; ++jj) mv[jj] = G[2 * s + (jj >> 2)][it][jj & 3] * __expf(acfi[it] - aj[jj]) * dfj[jj];
        u32x4 pk; pk.x = cvt_pk(mv[0], mv[1]); pk.y = cvt_pk(mv[2], mv[3]); pk.z = cvt_pk(mv[4], mv[5]); pk.w = cvt_pk(mv[6], mv[7]);
        mf[it] = as_bf16x8(pk);
      }
    } else if (s > wu) {
      float pj[8], dbj[8];
#pragma unroll
      for (int jj = 0; jj < 8; ++jj) { const int j = 32 * s + (jj < 4 ? 4 * q + jj : 16 + 4 * q + jj - 4); pj[jj] = sm[640 + j]; dbj[jj] = sm[384 + j]; }
#pragma unroll
      for (int it = 0; it < 2; ++it) {
        float mv[8];
#pragma unroll
        for (int jj = 0; jj < 8; ++jj) mv[jj] = G[2 * s + (jj >> 2)][it][jj & 3] * __expf(pj[jj] - prebi[it]) * dbj[jj];
        u32x4 pk; pk.x = cvt_pk(mv[0], mv[1]); pk.y = cvt_pk(mv[2], mv[3]); pk.z = cvt_pk(mv[4], mv[5]); pk.w = cvt_pk(mv[6], mv[7]);
        mf[it] = as_bf16x8(pk);
      }
    } else {
    float aj[8], pj[8], dfj[8], dbj[8];
#pragma unroll
    for (int jj = 0; jj < 8; ++jj) { const int j = 32 * s + (jj < 4 ? 4 * q + jj : 16 + 4 * q + jj - 4); aj[jj] = sm[512 + j]; pj[jj] = sm[640 + j]; dfj[jj] = sm[256 + j]; dbj[jj] = sm[384 + j]; }
#pragma unroll
    for (int it = 0; it < 2; ++it) {
      const int i = 32 * w + 16 * it + r;
      float mv[8];
#pragma unroll
      for (int jj = 0; jj < 8; ++jj) {
        const int j = 32 * s + (jj < 4 ? 4 * q + jj : 16 + 4 * q + jj - 4);
        const float gv = G[2 * s + (jj >> 2)][it][jj & 3];
        float m;
        if (j < i) m = gv * __expf(acfi[it] - aj[jj]) * dfj[jj];
        else if (j > i) m = gv * __expf(pj[jj] - prebi[it]) * dbj[jj];
        else m = gv * (dfj[jj] + dbj[jj]);
        mv[jj] = m;
      }
      u32x4 pk; pk.x = cvt_pk(mv[0], mv[1]); pk.y = cvt_pk(mv[2], mv[3]); pk.z = cvt_pk(mv[4], mv[5]); pk.w = cvt_pk(mv[6], mv[7]);
      mf[it] = as_bf16x8(pk);
    }
    }
#pragma unroll
    for (int pt = 0; pt < 4; ++pt) {
      const u32x2 lo2 = *(const u32x2*)(smh + SM_XT + (16 * pt + r) * 272 + (32 * s + 4 * q) * 2);
      const u32x2 hi2 = *(const u32x2*)(smh + SM_XT + (16 * pt + r) * 272 + (32 * s + 16 + 4 * q) * 2);
      const bf16x8 xf = as_bf16x8((u32x4){lo2.x, lo2.y, hi2.x, hi2.y});
      y[pt][0] = mfma16(xf, mf[0], y[pt][0]); y[pt][1] = mfma16(xf, mf[1], y[pt][1]);
    }
  }
  const float dsk = P.ssm_d[layer * 8 + h];
  const bf16_t* XT = (const bf16_t*)(smh + SM_XT);
  u32x2 zq[2][4]; f32x4 gq[4];
#pragma unroll
  for (int pt = 0; pt < 4; ++pt) {
    gq[pt] = *(const f32x4*)(P.ssm_g + layer * 512 + h * 64 + 16 * pt + 4 * q);
#pragma unroll
    for (int it = 0; it < 2; ++it) zq[it][pt] = *(const u32x2*)(PROJ + (size_t)(rowbase + 32 * w + 16 * it + r) * PW + 512 + h * 64 + 16 * pt + 4 * q);
  }
#pragma unroll
  for (int it = 0; it < 2; ++it) {
    const int i = 32 * w + 16 * it + r; const int row = rowbase + i;
    float ss = 0.f;
#pragma unroll
    for (int pt = 0; pt < 4; ++pt) {
      const int p0 = 16 * pt + 4 * q;
      const u32x2 zz = zq[it][pt];
      const f32x4 gg = gq[pt];
      const float zv[4] = {bflo(zz.x), bfhi(zz.x), bflo(zz.y), bfhi(zz.y)};
      float ov[4];
#pragma unroll
      for (int e = 0; e < 4; ++e) {
        const float xs = bf2f(XT[(p0 + e) * 136 + i]);
        const float yz = (y[pt][it][e] + dsk * xs) * silu_f(zv[e]);
        ss += yz * yz; ov[e] = yz * gg[e];
      }
      u32x2 o; o.x = cvt_pk(ov[0], ov[1]); o.y = cvt_pk(ov[2], ov[3]);
      *(u32x2*)(MIX + (size_t)row * 1024 + h * 64 + p0) = o;
    }
    ss += __shfl_xor(ss, 16); ss += __shfl_xor(ss, 32);
    if (q == 0 && do_atomic) atomicAdd(SSQ + row, ss);
  }
}

DEVI void mixer1_phase(const Params& P, int layer) {
  const int nA = 512, nV = 4 * 34 * 16, nC = (layer == 0) ? 64 : 0;
  const int total = nA + nV + nC;
#pragma unroll 1
  for (int it = VB; it < total; it += VG) {
    if (it < nA || it >= nA + nV) {
      int b, i1, i2; bool isctx = it >= nA;
      if (!isctx) { b = it >> 7; i1 = (it >> 2) & 31; i2 = it & 3; }
      else { const int e = it - nA - nV; b = e >> 4; i1 = (e >> 3) & 1; i2 = e & 7; }
      attn_item<0>(P, layer, b, i1, i2, isctx ? 1 : 0);
    } else { const int e = it - nA; const int b = e / 544, rem = e % 544; conv_item(P, layer, b, rem >> 4, rem & 15); }
  }
}
DEVI void mixer2_phase(const Params& P, int layer) {
  const int nB = 1024, nS = 4 * 34 * 8;
  const int total = nB + nS;
#pragma unroll 1
  for (int it = VB; it < total; it += VG) {
    if (it < nB) { const int b = it >> 8, gr = (it >> 2) & 63, h = it & 3; attn_item<1>(P, layer, b, gr, h, 0); }
    else { const int e = it - nB; const int b = e / 272, rem = e % 272; ssd_state_item(P, layer, b, rem >> 3, rem & 7); }
  }
}

DEVI void ssd_out_phase(const Params& P, int layer, int do_atomic = 1) {
  const int c0 = (layer == 0) ? 0 : 2;
  const int nc = 34 - c0;
  const int total = 4 * nc * 8;
#pragma unroll 1
  for (int it = VB; it < total; it += VG) {
    const int b = it / (nc * 8), rem = it % (nc * 8);
    ssd_out_item(P, layer, b, c0 + (rem >> 3), rem & 7, do_atomic);
  }
}


#define XB_TMO      128
#define XB_XCNT(j)  (256  + 64 * (j))
#define XB_XSUB(j)  (1280 + 64 * (j))
#define XB_XGEN(j)  (2304 + 64 * (j))
#define XB_TOP      3328
#define XB_TOPGEN   3392
#define XB_SPIN_CAP (1u << 18)
#define LAS __attribute__((address_space(3)))
DEVI unsigned xb_ld(unsigned* p)              { return __hip_atomic_load(p, __ATOMIC_RELAXED, __HIP_MEMORY_SCOPE_AGENT); }
DEVI unsigned xb_add(unsigned* p, unsigned v) { return __hip_atomic_fetch_add(p, v, __ATOMIC_RELAXED, __HIP_MEMORY_SCOPE_AGENT); }
DEVI unsigned xb_xcc_id() { return (unsigned)__builtin_amdgcn_s_getreg((3 << 11) | 20) & 0xFu; }
#define XB_SPIN(cond, bar) do { unsigned _sp = 0; while (cond) { __builtin_amdgcn_s_sleep(1); \
    if ((++_sp & 255u) == 0u) { if (xb_ld(&(bar)[XB_TMO])) break; if (_sp > XB_SPIN_CAP) { atomicAdd(&(bar)[XB_TMO], 1u); break; } } } } while (0)
struct XcdBarrier { unsigned* bar; unsigned x; volatile LAS unsigned* st; };
DEVI XcdBarrier xcd_barrier_post(unsigned* bar, volatile LAS unsigned* st) {
  XcdBarrier b; b.bar = bar; b.x = xb_xcc_id(); b.st = st;
  if (threadIdx.x == 0) (void)xb_add(&bar[XB_XCNT(b.x)], 1u);
  return b;
}
DEVI void xcd_barrier_complete(unsigned* bar, unsigned x, unsigned& nloc, unsigned& nx) {
  const unsigned G = gridDim.x * gridDim.y * gridDim.z;
  unsigned sum, cnt, mine, sp = 0u;
  for (;;) {
    sum = 0u; cnt = 0u; mine = 0u;
#pragma unroll
    for (unsigned j = 0; j < 16; ++j) { const unsigned c = xb_ld(&bar[XB_XCNT(j)]); sum += c; cnt += (c > 0u) ? 1u : 0u; mine = (j == x) ? c : mine; }
    if (sum == G) break;
    __builtin_amdgcn_s_sleep(1);
    if ((++sp & 255u) == 0u) { if (xb_ld(&bar[XB_TMO])) break; if (sp > XB_SPIN_CAP) { atomicAdd(&bar[XB_TMO], 1u); break; } }
  }
  nloc = mine > 0u ? mine : 1u; nx = cnt > 0u ? cnt : 1u;
}
DEVI void xcd_barrier(const XcdBarrier& b) {
  asm volatile("s_waitcnt vmcnt(0)" ::: "memory");
  __syncthreads();
  if (threadIdx.x == 0) {
    unsigned* bar = b.bar;
    __builtin_amdgcn_s_waitcnt(0);
    unsigned nloc = b.st[0], nx = b.st[1];
    if (nloc == 0u) { xcd_barrier_complete(bar, b.x, nloc, nx); b.st[0] = nloc; b.st[1] = nx; }
    const unsigned old = xb_add(&bar[XB_XSUB(b.x)], 1u);
    const unsigned gen = old / nloc;
    if (old + 1u == (gen + 1u) * nloc) {
      __builtin_amdgcn_fence(__ATOMIC_RELEASE, "agent");
      asm volatile("s_waitcnt vmcnt(0)" ::: "memory");
      const unsigned og = xb_add(&bar[XB_TOP], 1u);
      const unsigned tg = og / nx;
      if (og + 1u == (tg + 1u) * nx) xb_add(&bar[XB_TOPGEN], 1u);
      else XB_SPIN(xb_ld(&bar[XB_TOPGEN]) == tg, bar);
      __builtin_amdgcn_fence(__ATOMIC_ACQUIRE, "agent");
      xb_add(&bar[XB_XGEN(b.x)], 1u);
      asm volatile("s_waitcnt vmcnt(0)" ::: "memory");
    } else {
      XB_SPIN(xb_ld(&bar[XB_XGEN(b.x)]) == gen, bar);
      __builtin_amdgcn_fence(__ATOMIC_ACQUIRE, "agent");
      asm volatile("s_waitcnt vmcnt(0)" ::: "memory");
    }
  }
  __syncthreads();
}

__global__ void __launch_bounds__(512, 2) mega_fwd(Params P) {
  cg::grid_group grid = cg::this_grid();
  __shared__ uint4 xb_words;
  if (threadIdx.x == 0) xb_words = make_uint4(0u, 0u, 0u, 0u);
  __syncthreads();
  XcdBarrier xb = xcd_barrier_post((unsigned*)(P.ws + OFF_BAR), (volatile LAS unsigned*)&xb_words);
  if (P.ph_hi > 1000) grid.sync();
#define BAR() xcd_barrier(xb)
#ifndef REP_S
#define REP_S -1
#endif
#define RUN(S_, CALL) { if (REP_S == (S_)) { const int do_at = 0; (void)do_at; CALL; BAR(); } { const int do_at = 1; (void)do_at; CALL; } BAR(); }
#define LAYER(l) \
  RUN(0, (norm_phase(P, l, 0), (l == 1 ? prep_phase(P, 1, false) : (void)0))) \
  RUN(1, (gemm_phase<MODE_INPROJ, false>(P, l))) \
  RUN(2, mixer1_phase(P, l)) \
  RUN(9, mixer2_phase(P, l)) \
  RUN(3, ssd_scan_phase(P)) \
  RUN(4, ssd_out_phase(P, l, do_at)) \
  RUN(5, (gemm_phase<MODE_RESID, true>(P, l))) \
  RUN(6, norm_phase(P, l, 1)) \
  RUN(7, (gemm_phase<MODE_SWIGLU, false>(P, l))) \
  RUN(8, (gemm_phase<MODE_RESID, false>(P, l)))
  prep_phase(P, 0, true); BAR();
  LAYER(0)
  LAYER(1)
  final_norm_phase(P);
}

extern "C" void kernel_launch(void* const* d_in, const int* in_sizes, int n_in, void* d_out, int out_size, void* d_ws, size_t ws_size, hipStream_t stream) {
  static int grid_blocks = 0;
  if (!grid_blocks) {
    int dev = 0, cus = 0, per_cu = 0;
    hipGetDevice(&dev);
    hipDeviceGetAttribute(&cus, hipDeviceAttributeMultiprocessorCount, dev);
    hipOccupancyMaxActiveBlocksPerMultiprocessor(&per_cu, mega_fwd, 512, 0);
    if (per_cu < 1) per_cu = 1;
    if (per_cu > 1) per_cu = 1;
    grid_blocks = cus * per_cu;
    if (ws_size < WS_END) fprintf(stderr, "kernel_launch: workspace too small: %zu < %zu\n", ws_size, (size_t)WS_END);
  }
  Params p{};
  const float** pp = (const float**)&p;
  for (int i = 0; i < 21; ++i) pp[i] = (const float*)d_in[i];
  p.out = (float*)d_out; p.ws = (unsigned char*)d_ws;
  hipMemsetAsync((unsigned char*)d_ws + OFF_MODS, 0, SZ_MODS + SZ_BAR, stream);
#if LAUNCH_PER_PHASE
  for (int ph = 0; ph < NPH; ++ph) {
    p.ph_lo = ph; p.ph_hi = ph + 1;
    hipLaunchKernelGGL(mega_fwd, dim3(grid_blocks), dim3(256), 0, stream, p);
  }
#else
  p.ph_lo = 0; p.ph_hi = NPH;
  void* args[] = {&p};
  hipError_t e = hipLaunchCooperativeKernel((void*)mega_fwd, dim3(grid_blocks), dim3(512), args, 0, stream);
  if (e != hipSuccess) fprintf(stderr, "cooperative launch failed: %s (grid %d)\n", hipGetErrorString(e), grid_blocks);
#endif
}
```

```cpp
#include <hip/hip_runtime.h>
#include <hip/hip_cooperative_groups.h>
#include <cstdio>
#include <cstdint>
namespace cg = cooperative_groups;

#ifndef LAUNCH_PER_PHASE
#define LAUNCH_PER_PHASE 0
#endif

typedef unsigned short bf16_t;
typedef short bf16x8 __attribute__((ext_vector_type(8)));
typedef float f32x4 __attribute__((ext_vector_type(4)));
typedef unsigned u32x4 __attribute__((ext_vector_type(4)));
typedef unsigned u32x2 __attribute__((ext_vector_type(2)));
#define DEVI __device__ __forceinline__

constexpr int T = 16384, TC = 1024, TT = T + TC;
constexpr int PW = 2816;
constexpr int NPH = 20;
constexpr float EPSN = 1e-6f;

constexpr size_t SZ_WIN = (size_t)2944 * 1024 * 2, SZ_WOUT = (size_t)1024 * 1024 * 2, SZ_WFI = (size_t)5632 * 1024 * 2, SZ_WFO = (size_t)1024 * 2816 * 2;
constexpr size_t OFF_WIN = 0;
constexpr size_t OFF_WOUT = OFF_WIN + SZ_WIN;
constexpr size_t OFF_WFI = OFF_WOUT + SZ_WOUT;
constexpr size_t OFF_WFO = OFF_WFI + SZ_WFI;
constexpr size_t OFF_H = OFF_WFO + SZ_WFO;
constexpr size_t OFF_PROJ = OFF_H + (size_t)TT * 1024 * 2;
constexpr size_t OFF_VT = OFF_PROJ + (size_t)TT * PW * 2;
constexpr size_t OFF_DT = OFF_VT + (size_t)384 * TT * 2;
constexpr size_t OFF_XC = OFF_DT + (size_t)TT * 16 * 4;
constexpr size_t OFF_MODS = OFF_XC + (size_t)TC * 1024 * 4;
constexpr size_t SZ_MODS = (size_t)2 * 5 * 6144 * 4;
constexpr size_t OFF_BAR = OFF_MODS + SZ_MODS;
constexpr size_t SZ_BAR = 3456 * 4;
constexpr size_t OFF_SSQ = OFF_BAR + SZ_BAR;
constexpr size_t OFF_ST = OFF_SSQ + (size_t)TT * 4;
constexpr size_t OFF_CD = OFF_ST + (size_t)64 * 34 * 8192 * 2;
constexpr size_t OFF_ROPE = OFF_CD + (size_t)64 * 34 * 4;
constexpr size_t OFF_XN = OFF_ROPE + 2 * 1024 * 4;
constexpr size_t OFF_XTX = OFF_XN + (size_t)TT * 512 * 2;
constexpr size_t OFF_XTB = OFF_XTX + (size_t)512 * TT * 2;
constexpr size_t WS_END = OFF_XTB + (size_t)256 * TT * 2;
static_assert(WS_END <= (size_t)256 * 1024 * 1024, "workspace map exceeds 256 MiB");

struct Params {
  const float *x, *c, *ctx, *c_ctx, *w_mod, *b_mod, *g_mix, *w_in, *wa_sink, *na_rpb, *conv_w, *conv_b, *dt_bias, *a_log, *ssm_d, *ssm_g, *w_out, *g_ffn, *w_ffn_in, *w_ffn_out, *g_final;
  float* out; unsigned char* ws; int ph_lo, ph_hi;
};

constexpr int HSTR = 73728, SM_XB = 2 * HSTR, SMEM_BYTES = 2 * HSTR + 16;
__shared__ __attribute__((aligned(16))) unsigned char smem[SMEM_BYTES];
#define NOINL __device__ __forceinline__

typedef __bf16 bf16x2_t __attribute__((ext_vector_type(2)));
typedef float f32x2_t __attribute__((ext_vector_type(2)));
DEVI unsigned cvt_pk(float lo, float hi) { f32x2_t v = {lo, hi}; bf16x2_t b = __builtin_convertvector(v, bf16x2_t); return __builtin_bit_cast(unsigned, b); }
DEVI float bflo(unsigned u) { return __uint_as_float(u << 16); }
DEVI float bfhi(unsigned u) { return __uint_as_float(u & 0xffff0000u); }
DEVI float bf2f(bf16_t h) { return __uint_as_float((unsigned)h << 16); }
DEVI float silu_f(float v) { return v * __builtin_amdgcn_rcpf(1.f + __expf(-v)); }
DEVI float softplus_f(float v) { const float e = __expf(v); return v > 20.f ? v : (e < 1e-3f ? e * (1.f - 0.5f * e) : __logf(1.f + e)); }
DEVI float wave_sum(float v) {
#pragma unroll
  for (int o = 32; o > 0; o >>= 1) v += __shfl_xor(v, o);
  return v;
}
DEVI float wave_incl_scan(float v, int lane) {
#pragma unroll
  for (int o = 1; o < 64; o <<= 1) { const float u = __shfl_up(v, o); if (lane >= o) v += u; }
  return v;
}
DEVI f32x4 mfma16(bf16x8 a, bf16x8 b, f32x4 c) { return __builtin_amdgcn_mfma_f32_16x16x32_bf16(a, b, c, 0, 0, 0); }
DEVI bf16x8 as_bf16x8(u32x4 v) { union { u32x4 u; bf16x8 b; } x; x.u = v; return x.b; }

DEVI u32x4 scale8(u32x4 v, float s) {
  u32x4 o;
  o.x = cvt_pk(bflo(v.x) * s, bfhi(v.x) * s); o.y = cvt_pk(bflo(v.y) * s, bfhi(v.y) * s);
  o.z = cvt_pk(bflo(v.z) * s, bfhi(v.z) * s); o.w = cvt_pk(bflo(v.w) * s, bfhi(v.w) * s);
  return o;
}
DEVI int tid_opq() { int t; asm volatile("v_mov_b32 %0, %1" : "=v"(t) : "v"((int)(threadIdx.x & 255))); return t; }
DEVI int half_id() { return __builtin_amdgcn_readfirstlane((int)(threadIdx.x >> 8)); }
#define VB (blockIdx.x * 2 + half_id())
#define VG (gridDim.x * 2)
DEVI int ufy(int v) { return __builtin_amdgcn_readfirstlane(v); }

NOINL void prep_phase(const Params& P, int wl, bool full) {
  unsigned char* const smh = smem + half_id() * HSTR;
  float* tile = (float*)smh;
  const int t = tid_opq();
  constexpr int I_IN = 46 * 16, I_OUT = 16 * 16, I_FI = 88 * 16, I_FO = 16 * 44, I_L = I_IN + I_OUT + I_FI + I_FO;
  constexpr int I_MOD = 2 * 16 * 24;
  const int total = I_L + (full ? I_MOD + 1 : 0);
  for (int it = VB; it < total; it += VG) {
    if (it < I_L) {
      const int l = wl; int r = it;
      const float* W; bf16_t* Wt; int K, N, kind, nt_, kt_;
      if (r < I_IN) { kind = 0; W = P.w_in + (size_t)l * 1024 * 2832; N = 2832; K = 1024; Wt = (bf16_t*)(P.ws + OFF_WIN); nt_ = r / 16; kt_ = r % 16; }
      else if (r < I_IN + I_OUT) { r -= I_IN; kind = 1; W = P.w_out + (size_t)l * 1024 * 1024; N = 1024; K = 1024; Wt = (bf16_t*)(P.ws + OFF_WOUT); nt_ = r / 16; kt_ = r % 16; }
      else if (r < I_IN + I_OUT + I_FI) { r -= I_IN + I_OUT; kind = 2; W = P.w_ffn_in + (size_t)l * 1024 * 5632; N = 5632; K = 1024; Wt = (bf16_t*)(P.ws + OFF_WFI); nt_ = r / 16; kt_ = r % 16; }
      else { r -= I_IN + I_OUT + I_FI; kind = 3; W = P.w_ffn_out + (size_t)l * 2816 * 1024; N = 1024; K = 2816; Wt = (bf16_t*)(P.ws + OFF_WFO); nt_ = r / 44; kt_ = r % 44; }
      {
        const int n4 = (t & 15) * 4, np = nt_ * 64 + n4;
        int col;
        if (kind == 0) col = np < 2832 ? np : -1;
        else if (kind == 2) { const int qq = np >> 5, rr = np & 31; col = rr < 16 ? 16 * qq + rr : 2816 + 16 * qq + rr - 16; }
        else col = np;
#pragma unroll
        for (int i = 0; i < 4; ++i) {
          const int kk = i * 16 + (t >> 4);
          f32x4 v = (f32x4){0.f, 0.f, 0.f, 0.f};
          const int ksrc = kind == 1 ? ((kt_ * 64 + kk + 512) & 1023) : (kt_ * 64 + kk);
          if (col >= 0) v = *(const f32x4*)(W + (size_t)ksrc * N + col);
          tile[kk * 65 + n4] = v[0]; tile[kk * 65 + n4 + 1] = v[1]; tile[kk * 65 + n4 + 2] = v[2]; tile[kk * 65 + n4 + 3] = v[3];
        }
      }
      __syncthreads();
      {
        const int n = t >> 2, kc = (t & 3) * 16;
        u32x4 o0, o1;
        o0.x = cvt_pk(tile[(kc + 0) * 65 + n], tile[(kc + 1) * 65 + n]); o0.y = cvt_pk(tile[(kc + 2) * 65 + n], tile[(kc + 3) * 65 + n]);
        o0.z = cvt_pk(tile[(kc + 4) * 65 + n], tile[(kc + 5) * 65 + n]); o0.w = cvt_pk(tile[(kc + 6) * 65 + n], tile[(kc + 7) * 65 + n]);
        o1.x = cvt_pk(tile[(kc + 8) * 65 + n], tile[(kc + 9) * 65 + n]); o1.y = cvt_pk(tile[(kc + 10) * 65 + n], tile[(kc + 11) * 65 + n]);
        o1.z = cvt_pk(tile[(kc + 12) * 65 + n], tile[(kc + 13) * 65 + n]); o1.w = cvt_pk(tile[(kc + 14) * 65 + n], tile[(kc + 15) * 65 + n]);
        bf16_t* dst = Wt + (size_t)(nt_ * 64 + n) * K + kt_ * 64 + kc;
        *(u32x4*)dst = o0; *(u32x4*)(dst + 8) = o1;
      }
      __syncthreads();
    } else if (it < I_L + I_MOD) {
      const int m = it - I_L; const int l = m / 384, rem = m % 384, kc = rem / 24, cb = rem % 24;
      float* sv = (float*)smh;
      for (int e = t; e < 320; e += 256) { const int r = e >> 6, k = kc * 64 + (e & 63); const float v = r < 4 ? P.c[r * 1024 + k] : P.c_ctx[k]; sv[e] = v / (1.f + __expf(-v)); }
      __syncthreads();
      const int n = cb * 256 + t;
      float a0 = 0.f, a1 = 0.f, a2 = 0.f, a3 = 0.f, a4 = 0.f;
      const float* wp = P.w_mod + ((size_t)l * 1024 + kc * 64) * 6144 + n;
#pragma unroll 8
      for (int kk = 0; kk < 64; ++kk) { const float w = wp[(size_t)kk * 6144]; a0 += sv[kk] * w; a1 += sv[64 + kk] * w; a2 += sv[128 + kk] * w; a3 += sv[192 + kk] * w; a4 += sv[256 + kk] * w; }
      if (kc == 0) { const float bb = P.b_mod[l * 6144 + n]; a0 += bb; a1 += bb; a2 += bb; a3 += bb; a4 += bb; }
      float* md = (float*)(P.ws + OFF_MODS) + (size_t)l * 5 * 6144 + n;
      atomicAdd(md, a0); atomicAdd(md + 6144, a1); atomicAdd(md + 2 * 6144, a2); atomicAdd(md + 3 * 6144, a3); atomicAdd(md + 4 * 6144, a4);
      __syncthreads();
    } else {
      float* rc = (float*)(P.ws + OFF_ROPE);
      for (int e = t; e < 1024; e += 256) { const int pos = e >> 4, i = e & 15; const float inv = __builtin_amdgcn_exp2f(-(float)i * (13.287712379549449f / 16.f)); float xr = (float)pos * inv * 0.15915494309189535f; xr -= floorf(xr); rc[e] = __builtin_amdgcn_cosf(xr); rc[1024 + e] = __builtin_amdgcn_sinf(xr); }
    }
  }
}

NOINL void norm_phase(const Params& P, int layer, int which) {
  const float* src_lat = (layer == 0 && which == 0) ? P.x : P.out; const float* src_ctx = (layer == 0 && which == 0) ? P.ctx : (const float*)(P.ws + OFF_XC);
  const int M = (which == 0 || layer == 0) ? TT : T;
  const int t_ = tid_opq(); const int lane = t_ & 63, wv = t_ >> 6;
  const int gw = VB * 4 + wv, nw = VG * 4;
  const float* g = (which == 0 ? P.g_mix : P.g_ffn) + layer * 1024;
  bf16_t* H = (bf16_t*)(P.ws + OFF_H);
  float* ssq = (float*)(P.ws + OFF_SSQ);
  for (int row = gw; row < M; row += nw) {
    const float* xr = row < T ? src_lat + (size_t)row * 1024 : src_ctx + (size_t)(row - T) * 1024;
    const int mr = row < T ? (row >> 12) : 4;
    const float* md = (const float*)(P.ws + OFF_MODS) + (size_t)(layer * 5 + mr) * 6144 + which * 3072;
    f32x4 v[4]; float s = 0.f;
#pragma unroll
    for (int j = 0; j < 4; ++j) { v[j] = *(const f32x4*)(xr + 4 * (lane + 64 * j)); s += v[j][0] * v[j][0] + v[j][1] * v[j][1] + v[j][2] * v[j][2] + v[j][3] * v[j][3]; }
    s = wave_sum(s);
    const float rstd = rsqrtf(s * (1.f / 1024.f) + EPSN);
    f32x4 ggv[4], shv[4], scv[4];
#pragma unroll
    for (int j = 0; j < 4; ++j) { const int k = 4 * (lane + 64 * j); ggv[j] = *(const f32x4*)(g + k); shv[j] = *(const f32x4*)(md + k); scv[j] = *(const f32x4*)(md + 1024 + k); }
#pragma unroll
    for (int j = 0; j < 4; ++j) {
      const int k = 4 * (lane + 64 * j);
      const f32x4 gg = ggv[j], sh = shv[j], sc = scv[j];
      f32x4 h;
#pragma unroll
      for (int e = 0; e < 4; ++e) h[e] = v[j][e] * rstd * gg[e] * (1.f + sc[e]) + sh[e];
      u32x2 o; o.x = cvt_pk(h[0], h[1]); o.y = cvt_pk(h[2], h[3]);
      *(u32x2*)(H + (size_t)row * 1024 + k) = o;
    }
    if (which == 0 && lane == 0) ssq[row] = 0.f;
  }
}

NOINL void final_norm_phase(const Params& P) {
  const int t_ = tid_opq(); const int lane = t_ & 63, wv = t_ >> 6;
  const int gw = VB * 4 + wv, nw = VG * 4;
  for (int row = gw; row < T; row += nw) {
    float* xr = P.out + (size_t)row * 1024;
    f32x4 v[4]; float s = 0.f;
#pragma unroll
    for (int j = 0; j < 4; ++j) { v[j] = *(const f32x4*)(xr + 4 * (lane + 64 * j)); s += v[j][0] * v[j][0] + v[j][1] * v[j][1] + v[j][2] * v[j][2] + v[j][3] * v[j][3]; }
    s = wave_sum(s);
    const float rstd = rsqrtf(s * (1.f / 1024.f) + EPSN);
#pragma unroll
    for (int j = 0; j < 4; ++j) {
      const int k = 4 * (lane + 64 * j);
      const f32x4 gg = *(const f32x4*)(P.g_final + k);
      f32x4 h;
#pragma unroll
      for (int e = 0; e < 4; ++e) h[e] = v[j][e] * rstd * gg[e];
      *(f32x4*)(xr + k) = h;
    }
  }
}

namespace pg8 {
#define PG8_LAS __attribute__((address_space(3)))
typedef unsigned short bf16_t;
typedef short bf16x8 __attribute__((ext_vector_type(8)));
typedef float f32x4 __attribute__((ext_vector_type(4)));
typedef unsigned u32x4 __attribute__((ext_vector_type(4)));
constexpr int BM = 256, BK = 64, HALF = 128, HTB = HALF * BK * 2  , STAGE_BYTES = 8 * HTB, NXCD = 8, WGM = 8;

__host__ __device__ __forceinline__ int lds_byte(int r, int c) { const int st = (r >> 4) * 2 + (c >> 5), rr = r & 15, cc = c & 31, ob = rr * 64 + cc * 2; return st * 1024 + (ob ^ (((ob >> 9) & 1) << 5)); }
__host__ __device__ __forceinline__ void stage_rc(int b, int& R, int& C) { const int st = b / 1024, sb = b % 1024, swz = sb ^ (((sb >> 9) & 1) << 5); R = (st >> 1) * 16 + swz / 64; C = (st & 1) * 32 + (swz % 64) / 2; }
__host__ __device__ __forceinline__ int perm32(int rho) { const int n = rho >> 4, i = rho & 15; return 8 * (i >> 2) + 4 * n + (i & 3); }

struct Unit { int pm, pn; };
struct Gemm { const bf16_t* A; const bf16_t* Bt; int M, N, K; };

struct StaticOrder {
    int nM, nN, nwg, G, c;
    __host__ __device__ void init(int M, int N, int G_, int c_) { nM = M / BM; nN = N / BM; nwg = nM * nN; G = G_; c = c_; }
    __host__ __device__ bool next(int i, Unit& u) const {
        const long L = (long)i * G + c; if (L >= nwg) return false;
        int wgid = (int)L; { const int q = nwg / NXCD, r = nwg % NXCD, xcd = wgid % NXCD, off = wgid / NXCD; wgid = (xcd < r ? xcd * (q + 1) : r * (q + 1) + (xcd - r) * q) + off; }
        const int nig = WGM * nN, gid = wgid / nig, fm = gid * WGM, gsz = (nM - fm) < WGM ? (nM - fm) : WGM;
        u.pm = fm + ((wgid % nig) % gsz); u.pn = (wgid % nig) / gsz; return true;
    }
    __device__ __forceinline__ void a_ready(const Unit&) const {}
    __device__ __forceinline__ void done(const Unit&) const {}
};

template <class Epi, class Sched, bool ALIGN_EPI = false, bool SP2 = false>
__device__ __forceinline__ void gemm_phase(PG8_LAS unsigned char* lds, const Gemm g, const Sched& S, const Epi& E) {
    int tid_; asm volatile("v_mov_b32 %0, %1" : "=v"(tid_) : "v"((int)threadIdx.x)); const int tid = tid_, wid = __builtin_amdgcn_readfirstlane(tid >> 6), lane = tid & 63, wr = wid >> 2, wc = wid & 3, fr = lane & 15, fq = lane >> 4;
    const int K = g.K, nt = K / BK;
    unsigned voffA[2], voffB[2];
#pragma unroll
    for (int i = 0; i < 2; ++i) { int R, C; stage_rc(tid * 16 + i * 8192, R, C); const int Rb = Epi::PERM ? ((R & ~31) + perm32(R & 31)) : R;
        voffA[i] = (unsigned)(R * K + C) * 2u; voffB[i] = (unsigned)(Rb * K + C) * 2u; }
    const size_t kstep = (size_t)(BK * 2);
    const size_t hstep = (size_t)HALF * K * 2;
    const size_t tstep = 2 * hstep;
    const unsigned ldsw = (unsigned)wid * 1024u;
    const int aoff = lds_byte(wr * 64 + fr, fq * 8), boff = lds_byte(wc * 32 + fr, fq * 8);
#define PG8_SA(b, h) (((b) * 2 + (h)) * HTB)
#define PG8_SB(b, h) ((4 + (b) * 2 + (h)) * HTB)
#define PG8_STAGE(bufoff, gbase, voff) do { _Pragma("unroll") for (int _i = 0; _i < 2; ++_i) \
        __builtin_amdgcn_global_load_lds((const unsigned*)((const char*)(gbase) + (voff)[_i]), (PG8_LAS unsigned*)(lds + (bufoff) + ldsw + _i * 8192), 16, 0, 0); } while (0)
#define PG8_LDA(dst, b, h) do { _Pragma("unroll") for (int m = 0; m < 4; ++m) _Pragma("unroll") for (int k = 0; k < 2; ++k) dst[m][k] = *(const PG8_LAS bf16x8*)(lds + PG8_SA(b, h) + aoff + m * 2048 + k * 1024); } while (0)
#define PG8_LDB(dst, b, h) do { _Pragma("unroll") for (int n = 0; n < 2; ++n) _Pragma("unroll") for (int k = 0; k < 2; ++k) dst[n][k] = *(const PG8_LAS bf16x8*)(lds + PG8_SB(b, h) + boff + n * 2048 + k * 1024); } while (0)
#define PG8_MMA(ai, bj, At, Bt) do { __builtin_amdgcn_s_setprio(1); _Pragma("unroll") for (int m = 0; m < 4; ++m) _Pragma("unroll") for (int n = 0; n < 2; ++n) _Pragma("unroll") for (int k = 0; k < 2; ++k) \
        acc[ai][bj][m][n] = __builtin_amdgcn_mfma_f32_16x16x32_bf16(Bt[n][k], At[m][k], acc[ai][bj][m][n], 0, 0, 0); __builtin_amdgcn_s_setprio(0); } while (0)
#define PG8_WAIT_V(n) asm volatile("s_waitcnt vmcnt(" #n ")" ::: "memory")
#define PG8_WAIT_L(n) asm volatile("s_waitcnt lgkmcnt(" #n ")" ::: "memory")
#define PG8_BAR __builtin_amdgcn_s_barrier()
#define PG8_SCHED __builtin_amdgcn_sched_barrier(0)
    Unit cur, nxt; int ui = 0;
    if (!S.next(0, cur)) return;
    f32x4 acc[2][2][4][2];
#pragma unroll
    for (int a = 0; a < 2; ++a)
#pragma unroll
        for (int b = 0; b < 2; ++b)
#pragma unroll
            for (int m = 0; m < 4; ++m)
#pragma unroll
                for (int n = 0; n < 2; ++n) acc[a][b][m][n] = (f32x4){0.f, 0.f, 0.f, 0.f};
    bf16x8 At[4][2], B0[2][2], B1[2][2];
    const char* cA = (const char*)g.A + (size_t)cur.pm * tstep; const char* cB = (const char*)g.Bt + (size_t)cur.pn * tstep;
    S.a_ready(cur);
    if constexpr (SP2) {
        PG8_STAGE(PG8_SB(0, 0), cB, voffB); PG8_STAGE(PG8_SB(0, 1), cB + hstep, voffB); PG8_STAGE(PG8_SA(0, 0), cA, voffA); PG8_STAGE(PG8_SA(0, 1), cA + hstep, voffA);
        if (wr == 1) PG8_BAR;
        PG8_WAIT_V(2); PG8_BAR;
        PG8_STAGE(PG8_SB(1, 0), cB + kstep, voffB); PG8_STAGE(PG8_SA(1, 0), cA + kstep, voffA); PG8_STAGE(PG8_SB(1, 1), cB + hstep + kstep, voffB);
        PG8_WAIT_V(6); PG8_BAR;
    } else {
        PG8_STAGE(PG8_SB(0, 0), cB, voffB); PG8_STAGE(PG8_SA(0, 0), cA, voffA); PG8_STAGE(PG8_SB(0, 1), cB + hstep, voffB); PG8_STAGE(PG8_SA(0, 1), cA + hstep, voffA);
        if (wr == 1) PG8_BAR;
        PG8_WAIT_V(4); PG8_BAR;
        PG8_STAGE(PG8_SB(1, 0), cB + kstep, voffB); PG8_STAGE(PG8_SA(1, 0), cA + kstep, voffA); PG8_STAGE(PG8_SB(1, 1), cB + hstep + kstep, voffB);
        PG8_WAIT_V(6); PG8_BAR;
    }
    for (;;) {
        const bool has_next = S.next(ui + 1, nxt);
        const char* nA = has_next ? (const char*)g.A + (size_t)nxt.pm * tstep : cA; const char* nB = has_next ? (const char*)g.Bt + (size_t)nxt.pn * tstep : cB;
        for (int t = 0; t < nt; t += 2) {
            if constexpr (Epi::MIDSCALE) { if (t == 8) E.midscale(acc, cur, wr, fr); }
            const bool last = (t == nt - 2);
            const char* a1 = cA + (size_t)(t + 1) * kstep;
            const char* a2 = last ? nA : cA + (size_t)(t + 2) * kstep; const char* b2 = last ? nB : cB + (size_t)(t + 2) * kstep;
            const char* a3 = a2 + kstep; const char* b3 = b2 + kstep;
            if (last && has_next) S.a_ready(nxt);
            if constexpr (SP2) {
            PG8_LDB(B0, 0, 0); PG8_LDB(B1, 0, 1); PG8_SCHED; PG8_LDA(At, 0, 0); PG8_STAGE(PG8_SA(1, 1), a1 + hstep, voffA);
            PG8_WAIT_V(8); PG8_WAIT_L(0); PG8_BAR; PG8_MMA(0, 0, At, B0); PG8_MMA(0, 1, At, B1); PG8_BAR; PG8_SCHED;
            PG8_LDA(At, 0, 1); PG8_STAGE(PG8_SB(0, 0), b2, voffB); PG8_STAGE(PG8_SB(0, 1), b2 + hstep, voffB); PG8_STAGE(PG8_SA(0, 0), a2, voffA);
            PG8_WAIT_V(8); PG8_WAIT_L(0); PG8_BAR; PG8_MMA(1, 0, At, B0); PG8_MMA(1, 1, At, B1); PG8_BAR; PG8_SCHED;
            PG8_LDB(B0, 1, 0); PG8_LDB(B1, 1, 1); PG8_SCHED; PG8_LDA(At, 1, 0); PG8_STAGE(PG8_SA(0, 1), a2 + hstep, voffA);
            PG8_WAIT_V(8); PG8_WAIT_L(0); PG8_BAR; PG8_MMA(0, 0, At, B0); PG8_MMA(0, 1, At, B1); PG8_BAR; PG8_SCHED;
            PG8_LDA(At, 1, 1); PG8_STAGE(PG8_SB(1, 0), b3, voffB); PG8_STAGE(PG8_SB(1, 1), b3 + hstep, voffB); PG8_STAGE(PG8_SA(1, 0), a3, voffA);
            PG8_WAIT_V(8); PG8_WAIT_L(0); PG8_BAR; PG8_MMA(1, 0, At, B0); PG8_MMA(1, 1, At, B1); PG8_BAR; PG8_SCHED;
            } else {
            PG8_LDB(B0, 0, 0); PG8_SCHED; PG8_LDA(At, 0, 0); PG8_STAGE(PG8_SA(1, 1), a1 + hstep, voffA);
            PG8_WAIT_L(8); PG8_BAR; PG8_WAIT_L(0); PG8_MMA(0, 0, At, B0); PG8_BAR; PG8_SCHED;
            PG8_LDB(B1, 0, 1); PG8_STAGE(PG8_SB(0, 0), b2, voffB);
            PG8_BAR; PG8_WAIT_L(0); PG8_MMA(0, 1, At, B1); PG8_BAR;
            PG8_LDA(At, 0, 1); PG8_STAGE(PG8_SA(0, 0), a2, voffA);
            PG8_BAR; PG8_WAIT_L(0); PG8_MMA(1, 0, At, B0); PG8_BAR; PG8_SCHED;
            PG8_STAGE(PG8_SB(0, 1), b2 + hstep, voffB);
            PG8_WAIT_V(6); PG8_BAR; PG8_MMA(1, 1, At, B1); PG8_BAR;
            PG8_LDB(B0, 1, 0); PG8_SCHED; PG8_LDA(At, 1, 0); PG8_STAGE(PG8_SA(0, 1), a2 + hstep, voffA);
            PG8_WAIT_L(8); PG8_BAR; PG8_WAIT_L(0); PG8_MMA(0, 0, At, B0); PG8_BAR; PG8_SCHED;
            PG8_LDB(B1, 1, 1); PG8_STAGE(PG8_SB(1, 0), b3, voffB);
            PG8_BAR; PG8_WAIT_L(0); PG8_MMA(0, 1, At, B1); PG8_BAR;
            PG8_LDA(At, 1, 1); PG8_STAGE(PG8_SA(1, 0), a3, voffA);
            PG8_BAR; PG8_WAIT_L(0); PG8_MMA(1, 0, At, B0); PG8_BAR; PG8_SCHED;
            PG8_STAGE(PG8_SB(1, 1), b3 + hstep, voffB);
            PG8_WAIT_V(6); PG8_BAR; PG8_MMA(1, 1, At, B1); PG8_BAR;
            }
        }
        if constexpr (ALIGN_EPI) { if (wr == 0) PG8_BAR; }
        if constexpr (!Epi::AFTER_DRAIN) { E(acc, cur, wr, wc, fr, fq); S.done(cur); }
        if (!has_next) break;
#pragma unroll
        for (int a = 0; a < 2; ++a)
#pragma unroll
            for (int b = 0; b < 2; ++b)
#pragma unroll
                for (int m = 0; m < 4; ++m)
#pragma unroll
                    for (int n = 0; n < 2; ++n) acc[a][b][m][n] = (f32x4){0.f, 0.f, 0.f, 0.f};
        cur = nxt; cA = nA; cB = nB; ++ui;
        if constexpr (ALIGN_EPI) { if (wr == 1) PG8_BAR; }
    }
    PG8_WAIT_V(0);
    if constexpr (!ALIGN_EPI) { if (wr == 0) PG8_BAR; }
    PG8_BAR;
    if constexpr (Epi::AFTER_DRAIN) { E.fused(acc, cur, wr, wc, fr, fq, lds, wid, lane); S.done(cur); }
#undef PG8_SA
#undef PG8_SB
#undef PG8_STAGE
#undef PG8_LDA
#undef PG8_LDB
#undef PG8_MMA
#undef PG8_WAIT_V
#undef PG8_WAIT_L
#undef PG8_BAR
#undef PG8_SCHED
}
}

struct EpiInProj {
  static constexpr bool PERM = false, AFTER_DRAIN = false, MIDSCALE = false;
  unsigned char* ws;
  DEVI void operator()(const f32x4 (&acc)[2][2][4][2], const pg8::Unit& u, int wr, int wc, int fr, int fq) const {
    bf16_t* PROJ = (bf16_t*)(ws + OFF_PROJ); bf16_t* VT = (bf16_t*)(ws + OFF_VT); const float* rc = (const float*)(ws + OFF_ROPE);
    const int rowb = u.pm * 256 + wr * 64 + fr;
#pragma unroll
    for (int bj = 0; bj < 2; ++bj) {
      const int cb = u.pn * 256 + bj * 128;
      const bool isv = (cb == 1152) || (cb == 1536) || (cb == 1664);
      const bool do_rope = (cb < 256) || (cb == 1024);
      const float qs = cb < 512 ? 0.125f : 1.f;
      const int vchb = (cb == 1152 ? 0 : 128 + (cb - 1536)) + 32 * wc + 4 * fq;
#pragma unroll
      for (int ai = 0; ai < 2; ++ai)
#pragma unroll
        for (int m = 0; m < 4; ++m) {
          const int row = rowb + 128 * ai + 16 * m;
          f32x4 v0 = acc[ai][bj][m][0], v1 = acc[ai][bj][m][1];
          if (isv) {
#pragma unroll
            for (int e = 0; e < 4; ++e) { VT[(unsigned)((vchb + e) * TT + row)] = (bf16_t)(cvt_pk(v0[e], 0.f) & 0xffffu); VT[(unsigned)((vchb + 16 + e) * TT + row)] = (bf16_t)(cvt_pk(v1[e], 0.f) & 0xffffu); }
          } else {
            if (do_rope && row < T) {
              const int pos = row & 4095, pp = (wc & 1) ? (pos & 63) : (pos >> 6);
              const f32x4 cs = *(const f32x4*)(rc + pp * 16 + 4 * fq), sn = *(const f32x4*)(rc + 1024 + pp * 16 + 4 * fq);
#pragma unroll
              for (int e = 0; e < 4; ++e) { const float x1 = v0[e], x2 = v1[e]; v0[e] = x1 * cs[e] - x2 * sn[e]; v1[e] = x2 * cs[e] + x1 * sn[e]; }
            }
            u32x2 o0, o1; o0.x = cvt_pk(v0[0] * qs, v0[1] * qs); o0.y = cvt_pk(v0[2] * qs, v0[3] * qs); o1.x = cvt_pk(v1[0] * qs, v1[1] * qs); o1.y = cvt_pk(v1[2] * qs, v1[3] * qs);
            bf16_t* dst = PROJ + (unsigned)(row * PW + cb + 32 * wc + 4 * fq);
            *(u32x2*)dst = o0; *(u32x2*)(dst + 16) = o1;
          }
        }
    }
  }
};
struct EpiSwiglu {
  static constexpr bool PERM = false, AFTER_DRAIN = false, MIDSCALE = false;
  unsigned char* ws;
  DEVI void operator()(const f32x4 (&acc)[2][2][4][2], const pg8::Unit& u, int wr, int wc, int fr, int fq) const {
    bf16_t* G = (bf16_t*)(ws + OFF_PROJ);
    const int rowb = u.pm * 256 + wr * 64 + fr;
#pragma unroll
    for (int bj = 0; bj < 2; ++bj)
#pragma unroll
      for (int ai = 0; ai < 2; ++ai)
#pragma unroll
        for (int m = 0; m < 4; ++m) {
          const int row = rowb + 128 * ai + 16 * m;
          float o[4];
#pragma unroll
          for (int e = 0; e < 4; ++e) o[e] = silu_f(acc[ai][bj][m][0][e]) * acc[ai][bj][m][1][e];
          u32x2 ov; ov.x = cvt_pk(o[0], o[1]); ov.y = cvt_pk(o[2], o[3]);
          *(u32x2*)(G + (unsigned)(row * 2816 + u.pn * 128 + bj * 64 + wc * 16 + 4 * fq)) = ov;
        }
  }
};
template <bool MID>
struct EpiResid {
  static constexpr bool PERM = false, AFTER_DRAIN = false, MIDSCALE = MID;
  unsigned char* ws; const float* rin_lat; const float* rin_ctx; float* rout_lat; float* rout_ctx; int layer, gate_idx;
  DEVI void midscale(f32x4 (&acc)[2][2][4][2], const pg8::Unit& u, int wr, int fr) const {
    const float* ssq = (const float*)(ws + OFF_SSQ) + u.pm * 256 + wr * 64 + fr;
    float sq[8];
#pragma unroll
    for (int k = 0; k < 8; ++k) sq[k] = ssq[128 * (k >> 2) + 16 * (k & 3)];
#pragma unroll
    for (int ai = 0; ai < 2; ++ai)
#pragma unroll
      for (int m = 0; m < 4; ++m) {
        const float rs = rsqrtf(sq[ai * 4 + m] * (1.f / 512.f) + EPSN);
#pragma unroll
        for (int bj = 0; bj < 2; ++bj) { acc[ai][bj][m][0] = acc[ai][bj][m][0] * rs; acc[ai][bj][m][1] = acc[ai][bj][m][1] * rs; }
      }
  }
  DEVI void operator()(const f32x4 (&acc)[2][2][4][2], const pg8::Unit& u, int wr, int wc, int fr, int fq) const {
    const bool lat = u.pm < T / 256;
    const int mr = lat ? (u.pm >> 4) : 4;
    const float* gpb = (const float*)(ws + OFF_MODS) + (size_t)(layer * 5 + mr) * 6144 + gate_idx * 1024;
    const float* rinb = lat ? rin_lat : rin_ctx; float* routb = lat ? rout_lat : rout_ctx;
    const int col0 = u.pn * 256 + wc * 32 + 4 * fq;
    const unsigned off0 = (unsigned)(((lat ? u.pm : u.pm - T / 256) * 256 + wr * 64 + fr) * 1024 + col0);
#pragma unroll
    for (int bj = 0; bj < 2; ++bj)
#pragma unroll
      for (int n = 0; n < 2; ++n) {
        const f32x4 gv = *(const f32x4*)(gpb + col0 + 128 * bj + 16 * n);
        f32x4 rv[8];
#pragma unroll
        for (int k = 0; k < 8; ++k) rv[k] = *(const f32x4*)(rinb + off0 + (unsigned)((128 * (k >> 2) + 16 * (k & 3)) * 1024 + 128 * bj + 16 * n));
#pragma unroll
        for (int ai = 0; ai < 2; ++ai)
#pragma unroll
          for (int m = 0; m < 4; ++m) {
            const unsigned off = off0 + (unsigned)((128 * ai + 16 * m) * 1024 + 128 * bj + 16 * n);
            f32x4 o;
#pragma unroll
            for (int e = 0; e < 4; ++e) o[e] = rv[ai * 4 + m][e] + gv[e] * acc[ai][bj][m][n][e];
            *(f32x4*)(routb + off) = o;
          }
      }
  }
};
constexpr int MODE_INPROJ = 0, MODE_RESID = 1, MODE_SWIGLU = 2;
template <int MODE, bool ASCALE>
DEVI void gemm_phase(const Params& P, int layer) {
  constexpr int K = (MODE == MODE_RESID && !ASCALE) ? 2816 : 1024;
  constexpr int N = MODE == MODE_INPROJ ? 2816 : (MODE == MODE_SWIGLU ? 5632 : 1024);
  const int M = (MODE == MODE_INPROJ || (layer == 0 && MODE != MODE_RESID)) ? TT : T;
  const bf16_t* A = (const bf16_t*)(P.ws + ((MODE == MODE_RESID && !ASCALE) ? OFF_PROJ : OFF_H));
  const bf16_t* Wt = (const bf16_t*)(P.ws + (MODE == MODE_INPROJ ? OFF_WIN : MODE == MODE_SWIGLU ? OFF_WFI : ASCALE ? OFF_WOUT : OFF_WFO));
  pg8::Gemm g{A, Wt, M, N, K}; pg8::StaticOrder S; S.init(M, N, (int)gridDim.x, (int)blockIdx.x);
  PG8_LAS unsigned char* lds = (PG8_LAS unsigned char*)smem;
  if constexpr (MODE == MODE_INPROJ) {
    EpiInProj E{P.ws};
    pg8::gemm_phase<EpiInProj, pg8::StaticOrder, true, true>(lds, g, S, E);
    const int lane = threadIdx.x & 63, r = lane & 15, q = lane >> 4;
    const bf16_t* Wd = Wt + (size_t)(2816 + r) * 1024 + 8 * q;
    float* DTb = (float*)(P.ws + OFF_DT);
    for (int tile = blockIdx.x * 8 + (threadIdx.x >> 6); tile < TT / 16; tile += gridDim.x * 8) {
      const bf16_t* Ar = A + (size_t)(16 * tile + r) * 1024 + 8 * q;
      f32x4 acc = (f32x4){0.f, 0.f, 0.f, 0.f};
#pragma unroll 8
      for (int s2 = 0; s2 < 32; ++s2) acc = mfma16(*(const bf16x8*)(Ar + 32 * s2), *(const bf16x8*)(Wd + 32 * s2), acc);
#pragma unroll
      for (int e = 0; e < 4; ++e) DTb[(size_t)(16 * tile + 4 * q + e) * 16 + r] = acc[e];
    }
  } else if constexpr (MODE == MODE_SWIGLU) {
    EpiSwiglu E{P.ws};
    pg8::gemm_phase<EpiSwiglu, pg8::StaticOrder, true, true>(lds, g, S, E);
  } else {
    float* XCp = (float*)(P.ws + OFF_XC);
    EpiResid<ASCALE> E{P.ws, (ASCALE && layer == 0) ? P.x : P.out, (ASCALE && layer == 0) ? P.ctx : XCp, P.out, XCp, layer, ASCALE ? 2 : 5};
    pg8::gemm_phase<EpiResid<ASCALE>, pg8::StaticOrder, true, true>(lds, g, S, E);
    if (layer == 0) {
      const int lane = threadIdx.x & 63, r = lane & 15, q = lane >> 4, w8 = threadIdx.x >> 6;
      const float* gpb = (const float*)(P.ws + OFF_MODS) + (size_t)(layer * 5 + 4) * 6144 + (ASCALE ? 2 : 5) * 1024;
      const float* rinb = ASCALE ? P.ctx : XCp;
      const float* ssq = (const float*)(P.ws + OFF_SSQ) + T;
      constexpr int PER = K / 32 / 8;
      float* part = (float*)smem;
      for (int tl = blockIdx.x; tl < 256; tl += gridDim.x) {
        const int r0 = (tl >> 4) * 64, n0 = (tl & 15) * 64;
        const bf16_t* Ar = A + (size_t)(T + r0 + r) * K + w8 * PER * 32 + 8 * q;
        const bf16_t* Br = Wt + (size_t)(n0 + r) * K + w8 * PER * 32 + 8 * q;
        f32x4 acc[4][4];
#pragma unroll
        for (int i = 0; i < 4; ++i)
#pragma unroll
          for (int j = 0; j < 4; ++j) acc[i][j] = (f32x4){0.f, 0.f, 0.f, 0.f};
#pragma unroll 2
        for (int s2 = 0; s2 < PER; ++s2) {
          bf16x8 af[4], bfr[4];
#pragma unroll
          for (int i = 0; i < 4; ++i) { af[i] = *(const bf16x8*)(Ar + (size_t)(16 * i) * K + 32 * s2); bfr[i] = *(const bf16x8*)(Br + (size_t)(16 * i) * K + 32 * s2); }
#pragma unroll
          for (int i = 0; i < 4; ++i)
#pragma unroll
            for (int j = 0; j < 4; ++j) acc[i][j] = mfma16(af[i], bfr[j], acc[i][j]);
        }
        const bool sc = ASCALE && w8 < 4;
        float sqv[16];
#pragma unroll
        for (int k = 0; k < 16; ++k) sqv[k] = ssq[r0 + 16 * (k >> 2) + 4 * q + (k & 3)];
#pragma unroll
        for (int i = 0; i < 4; ++i)
#pragma unroll
          for (int e = 0; e < 4; ++e) {
            const float rs = sc ? rsqrtf(sqv[i * 4 + e] * (1.f / 512.f) + EPSN) : 1.f;
#pragma unroll
            for (int j = 0; j < 4; ++j) part[w8 * 4096 + (16 * i + 4 * q + e) * 64 + 16 * j + r] = acc[i][j][e] * rs;
          }
        __syncthreads();
        float rres[8], gres[8];
#pragma unroll
        for (int k = 0; k < 8; ++k) { const int o = (int)threadIdx.x + 512 * k; rres[k] = rinb[(unsigned)((r0 + (o >> 6)) * 1024 + n0 + (o & 63))]; gres[k] = gpb[n0 + (o & 63)]; }
#pragma unroll
        for (int k = 0; k < 8; ++k) {
          const int o = (int)threadIdx.x + 512 * k, row = o >> 6, col = o & 63;
          float sum = 0.f;
#pragma unroll
          for (int pw = 0; pw < 8; ++pw) sum += part[pw * 4096 + o];
          XCp[(unsigned)((r0 + row) * 1024 + n0 + col)] = rres[k] + gres[k] * sum;
        }
        __syncthreads();
      }
    }
  }
}

template <int KIND>
NOINL void attn_item(const Params& P, int layer, int b, int i1, int i2, int isctx_) {
  unsigned char* const smh = smem + half_id() * HSTR;
  const bool isctx = isctx_ != 0;
  constexpr int NQT = (KIND == 1) ? 1 : 2;
  const int t = tid_opq(), lane = t & 63, w = t >> 6, r = lane & 15, q = lane >> 4, r7 = r & 7;
  const bf16_t* PROJ = (const bf16_t*)(P.ws + OFF_PROJ);
  const bf16_t* VT = (const bf16_t*)(P.ws + OFF_VT);
  bf16_t* MIX = (bf16_t*)(P.ws + OFF_H);
  constexpr bool DBL = (KIND == 1);
  constexpr int VSTR = DBL ? 272 : 136;
  unsigned char* Ks = smh; unsigned char* Vs = smh + (DBL ? 16384 : 8192); float* rpb = (float*)(smh + 33792);
  const int col0 = w == 0 ? 0 : (w == 1 ? 8 : (w == 2 ? 24 : 32));
  int qrow[NQT]; int qcol, kcol, vch, ocol, ntile; bool has_sink = false; float sinkv = 0.f;
  int r0g = 0;
  if (KIND == 0 && !isctx) {
    const int n = i1, head = i2;
#pragma unroll
    for (int qt = 0; qt < NQT; ++qt) qrow[qt] = b * 4096 + 128 * n + 32 * w + 16 * qt + r;
    qcol = head * 64; kcol = 1024 + (head >> 1) * 64; vch = (head >> 1) * 64; ocol = 512 + head * 64; ntile = 10; has_sink = true; sinkv = P.wa_sink[layer * 4 + head];
  } else if (KIND == 1) {
    const int gr = i1, h = i2;
    qrow[0] = b * 4096 + gr * 64 + 16 * w + r;
    qcol = 256 + 64 * h; kcol = 1280 + 64 * h; vch = 128 + 64 * h; ocol = 768 + 64 * h; ntile = 8;
    r0g = gr - 4 < 0 ? 0 : (gr - 4 > 56 ? 56 : gr - 4);
    __syncthreads();
    for (int e = t; e < 465; e += 256) rpb[e] = P.na_rpb[(size_t)(layer * 4 + h) * 465 + e];
  } else {
    const int qb = i1, hh = i2;
#pragma unroll
    for (int qt = 0; qt < NQT; ++qt) qrow[qt] = T + b * 256 + 128 * qb + 32 * w + 16 * qt + r;
    ntile = 4;
    if (hh < 4) { qcol = hh * 64; kcol = 1024 + (hh >> 1) * 64; vch = (hh >> 1) * 64; ocol = 512 + hh * 64; has_sink = true; sinkv = P.wa_sink[layer * 4 + hh]; }
    else { const int h = hh - 4; qcol = 256 + 64 * h; kcol = 1280 + 64 * h; vch = 128 + 64 * h; ocol = 768 + 64 * h; }
  }
  bf16x8 qf[NQT][2];
#pragma unroll
  for (int qt = 0; qt < NQT; ++qt)
#pragma unroll
    for (int s = 0; s < 2; ++s) qf[qt][s] = *(const bf16x8*)(PROJ + (size_t)qrow[qt] * PW + qcol + 32 * s + 8 * q);
  f32x4 o[4][NQT]; float mrun[NQT], lrun[NQT];
#pragma unroll
  for (int qt = 0; qt < NQT; ++qt) { mrun[qt] = -1e30f; lrun[qt] = 0.f;
#pragma unroll
    for (int dt = 0; dt < 4; ++dt) o[dt][qt] = (f32x4){0.f, 0.f, 0.f, 0.f}; }

  const int skip = (KIND == 0 && !isctx && i1 == 0) ? 2 : 0;
  const int nvalid = ntile - skip - ((KIND == 0 && !isctx && i1 == 31) ? 2 : 0);
  const int skey = t >> 2, sc0 = (t & 3) * 2;
  u32x4 pk0, pk1, pv0, pv1, pk2, pk3, pv2, pv3;
#define KV_ROW0(IDX, TI, KROW0) const int TI = (IDX) < 4 ? (IDX) : (IDX) + skip; \
    const int KROW0 = TI < 4 ? T + b * 256 + 64 * TI : (KIND == 1 ? b * 4096 + (r0g + 2 * (TI - 4)) * 64 : b * 4096 + 128 * (i1 - 1) + 64 * (TI - 4));
#define KV_LOAD(IDX) { KV_ROW0(IDX, ti_, kr0_) \
    const bf16_t* kp = PROJ + (size_t)(kr0_ + skey) * PW + kcol + sc0 * 8; pk0 = *(const u32x4*)kp; pk1 = *(const u32x4*)(kp + 8); \
    const bf16_t* vp = VT + (size_t)(vch + skey) * TT + kr0_ + sc0 * 8; pv0 = *(const u32x4*)vp; pv1 = *(const u32x4*)(vp + 8); \
    if (DBL && ti_ >= 4) { pk2 = *(const u32x4*)(kp + 64 * PW); pk3 = *(const u32x4*)(kp + 64 * PW + 8); pv2 = *(const u32x4*)(vp + 64); pv3 = *(const u32x4*)(vp + 72); } }
  KV_LOAD(0);
#pragma unroll 1
  for (int idx = 0; idx < nvalid; ++idx) {
    KV_ROW0(idx, ti, krow0)
    (void)krow0;
    const int kbase = 128 * (i1 - 1) + 64 * (ti - 4); const int kr = r0g + 2 * (ti - 4);
    const bool local2 = DBL && ti >= 4;
    __syncthreads();
    {
      *(u32x4*)(Ks + skey * 128 + ((sc0 ^ (skey & 7)) << 4)) = pk0; *(u32x4*)(Ks + skey * 128 + (((sc0 + 1) ^ (skey & 7)) << 4)) = pk1;
      u32x2* dst = (u32x2*)(Vs + skey * VSTR + sc0 * 16);
      dst[0] = (u32x2){pv0.x, pv0.y}; dst[1] = (u32x2){pv0.z, pv0.w}; dst[2] = (u32x2){pv1.x, pv1.y}; dst[3] = (u32x2){pv1.z, pv1.w};
      if (local2) {
        *(u32x4*)(Ks + (skey + 64) * 128 + ((sc0 ^ (skey & 7)) << 4)) = pk2; *(u32x4*)(Ks + (skey + 64) * 128 + (((sc0 + 1) ^ (skey & 7)) << 4)) = pk3;
        u32x2* dst2 = (u32x2*)(Vs + skey * VSTR + 128 + sc0 * 16);
        dst2[0] = (u32x2){pv2.x, pv2.y}; dst2[1] = (u32x2){pv2.z, pv2.w}; dst2[2] = (u32x2){pv3.x, pv3.y}; dst2[3] = (u32x2){pv3.z, pv3.w};
      }
    }
    __syncthreads();
    if (idx + 1 < nvalid) KV_LOAD(idx + 1);
    f32x4 sc[4][NQT];
#pragma unroll
    for (int kt = 0; kt < 4; ++kt) {
      const int krow = (local2 ? (kt >> 1) * 64 + col0 + 16 * (kt & 1) : 16 * kt) + r;
      const bf16x8 kf0 = *(const bf16x8*)(Ks + krow * 128 + ((q ^ r7) << 4));
      const bf16x8 kf1 = *(const bf16x8*)(Ks + krow * 128 + (((4 + q) ^ r7) << 4));
#pragma unroll
      for (int qt = 0; qt < NQT; ++qt) { sc[kt][qt] = mfma16(kf0, qf[qt][0], (f32x4){0.f, 0.f, 0.f, 0.f}); sc[kt][qt] = mfma16(kf1, qf[qt][1], sc[kt][qt]); }
    }
    if (ti >= 4) {
      if (KIND == 0) {
#pragma unroll
        for (int qt = 0; qt < NQT; ++qt) { const int qpos = 128 * i1 + 32 * w + 16 * qt + r;
#pragma unroll
          for (int kt = 0; kt < 4; ++kt)
#pragma unroll
            for (int e = 0; e < 4; ++e) { const int d = qpos - (kbase + 16 * kt + 4 * q + e); if (d > 128 || d < -128) sc[kt][qt][e] = -1e30f; } }
      } else if (KIND == 1) {
        const int qc = 16 * w + r; const int cs = qc - 8 < 0 ? 0 : (qc - 8 > 48 ? 48 : qc - 8);
#pragma unroll
        for (int kt = 0; kt < 4; ++kt) {
          const int dy = kr + (kt >> 1) - i1 + 7;
#pragma unroll
          for (int e = 0; e < 4; ++e) { const int kc = col0 + 16 * (kt & 1) + 4 * q + e; const bool ok = (kc >= cs) && (kc < cs + 16);
            int dx = kc - qc + 15; dx = dx < 0 ? 0 : (dx > 30 ? 30 : dx);
            sc[kt][0][e] = ok ? sc[kt][0][e] + rpb[dy * 31 + dx] : -1e30f; }
        }
      }
    }
    bf16x8 pf[2][NQT];
#pragma unroll
    for (int qt = 0; qt < NQT; ++qt) {
      float mx = -1e30f;
#pragma unroll
      for (int kt = 0; kt < 4; ++kt)
#pragma unroll
        for (int e = 0; e < 4; ++e) mx = fmaxf(mx, sc[kt][qt][e]);
      mx = fmaxf(mx, __shfl_xor(mx, 16)); mx = fmaxf(mx, __shfl_xor(mx, 32));
      const float mn = fmaxf(mrun[qt], mx); const float alpha = __expf(mrun[qt] - mn); mrun[qt] = mn;
      float ls = 0.f;
#pragma unroll
      for (int kt = 0; kt < 4; ++kt)
#pragma unroll
        for (int e = 0; e < 4; ++e) { const float p = __expf(sc[kt][qt][e] - mn); sc[kt][qt][e] = p; ls += p; }
      lrun[qt] = lrun[qt] * alpha + ls;
#pragma unroll
      for (int dt = 0; dt < 4; ++dt) o[dt][qt] = o[dt][qt] * alpha;
#pragma unroll
      for (int s = 0; s < 2; ++s) {
        u32x4 pk; pk.x = cvt_pk(sc[2 * s][qt][0], sc[2 * s][qt][1]); pk.y = cvt_pk(sc[2 * s][qt][2], sc[2 * s][qt][3]);
        pk.z = cvt_pk(sc[2 * s + 1][qt][0], sc[2 * s + 1][qt][1]); pk.w = cvt_pk(sc[2 * s + 1][qt][2], sc[2 * s + 1][qt][3]);
        pf[s][qt] = as_bf16x8(pk);
      }
    }
#pragma unroll
    for (int s = 0; s < 2; ++s)
#pragma unroll
      for (int dt = 0; dt < 4; ++dt) {
        const int vkb = local2 ? 64 * s + col0 : 32 * s;
        const u32x2 lo = *(const u32x2*)(Vs + (16 * dt + r) * VSTR + (vkb + 4 * q) * 2);
        const u32x2 hi = *(const u32x2*)(Vs + (16 * dt + r) * VSTR + (vkb + 16 + 4 * q) * 2);
        const bf16x8 vf = as_bf16x8((u32x4){lo.x, lo.y, hi.x, hi.y});
#pragma unroll
        for (int qt = 0; qt < NQT; ++qt) o[dt][qt] = mfma16(vf, pf[s][qt], o[dt][qt]);
      }
  }
#pragma unroll
  for (int qt = 0; qt < NQT; ++qt) {
    float l = lrun[qt]; l += __shfl_xor(l, 16); l += __shfl_xor(l, 32);
    float mf = mrun[qt]; float scale;
    if (has_sink) { const float m2 = fmaxf(mf, sinkv); const float a = __expf(mf - m2); l = l * a + __expf(sinkv - m2); scale = a / l; }
    else scale = 1.f / l;
#pragma unroll
    for (int dt = 0; dt < 4; ++dt) {
      u32x2 ov; ov.x = cvt_pk(o[dt][qt][0] * scale, o[dt][qt][1] * scale); ov.y = cvt_pk(o[dt][qt][2] * scale, o[dt][qt][3] * scale);
      *(u32x2*)(MIX + (size_t)qrow[qt] * 1024 + ocol + 16 * dt + 4 * q) = ov;
    }
  }
}

DEVI void ssd_load_raw(unsigned char* raw, const bf16_t* PROJ, int rowbase, int lo, int hi, int col0) {
  for (int e = tid_opq(); e < 134 * 8; e += 256) {
    const int rr = e >> 3, ch = e & 7; const int row = rowbase - 3 + rr;
    u32x4 v = (u32x4){0u, 0u, 0u, 0u};
    if (row >= lo && row < hi) v = *(const u32x4*)(PROJ + (size_t)row * PW + col0 + ch * 8);
    *(u32x4*)(raw + rr * 128 + ch * 16) = v;
  }
}

template <bool TRANSP, bool WEIGHTED>
DEVI void ssd_conv(const unsigned char* raw, const float* cw  , const float* cb, unsigned char* out1, unsigned char* out2, const float* wt1, const float* wt2) {
  const int t_ = tid_opq(); const int c = t_ & 63, tq = t_ >> 6;
  float wj[7];
#pragma unroll
  for (int j = 0; j < 7; ++j) wj[j] = cw[j * 1024 + c];
  const float bias = cb[c];
  const bf16_t* rp = (const bf16_t*)raw + c;
  float w0 = bf2f(rp[(32 * tq + 0) * 64]), w1 = bf2f(rp[(32 * tq + 1) * 64]), w2 = bf2f(rp[(32 * tq + 2) * 64]), w3 = bf2f(rp[(32 * tq + 3) * 64]), w4 = bf2f(rp[(32 * tq + 4) * 64]), w5 = bf2f(rp[(32 * tq + 5) * 64]);
  float hold1[4], hold2[4];
#pragma unroll 1
  for (int tg = 0; tg < 8; ++tg) {
#pragma unroll
    for (int t4 = 0; t4 < 4; ++t4) {
      const int tok = 32 * tq + 4 * tg + t4;
      const float w6 = bf2f(rp[(tok + 6) * 64]);
      float v = bias + wj[0] * w0 + wj[1] * w1 + wj[2] * w2 + wj[3] * w3 + wj[4] * w4 + wj[5] * w5 + wj[6] * w6;
      v = silu_f(v);
      w0 = w1; w1 = w2; w2 = w3; w3 = w4; w4 = w5; w5 = w6;
      if (TRANSP) {
        hold1[t4] = WEIGHTED ? v * wt1[tok] : v;
        if (WEIGHTED) hold2[t4] = v * wt2[tok];
        if (t4 == 3) {
          u32x2 o; o.x = cvt_pk(hold1[0], hold1[1]); o.y = cvt_pk(hold1[2], hold1[3]);
          *(u32x2*)(out1 + c * 272 + (tok - 3) * 2) = o;
          if (WEIGHTED) { u32x2 o2; o2.x = cvt_pk(hold2[0], hold2[1]); o2.y = cvt_pk(hold2[2], hold2[3]); *(u32x2*)(out2 + c * 272 + (tok - 3) * 2) = o2; }
        }
      } else {
        *(bf16_t*)(out1 + tok * 128 + (((c >> 3) ^ (tok & 7)) << 4) + (c & 7) * 2) = (bf16_t)(cvt_pk(v, 0.f) & 0xffffu);
      }
    }
  }
}

constexpr int SM_RAW = 0, SM_X1 = 17152, SM_X2 = 34560, SM_BT = 51968, SM_SMALL = 69376;
constexpr int SM_XT = 17152, SM_BN = 34560, SM_CN = 50944;

NOINL void conv_item(const Params& P, int layer, int b, int cidx, int slab) {
  unsigned char* const smh = smem + half_id() * HSTR;
  const int t = tid_opq(), c = t & 63, tq = t >> 6;
  const bf16_t* PROJ = (const bf16_t*)(P.ws + OFF_PROJ);
  bf16_t* XN = (bf16_t*)(P.ws + OFF_XN);
  int rowbase, lo, hi;
  if (cidx < 2) { lo = T + b * 256; hi = lo + 256; rowbase = lo + cidx * 128; } else { lo = b * 4096; hi = lo + 4096; rowbase = lo + (cidx - 2) * 128; }
  __syncthreads();
  ssd_load_raw(smh + SM_RAW, PROJ, rowbase, lo, hi, 1792 + slab * 64);
  __syncthreads();
  const float* cw = P.conv_w + (size_t)layer * 7 * 1024 + slab * 64 + c;
  float wj[7];
#pragma unroll
  for (int j = 0; j < 7; ++j) wj[j] = cw[j * 1024];
  const float bias = P.conv_b[layer * 1024 + slab * 64 + c];
  const bf16_t* rp = (const bf16_t*)(smh + SM_RAW) + c;
  float w0 = bf2f(rp[(32 * tq + 0) * 64]), w1 = bf2f(rp[(32 * tq + 1) * 64]), w2 = bf2f(rp[(32 * tq + 2) * 64]), w3 = bf2f(rp[(32 * tq + 3) * 64]), w4 = bf2f(rp[(32 * tq + 4) * 64]), w5 = bf2f(rp[(32 * tq + 5) * 64]);
  const bool nat = slab >= 8, tr = slab < 12;
  bf16_t* trp = slab < 8 ? (bf16_t*)(P.ws + OFF_XTX) + (size_t)(slab * 64 + c) * TT : (bf16_t*)(P.ws + OFF_XTB) + (size_t)((slab - 8) * 64 + c) * TT;
#pragma unroll 1
  for (int tg = 0; tg < 4; ++tg) {
    float hold[8];
#pragma unroll
    for (int t8 = 0; t8 < 8; ++t8) {
      const int tok = 32 * tq + 8 * tg + t8;
      const float w6 = bf2f(rp[(tok + 6) * 64]);
      float v = bias + wj[0] * w0 + wj[1] * w1 + wj[2] * w2 + wj[3] * w3 + wj[4] * w4 + wj[5] * w5 + wj[6] * w6;
      v = silu_f(v);
      w0 = w1; w1 = w2; w2 = w3; w3 = w4; w4 = w5; w5 = w6;
      hold[t8] = v;
      if (nat) XN[(size_t)(rowbase + tok) * 512 + (slab - 8) * 64 + c] = (bf16_t)(cvt_pk(v, 0.f) & 0xffffu);
    }
    if (tr) {
      u32x4 o; o.x = cvt_pk(hold[0], hold[1]); o.y = cvt_pk(hold[2], hold[3]); o.z = cvt_pk(hold[4], hold[5]); o.w = cvt_pk(hold[6], hold[7]);
      *(u32x4*)(trp + rowbase + 32 * tq + 8 * tg) = o;
    }
  }
}

NOINL void ssd_state_item(const Params& P, int layer, int b, int cidx, int h) {
  unsigned char* const smh = smem + half_id() * HSTR;
  const int t = tid_opq(), lane = t & 63, w = t >> 6, r = lane & 15, q = lane >> 4;
  const bf16_t* PROJ = (const bf16_t*)(P.ws + OFF_PROJ);
  const float* DTb = (const float*)(P.ws + OFF_DT);
  bf16_t* ST = (bf16_t*)(P.ws + OFF_ST);
  float* CD = (float*)(P.ws + OFF_CD);
  float* sm = (float*)(smh + SM_SMALL);
  int rowbase, lo, hi;
  if (cidx < 2) { lo = T + b * 256; hi = lo + 256; rowbase = lo + cidx * 128; } else { lo = b * 4096; hi = lo + 4096; rowbase = lo + (cidx - 2) * 128; }
  const int g = h >> 2;
  const float Af = -__expf(P.a_log[layer * 16 + h]), Ab = -__expf(P.a_log[layer * 16 + 8 + h]);
  __syncthreads();
  float inf_ = 0.f, inb_ = 0.f, ab_ = 0.f;
  if (t < 128) {
    const float df = softplus_f(DTb[(size_t)(rowbase + t) * 16 + h] + P.dt_bias[layer * 16 + h]);
    const float db = softplus_f(DTb[(size_t)(rowbase + t) * 16 + 8 + h] + P.dt_bias[layer * 16 + 8 + h]);
    sm[256 + t] = df; sm[384 + t] = db;
    ab_ = db * Ab; inf_ = wave_incl_scan(df * Af, lane); inb_ = wave_incl_scan(ab_, lane);
    if (lane == 63) { sm[772 + w] = inf_; sm[774 + w] = inb_; }
  }
  __syncthreads();
  if (t < 128) {
    const float acf = inf_ + (w == 1 ? sm[772] : 0.f), totf = sm[772] + sm[773];
    const float preb = inb_ - ab_ + (w == 1 ? sm[774] : 0.f), totb = sm[774] + sm[775];
    sm[512 + t] = __expf(totf - acf) * sm[256 + t];
    sm[640 + t] = __expf(preb) * sm[384 + t];
    if (t == 0) { const int seq = (b * 8 + h) * 2; CD[seq * 34 + cidx] = __expf(totf); CD[(seq + 1) * 34 + cidx] = __expf(totb); }
  }
  __syncthreads();
  {
    const bf16_t* XTX = (const bf16_t*)(P.ws + OFF_XTX);
#pragma unroll
    for (int k = 0; k < 4; ++k) {
      const int e = t + 256 * k, p = e >> 4, c16 = e & 15;
      const u32x4 v = *(const u32x4*)(XTX + (size_t)(h * 64 + p) * TT + rowbase + c16 * 8);
      const float* wf = sm + 512 + c16 * 8; const float* wb = sm + 640 + c16 * 8;
      u32x4 of, ob;
      of.x = cvt_pk(bflo(v.x) * wf[0], bfhi(v.x) * wf[1]); of.y = cvt_pk(bflo(v.y) * wf[2], bfhi(v.y) * wf[3]); of.z = cvt_pk(bflo(v.z) * wf[4], bfhi(v.z) * wf[5]); of.w = cvt_pk(bflo(v.w) * wf[6], bfhi(v.w) * wf[7]);
      ob.x = cvt_pk(bflo(v.x) * wb[0], bfhi(v.x) * wb[1]); ob.y = cvt_pk(bflo(v.y) * wb[2], bfhi(v.y) * wb[3]); ob.z = cvt_pk(bflo(v.z) * wb[4], bfhi(v.z) * wb[5]); ob.w = cvt_pk(bflo(v.w) * wb[6], bfhi(v.w) * wb[7]);
      *(u32x4*)(smh + SM_X1 + p * 272 + c16 * 16) = of; *(u32x4*)(smh + SM_X2 + p * 272 + c16 * 16) = ob;
    }
  }
#pragma unroll 1
  for (int nh = 0; nh < 2; ++nh) {
    {
      const bf16_t* XTB = (const bf16_t*)(P.ws + OFF_XTB);
#pragma unroll
      for (int k = 0; k < 4; ++k) {
        const int e = t + 256 * k, n = e >> 4, c16 = e & 15;
        *(u32x4*)(smh + SM_BT + n * 272 + c16 * 16) = *(const u32x4*)(XTB + (size_t)(g * 128 + nh * 64 + n) * TT + rowbase + c16 * 8);
      }
    }
    __syncthreads();
    f32x4 acc[4][2];
#pragma unroll
    for (int nt = 0; nt < 4; ++nt) { acc[nt][0] = (f32x4){0.f, 0.f, 0.f, 0.f}; acc[nt][1] = (f32x4){0.f, 0.f, 0.f, 0.f}; }
#pragma unroll
    for (int s = 0; s < 4; ++s) {
      const bf16x8 xf = *(const bf16x8*)(smh + SM_X1 + (16 * w + r) * 272 + (32 * s + 8 * q) * 2);
      const bf16x8 xb = *(const bf16x8*)(smh + SM_X2 + (16 * w + r) * 272 + (32 * s + 8 * q) * 2);
#pragma unroll
      for (int nt = 0; nt < 4; ++nt) {
        const bf16x8 bt = *(const bf16x8*)(smh + SM_BT + (16 * nt + r) * 272 + (32 * s + 8 * q) * 2);
        acc[nt][0] = mfma16(bt, xf, acc[nt][0]); acc[nt][1] = mfma16(bt, xb, acc[nt][1]);
      }
    }
#pragma unroll
    for (int dir = 0; dir < 2; ++dir) {
      bf16_t* sp = ST + ((size_t)(((b * 8 + h) * 2 + dir) * 34 + cidx)) * 8192 + (16 * w + r) * 128 + nh * 64 + 4 * q;
#pragma unroll
      for (int nt = 0; nt < 4; ++nt) { u32x2 ov; ov.x = cvt_pk(acc[nt][dir][0], acc[nt][dir][1]); ov.y = cvt_pk(acc[nt][dir][2], acc[nt][dir][3]); *(u32x2*)(sp + 16 * nt) = ov; }
    }
    __syncthreads();
  }
}

NOINL void ssd_scan_phase(const Params& P) {
  bf16_t* ST = (bf16_t*)(P.ws + OFF_ST);
  const float* CD = (const float*)(P.ws + OFF_CD);
  const int total = 64 * 2048;
  for (int gidx = VB * 256 + tid_opq(); gidx < total; gidx += VG * 256) {
    const int seq = gidx >> 11, e = gidx & 2047, dir = seq & 1;
    bf16_t* base = ST + (size_t)seq * 34 * 8192 + e * 4;
    const float* cd = CD + seq * 34;
    u32x2 v[34];
#pragma unroll
    for (int k = 0; k < 34; ++k) { const int ci = dir == 0 ? k : (k == 0 ? 1 : (k == 1 ? 0 : 35 - k)); v[k] = *(const u32x2*)(base + (size_t)ci * 8192); }
    float dk[34];
#pragma unroll
    for (int k = 0; k < 34; ++k) { const int ci = dir == 0 ? k : (k == 0 ? 1 : (k == 1 ? 0 : 35 - k)); dk[k] = cd[ci]; }
    float h0 = 0.f, h1 = 0.f, h2 = 0.f, h3 = 0.f;
#pragma unroll
    for (int k = 0; k < 34; ++k) {
      const int ci = dir == 0 ? k : (k == 0 ? 1 : (k == 1 ? 0 : 35 - k));
      u32x2 ov; ov.x = cvt_pk(h0, h1); ov.y = cvt_pk(h2, h3);
      *(u32x2*)(base + (size_t)ci * 8192) = ov;
      const float d = dk[k];
      h0 = h0 * d + bflo(v[k].x); h1 = h1 * d + bfhi(v[k].x); h2 = h2 * d + bflo(v[k].y); h3 = h3 * d + bfhi(v[k].y);
    }
  }
}

NOINL void ssd_out_item(const Params& P, int layer, int b, int cidx, int h, int do_atomic) {
  unsigned char* const smh = smem + half_id() * HSTR;
  const int t = tid_opq(), lane = t & 63, w = t >> 6, r = lane & 15, q = lane >> 4, r7 = r & 7;
  const bf16_t* PROJ = (const bf16_t*)(P.ws + OFF_PROJ);
  const float* DTb = (const float*)(P.ws + OFF_DT);
  const bf16_t* ST = (const bf16_t*)(P.ws + OFF_ST);
  bf16_t* MIX = (bf16_t*)(P.ws + OFF_H);
  float* SSQ = (float*)(P.ws + OFF_SSQ);
  float* sm = (float*)(smh + SM_SMALL);
  int rowbase, lo, hi;
  if (cidx < 2) { lo = T + b * 256; hi = lo + 256; rowbase = lo + cidx * 128; } else { lo = b * 4096; hi = lo + 4096; rowbase = lo + (cidx - 2) * 128; }
  const int g = h >> 2;
  const float Af = -__expf(P.a_log[layer * 16 + h]), Ab = -__expf(P.a_log[layer * 16 + 8 + h]);
  __syncthreads();
  float inf_ = 0.f, inb_ = 0.f, ab_ = 0.f;
  if (t < 128) {
    const float df = softplus_f(DTb[(size_t)(rowbase + t) * 16 + h] + P.dt_bias[layer * 16 + h]);
    const float db = softplus_f(DTb[(size_t)(rowbase + t) * 16 + 8 + h] + P.dt_bias[layer * 16 + 8 + h]);
    sm[256 + t] = df; sm[384 + t] = db;
    ab_ = db * Ab; inf_ = wave_incl_scan(df * Af, lane); inb_ = wave_incl_scan(ab_, lane);
    if (lane == 63) { sm[772 + w] = inf_; sm[774 + w] = inb_; }
  }
  {
    const bf16_t* XTX = (const bf16_t*)(P.ws + OFF_XTX);
#pragma unroll
    for (int k = 0; k < 4; ++k) {
      const int e = t + 256 * k, p = e >> 4, c16 = e & 15;
      *(u32x4*)(smh + SM_XT + p * 272 + c16 * 16) = *(const u32x4*)(XTX + (size_t)(h * 64 + p) * TT + rowbase + c16 * 8);
    }
  }
  __syncthreads();
  if (t < 128) {
    const float acf = inf_ + (w == 1 ? sm[772] : 0.f);
    const float preb = inb_ - ab_ + (w == 1 ? sm[774] : 0.f), totb = sm[774] + sm[775];
    sm[512 + t] = acf; sm[640 + t] = preb;
    if (t == 0) sm[768] = totb;
  }
  __syncthreads();
  f32x4 G[8][2], y[4][2];
#pragma unroll
  for (int jt = 0; jt < 8; ++jt) { G[jt][0] = (f32x4){0.f, 0.f, 0.f, 0.f}; G[jt][1] = (f32x4){0.f, 0.f, 0.f, 0.f}; }
#pragma unroll
  for (int pt = 0; pt < 4; ++pt) { y[pt][0] = (f32x4){0.f, 0.f, 0.f, 0.f}; y[pt][1] = (f32x4){0.f, 0.f, 0.f, 0.f}; }
  float acfi[2], prebi[2], efi[2][2];
#pragma unroll
  for (int it = 0; it < 2; ++it) {
    const int i = 32 * w + 16 * it + r;
    acfi[it] = sm[512 + i]; prebi[it] = sm[640 + i];
    efi[0][it] = __expf(acfi[it]); efi[1][it] = __expf(sm[768] - prebi[it]);
  }
#pragma unroll 1
  for (int nh = 0; nh < 2; ++nh) {
    {
      const bf16_t* XN = (const bf16_t*)(P.ws + OFF_XN);
#pragma unroll
      for (int k = 0; k < 4; ++k) {
        const int e = t + 256 * k, tok = e >> 3, ch = e & 7;
        const bf16_t* src = XN + (size_t)(rowbase + tok) * 512 + g * 128 + nh * 64 + ch * 8;
        *(u32x4*)(smh + SM_BN + tok * 128 + ((ch ^ (tok & 7)) << 4)) = *(const u32x4*)src;
        *(u32x4*)(smh + SM_CN + tok * 128 + ((ch ^ (tok & 7)) << 4)) = *(const u32x4*)(src + 256);
      }
      const int hp_ = t >> 2, hc_ = (t & 3) * 2;
#pragma unroll
      for (int d = 0; d < 2; ++d) {
        const bf16_t* hsrc = ST + ((size_t)(((b * 8 + h) * 2 + d) * 34 + cidx)) * 8192 + hp_ * 128 + nh * 64 + hc_ * 8;
        *(u32x4*)(smh + SM_RAW + d * 8192 + hp_ * 128 + ((hc_ ^ (hp_ & 7)) << 4)) = *(const u32x4*)hsrc;
        *(u32x4*)(smh + SM_RAW + d * 8192 + hp_ * 128 + (((hc_ + 1) ^ (hp_ & 7)) << 4)) = *(const u32x4*)(hsrc + 8);
      }
    }
    __syncthreads();
    bf16x8 cf[2][2];
#pragma unroll
    for (int it = 0; it < 2; ++it)
#pragma unroll
      for (int s = 0; s < 2; ++s) cf[it][s] = *(const bf16x8*)(smh + SM_CN + (32 * w + 16 * it + r) * 128 + (((4 * s + q) ^ r7) << 4));
#pragma unroll
    for (int jt = 0; jt < 8; ++jt)
#pragma unroll
      for (int s = 0; s < 2; ++s) {
        const bf16x8 bfr = *(const bf16x8*)(smh + SM_BN + (16 * jt + r) * 128 + (((4 * s + q) ^ r7) << 4));
        G[jt][0] = mfma16(bfr, cf[0][s], G[jt][0]); G[jt][1] = mfma16(bfr, cf[1][s], G[jt][1]);
      }
#pragma unroll
    for (int d = 0; d < 2; ++d) {
#pragma unroll
      for (int s = 0; s < 2; ++s) {
        union { bf16x8 b; u32x4 u; } c0, c1; c0.b = cf[0][s]; c1.b = cf[1][s];
        const bf16x8 cs0 = as_bf16x8(scale8(c0.u, efi[d][0])), cs1 = as_bf16x8(scale8(c1.u, efi[d][1]));
#pragma unroll
        for (int pt = 0; pt < 4; ++pt) {
          const bf16x8 hf = *(const bf16x8*)(smh + SM_RAW + d * 8192 + (16 * pt + r) * 128 + (((4 * s + q) ^ r7) << 4));
          y[pt][0] = mfma16(hf, cs0, y[pt][0]); y[pt][1] = mfma16(hf, cs1, y[pt][1]);
        }
      }
    }
    __syncthreads();
  }
#pragma unroll
  for (int s = 0; s < 4; ++s) {
    asm volatile("" ::: "memory");
    bf16x8 mf[2];
    const int wu = __builtin_amdgcn_readfirstlane(w);
    if (s < wu) {
      float aj[8], dfj[8];
#pragma unroll
      for (int jj = 0; jj < 8; ++jj) { const int j = 32 * s + (jj < 4 ? 4 * q + jj : 16 + 4 * q + jj - 4); aj[jj] = sm[512 + j]; dfj[jj] = sm[256 + j]; }
#pragma unroll
      for (int it = 0; it < 2; ++it) {
        float mv[8];
#pragma unroll
        for (int jj = 0; jj < 8; ++jj) mv[jj] = G[2 * s + (jj >> 2)][it][jj & 3] * __expf(acfi[it] - aj[jj]) * dfj[jj];
        u32x4 pk; pk.x = cvt_pk(mv[0], mv[1]); pk.y = cvt_pk(mv[2], mv[3]); pk.z = cvt_pk(mv[4], mv[5]); pk.w = cvt_pk(mv[6], mv[7]);
        mf[it] = as_bf16x8(pk);
      }
    } else if (s > wu) {
      float pj[8], dbj[8];
#pragma unroll
      for (int jj = 0; jj < 8; ++jj) { const int j = 32 * s + (jj < 4 ? 4 * q + jj : 16 + 4 * q + jj - 4); pj[jj] = sm[640 + j]; dbj[jj] = sm[384 + j]; }
#pragma unroll
      for (int it = 0; it < 2; ++it) {
        float mv[8];
#pragma unroll
        for (int jj = 0; jj < 8; ++jj) mv[jj] = G[2 * s + (jj >> 2)][it][jj & 3] * __expf(pj[jj] - prebi[it]) * dbj[jj];
        u32x4 pk; pk.x = cvt_pk(mv[0], mv[1]); pk.y = cvt_pk(mv[2], mv[3]); pk.z = cvt_pk(mv[4], mv[5]); pk.w = cvt_pk(mv[6], mv[7]);
        mf[it] = as_bf16x8(pk);
      }
    } else {
    float aj[8], pj[8], dfj[8], dbj[8];
#pragma unroll
    for (int jj = 0; jj < 8; ++jj) { const int j = 32 * s + (jj < 4 ? 4 * q + jj : 16 + 4 * q + jj - 4); aj[jj] = sm[512 + j]; pj[jj] = sm[640 + j]; dfj[jj] = sm[256 + j]; dbj[jj] = sm[384 + j]; }
#pragma unroll
    for (int it = 0; it < 2; ++it) {
      const int i = 32 * w + 16 * it + r;
      float mv[8];
#pragma unroll
      for (int jj = 0; jj < 8; ++jj) {
        const int j = 32 * s + (jj < 4 ? 4 * q + jj : 16 + 4 * q + jj - 4);
        const float gv = G[2 * s + (jj >> 2)][it][jj & 3];
        float m;
        if (j < i) m = gv * __expf(acfi[it] - aj[jj]) * dfj[jj];
        else if (j > i) m = gv * __expf(pj[jj] - prebi[it]) * dbj[jj];
        else m = gv * (dfj[jj] + dbj[jj]);
        mv[jj] = m;
      }
      u32x4 pk; pk.x = cvt_pk(mv[0], mv[1]); pk.y = cvt_pk(mv[2], mv[3]); pk.z = cvt_pk(mv[4], mv[5]); pk.w = cvt_pk(mv[6], mv[7]);
      mf[it] = as_bf16x8(pk);
    }
    }
#pragma unroll
    for (int pt = 0; pt < 4; ++pt) {
      const u32x2 lo2 = *(const u32x2*)(smh + SM_XT + (16 * pt + r) * 272 + (32 * s + 4 * q) * 2);
      const u32x2 hi2 = *(const u32x2*)(smh + SM_XT + (16 * pt + r) * 272 + (32 * s + 16 + 4 * q) * 2);
      const bf16x8 xf = as_bf16x8((u32x4){lo2.x, lo2.y, hi2.x, hi2.y});
      y[pt][0] = mfma16(xf, mf[0], y[pt][0]); y[pt][1] = mfma16(xf, mf[1], y[pt][1]);
    }
  }
  const float dsk = P.ssm_d[layer * 8 + h];
  const bf16_t* XT = (const bf16_t*)(smh + SM_XT);
  u32x2 zq[2][4]; f32x4 gq[4];
#pragma unroll
  for (int pt = 0; pt < 4; ++pt) {
    gq[pt] = *(const f32x4*)(P.ssm_g + layer * 512 + h * 64 + 16 * pt + 4 * q);
#pragma unroll
    for (int it = 0; it < 2; ++it) zq[it][pt] = *(const u32x2*)(PROJ + (size_t)(rowbase + 32 * w + 16 * it + r) * PW + 512 + h * 64 + 16 * pt + 4 * q);
  }
#pragma unroll
  for (int it = 0; it < 2; ++it) {
    const int i = 32 * w + 16 * it + r; const int row = rowbase + i;
    float ss = 0.f;
#pragma unroll
    for (int pt = 0; pt < 4; ++pt) {
      const int p0 = 16 * pt + 4 * q;
      const u32x2 zz = zq[it][pt];
      const f32x4 gg = gq[pt];
      const float zv[4] = {bflo(zz.x), bfhi(zz.x), bflo(zz.y), bfhi(zz.y)};
      float ov[4];
#pragma unroll
      for (int e = 0; e < 4; ++e) {
        const float xs = bf2f(XT[(p0 + e) * 136 + i]);
        const float yz = (y[pt][it][e] + dsk * xs) * silu_f(zv[e]);
        ss += yz * yz; ov[e] = yz * gg[e];
      }
      u32x2 o; o.x = cvt_pk(ov[0], ov[1]); o.y = cvt_pk(ov[2], ov[3]);
      *(u32x2*)(MIX + (size_t)row * 1024 + h * 64 + p0) = o;
    }
    ss += __shfl_xor(ss, 16); ss += __shfl_xor(ss, 32);
    if (q == 0 && do_atomic) atomicAdd(SSQ + row, ss);
  }
}

DEVI void mixer1_phase(const Params& P, int layer) {
  const int nA = 512, nV = 4 * 34 * 16, nC = (layer == 0) ? 64 : 0;
  const int total = nA + nV + nC;
#pragma unroll 1
  for (int it = VB; it < total; it += VG) {
    if (it < nA || it >= nA + nV) {
      int b, i1, i2; bool isctx = it >= nA;
      if (!isctx) { b = it >> 7; i1 = (it >> 2) & 31; i2 = it & 3; }
      else { const int e = it - nA - nV; b = e >> 4; i1 = (e >> 3) & 1; i2 = e & 7; }
      attn_item<0>(P, layer, b, i1, i2, isctx ? 1 : 0);
    } else { const int e = it - nA; const int b = e / 544, rem = e % 544; conv_item(P, layer, b, rem >> 4, rem & 15); }
  }
}
DEVI void mixer2_phase(const Params& P, int layer) {
  const int nB = 1024, nS = 4 * 34 * 8;
  const int total = nB + nS;
#pragma unroll 1
  for (int it = VB; it < total; it += VG) {
    if (it < nB) { const int b = it >> 8, gr = (it >> 2) & 63, h = it & 3; attn_item<1>(P, layer, b, gr, h, 0); }
    else { const int e = it - nB; const int b = e / 272, rem = e % 272; ssd_state_item(P, layer, b, rem >> 3, rem & 7); }
  }
}

DEVI void ssd_out_phase(const Params& P, int layer, int do_atomic = 1) {
  const int c0 = (layer == 0) ? 0 : 2;
  const int nc = 34 - c0;
  const int total = 4 * nc * 8;
#pragma unroll 1
  for (int it = VB; it < total; it += VG) {
    const int b = it / (nc * 8), rem = it % (nc * 8);
    ssd_out_item(P, layer, b, c0 + (rem >> 3), rem & 7, do_atomic);
  }
}


#define XB_TMO      128
#define XB_XCNT(j)  (256  + 64 * (j))
#define XB_XSUB(j)  (1280 + 64 * (j))
#define XB_XGEN(j)  (2304 + 64 * (j))
#define XB_TOP      3328
#define XB_TOPGEN   3392
#define XB_SPIN_CAP (1u << 18)
#define LAS __attribute__((address_space(3)))
DEVI unsigned xb_ld(unsigned* p)              { return __hip_atomic_load(p, __ATOMIC_RELAXED, __HIP_MEMORY_SCOPE_AGENT); }
DEVI unsigned xb_add(unsigned* p, unsigned v) { return __hip_atomic_fetch_add(p, v, __ATOMIC_RELAXED, __HIP_MEMORY_SCOPE_AGENT); }
DEVI unsigned xb_xcc_id() { return (unsigned)__builtin_amdgcn_s_getreg((3 << 11) | 20) & 0xFu; }
#define XB_SPIN(cond, bar) do { unsigned _sp = 0; while (cond) { __builtin_amdgcn_s_sleep(1); \
    if ((++_sp & 255u) == 0u) { if (xb_ld(&(bar)[XB_TMO])) break; if (_sp > XB_SPIN_CAP) { atomicAdd(&(bar)[XB_TMO], 1u); break; } } } } while (0)
struct XcdBarrier { unsigned* bar; unsigned x; volatile LAS unsigned* st; };
DEVI XcdBarrier xcd_barrier_post(unsigned* bar, volatile LAS unsigned* st) {
  XcdBarrier b; b.bar = bar; b.x = xb_xcc_id(); b.st = st;
  if (threadIdx.x == 0) (void)xb_add(&bar[XB_XCNT(b.x)], 1u);
  return b;
}
DEVI void xcd_barrier_complete(unsigned* bar, unsigned x, unsigned& nloc, unsigned& nx) {
  const unsigned G = gridDim.x * gridDim.y * gridDim.z;
  unsigned sum, cnt, mine, sp = 0u;
  for (;;) {
    sum = 0u; cnt = 0u; mine = 0u;
#pragma unroll
    for (unsigned j = 0; j < 16; ++j) { const unsigned c = xb_ld(&bar[XB_XCNT(j)]); sum += c; cnt += (c > 0u) ? 1u : 0u; mine = (j == x) ? c : mine; }
    if (sum == G) break;
    __builtin_amdgcn_s_sleep(1);
    if ((++sp & 255u) == 0u) { if (xb_ld(&bar[XB_TMO])) break; if (sp > XB_SPIN_CAP) { atomicAdd(&bar[XB_TMO], 1u); break; } }
  }
  nloc = mine > 0u ? mine : 1u; nx = cnt > 0u ? cnt : 1u;
}
DEVI void xcd_barrier(const XcdBarrier& b) {
  asm volatile("s_waitcnt vmcnt(0)" ::: "memory");
  __syncthreads();
  if (threadIdx.x == 0) {
    unsigned* bar = b.bar;
    __builtin_amdgcn_s_waitcnt(0);
    unsigned nloc = b.st[0], nx = b.st[1];
    if (nloc == 0u) { xcd_barrier_complete(bar, b.x, nloc, nx); b.st[0] = nloc; b.st[1] = nx; }
    const unsigned old = xb_add(&bar[XB_XSUB(b.x)], 1u);
    const unsigned gen = old / nloc;
    if (old + 1u == (gen + 1u) * nloc) {
      __builtin_amdgcn_fence(__ATOMIC_RELEASE, "agent");
      asm volatile("s_waitcnt vmcnt(0)" ::: "memory");
      const unsigned og = xb_add(&bar[XB_TOP], 1u);
      const unsigned tg = og / nx;
      if (og + 1u == (tg + 1u) * nx) xb_add(&bar[XB_TOPGEN], 1u);
      else XB_SPIN(xb_ld(&bar[XB_TOPGEN]) == tg, bar);
      __builtin_amdgcn_fence(__ATOMIC_ACQUIRE, "agent");
      xb_add(&bar[XB_XGEN(b.x)], 1u);
      asm volatile("s_waitcnt vmcnt(0)" ::: "memory");
    } else {
      XB_SPIN(xb_ld(&bar[XB_XGEN(b.x)]) == gen, bar);
      __builtin_amdgcn_fence(__ATOMIC_ACQUIRE, "agent");
      asm volatile("s_waitcnt vmcnt(0)" ::: "memory");
    }
  }
  __syncthreads();
}

__global__ void __launch_bounds__(512, 2) mega_fwd(Params P) {
  cg::grid_group grid = cg::this_grid();
  if (threadIdx.x == 0) *(uint4*)(smem + SM_XB) = make_uint4(0u, 0u, 0u, 0u);
  __syncthreads();
  XcdBarrier xb = xcd_barrier_post((unsigned*)(P.ws + OFF_BAR), (volatile LAS unsigned*)(smem + SM_XB));
  if (P.ph_hi > 1000) grid.sync();
#define BAR() xcd_barrier(xb)
#ifndef REP_S
#define REP_S -1
#endif
#define RUN(S_, CALL) { if (REP_S == (S_)) { const int do_at = 0; (void)do_at; CALL; BAR(); } { const int do_at = 1; (void)do_at; CALL; } BAR(); }
#define LAYER(l) \
  RUN(0, (norm_phase(P, l, 0), (l == 1 ? prep_phase(P, 1, false) : (void)0))) \
  RUN(1, (gemm_phase<MODE_INPROJ, false>(P, l))) \
  RUN(2, mixer1_phase(P, l)) \
  RUN(9, mixer2_phase(P, l)) \
  RUN(3, ssd_scan_phase(P)) \
  RUN(4, ssd_out_phase(P, l, do_at)) \
  RUN(5, (gemm_phase<MODE_RESID, true>(P, l))) \
  RUN(6, norm_phase(P, l, 1)) \
  RUN(7, (gemm_phase<MODE_SWIGLU, false>(P, l))) \
  RUN(8, (gemm_phase<MODE_RESID, false>(P, l)))
  prep_phase(P, 0, true); BAR();
  LAYER(0)
  LAYER(1)
  final_norm_phase(P);
}

extern "C" void kernel_launch(void* const* d_in, const int* in_sizes, int n_in, void* d_out, int out_size, void* d_ws, size_t ws_size, hipStream_t stream) {
  static int grid_blocks = 0;
  if (!grid_blocks) {
    int dev = 0, cus = 0, per_cu = 0;
    hipGetDevice(&dev);
    hipDeviceGetAttribute(&cus, hipDeviceAttributeMultiprocessorCount, dev);
    hipOccupancyMaxActiveBlocksPerMultiprocessor(&per_cu, mega_fwd, 512, 0);
    if (per_cu < 1) per_cu = 1;
    if (per_cu > 1) per_cu = 1;
    grid_blocks = cus * per_cu;
    if (ws_size < WS_END) fprintf(stderr, "kernel_launch: workspace too small: %zu < %zu\n", ws_size, (size_t)WS_END);
  }
  Params p{};
  const float** pp = (const float**)&p;
  for (int i = 0; i < 21; ++i) pp[i] = (const float*)d_in[i];
  p.out = (float*)d_out; p.ws = (unsigned char*)d_ws;
  hipMemsetAsync((unsigned char*)d_ws + OFF_MODS, 0, SZ_MODS + SZ_BAR, stream);
#if LAUNCH_PER_PHASE
  for (int ph = 0; ph < NPH; ++ph) {
    p.ph_lo = ph; p.ph_hi = ph + 1;
    hipLaunchKernelGGL(mega_fwd, dim3(grid_blocks), dim3(256), 0, stream, p);
  }
#else
  p.ph_lo = 0; p.ph_hi = NPH;
  void* args[] = {&p};
  hipError_t e = hipLaunchCooperativeKernel((void*)mega_fwd, dim3(grid_blocks), dim3(512), args, 0, stream);
  if (e != hipSuccess) fprintf(stderr, "cooperative launch failed: %s (grid %d)\n", hipGetErrorString(e), grid_blocks);
#endif
}
```

```cpp
#include <hip/hip_runtime.h>
#include <hip/hip_cooperative_groups.h>
#include <cstdio>
#include <cstdint>
namespace cg = cooperative_groups;

#ifndef LAUNCH_PER_PHASE
#define LAUNCH_PER_PHASE 0
#endif

typedef unsigned short bf16_t;
typedef short bf16x8 __attribute__((ext_vector_type(8)));
typedef float f32x4 __attribute__((ext_vector_type(4)));
typedef unsigned u32x4 __attribute__((ext_vector_type(4)));
typedef unsigned u32x2 __attribute__((ext_vector_type(2)));
#define DEVI __device__ __forceinline__

constexpr int T = 16384, TC = 1024, TT = T + TC;
constexpr int PW = 2816;
constexpr int NPH = 20;
constexpr float EPSN = 1e-6f;

constexpr size_t SZ_WIN = (size_t)2944 * 1024 * 2, SZ_WOUT = (size_t)1024 * 1024 * 2, SZ_WFI = (size_t)5632 * 1024 * 2, SZ_WFO = (size_t)1024 * 2816 * 2;
constexpr size_t OFF_WIN = 0;
constexpr size_t OFF_WOUT = OFF_WIN + SZ_WIN;
constexpr size_t OFF_WFI = OFF_WOUT + SZ_WOUT;
constexpr size_t OFF_WFO = OFF_WFI + SZ_WFI;
constexpr size_t OFF_H = OFF_WFO + SZ_WFO;
constexpr size_t OFF_PROJ = OFF_H + (size_t)TT * 1024 * 2;
constexpr size_t OFF_VT = OFF_PROJ + (size_t)TT * PW * 2;
constexpr size_t OFF_DT = OFF_VT + (size_t)384 * TT * 2;
constexpr size_t OFF_XC = OFF_DT + (size_t)TT * 16 * 4;
constexpr size_t OFF_MODS = OFF_XC + (size_t)TC * 1024 * 4;
constexpr size_t SZ_MODS = (size_t)2 * 5 * 6144 * 4;
constexpr size_t OFF_BAR = OFF_MODS + SZ_MODS;
constexpr size_t SZ_BAR = 3456 * 4;
constexpr size_t OFF_SSQ = OFF_BAR + SZ_BAR;
constexpr size_t OFF_ST = OFF_SSQ + (size_t)TT * 4;
constexpr size_t OFF_CD = OFF_ST + (size_t)64 * 34 * 8192 * 2;
constexpr size_t OFF_ROPE = OFF_CD + (size_t)64 * 34 * 4;
constexpr size_t OFF_XN = OFF_ROPE + 2 * 1024 * 4;
constexpr size_t OFF_XTX = OFF_XN + (size_t)TT * 512 * 2;
constexpr size_t OFF_XTB = OFF_XTX + (size_t)512 * TT * 2;
constexpr size_t WS_END = OFF_XTB + (size_t)256 * TT * 2;
static_assert(WS_END <= (size_t)256 * 1024 * 1024, "workspace map exceeds 256 MiB");

struct Params {
  const float *x, *c, *ctx, *c_ctx, *w_mod, *b_mod, *g_mix, *w_in, *wa_sink, *na_rpb, *conv_w, *conv_b, *dt_bias, *a_log, *ssm_d, *ssm_g, *w_out, *g_ffn, *w_ffn_in, *w_ffn_out, *g_final;
  float* out; unsigned char* ws; int ph_lo, ph_hi;
};

constexpr int HSTR = 73728, SM_XB = 2 * HSTR, SMEM_BYTES = 2 * HSTR + 16;
__shared__ __attribute__((aligned(16))) unsigned char smem[SMEM_BYTES];
#define NOINL __device__ __forceinline__

typedef __bf16 bf16x2_t __attribute__((ext_vector_type(2)));
typedef float f32x2_t __attribute__((ext_vector_type(2)));
DEVI unsigned cvt_pk(float lo, float hi) { f32x2_t v = {lo, hi}; bf16x2_t b = __builtin_convertvector(v, bf16x2_t); return __builtin_bit_cast(unsigned, b); }
DEVI float bflo(unsigned u) { return __uint_as_float(u << 16); }
DEVI float bfhi(unsigned u) { return __uint_as_float(u & 0xffff0000u); }
DEVI float bf2f(bf16_t h) { return __uint_as_float((unsigned)h << 16); }
DEVI float silu_f(float v) { return v * __builtin_amdgcn_rcpf(1.f + __expf(-v)); }
DEVI float softplus_f(float v) { const float e = __expf(v); return v > 20.f ? v : (e < 1e-3f ? e * (1.f - 0.5f * e) : __logf(1.f + e)); }
DEVI float wave_sum(float v) {
#pragma unroll
  for (int o = 32; o > 0; o >>= 1) v += __shfl_xor(v, o);
  return v;
}
DEVI float wave_incl_scan(float v, int lane) {
#pragma unroll
  for (int o = 1; o < 64; o <<= 1) { const float u = __shfl_up(v, o); if (lane >= o) v += u; }
  return v;
}
DEVI f32x4 mfma16(bf16x8 a, bf16x8 b, f32x4 c) { return __builtin_amdgcn_mfma_f32_16x16x32_bf16(a, b, c, 0, 0, 0); }
DEVI bf16x8 as_bf16x8(u32x4 v) { union { u32x4 u; bf16x8 b; } x; x.u = v; return x.b; }

DEVI u32x4 scale8(u32x4 v, float s) {
  u32x4 o;
  o.x = cvt_pk(bflo(v.x) * s, bfhi(v.x) * s); o.y = cvt_pk(bflo(v.y) * s, bfhi(v.y) * s);
  o.z = cvt_pk(bflo(v.z) * s, bfhi(v.z) * s); o.w = cvt_pk(bflo(v.w) * s, bfhi(v.w) * s);
  return o;
}
DEVI int tid_opq() { int t; asm volatile("v_mov_b32 %0, %1" : "=v"(t) : "v"((int)(threadIdx.x & 255))); return t; }
DEVI int half_id() { return __builtin_amdgcn_readfirstlane((int)(threadIdx.x >> 8)); }
#define VB (blockIdx.x * 2 + half_id())
#define VG (gridDim.x * 2)
DEVI int ufy(int v) { return __builtin_amdgcn_readfirstlane(v); }

NOINL void prep_phase(const Params& P, int wl, bool full) {
  unsigned char* const smh = smem + half_id() * HSTR;
  float* tile = (float*)smh;
  const int t = tid_opq();
  constexpr int I_IN = 46 * 16, I_OUT = 16 * 16, I_FI = 88 * 16, I_FO = 16 * 44, I_L = I_IN + I_OUT + I_FI + I_FO;
  constexpr int I_MOD = 2 * 16 * 24;
  const int total = I_L + (full ? I_MOD + 1 : 0);
  for (int it = VB; it < total; it += VG) {
    if (it < I_L) {
      const int l = wl; int r = it;
      const float* W; bf16_t* Wt; int K, N, kind, nt_, kt_;
      if (r < I_IN) { kind = 0; W = P.w_in + (size_t)l * 1024 * 2832; N = 2832; K = 1024; Wt = (bf16_t*)(P.ws + OFF_WIN); nt_ = r / 16; kt_ = r % 16; }
      else if (r < I_IN + I_OUT) { r -= I_IN; kind = 1; W = P.w_out + (size_t)l * 1024 * 1024; N = 1024; K = 1024; Wt = (bf16_t*)(P.ws + OFF_WOUT); nt_ = r / 16; kt_ = r % 16; }
      else if (r < I_IN + I_OUT + I_FI) { r -= I_IN + I_OUT; kind = 2; W = P.w_ffn_in + (size_t)l * 1024 * 5632; N = 5632; K = 1024; Wt = (bf16_t*)(P.ws + OFF_WFI); nt_ = r / 16; kt_ = r % 16; }
      else { r -= I_IN + I_OUT + I_FI; kind = 3; W = P.w_ffn_out + (size_t)l * 2816 * 1024; N = 1024; K = 2816; Wt = (bf16_t*)(P.ws + OFF_WFO); nt_ = r / 44; kt_ = r % 44; }
      {
        const int n4 = (t & 15) * 4, np = nt_ * 64 + n4;
        int col;
        if (kind == 0) col = np < 2832 ? np : -1;
        else if (kind == 2) { const int w_ = np & 255;
          col = ((w_ >> 4) & 1) * 2816 + (np >> 8) * 128 + ((w_ >> 5) & 3) * 32 + ((w_ >> 2) & 3) * 8 + (w_ >> 7) * 4 + (w_ & 3); }
        else col = np;
#pragma unroll
        for (int i = 0; i < 4; ++i) {
          const int kk = i * 16 + (t >> 4);
          f32x4 v = (f32x4){0.f, 0.f, 0.f, 0.f};
          const int ksrc = kind == 1 ? ((kt_ * 64 + kk + 512) & 1023) : (kt_ * 64 + kk);
          if (col >= 0) v = *(const f32x4*)(W + (size_t)ksrc * N + col);
          tile[kk * 65 + n4] = v[0]; tile[kk * 65 + n4 + 1] = v[1]; tile[kk * 65 + n4 + 2] = v[2]; tile[kk * 65 + n4 + 3] = v[3];
        }
      }
      __syncthreads();
      {
        const int n = t >> 2, kc = (t & 3) * 16;
        u32x4 o0, o1;
        o0.x = cvt_pk(tile[(kc + 0) * 65 + n], tile[(kc + 1) * 65 + n]); o0.y = cvt_pk(tile[(kc + 2) * 65 + n], tile[(kc + 3) * 65 + n]);
        o0.z = cvt_pk(tile[(kc + 4) * 65 + n], tile[(kc + 5) * 65 + n]); o0.w = cvt_pk(tile[(kc + 6) * 65 + n], tile[(kc + 7) * 65 + n]);
        o1.x = cvt_pk(tile[(kc + 8) * 65 + n], tile[(kc + 9) * 65 + n]); o1.y = cvt_pk(tile[(kc + 10) * 65 + n], tile[(kc + 11) * 65 + n]);
        o1.z = cvt_pk(tile[(kc + 12) * 65 + n], tile[(kc + 13) * 65 + n]); o1.w = cvt_pk(tile[(kc + 14) * 65 + n], tile[(kc + 15) * 65 + n]);
        bf16_t* dst = Wt + (size_t)(nt_ * 64 + n) * K + kt_ * 64 + kc;
        *(u32x4*)dst = o0; *(u32x4*)(dst + 8) = o1;
      }
      __syncthreads();
    } else if (it < I_L + I_MOD) {
      const int m = it - I_L; const int l = m / 384, rem = m % 384, kc = rem / 24, cb = rem % 24;
      float* sv = (float*)smh;
      for (int e = t; e < 320; e += 256) { const int r = e >> 6, k = kc * 64 + (e & 63); const float v = r < 4 ? P.c[r * 1024 + k] : P.c_ctx[k]; sv[e] = v / (1.f + __expf(-v)); }
      __syncthreads();
      const int n = cb * 256 + t;
      float a0 = 0.f, a1 = 0.f, a2 = 0.f, a3 = 0.f, a4 = 0.f;
      const float* wp = P.w_mod + ((size_t)l * 1024 + kc * 64) * 6144 + n;
#pragma unroll 8
      for (int kk = 0; kk < 64; ++kk) { const float w = wp[(size_t)kk * 6144]; a0 += sv[kk] * w; a1 += sv[64 + kk] * w; a2 += sv[128 + kk] * w; a3 += sv[192 + kk] * w; a4 += sv[256 + kk] * w; }
      if (kc == 0) { const float bb = P.b_mod[l * 6144 + n]; a0 += bb; a1 += bb; a2 += bb; a3 += bb; a4 += bb; }
      float* md = (float*)(P.ws + OFF_MODS) + (size_t)l * 5 * 6144 + n;
      atomicAdd(md, a0); atomicAdd(md + 6144, a1); atomicAdd(md + 2 * 6144, a2); atomicAdd(md + 3 * 6144, a3); atomicAdd(md + 4 * 6144, a4);
      __syncthreads();
    } else {
      float* rc = (float*)(P.ws + OFF_ROPE);
      for (int e = t; e < 1024; e += 256) { const int pos = e >> 4, i = e & 15; const float inv = __builtin_amdgcn_exp2f(-(float)i * (13.287712379549449f / 16.f)); float xr = (float)pos * inv * 0.15915494309189535f; xr -= floorf(xr); rc[e] = __builtin_amdgcn_cosf(xr); rc[1024 + e] = __builtin_amdgcn_sinf(xr); }
    }
  }
}

NOINL void norm_phase(const Params& P, int layer, int which) {
  const float* src_lat = (layer == 0 && which == 0) ? P.x : P.out; const float* src_ctx = (layer == 0 && which == 0) ? P.ctx : (const float*)(P.ws + OFF_XC);
  const int M = (which == 0 || layer == 0) ? TT : T;
  const int t_ = tid_opq(); const int lane = t_ & 63, wv = t_ >> 6;
  const int gw = VB * 4 + wv, nw = VG * 4;
  const float* g = (which == 0 ? P.g_mix : P.g_ffn) + layer * 1024;
  bf16_t* H = (bf16_t*)(P.ws + OFF_H);
  float* ssq = (float*)(P.ws + OFF_SSQ);
  for (int row = gw; row < M; row += nw) {
    const float* xr = row < T ? src_lat + (size_t)row * 1024 : src_ctx + (size_t)(row - T) * 1024;
    const int mr = row < T ? (row >> 12) : 4;
    const float* md = (const float*)(P.ws + OFF_MODS) + (size_t)(layer * 5 + mr) * 6144 + which * 3072;
    f32x4 v[4]; float s = 0.f;
#pragma unroll
    for (int j = 0; j < 4; ++j) { v[j] = *(const f32x4*)(xr + 4 * (lane + 64 * j)); s += v[j][0] * v[j][0] + v[j][1] * v[j][1] + v[j][2] * v[j][2] + v[j][3] * v[j][3]; }
    s = wave_sum(s);
    const float rstd = rsqrtf(s * (1.f / 1024.f) + EPSN);
    f32x4 ggv[4], shv[4], scv[4];
#pragma unroll
    for (int j = 0; j < 4; ++j) { const int k = 4 * (lane + 64 * j); ggv[j] = *(const f32x4*)(g + k); shv[j] = *(const f32x4*)(md + k); scv[j] = *(const f32x4*)(md + 1024 + k); }
#pragma unroll
    for (int j = 0; j < 4; ++j) {
      const int k = 4 * (lane + 64 * j);
      const f32x4 gg = ggv[j], sh = shv[j], sc = scv[j];
      f32x4 h;
#pragma unroll
      for (int e = 0; e < 4; ++e) h[e] = v[j][e] * rstd * gg[e] * (1.f + sc[e]) + sh[e];
      u32x2 o; o.x = cvt_pk(h[0], h[1]); o.y = cvt_pk(h[2], h[3]);
      *(u32x2*)(H + (size_t)row * 1024 + k) = o;
    }
    if (which == 0 && lane == 0) ssq[row] = 0.f;
  }
}

NOINL void final_norm_phase(const Params& P) {
  const int t_ = tid_opq(); const int lane = t_ & 63, wv = t_ >> 6;
  const int gw = VB * 4 + wv, nw = VG * 4;
  for (int row = gw; row < T; row += nw) {
    float* xr = P.out + (size_t)row * 1024;
    f32x4 v[4]; float s = 0.f;
#pragma unroll
    for (int j = 0; j < 4; ++j) { v[j] = *(const f32x4*)(xr + 4 * (lane + 64 * j)); s += v[j][0] * v[j][0] + v[j][1] * v[j][1] + v[j][2] * v[j][2] + v[j][3] * v[j][3]; }
    s = wave_sum(s);
    const float rstd = rsqrtf(s * (1.f / 1024.f) + EPSN);
#pragma unroll
    for (int j = 0; j < 4; ++j) {
      const int k = 4 * (lane + 64 * j);
      const f32x4 gg = *(const f32x4*)(P.g_final + k);
      f32x4 h;
#pragma unroll
      for (int e = 0; e < 4; ++e) h[e] = v[j][e] * rstd * gg[e];
      *(f32x4*)(xr + k) = h;
    }
  }
}

namespace pg8 {
#define PG8_LAS __attribute__((address_space(3)))
typedef unsigned short bf16_t;
typedef short bf16x8 __attribute__((ext_vector_type(8)));
typedef float f32x4 __attribute__((ext_vector_type(4)));
typedef unsigned u32x4 __attribute__((ext_vector_type(4)));
constexpr int BM = 256, BK = 64, HALF = 128, HTB = HALF * BK * 2  , STAGE_BYTES = 8 * HTB, NXCD = 8, WGM = 8;

__host__ __device__ __forceinline__ int lds_byte(int r, int c) { const int st = (r >> 4) * 2 + (c >> 5), rr = r & 15, cc = c & 31, ob = rr * 64 + cc * 2; return st * 1024 + (ob ^ (((ob >> 9) & 1) << 5)); }
__host__ __device__ __forceinline__ void stage_rc(int b, int& R, int& C) { const int st = b / 1024, sb = b % 1024, swz = sb ^ (((sb >> 9) & 1) << 5); R = (st >> 1) * 16 + swz / 64; C = (st & 1) * 32 + (swz % 64) / 2; }
__host__ __device__ __forceinline__ int perm32(int rho) { const int n = rho >> 4, i = rho & 15; return 8 * (i >> 2) + 4 * n + (i & 3); }

struct Unit { int pm, pn; };
struct Gemm { const bf16_t* A; const bf16_t* Bt; int M, N, K; };

struct StaticOrder {
    int nM, nN, nwg, G, c;
    __host__ __device__ void init(int M, int N, int G_, int c_) { nM = M / BM; nN = N / BM; nwg = nM * nN; G = G_; c = c_; }
    __host__ __device__ bool next(int i, Unit& u) const {
        const long L = (long)i * G + c; if (L >= nwg) return false;
        int wgid = (int)L; { const int q = nwg / NXCD, r = nwg % NXCD, xcd = wgid % NXCD, off = wgid / NXCD; wgid = (xcd < r ? xcd * (q + 1) : r * (q + 1) + (xcd - r) * q) + off; }
        const int nig = WGM * nN, gid = wgid / nig, fm = gid * WGM, gsz = (nM - fm) < WGM ? (nM - fm) : WGM;
        u.pm = fm + ((wgid % nig) % gsz); u.pn = (wgid % nig) / gsz; return true;
    }
    __device__ __forceinline__ void a_ready(const Unit&) const {}
    __device__ __forceinline__ void done(const Unit&) const {}
};

template <class Epi, class Sched, bool ALIGN_EPI = false, bool SP2 = false>
__device__ __forceinline__ void gemm_phase(PG8_LAS unsigned char* lds, const Gemm g, const Sched& S, const Epi& E) {
    int tid_; asm volatile("v_mov_b32 %0, %1" : "=v"(tid_) : "v"((int)threadIdx.x)); const int tid = tid_, wid = __builtin_amdgcn_readfirstlane(tid >> 6), lane = tid & 63, wr = wid >> 2, wc = wid & 3, fr = lane & 15, fq = lane >> 4;
    const int K = g.K, nt = K / BK;
    unsigned voffA[2], voffB[2];
#pragma unroll
    for (int i = 0; i < 2; ++i) { int R, C; stage_rc(tid * 16 + i * 8192, R, C); const int Rb = Epi::PERM ? ((R & ~31) + perm32(R & 31)) : R;
        voffA[i] = (unsigned)(R * K + C) * 2u; voffB[i] = (unsigned)(Rb * K + C) * 2u; }
    const size_t kstep = (size_t)(BK * 2);
    const size_t hstep = (size_t)HALF * K * 2;
    const size_t tstep = 2 * hstep;
    const unsigned ldsw = (unsigned)wid * 1024u;
    const int aoff = lds_byte(wr * 64 + fr, fq * 8), boff = lds_byte(wc * 32 + fr, fq * 8);
#define PG8_SA(b, h) (((b) * 2 + (h)) * HTB)
#define PG8_SB(b, h) ((4 + (b) * 2 + (h)) * HTB)
#define PG8_STAGE(bufoff, gbase, voff) do { _Pragma("unroll") for (int _i = 0; _i < 2; ++_i) \
        __builtin_amdgcn_global_load_lds((const unsigned*)((const char*)(gbase) + (voff)[_i]), (PG8_LAS unsigned*)(lds + (bufoff) + ldsw + _i * 8192), 16, 0, 0); } while (0)
#define PG8_LDA(dst, b, h) do { _Pragma("unroll") for (int m = 0; m < 4; ++m) _Pragma("unroll") for (int k = 0; k < 2; ++k) dst[m][k] = *(const PG8_LAS bf16x8*)(lds + PG8_SA(b, h) + aoff + m * 2048 + k * 1024); } while (0)
#define PG8_LDB(dst, b, h) do { _Pragma("unroll") for (int n = 0; n < 2; ++n) _Pragma("unroll") for (int k = 0; k < 2; ++k) dst[n][k] = *(const PG8_LAS bf16x8*)(lds + PG8_SB(b, h) + boff + n * 2048 + k * 1024); } while (0)
#define PG8_MMA(ai, bj, At, Bt) do { __builtin_amdgcn_s_setprio(1); _Pragma("unroll") for (int m = 0; m < 4; ++m) _Pragma("unroll") for (int n = 0; n < 2; ++n) _Pragma("unroll") for (int k = 0; k < 2; ++k) \
        acc[ai][bj][m][n] = __builtin_amdgcn_mfma_f32_16x16x32_bf16(Bt[n][k], At[m][k], acc[ai][bj][m][n], 0, 0, 0); __builtin_amdgcn_s_setprio(0); } while (0)
#define PG8_WAIT_V(n) asm volatile("s_waitcnt vmcnt(" #n ")" ::: "memory")
#define PG8_WAIT_L(n) asm volatile("s_waitcnt lgkmcnt(" #n ")" ::: "memory")
#define PG8_BAR __builtin_amdgcn_s_barrier()
#define PG8_SCHED __builtin_amdgcn_sched_barrier(0)
    Unit cur, nxt; int ui = 0;
    if (!S.next(0, cur)) return;
    f32x4 acc[2][2][4][2];
#pragma unroll
    for (int a = 0; a < 2; ++a)
#pragma unroll
        for (int b = 0; b < 2; ++b)
#pragma unroll
            for (int m = 0; m < 4; ++m)
#pragma unroll
                for (int n = 0; n < 2; ++n) acc[a][b][m][n] = (f32x4){0.f, 0.f, 0.f, 0.f};
    bf16x8 At[4][2], B0[2][2], B1[2][2];
    const char* cA = (const char*)g.A + (size_t)cur.pm * tstep; const char* cB = (const char*)g.Bt + (size_t)cur.pn * tstep;
    S.a_ready(cur);
    if constexpr (SP2) {
        PG8_STAGE(PG8_SB(0, 0), cB, voffB); PG8_STAGE(PG8_SB(0, 1), cB + hstep, voffB); PG8_STAGE(PG8_SA(0, 0), cA, voffA); PG8_STAGE(PG8_SA(0, 1), cA + hstep, voffA);
        if (wr == 1) PG8_BAR;
        PG8_WAIT_V(2); PG8_BAR;
        PG8_STAGE(PG8_SB(1, 0), cB + kstep, voffB); PG8_STAGE(PG8_SA(1, 0), cA + kstep, voffA); PG8_STAGE(PG8_SB(1, 1), cB + hstep + kstep, voffB);
        PG8_WAIT_V(6); PG8_BAR;
    } else {
        PG8_STAGE(PG8_SB(0, 0), cB, voffB); PG8_STAGE(PG8_SA(0, 0), cA, voffA); PG8_STAGE(PG8_SB(0, 1), cB + hstep, voffB); PG8_STAGE(PG8_SA(0, 1), cA + hstep, voffA);
        if (wr == 1) PG8_BAR;
        PG8_WAIT_V(4); PG8_BAR;
        PG8_STAGE(PG8_SB(1, 0), cB + kstep, voffB); PG8_STAGE(PG8_SA(1, 0), cA + kstep, voffA); PG8_STAGE(PG8_SB(1, 1), cB + hstep + kstep, voffB);
        PG8_WAIT_V(6); PG8_BAR;
    }
    for (;;) {
        const bool has_next = S.next(ui + 1, nxt);
        const char* nA = has_next ? (const char*)g.A + (size_t)nxt.pm * tstep : cA; const char* nB = has_next ? (const char*)g.Bt + (size_t)nxt.pn * tstep : cB;
        for (int t = 0; t < nt; t += 2) {
            if constexpr (Epi::MIDSCALE) { if (t == 8) E.midscale(acc, cur, wr, fr); }
            const bool last = (t == nt - 2);
            const char* a1 = cA + (size_t)(t + 1) * kstep;
            const char* a2 = last ? nA : cA + (size_t)(t + 2) * kstep; const char* b2 = last ? nB : cB + (size_t)(t + 2) * kstep;
            const char* a3 = a2 + kstep; const char* b3 = b2 + kstep;
            if (last && has_next) S.a_ready(nxt);
            if constexpr (SP2) {
            PG8_LDB(B0, 0, 0); PG8_LDB(B1, 0, 1); PG8_SCHED; PG8_LDA(At, 0, 0); PG8_STAGE(PG8_SA(1, 1), a1 + hstep, voffA);
            PG8_WAIT_V(8); PG8_WAIT_L(0); PG8_BAR; PG8_MMA(0, 0, At, B0); PG8_MMA(0, 1, At, B1); PG8_BAR; PG8_SCHED;
            PG8_LDA(At, 0, 1); PG8_STAGE(PG8_SB(0, 0), b2, voffB); PG8_STAGE(PG8_SB(0, 1), b2 + hstep, voffB); PG8_STAGE(PG8_SA(0, 0), a2, voffA);
            PG8_WAIT_V(8); PG8_WAIT_L(0); PG8_BAR; PG8_MMA(1, 0, At, B0); PG8_MMA(1, 1, At, B1); PG8_BAR; PG8_SCHED;
            PG8_LDB(B0, 1, 0); PG8_LDB(B1, 1, 1); PG8_SCHED; PG8_LDA(At, 1, 0); PG8_STAGE(PG8_SA(0, 1), a2 + hstep, voffA);
            PG8_WAIT_V(8); PG8_WAIT_L(0); PG8_BAR; PG8_MMA(0, 0, At, B0); PG8_MMA(0, 1, At, B1); PG8_BAR; PG8_SCHED;
            PG8_LDA(At, 1, 1); PG8_STAGE(PG8_SB(1, 0), b3, voffB); PG8_STAGE(PG8_SB(1, 1), b3 + hstep, voffB); PG8_STAGE(PG8_SA(1, 0), a3, voffA);
            PG8_WAIT_V(8); PG8_WAIT_L(0); PG8_BAR; PG8_MMA(1, 0, At, B0); PG8_MMA(1, 1, At, B1); PG8_BAR; PG8_SCHED;
            } else {
            PG8_LDB(B0, 0, 0); PG8_SCHED; PG8_LDA(At, 0, 0); PG8_STAGE(PG8_SA(1, 1), a1 + hstep, voffA);
            PG8_WAIT_L(8); PG8_BAR; PG8_WAIT_L(0); PG8_MMA(0, 0, At, B0); PG8_BAR; PG8_SCHED;
            PG8_LDB(B1, 0, 1); PG8_STAGE(PG8_SB(0, 0), b2, voffB);
            PG8_BAR; PG8_WAIT_L(0); PG8_MMA(0, 1, At, B1); PG8_BAR;
            PG8_LDA(At, 0, 1); PG8_STAGE(PG8_SA(0, 0), a2, voffA);
            PG8_BAR; PG8_WAIT_L(0); PG8_MMA(1, 0, At, B0); PG8_BAR; PG8_SCHED;
            PG8_STAGE(PG8_SB(0, 1), b2 + hstep, voffB);
            PG8_WAIT_V(6); PG8_BAR; PG8_MMA(1, 1, At, B1); PG8_BAR;
            PG8_LDB(B0, 1, 0); PG8_SCHED; PG8_LDA(At, 1, 0); PG8_STAGE(PG8_SA(0, 1), a2 + hstep, voffA);
            PG8_WAIT_L(8); PG8_BAR; PG8_WAIT_L(0); PG8_MMA(0, 0, At, B0); PG8_BAR; PG8_SCHED;
            PG8_LDB(B1, 1, 1); PG8_STAGE(PG8_SB(1, 0), b3, voffB);
            PG8_BAR; PG8_WAIT_L(0); PG8_MMA(0, 1, At, B1); PG8_BAR;
            PG8_LDA(At, 1, 1); PG8_STAGE(PG8_SA(1, 0), a3, voffA);
            PG8_BAR; PG8_WAIT_L(0); PG8_MMA(1, 0, At, B0); PG8_BAR; PG8_SCHED;
            PG8_STAGE(PG8_SB(1, 1), b3 + hstep, voffB);
            PG8_WAIT_V(6); PG8_BAR; PG8_MMA(1, 1, At, B1); PG8_BAR;
            }
        }
        if constexpr (ALIGN_EPI) { if (wr == 0) PG8_BAR; }
        if constexpr (!Epi::AFTER_DRAIN) { E(acc, cur, wr, wc, fr, fq); S.done(cur); }
        if (!has_next) break;
#pragma unroll
        for (int a = 0; a < 2; ++a)
#pragma unroll
            for (int b = 0; b < 2; ++b)
#pragma unroll
                for (int m = 0; m < 4; ++m)
#pragma unroll
                    for (int n = 0; n < 2; ++n) acc[a][b][m][n] = (f32x4){0.f, 0.f, 0.f, 0.f};
        cur = nxt; cA = nA; cB = nB; ++ui;
        if constexpr (ALIGN_EPI) { if (wr == 1) PG8_BAR; }
    }
    PG8_WAIT_V(0);
    if constexpr (!ALIGN_EPI) { if (wr == 0) PG8_BAR; }
    PG8_BAR;
    if constexpr (Epi::AFTER_DRAIN) { E.fused(acc, cur, wr, wc, fr, fq, lds, wid, lane); S.done(cur); }
#undef PG8_SA
#undef PG8_SB
#undef PG8_STAGE
#undef PG8_LDA
#undef PG8_LDB
#undef PG8_MMA
#undef PG8_WAIT_V
#undef PG8_WAIT_L
#undef PG8_BAR
#undef PG8_SCHED
}
}

struct EpiInProj {
  static constexpr bool PERM = false, AFTER_DRAIN = false, MIDSCALE = false;
  unsigned char* ws;
  DEVI void operator()(const f32x4 (&acc)[2][2][4][2], const pg8::Unit& u, int wr, int wc, int fr, int fq) const {
    bf16_t* PROJ = (bf16_t*)(ws + OFF_PROJ); bf16_t* VT = (bf16_t*)(ws + OFF_VT); const float* rc = (const float*)(ws + OFF_ROPE);
    const int rowb = u.pm * 256 + wr * 64 + fr;
#pragma unroll
    for (int bj = 0; bj < 2; ++bj) {
      const int cb = u.pn * 256 + bj * 128;
      const bool isv = (cb == 1152) || (cb == 1536) || (cb == 1664);
      const bool do_rope = (cb < 256) || (cb == 1024);
      const float qs = cb < 512 ? 0.125f : 1.f;
      const int vchb = (cb == 1152 ? 0 : 128 + (cb - 1536)) + 32 * wc + 4 * fq;
#pragma unroll
      for (int ai = 0; ai < 2; ++ai)
#pragma unroll
        for (int m = 0; m < 4; ++m) {
          const int row = rowb + 128 * ai + 16 * m;
          f32x4 v0 = acc[ai][bj][m][0], v1 = acc[ai][bj][m][1];
          if (isv) {
#pragma unroll
            for (int e = 0; e < 4; ++e) { VT[(unsigned)((vchb + e) * TT + row)] = (bf16_t)(cvt_pk(v0[e], 0.f) & 0xffffu); VT[(unsigned)((vchb + 16 + e) * TT + row)] = (bf16_t)(cvt_pk(v1[e], 0.f) & 0xffffu); }
          } else {
            if (do_rope && row < T) {
              const int pos = row & 4095, pp = (wc & 1) ? (pos & 63) : (pos >> 6);
              const f32x4 cs = *(const f32x4*)(rc + pp * 16 + 4 * fq), sn = *(const f32x4*)(rc + 1024 + pp * 16 + 4 * fq);
#pragma unroll
              for (int e = 0; e < 4; ++e) { const float x1 = v0[e], x2 = v1[e]; v0[e] = x1 * cs[e] - x2 * sn[e]; v1[e] = x2 * cs[e] + x1 * sn[e]; }
            }
            u32x2 o0, o1; o0.x = cvt_pk(v0[0] * qs, v0[1] * qs); o0.y = cvt_pk(v0[2] * qs, v0[3] * qs); o1.x = cvt_pk(v1[0] * qs, v1[1] * qs); o1.y = cvt_pk(v1[2] * qs, v1[3] * qs);
            bf16_t* dst = PROJ + (unsigned)(row * PW + cb + 32 * wc + 4 * fq);
            *(u32x2*)dst = o0; *(u32x2*)(dst + 16) = o1;
          }
        }
    }
  }
};
struct EpiSwiglu {
  static constexpr bool PERM = false, AFTER_DRAIN = false, MIDSCALE = false;
  unsigned char* ws;
  DEVI void operator()(const f32x4 (&acc)[2][2][4][2], const pg8::Unit& u, int wr, int wc, int fr, int fq) const {
    bf16_t* G = (bf16_t*)(ws + OFF_PROJ);
    const int rowb = u.pm * 256 + wr * 64 + fr;
#pragma unroll
    for (int ai = 0; ai < 2; ++ai)
#pragma unroll
      for (int m = 0; m < 4; ++m) {
        const int row = rowb + 128 * ai + 16 * m;
        float o0[4], o1[4];
#pragma unroll
        for (int e = 0; e < 4; ++e) { o0[e] = silu_f(acc[ai][0][m][0][e]) * acc[ai][0][m][1][e]; o1[e] = silu_f(acc[ai][1][m][0][e]) * acc[ai][1][m][1][e]; }
        u32x4 ov; ov.x = cvt_pk(o0[0], o0[1]); ov.y = cvt_pk(o0[2], o0[3]); ov.z = cvt_pk(o1[0], o1[1]); ov.w = cvt_pk(o1[2], o1[3]);
        *(u32x4*)(G + (unsigned)(row * 2816 + u.pn * 128 + wc * 32 + 8 * fq)) = ov;
      }
  }
};
template <bool MID>
struct EpiResid {
  static constexpr bool PERM = false, AFTER_DRAIN = false, MIDSCALE = MID;
  unsigned char* ws; const float* rin_lat; const float* rin_ctx; float* rout_lat; float* rout_ctx; int layer, gate_idx;
  DEVI void midscale(f32x4 (&acc)[2][2][4][2], const pg8::Unit& u, int wr, int fr) const {
    const float* ssq = (const float*)(ws + OFF_SSQ) + u.pm * 256 + wr * 64 + fr;
    float sq[8];
#pragma unroll
    for (int k = 0; k < 8; ++k) sq[k] = ssq[128 * (k >> 2) + 16 * (k & 3)];
#pragma unroll
    for (int ai = 0; ai < 2; ++ai)
#pragma unroll
      for (int m = 0; m < 4; ++m) {
        const float rs = rsqrtf(sq[ai * 4 + m] * (1.f / 512.f) + EPSN);
#pragma unroll
        for (int bj = 0; bj < 2; ++bj) { acc[ai][bj][m][0] = acc[ai][bj][m][0] * rs; acc[ai][bj][m][1] = acc[ai][bj][m][1] * rs; }
      }
  }
  DEVI void operator()(const f32x4 (&acc)[2][2][4][2], const pg8::Unit& u, int wr, int wc, int fr, int fq) const {
    const bool lat = u.pm < T / 256;
    const int mr = lat ? (u.pm >> 4) : 4;
    const float* gpb = (const float*)(ws + OFF_MODS) + (size_t)(layer * 5 + mr) * 6144 + gate_idx * 1024;
    const float* rinb = lat ? rin_lat : rin_ctx; float* routb = lat ? rout_lat : rout_ctx;
    const int col0 = u.pn * 256 + wc * 32 + 4 * fq;
    const unsigned off0 = (unsigned)(((lat ? u.pm : u.pm - T / 256) * 256 + wr * 64 + fr) * 1024 + col0);
#pragma unroll
    for (int bj = 0; bj < 2; ++bj)
#pragma unroll
      for (int n = 0; n < 2; ++n) {
        const f32x4 gv = *(const f32x4*)(gpb + col0 + 128 * bj + 16 * n);
        f32x4 rv[8];
#pragma unroll
        for (int k = 0; k < 8; ++k) rv[k] = *(const f32x4*)(rinb + off0 + (unsigned)((128 * (k >> 2) + 16 * (k & 3)) * 1024 + 128 * bj + 16 * n));
#pragma unroll
        for (int ai = 0; ai < 2; ++ai)
#pragma unroll
          for (int m = 0; m < 4; ++m) {
            const unsigned off = off0 + (unsigned)((128 * ai + 16 * m) * 1024 + 128 * bj + 16 * n);
            f32x4 o;
#pragma unroll
            for (int e = 0; e < 4; ++e) o[e] = rv[ai * 4 + m][e] + gv[e] * acc[ai][bj][m][n][e];
            *(f32x4*)(routb + off) = o;
          }
      }
  }
};
constexpr int MODE_INPROJ = 0, MODE_RESID = 1, MODE_SWIGLU = 2;
template <int MODE, bool ASCALE>
DEVI void gemm_phase(const Params& P, int layer) {
  constexpr int K = (MODE == MODE_RESID && !ASCALE) ? 2816 : 1024;
  constexpr int N = MODE == MODE_INPROJ ? 2816 : (MODE == MODE_SWIGLU ? 5632 : 1024);
  const int M = (MODE == MODE_INPROJ || (layer == 0 && MODE != MODE_RESID)) ? TT : T;
  const bf16_t* A = (const bf16_t*)(P.ws + ((MODE == MODE_RESID && !ASCALE) ? OFF_PROJ : OFF_H));
  const bf16_t* Wt = (const bf16_t*)(P.ws + (MODE == MODE_INPROJ ? OFF_WIN : MODE == MODE_SWIGLU ? OFF_WFI : ASCALE ? OFF_WOUT : OFF_WFO));
  pg8::Gemm g{A, Wt, M, N, K}; pg8::StaticOrder S; S.init(M, N, (int)gridDim.x, (int)blockIdx.x);
  PG8_LAS unsigned char* lds = (PG8_LAS unsigned char*)smem;
  if constexpr (MODE == MODE_INPROJ) {
    EpiInProj E{P.ws};
    pg8::gemm_phase<EpiInProj, pg8::StaticOrder, true, true>(lds, g, S, E);
    const int lane = threadIdx.x & 63, r = lane & 15, q = lane >> 4;
    const bf16_t* Wd = Wt + (size_t)(2816 + r) * 1024 + 8 * q;
    float* DTb = (float*)(P.ws + OFF_DT);
    for (int tile = blockIdx.x * 8 + (threadIdx.x >> 6); tile < TT / 16; tile += gridDim.x * 8) {
      const bf16_t* Ar = A + (size_t)(16 * tile + r) * 1024 + 8 * q;
      f32x4 acc = (f32x4){0.f, 0.f, 0.f, 0.f};
#pragma unroll 8
      for (int s2 = 0; s2 < 32; ++s2) acc = mfma16(*(const bf16x8*)(Ar + 32 * s2), *(const bf16x8*)(Wd + 32 * s2), acc);
#pragma unroll
      for (int e = 0; e < 4; ++e) DTb[(size_t)(16 * tile + 4 * q + e) * 16 + r] = acc[e];
    }
  } else if constexpr (MODE == MODE_SWIGLU) {
    EpiSwiglu E{P.ws};
    pg8::gemm_phase<EpiSwiglu, pg8::StaticOrder, true, true>(lds, g, S, E);
  } else {
    float* XCp = (float*)(P.ws + OFF_XC);
    EpiResid<ASCALE> E{P.ws, (ASCALE && layer == 0) ? P.x : P.out, (ASCALE && layer == 0) ? P.ctx : XCp, P.out, XCp, layer, ASCALE ? 2 : 5};
    pg8::gemm_phase<EpiResid<ASCALE>, pg8::StaticOrder, true, true>(lds, g, S, E);
    if (layer == 0) {
      const int lane = threadIdx.x & 63, r = lane & 15, q = lane >> 4, w8 = threadIdx.x >> 6;
      const float* gpb = (const float*)(P.ws + OFF_MODS) + (size_t)(layer * 5 + 4) * 6144 + (ASCALE ? 2 : 5) * 1024;
      const float* rinb = ASCALE ? P.ctx : XCp;
      const float* ssq = (const float*)(P.ws + OFF_SSQ) + T;
      constexpr int PER = K / 32 / 8;
      float* part = (float*)smem;
      for (int tl = blockIdx.x; tl < 256; tl += gridDim.x) {
        const int r0 = (tl >> 4) * 64, n0 = (tl & 15) * 64;
        const bf16_t* Ar = A + (size_t)(T + r0 + r) * K + w8 * PER * 32 + 8 * q;
        const bf16_t* Br = Wt + (size_t)(n0 + r) * K + w8 * PER * 32 + 8 * q;
        f32x4 acc[4][4];
#pragma unroll
        for (int i = 0; i < 4; ++i)
#pragma unroll
          for (int j = 0; j < 4; ++j) acc[i][j] = (f32x4){0.f, 0.f, 0.f, 0.f};
#pragma unroll 2
        for (int s2 = 0; s2 < PER; ++s2) {
          bf16x8 af[4], bfr[4];
#pragma unroll
          for (int i = 0; i < 4; ++i) { af[i] = *(const bf16x8*)(Ar + (size_t)(16 * i) * K + 32 * s2); bfr[i] = *(const bf16x8*)(Br + (size_t)(16 * i) * K + 32 * s2); }
#pragma unroll
          for (int i = 0; i < 4; ++i)
#pragma unroll
            for (int j = 0; j < 4; ++j) acc[i][j] = mfma16(af[i], bfr[j], acc[i][j]);
        }
        const bool sc = ASCALE && w8 < 4;
        float sqv[16];
#pragma unroll
        for (int k = 0; k < 16; ++k) sqv[k] = ssq[r0 + 16 * (k >> 2) + 4 * q + (k & 3)];
#pragma unroll
        for (int i = 0; i < 4; ++i)
#pragma unroll
          for (int e = 0; e < 4; ++e) {
            const float rs = sc ? rsqrtf(sqv[i * 4 + e] * (1.f / 512.f) + EPSN) : 1.f;
#pragma unroll
            for (int j = 0; j < 4; ++j) part[w8 * 4096 + (16 * i + 4 * q + e) * 64 + 16 * j + r] = acc[i][j][e] * rs;
          }
        __syncthreads();
        float rres[8], gres[8];
#pragma unroll
        for (int k = 0; k < 8; ++k) { const int o = (int)threadIdx.x + 512 * k; rres[k] = rinb[(unsigned)((r0 + (o >> 6)) * 1024 + n0 + (o & 63))]; gres[k] = gpb[n0 + (o & 63)]; }
#pragma unroll
        for (int k = 0; k < 8; ++k) {
          const int o = (int)threadIdx.x + 512 * k, row = o >> 6, col = o & 63;
          float sum = 0.f;
#pragma unroll
          for (int pw = 0; pw < 8; ++pw) sum += part[pw * 4096 + o];
          XCp[(unsigned)((r0 + row) * 1024 + n0 + col)] = rres[k] + gres[k] * sum;
        }
        __syncthreads();
      }
    }
  }
}

template <int KIND>
NOINL void attn_item(const Params& P, int layer, int b, int i1, int i2, int isctx_) {
  unsigned char* const smh = smem + half_id() * HSTR;
  const bool isctx = isctx_ != 0;
  constexpr int NQT = (KIND == 1) ? 1 : 2;
  const int t = tid_opq(), lane = t & 63, w = t >> 6, r = lane & 15, q = lane >> 4, r7 = r & 7;
  const bf16_t* PROJ = (const bf16_t*)(P.ws + OFF_PROJ);
  const bf16_t* VT = (const bf16_t*)(P.ws + OFF_VT);
  bf16_t* MIX = (bf16_t*)(P.ws + OFF_H);
  constexpr bool DBL = (KIND == 1);
  constexpr int VSTR = DBL ? 272 : 136;
  unsigned char* Ks = smh; unsigned char* Vs = smh + (DBL ? 16384 : 8192); float* rpb = (float*)(smh + 33792);
  const int col0 = w == 0 ? 0 : (w == 1 ? 8 : (w == 2 ? 24 : 32));
  int qrow[NQT]; int qcol, kcol, vch, ocol, ntile; bool has_sink = false; float sinkv = 0.f;
  int r0g = 0;
  if (KIND == 0 && !isctx) {
    const int n = i1, head = i2;
#pragma unroll
    for (int qt = 0; qt < NQT; ++qt) qrow[qt] = b * 4096 + 128 * n + 32 * w + 16 * qt + r;
    qcol = head * 64; kcol = 1024 + (head >> 1) * 64; vch = (head >> 1) * 64; ocol = 512 + head * 64; ntile = 10; has_sink = true; sinkv = P.wa_sink[layer * 4 + head];
  } else if (KIND == 1) {
    const int gr = i1, h = i2;
    qrow[0] = b * 4096 + gr * 64 + 16 * w + r;
    qcol = 256 + 64 * h; kcol = 1280 + 64 * h; vch = 128 + 64 * h; ocol = 768 + 64 * h; ntile = 8;
    r0g = gr - 4 < 0 ? 0 : (gr - 4 > 56 ? 56 : gr - 4);
    __syncthreads();
    for (int e = t; e < 465; e += 256) rpb[e] = P.na_rpb[(size_t)(layer * 4 + h) * 465 + e];
  } else {
    const int qb = i1, hh = i2;
#pragma unroll
    for (int qt = 0; qt < NQT; ++qt) qrow[qt] = T + b * 256 + 128 * qb + 32 * w + 16 * qt + r;
    ntile = 4;
    if (hh < 4) { qcol = hh * 64; kcol = 1024 + (hh >> 1) * 64; vch = (hh >> 1) * 64; ocol = 512 + hh * 64; has_sink = true; sinkv = P.wa_sink[layer * 4 + hh]; }
    else { const int h = hh - 4; qcol = 256 + 64 * h; kcol = 1280 + 64 * h; vch = 128 + 64 * h; ocol = 768 + 64 * h; }
  }
  bf16x8 qf[NQT][2];
#pragma unroll
  for (int qt = 0; qt < NQT; ++qt)
#pragma unroll
    for (int s = 0; s < 2; ++s) qf[qt][s] = *(const bf16x8*)(PROJ + (size_t)qrow[qt] * PW + qcol + 32 * s + 8 * q);
  f32x4 o[4][NQT]; float mrun[NQT], lrun[NQT];
#pragma unroll
  for (int qt = 0; qt < NQT; ++qt) { mrun[qt] = -1e30f; lrun[qt] = 0.f;
#pragma unroll
    for (int dt = 0; dt < 4; ++dt) o[dt][qt] = (f32x4){0.f, 0.f, 0.f, 0.f}; }

  const int skip = (KIND == 0 && !isctx && i1 == 0) ? 2 : 0;
  const int nvalid = ntile - skip - ((KIND == 0 && !isctx && i1 == 31) ? 2 : 0);
  const int skey = t >> 2, sc0 = (t & 3) * 2;
  u32x4 pk0, pk1, pv0, pv1, pk2, pk3, pv2, pv3;
#define KV_ROW0(IDX, TI, KROW0) const int TI = (IDX) < 4 ? (IDX) : (IDX) + skip; \
    const int KROW0 = TI < 4 ? T + b * 256 + 64 * TI : (KIND == 1 ? b * 4096 + (r0g + 2 * (TI - 4)) * 64 : b * 4096 + 128 * (i1 - 1) + 64 * (TI - 4));
#define KV_LOAD(IDX) { KV_ROW0(IDX, ti_, kr0_) \
    const bf16_t* kp = PROJ + (size_t)(kr0_ + skey) * PW + kcol + sc0 * 8; pk0 = *(const u32x4*)kp; pk1 = *(const u32x4*)(kp + 8); \
    const bf16_t* vp = VT + (size_t)(vch + skey) * TT + kr0_ + sc0 * 8; pv0 = *(const u32x4*)vp; pv1 = *(const u32x4*)(vp + 8); \
    if (DBL && ti_ >= 4) { pk2 = *(const u32x4*)(kp + 64 * PW); pk3 = *(const u32x4*)(kp + 64 * PW + 8); pv2 = *(const u32x4*)(vp + 64); pv3 = *(const u32x4*)(vp + 72); } }
  KV_LOAD(0);
#pragma unroll 1
  for (int idx = 0; idx < nvalid; ++idx) {
    KV_ROW0(idx, ti, krow0)
    (void)krow0;
    const int kbase = 128 * (i1 - 1) + 64 * (ti - 4); const int kr = r0g + 2 * (ti - 4);
    const bool local2 = DBL && ti >= 4;
    __syncthreads();
    {
      *(u32x4*)(Ks + skey * 128 + ((sc0 ^ (skey & 7)) << 4)) = pk0; *(u32x4*)(Ks + skey * 128 + (((sc0 + 1) ^ (skey & 7)) << 4)) = pk1;
      u32x2* dst = (u32x2*)(Vs + skey * VSTR + sc0 * 16);
      dst[0] = (u32x2){pv0.x, pv0.y}; dst[1] = (u32x2){pv0.z, pv0.w}; dst[2] = (u32x2){pv1.x, pv1.y}; dst[3] = (u32x2){pv1.z, pv1.w};
      if (local2) {
        *(u32x4*)(Ks + (skey + 64) * 128 + ((sc0 ^ (skey & 7)) << 4)) = pk2; *(u32x4*)(Ks + (skey + 64) * 128 + (((sc0 + 1) ^ (skey & 7)) << 4)) = pk3;
        u32x2* dst2 = (u32x2*)(Vs + skey * VSTR + 128 + sc0 * 16);
        dst2[0] = (u32x2){pv2.x, pv2.y}; dst2[1] = (u32x2){pv2.z, pv2.w}; dst2[2] = (u32x2){pv3.x, pv3.y}; dst2[3] = (u32x2){pv3.z, pv3.w};
      }
    }
    __syncthreads();
    if (idx + 1 < nvalid) KV_LOAD(idx + 1);
    f32x4 sc[4][NQT];
#pragma unroll
    for (int kt = 0; kt < 4; ++kt) {
      const int krow = (local2 ? (kt >> 1) * 64 + col0 + 16 * (kt & 1) : 16 * kt) + r;
      const bf16x8 kf0 = *(const bf16x8*)(Ks + krow * 128 + ((q ^ r7) << 4));
      const bf16x8 kf1 = *(const bf16x8*)(Ks + krow * 128 + (((4 + q) ^ r7) << 4));
#pragma unroll
      for (int qt = 0; qt < NQT; ++qt) { sc[kt][qt] = mfma16(kf0, qf[qt][0], (f32x4){0.f, 0.f, 0.f, 0.f}); sc[kt][qt] = mfma16(kf1, qf[qt][1], sc[kt][qt]); }
    }
    if (ti >= 4) {
      if (KIND == 0) {
#pragma unroll
        for (int qt = 0; qt < NQT; ++qt) { const int qpos = 128 * i1 + 32 * w + 16 * qt + r;
#pragma unroll
          for (int kt = 0; kt < 4; ++kt)
#pragma unroll
            for (int e = 0; e < 4; ++e) { const int d = qpos - (kbase + 16 * kt + 4 * q + e); if (d > 128 || d < -128) sc[kt][qt][e] = -1e30f; } }
      } else if (KIND == 1) {
        const int qc = 16 * w + r; const int cs = qc - 8 < 0 ? 0 : (qc - 8 > 48 ? 48 : qc - 8);
#pragma unroll
        for (int kt = 0; kt < 4; ++kt) {
          const int dy = kr + (kt >> 1) - i1 + 7;
#pragma unroll
          for (int e = 0; e < 4; ++e) { const int kc = col0 + 16 * (kt & 1) + 4 * q + e; const bool ok = (kc >= cs) && (kc < cs + 16);
            int dx = kc - qc + 15; dx = dx < 0 ? 0 : (dx > 30 ? 30 : dx);
            sc[kt][0][e] = ok ? sc[kt][0][e] + rpb[dy * 31 + dx] : -1e30f; }
        }
      }
    }
    bf16x8 pf[2][NQT];
#pragma unroll
    for (int qt = 0; qt < NQT; ++qt) {
      float mx = -1e30f;
#pragma unroll
      for (int kt = 0; kt < 4; ++kt)
#pragma unroll
        for (int e = 0; e < 4; ++e) mx = fmaxf(mx, sc[kt][qt][e]);
      mx = fmaxf(mx, __shfl_xor(mx, 16)); mx = fmaxf(mx, __shfl_xor(mx, 32));
      const float mn = fmaxf(mrun[qt], mx); const float alpha = __expf(mrun[qt] - mn); mrun[qt] = mn;
      float ls = 0.f;
#pragma unroll
      for (int kt = 0; kt < 4; ++kt)
#pragma unroll
        for (int e = 0; e < 4; ++e) { const float p = __expf(sc[kt][qt][e] - mn); sc[kt][qt][e] = p; ls += p; }
      lrun[qt] = lrun[qt] * alpha + ls;
#pragma unroll
      for (int dt = 0; dt < 4; ++dt) o[dt][qt] = o[dt][qt] * alpha;
#pragma unroll
      for (int s = 0; s < 2; ++s) {
        u32x4 pk; pk.x = cvt_pk(sc[2 * s][qt][0], sc[2 * s][qt][1]); pk.y = cvt_pk(sc[2 * s][qt][2], sc[2 * s][qt][3]);
        pk.z = cvt_pk(sc[2 * s + 1][qt][0], sc[2 * s + 1][qt][1]); pk.w = cvt_pk(sc[2 * s + 1][qt][2], sc[2 * s + 1][qt][3]);
        pf[s][qt] = as_bf16x8(pk);
      }
    }
#pragma unroll
    for (int s = 0; s < 2; ++s)
#pragma unroll
      for (int dt = 0; dt < 4; ++dt) {
        const int vkb = local2 ? 64 * s + col0 : 32 * s;
        const u32x2 lo = *(const u32x2*)(Vs + (16 * dt + r) * VSTR + (vkb + 4 * q) * 2);
        const u32x2 hi = *(const u32x2*)(Vs + (16 * dt + r) * VSTR + (vkb + 16 + 4 * q) * 2);
        const bf16x8 vf = as_bf16x8((u32x4){lo.x, lo.y, hi.x, hi.y});
#pragma unroll
        for (int qt = 0; qt < NQT; ++qt) o[dt][qt] = mfma16(vf, pf[s][qt], o[dt][qt]);
      }
  }
#pragma unroll
  for (int qt = 0; qt < NQT; ++qt) {
    float l = lrun[qt]; l += __shfl_xor(l, 16); l += __shfl_xor(l, 32);
    float mf = mrun[qt]; float scale;
    if (has_sink) { const float m2 = fmaxf(mf, sinkv); const float a = __expf(mf - m2); l = l * a + __expf(sinkv - m2); scale = a / l; }
    else scale = 1.f / l;
#pragma unroll
    for (int dt = 0; dt < 4; ++dt) {
      u32x2 ov; ov.x = cvt_pk(o[dt][qt][0] * scale, o[dt][qt][1] * scale); ov.y = cvt_pk(o[dt][qt][2] * scale, o[dt][qt][3] * scale);
      *(u32x2*)(MIX + (size_t)qrow[qt] * 1024 + ocol + 16 * dt + 4 * q) = ov;
    }
  }
}

DEVI void ssd_load_raw(unsigned char* raw, const bf16_t* PROJ, int rowbase, int lo, int hi, int col0) {
  for (int e = tid_opq(); e < 134 * 8; e += 256) {
    const int rr = e >> 3, ch = e & 7; const int row = rowbase - 3 + rr;
    u32x4 v = (u32x4){0u, 0u, 0u, 0u};
    if (row >= lo && row < hi) v = *(const u32x4*)(PROJ + (size_t)row * PW + col0 + ch * 8);
    *(u32x4*)(raw + rr * 128 + ch * 16) = v;
  }
}

template <bool TRANSP, bool WEIGHTED>
DEVI void ssd_conv(const unsigned char* raw, const float* cw  , const float* cb, unsigned char* out1, unsigned char* out2, const float* wt1, const float* wt2) {
  const int t_ = tid_opq(); const int c = t_ & 63, tq = t_ >> 6;
  float wj[7];
#pragma unroll
  for (int j = 0; j < 7; ++j) wj[j] = cw[j * 1024 + c];
  const float bias = cb[c];
  const bf16_t* rp = (const bf16_t*)raw + c;
  float w0 = bf2f(rp[(32 * tq + 0) * 64]), w1 = bf2f(rp[(32 * tq + 1) * 64]), w2 = bf2f(rp[(32 * tq + 2) * 64]), w3 = bf2f(rp[(32 * tq + 3) * 64]), w4 = bf2f(rp[(32 * tq + 4) * 64]), w5 = bf2f(rp[(32 * tq + 5) * 64]);
  float hold1[4], hold2[4];
#pragma unroll 1
  for (int tg = 0; tg < 8; ++tg) {
#pragma unroll
    for (int t4 = 0; t4 < 4; ++t4) {
      const int tok = 32 * tq + 4 * tg + t4;
      const float w6 = bf2f(rp[(tok + 6) * 64]);
      float v = bias + wj[0] * w0 + wj[1] * w1 + wj[2] * w2 + wj[3] * w3 + wj[4] * w4 + wj[5] * w5 + wj[6] * w6;
      v = silu_f(v);
      w0 = w1; w1 = w2; w2 = w3; w3 = w4; w4 = w5; w5 = w6;
      if (TRANSP) {
        hold1[t4] = WEIGHTED ? v * wt1[tok] : v;
        if (WEIGHTED) hold2[t4] = v * wt2[tok];
        if (t4 == 3) {
          u32x2 o; o.x = cvt_pk(hold1[0], hold1[1]); o.y = cvt_pk(hold1[2], hold1[3]);
          *(u32x2*)(out1 + c * 272 + (tok - 3) * 2) = o;
          if (WEIGHTED) { u32x2 o2; o2.x = cvt_pk(hold2[0], hold2[1]); o2.y = cvt_pk(hold2[2], hold2[3]); *(u32x2*)(out2 + c * 272 + (tok - 3) * 2) = o2; }
        }
      } else {
        *(bf16_t*)(out1 + tok * 128 + (((c >> 3) ^ (tok & 7)) << 4) + (c & 7) * 2) = (bf16_t)(cvt_pk(v, 0.f) & 0xffffu);
      }
    }
  }
}

constexpr int SM_RAW = 0, SM_X1 = 17152, SM_X2 = 34560, SM_BT = 51968, SM_SMALL = 69376;
constexpr int SM_XT = 17152, SM_BN = 34560, SM_CN = 50944;

NOINL void conv_item(const Params& P, int layer, int b, int cidx, int slab) {
  unsigned char* const smh = smem + half_id() * HSTR;
  const int t = tid_opq(), c = t & 63, tq = t >> 6;
  const bf16_t* PROJ = (const bf16_t*)(P.ws + OFF_PROJ);
  bf16_t* XN = (bf16_t*)(P.ws + OFF_XN);
  int rowbase, lo, hi;
  if (cidx < 2) { lo = T + b * 256; hi = lo + 256; rowbase = lo + cidx * 128; } else { lo = b * 4096; hi = lo + 4096; rowbase = lo + (cidx - 2) * 128; }
  __syncthreads();
  ssd_load_raw(smh + SM_RAW, PROJ, rowbase, lo, hi, 1792 + slab * 64);
  __syncthreads();
  const float* cw = P.conv_w + (size_t)layer * 7 * 1024 + slab * 64 + c;
  float wj[7];
#pragma unroll
  for (int j = 0; j < 7; ++j) wj[j] = cw[j * 1024];
  const float bias = P.conv_b[layer * 1024 + slab * 64 + c];
  const bf16_t* rp = (const bf16_t*)(smh + SM_RAW) + c;
  float w0 = bf2f(rp[(32 * tq + 0) * 64]), w1 = bf2f(rp[(32 * tq + 1) * 64]), w2 = bf2f(rp[(32 * tq + 2) * 64]), w3 = bf2f(rp[(32 * tq + 3) * 64]), w4 = bf2f(rp[(32 * tq + 4) * 64]), w5 = bf2f(rp[(32 * tq + 5) * 64]);
  const bool nat = slab >= 8, tr = slab < 12;
  bf16_t* trp = slab < 8 ? (bf16_t*)(P.ws + OFF_XTX) + (size_t)(slab * 64 + c) * TT : (bf16_t*)(P.ws + OFF_XTB) + (size_t)((slab - 8) * 64 + c) * TT;
#pragma unroll 1
  for (int tg = 0; tg < 4; ++tg) {
    float hold[8];
#pragma unroll
    for (int t8 = 0; t8 < 8; ++t8) {
      const int tok = 32 * tq + 8 * tg + t8;
      const float w6 = bf2f(rp[(tok + 6) * 64]);
      float v = bias + wj[0] * w0 + wj[1] * w1 + wj[2] * w2 + wj[3] * w3 + wj[4] * w4 + wj[5] * w5 + wj[6] * w6;
      v = silu_f(v);
      w0 = w1; w1 = w2; w2 = w3; w3 = w4; w4 = w5; w5 = w6;
      hold[t8] = v;
      if (nat) XN[(size_t)(rowbase + tok) * 512 + (slab - 8) * 64 + c] = (bf16_t)(cvt_pk(v, 0.f) & 0xffffu);
    }
    if (tr) {
      u32x4 o; o.x = cvt_pk(hold[0], hold[1]); o.y = cvt_pk(hold[2], hold[3]); o.z = cvt_pk(hold[4], hold[5]); o.w = cvt_pk(hold[6], hold[7]);
      *(u32x4*)(trp + rowbase + 32 * tq + 8 * tg) = o;
    }
  }
}

NOINL void ssd_state_item(const Params& P, int layer, int b, int cidx, int h) {
  unsigned char* const smh = smem + half_id() * HSTR;
  const int t = tid_opq(), lane = t & 63, w = t >> 6, r = lane & 15, q = lane >> 4;
  const bf16_t* PROJ = (const bf16_t*)(P.ws + OFF_PROJ);
  const float* DTb = (const float*)(P.ws + OFF_DT);
  bf16_t* ST = (bf16_t*)(P.ws + OFF_ST);
  float* CD = (float*)(P.ws + OFF_CD);
  float* sm = (float*)(smh + SM_SMALL);
  int rowbase, lo, hi;
  if (cidx < 2) { lo = T + b * 256; hi = lo + 256; rowbase = lo + cidx * 128; } else { lo = b * 4096; hi = lo + 4096; rowbase = lo + (cidx - 2) * 128; }
  const int g = h >> 2;
  const float Af = -__expf(P.a_log[layer * 16 + h]), Ab = -__expf(P.a_log[layer * 16 + 8 + h]);
  __syncthreads();
  float inf_ = 0.f, inb_ = 0.f, ab_ = 0.f;
  if (t < 128) {
    const float df = softplus_f(DTb[(size_t)(rowbase + t) * 16 + h] + P.dt_bias[layer * 16 + h]);
    const float db = softplus_f(DTb[(size_t)(rowbase + t) * 16 + 8 + h] + P.dt_bias[layer * 16 + 8 + h]);
    sm[256 + t] = df; sm[384 + t] = db;
    ab_ = db * Ab; inf_ = wave_incl_scan(df * Af, lane); inb_ = wave_incl_scan(ab_, lane);
    if (lane == 63) { sm[772 + w] = inf_; sm[774 + w] = inb_; }
  }
  __syncthreads();
  if (t < 128) {
    const float acf = inf_ + (w == 1 ? sm[772] : 0.f), totf = sm[772] + sm[773];
    const float preb = inb_ - ab_ + (w == 1 ? sm[774] : 0.f), totb = sm[774] + sm[775];
    sm[512 + t] = __expf(totf - acf) * sm[256 + t];
    sm[640 + t] = __expf(preb) * sm[384 + t];
    if (t == 0) { const int seq = (b * 8 + h) * 2; CD[seq * 34 + cidx] = __expf(totf); CD[(seq + 1) * 34 + cidx] = __expf(totb); }
  }
  __syncthreads();
  {
    const bf16_t* XTX = (const bf16_t*)(P.ws + OFF_XTX);
#pragma unroll
    for (int k = 0; k < 4; ++k) {
      const int e = t + 256 * k, p = e >> 4, c16 = e & 15;
      const u32x4 v = *(const u32x4*)(XTX + (size_t)(h * 64 + p) * TT + rowbase + c16 * 8);
      const float* wf = sm + 512 + c16 * 8; const float* wb = sm + 640 + c16 * 8;
      u32x4 of, ob;
      of.x = cvt_pk(bflo(v.x) * wf[0], bfhi(v.x) * wf[1]); of.y = cvt_pk(bflo(v.y) * wf[2], bfhi(v.y) * wf[3]); of.z = cvt_pk(bflo(v.z) * wf[4], bfhi(v.z) * wf[5]); of.w = cvt_pk(bflo(v.w) * wf[6], bfhi(v.w) * wf[7]);
      ob.x = cvt_pk(bflo(v.x) * wb[0], bfhi(v.x) * wb[1]); ob.y = cvt_pk(bflo(v.y) * wb[2], bfhi(v.y) * wb[3]); ob.z = cvt_pk(bflo(v.z) * wb[4], bfhi(v.z) * wb[5]); ob.w = cvt_pk(bflo(v.w) * wb[6], bfhi(v.w) * wb[7]);
      *(u32x4*)(smh + SM_X1 + p * 272 + c16 * 16) = of; *(u32x4*)(smh + SM_X2 + p * 272 + c16 * 16) = ob;
    }
  }
#pragma unroll 1
  for (int nh = 0; nh < 2; ++nh) {
    {
      const bf16_t* XTB = (const bf16_t*)(P.ws + OFF_XTB);
#pragma unroll
      for (int k = 0; k < 4; ++k) {
        const int e = t + 256 * k, n = e >> 4, c16 = e & 15;
        *(u32x4*)(smh + SM_BT + n * 272 + c16 * 16) = *(const u32x4*)(XTB + (size_t)(g * 128 + nh * 64 + n) * TT + rowbase + c16 * 8);
      }
    }
    __syncthreads();
    f32x4 acc[4][2];
#pragma unroll
    for (int nt = 0; nt < 4; ++nt) { acc[nt][0] = (f32x4){0.f, 0.f, 0.f, 0.f}; acc[nt][1] = (f32x4){0.f, 0.f, 0.f, 0.f}; }
#pragma unroll
    for (int s = 0; s < 4; ++s) {
      const bf16x8 xf = *(const bf16x8*)(smh + SM_X1 + (16 * w + r) * 272 + (32 * s + 8 * q) * 2);
      const bf16x8 xb = *(const bf16x8*)(smh + SM_X2 + (16 * w + r) * 272 + (32 * s + 8 * q) * 2);
#pragma unroll
      for (int nt = 0; nt < 4; ++nt) {
        const bf16x8 bt = *(const bf16x8*)(smh + SM_BT + (16 * nt + r) * 272 + (32 * s + 8 * q) * 2);
        acc[nt][0] = mfma16(bt, xf, acc[nt][0]); acc[nt][1] = mfma16(bt, xb, acc[nt][1]);
      }
    }
#pragma unroll
    for (int dir = 0; dir < 2; ++dir) {
      bf16_t* sp = ST + ((size_t)(((b * 8 + h) * 2 + dir) * 34 + cidx)) * 8192 + (16 * w + r) * 128 + nh * 64 + 4 * q;
#pragma unroll
      for (int nt = 0; nt < 4; ++nt) { u32x2 ov; ov.x = cvt_pk(acc[nt][dir][0], acc[nt][dir][1]); ov.y = cvt_pk(acc[nt][dir][2], acc[nt][dir][3]); *(u32x2*)(sp + 16 * nt) = ov; }
    }
    __syncthreads();
  }
}

NOINL void ssd_scan_phase(const Params& P) {
  bf16_t* ST = (bf16_t*)(P.ws + OFF_ST);
  const float* CD = (const float*)(P.ws + OFF_CD);
  const int total = 64 * 2048;
  for (int gidx = VB * 256 + tid_opq(); gidx < total; gidx += VG * 256) {
    const int seq = gidx >> 11, e = gidx & 2047, dir = seq & 1;
    bf16_t* base = ST + (size_t)seq * 34 * 8192 + e * 4;
    const float* cd = CD + seq * 34;
    u32x2 v[34];
#pragma unroll
    for (int k = 0; k < 34; ++k) { const int ci = dir == 0 ? k : (k == 0 ? 1 : (k == 1 ? 0 : 35 - k)); v[k] = *(const u32x2*)(base + (size_t)ci * 8192); }
    float dk[34];
#pragma unroll
    for (int k = 0; k < 34; ++k) { const int ci = dir == 0 ? k : (k == 0 ? 1 : (k == 1 ? 0 : 35 - k)); dk[k] = cd[ci]; }
    float h0 = 0.f, h1 = 0.f, h2 = 0.f, h3 = 0.f;
#pragma unroll
    for (int k = 0; k < 34; ++k) {
      const int ci = dir == 0 ? k : (k == 0 ? 1 : (k == 1 ? 0 : 35 - k));
      u32x2 ov; ov.x = cvt_pk(h0, h1); ov.y = cvt_pk(h2, h3);
      *(u32x2*)(base + (size_t)ci * 8192) = ov;
      const float d = dk[k];
      h0 = h0 * d + bflo(v[k].x); h1 = h1 * d + bfhi(v[k].x); h2 = h2 * d + bflo(v[k].y); h3 = h3 * d + bfhi(v[k].y);
    }
  }
}

NOINL void ssd_out_item(const Params& P, int layer, int b, int cidx, int h, int do_atomic) {
  unsigned char* const smh = smem + half_id() * HSTR;
  const int t = tid_opq(), lane = t & 63, w = t >> 6, r = lane & 15, q = lane >> 4, r7 = r & 7;
  const bf16_t* PROJ = (const bf16_t*)(P.ws + OFF_PROJ);
  const float* DTb = (const float*)(P.ws + OFF_DT);
  const bf16_t* ST = (const bf16_t*)(P.ws + OFF_ST);
  bf16_t* MIX = (bf16_t*)(P.ws + OFF_H);
  float* SSQ = (float*)(P.ws + OFF_SSQ);
  float* sm = (float*)(smh + SM_SMALL);
  int rowbase, lo, hi;
  if (cidx < 2) { lo = T + b * 256; hi = lo + 256; rowbase = lo + cidx * 128; } else { lo = b * 4096; hi = lo + 4096; rowbase = lo + (cidx - 2) * 128; }
  const int g = h >> 2;
  const float Af = -__expf(P.a_log[layer * 16 + h]), Ab = -__expf(P.a_log[layer * 16 + 8 + h]);
  __syncthreads();
  float inf_ = 0.f, inb_ = 0.f, ab_ = 0.f;
  if (t < 128) {
    const float df = softplus_f(DTb[(size_t)(rowbase + t) * 16 + h] + P.dt_bias[layer * 16 + h]);
    const float db = softplus_f(DTb[(size_t)(rowbase + t) * 16 + 8 + h] + P.dt_bias[layer * 16 + 8 + h]);
    sm[256 + t] = df; sm[384 + t] = db;
    ab_ = db * Ab; inf_ = wave_incl_scan(df * Af, lane); inb_ = wave_incl_scan(ab_, lane);
    if (lane == 63) { sm[772 + w] = inf_; sm[774 + w] = inb_; }
  }
  {
    const bf16_t* XTX = (const bf16_t*)(P.ws + OFF_XTX);
#pragma unroll
    for (int k = 0; k < 4; ++k) {
      const int e = t + 256 * k, p = e >> 4, c16 = e & 15;
      *(u32x4*)(smh + SM_XT + p * 272 + c16 * 16) = *(const u32x4*)(XTX + (size_t)(h * 64 + p) * TT + rowbase + c16 * 8);
    }
  }
  __syncthreads();
  if (t < 128) {
    const float acf = inf_ + (w == 1 ? sm[772] : 0.f);
    const float preb = inb_ - ab_ + (w == 1 ? sm[774] : 0.f), totb = sm[774] + sm[775];
    sm[512 + t] = acf; sm[640 + t] = preb;
    if (t == 0) sm[768] = totb;
  }
  __syncthreads();
  f32x4 G[8][2], y[4][2];
#pragma unroll
  for (int jt = 0; jt < 8; ++jt) { G[jt][0] = (f32x4){0.f, 0.f, 0.f, 0.f}; G[jt][1] = (f32x4){0.f, 0.f, 0.f, 0.f}; }
#pragma unroll
  for (int pt = 0; pt < 4; ++pt) { y[pt][0] = (f32x4){0.f, 0.f, 0.f, 0.f}; y[pt][1] = (f32x4){0.f, 0.f, 0.f, 0.f}; }
  float acfi[2], prebi[2], efi[2][2];
#pragma unroll
  for (int it = 0; it < 2; ++it) {
    const int i = 32 * w + 16 * it + r;
    acfi[it] = sm[512 + i]; prebi[it] = sm[640 + i];
    efi[0][it] = __expf(acfi[it]); efi[1][it] = __expf(sm[768] - prebi[it]);
  }
#pragma unroll 1
  for (int nh = 0; nh < 2; ++nh) {
    {
      const bf16_t* XN = (const bf16_t*)(P.ws + OFF_XN);
#pragma unroll
      for (int k = 0; k < 4; ++k) {
        const int e = t + 256 * k, tok = e >> 3, ch = e & 7;
        const bf16_t* src = XN + (size_t)(rowbase + tok) * 512 + g * 128 + nh * 64 + ch * 8;
        *(u32x4*)(smh + SM_BN + tok * 128 + ((ch ^ (tok & 7)) << 4)) = *(const u32x4*)src;
        *(u32x4*)(smh + SM_CN + tok * 128 + ((ch ^ (tok & 7)) << 4)) = *(const u32x4*)(src + 256);
      }
      const int hp_ = t >> 2, hc_ = (t & 3) * 2;
#pragma unroll
      for (int d = 0; d < 2; ++d) {
        const bf16_t* hsrc = ST + ((size_t)(((b * 8 + h) * 2 + d) * 34 + cidx)) * 8192 + hp_ * 128 + nh * 64 + hc_ * 8;
        *(u32x4*)(smh + SM_RAW + d * 8192 + hp_ * 128 + ((hc_ ^ (hp_ & 7)) << 4)) = *(const u32x4*)hsrc;
        *(u32x4*)(smh + SM_RAW + d * 8192 + hp_ * 128 + (((hc_ + 1) ^ (hp_ & 7)) << 4)) = *(const u32x4*)(hsrc + 8);
      }
    }
    __syncthreads();
    bf16x8 cf[2][2];
#pragma unroll
    for (int it = 0; it < 2; ++it)
#pragma unroll
      for (int s = 0; s < 2; ++s) cf[it][s] = *(const bf16x8*)(smh + SM_CN + (32 * w + 16 * it + r) * 128 + (((4 * s + q) ^ r7) << 4));
#pragma unroll
    for (int jt = 0; jt < 8; ++jt)
#pragma unroll
      for (int s = 0; s < 2; ++s) {
        const bf16x8 bfr = *(const bf16x8*)(smh + SM_BN + (16 * jt + r) * 128 + (((4 * s + q) ^ r7) << 4));
        G[jt][0] = mfma16(bfr, cf[0][s], G[jt][0]); G[jt][1] = mfma16(bfr, cf[1][s], G[jt][1]);
      }
#pragma unroll
    for (int d = 0; d < 2; ++d) {
#pragma unroll
      for (int s = 0; s < 2; ++s) {
        union { bf16x8 b; u32x4 u; } c0, c1; c0.b = cf[0][s]; c1.b = cf[1][s];
        const bf16x8 cs0 = as_bf16x8(scale8(c0.u, efi[d][0])), cs1 = as_bf16x8(scale8(c1.u, efi[d][1]));
#pragma unroll
        for (int pt = 0; pt < 4; ++pt) {
          const bf16x8 hf = *(const bf16x8*)(smh + SM_RAW + d * 8192 + (16 * pt + r) * 128 + (((4 * s + q) ^ r7) << 4));
          y[pt][0] = mfma16(hf, cs0, y[pt][0]); y[pt][1] = mfma16(hf, cs1, y[pt][1]);
        }
      }
    }
    __syncthreads();
  }
#pragma unroll
  for (int s = 0; s < 4; ++s) {
    asm volatile("" ::: "memory");
    bf16x8 mf[2];
    const int wu = __builtin_amdgcn_readfirstlane(w);
    if (s < wu) {
      float aj[8], dfj[8];
#pragma unroll
      for (int jj = 0; jj < 8; ++jj) { const int j = 32 * s + (jj < 4 ? 4 * q + jj : 16 + 4 * q + jj - 4); aj[jj] = sm[512 + j]; dfj[jj] = sm[256 + j]; }
#pragma unroll
      for (int it = 0; it < 2; ++it) {
        float mv[8];
#pragma unroll
        for (int jj = 0; jj < 8; ++jj) mv[jj] = G[2 * s + (jj >> 2)][it][jj & 3] * __expf(acfi[it] - aj[jj]) * dfj[jj];
        u32x4 pk; pk.x = cvt_pk(mv[0], mv[1]); pk.y = cvt_pk(mv[2], mv[3]); pk.z = cvt_pk(mv[4], mv[5]); pk.w = cvt_pk(mv[6], mv[7]);
        mf[it] = as_bf16x8(pk);
      }
    } else if (s > wu) {
      float pj[8], dbj[8];
#pragma unroll
      for (int jj = 0; jj < 8; ++jj) { const int j = 32 * s + (jj < 4 ? 4 * q + jj : 16 + 4 * q + jj - 4); pj[jj] = sm[640 + j]; dbj[jj] = sm[384 + j]; }
#pragma unroll
      for (int it = 0; it < 2; ++it) {
        float mv[8];
#pragma unroll
        for (int jj = 0; jj < 8; ++jj) mv[jj] = G[2 * s + (jj >> 2)][it][jj & 3] * __expf(pj[jj] - prebi[it]) * dbj[jj];
        u32x4 pk; pk.x = cvt_pk(mv[0], mv[1]); pk.y = cvt_pk(mv[2], mv[3]); pk.z = cvt_pk(mv[4], mv[5]); pk.w = cvt_pk(mv[6], mv[7]);
        mf[it] = as_bf16x8(pk);
      }
    } else {
    float aj[8], pj[8], dfj[8], dbj[8];
#pragma unroll
    for (int jj = 0; jj < 8; ++jj) { const int j = 32 * s + (jj < 4 ? 4 * q + jj : 16 + 4 * q + jj - 4); aj[jj] = sm[512 + j]; pj[jj] = sm[640 + j]; dfj[jj] = sm[256 + j]; dbj[jj] = sm[384 + j]; }
#pragma unroll
    for (int it = 0; it < 2; ++it) {
      const int i = 32 * w + 16 * it + r;
      float mv[8];
#pragma unroll
      for (int jj = 0; jj < 8; ++jj) {
        const int j = 32 * s + (jj < 4 ? 4 * q + jj : 16 + 4 * q + jj - 4);
        const float gv = G[2 * s + (jj >> 2)][it][jj & 3];
        float m;
        if (j < i) m = gv * __expf(acfi[it] - aj[jj]) * dfj[jj];
        else if (j > i) m = gv * __expf(pj[jj] - prebi[it]) * dbj[jj];
        else m = gv * (dfj[jj] + dbj[jj]);
        mv[jj] = m;
      }
      u32x4 pk; pk.x = cvt_pk(mv[0], mv[1]); pk.y = cvt_pk(mv[2], mv[3]); pk.z = cvt_pk(mv[4], mv[5]); pk.w = cvt_pk(mv[6], mv[7]);
      mf[it] = as_bf16x8(pk);
    }
    }
#pragma unroll
    for (int pt = 0; pt < 4; ++pt) {
      const u32x2 lo2 = *(const u32x2*)(smh + SM_XT + (16 * pt + r) * 272 + (32 * s + 4 * q) * 2);
      const u32x2 hi2 = *(const u32x2*)(smh + SM_XT + (16 * pt + r) * 272 + (32 * s + 16 + 4 * q) * 2);
      const bf16x8 xf = as_bf16x8((u32x4){lo2.x, lo2.y, hi2.x, hi2.y});
      y[pt][0] = mfma16(xf, mf[0], y[pt][0]); y[pt][1] = mfma16(xf, mf[1], y[pt][1]);
    }
  }
  const float dsk = P.ssm_d[layer * 8 + h];
  const bf16_t* XT = (const bf16_t*)(smh + SM_XT);
  u32x2 zq[2][4]; f32x4 gq[4];
#pragma unroll
  for (int pt = 0; pt < 4; ++pt) {
    gq[pt] = *(const f32x4*)(P.ssm_g + layer * 512 + h * 64 + 16 * pt + 4 * q);
#pragma unroll
    for (int it = 0; it < 2; ++it) zq[it][pt] = *(const u32x2*)(PROJ + (size_t)(rowbase + 32 * w + 16 * it + r) * PW + 512 + h * 64 + 16 * pt + 4 * q);
  }
#pragma unroll
  for (int it = 0; it < 2; ++it) {
    const int i = 32 * w + 16 * it + r; const int row = rowbase + i;
    float ss = 0.f;
#pragma unroll
    for (int pt = 0; pt < 4; ++pt) {
      const int p0 = 16 * pt + 4 * q;
      const u32x2 zz = zq[it][pt];
      const f32x4 gg = gq[pt];
      const float zv[4] = {bflo(zz.x), bfhi(zz.x), bflo(zz.y), bfhi(zz.y)};
      float ov[4];
#pragma unroll
      for (int e = 0; e < 4; ++e) {
        const float xs = bf2f(XT[(p0 + e) * 136 + i]);
        const float yz = (y[pt][it][e] + dsk * xs) * silu_f(zv[e]);
        ss += yz * yz; ov[e] = yz * gg[e];
      }
      u32x2 o; o.x = cvt_pk(ov[0], ov[1]); o.y = cvt_pk(ov[2], ov[3]);
      *(u32x2*)(MIX + (size_t)row * 1024 + h * 64 + p0) = o;
    }
    ss += __shfl_xor(ss, 16); ss += __shfl_xor(ss, 32);
    if (q == 0 && do_atomic) atomicAdd(SSQ + row, ss);
  }
}

DEVI void mixer1_phase(const Params& P, int layer) {
  const int nA = 512, nV = 4 * 34 * 16, nC = (layer == 0) ? 64 : 0;
  const int total = nA + nV + nC;
#pragma unroll 1
  for (int it = VB; it < total; it += VG) {
    if (it < nA || it >= nA + nV) {
      int b, i1, i2; bool isctx = it >= nA;
      if (!isctx) { b = it >> 7; i1 = (it >> 2) & 31; i2 = it & 3; }
      else { const int e = it - nA - nV; b = e >> 4; i1 = (e >> 3) & 1; i2 = e & 7; }
      attn_item<0>(P, layer, b, i1, i2, isctx ? 1 : 0);
    } else { const int e = it - nA; const int b = e / 544, rem = e % 544; conv_item(P, layer, b, rem >> 4, rem & 15); }
  }
}
DEVI void mixer2_phase(const Params& P, int layer) {
  const int nB = 1024, nS = 4 * 34 * 8;
  const int total = nB + nS;
#pragma unroll 1
  for (int it = VB; it < total; it += VG) {
    if (it < nB) { const int b = it >> 8, gr = (it >> 2) & 63, h = it & 3; attn_item<1>(P, layer, b, gr, h, 0); }
    else { const int e = it - nB; const int b = e / 272, rem = e % 272; ssd_state_item(P, layer, b, rem >> 3, rem & 7); }
  }
}

DEVI void ssd_out_phase(const Params& P, int layer, int do_atomic = 1) {
  const int c0 = (layer == 0) ? 0 : 2;
  const int nc = 34 - c0;
  const int total = 4 * nc * 8;
#pragma unroll 1
  for (int it = VB; it < total; it += VG) {
    const int b = it / (nc * 8), rem = it % (nc * 8);
    ssd_out_item(P, layer, b, c0 + (rem >> 3), rem & 7, do_atomic);
  }
}


#define XB_TMO      128
#define XB_XCNT(j)  (256  + 64 * (j))
#define XB_XSUB(j)  (1280 + 64 * (j))
#define XB_XGEN(j)  (2304 + 64 * (j))
#define XB_TOP      3328
#define XB_TOPGEN   3392
#define XB_SPIN_CAP (1u << 18)
#define LAS __attribute__((address_space(3)))
DEVI unsigned xb_ld(unsigned* p)              { return __hip_atomic_load(p, __ATOMIC_RELAXED, __HIP_MEMORY_SCOPE_AGENT); }
DEVI unsigned xb_add(unsigned* p, unsigned v) { return __hip_atomic_fetch_add(p, v, __ATOMIC_RELAXED, __HIP_MEMORY_SCOPE_AGENT); }
DEVI unsigned xb_xcc_id() { return (unsigned)__builtin_amdgcn_s_getreg((3 << 11) | 20) & 0xFu; }
#define XB_SPIN(cond, bar) do { unsigned _sp = 0; while (cond) { __builtin_amdgcn_s_sleep(1); \
    if ((++_sp & 255u) == 0u) { if (xb_ld(&(bar)[XB_TMO])) break; if (_sp > XB_SPIN_CAP) { atomicAdd(&(bar)[XB_TMO], 1u); break; } } } } while (0)
struct XcdBarrier { unsigned* bar; unsigned x; volatile LAS unsigned* st; };
DEVI XcdBarrier xcd_barrier_post(unsigned* bar, volatile LAS unsigned* st) {
  XcdBarrier b; b.bar = bar; b.x = xb_xcc_id(); b.st = st;
  if (threadIdx.x == 0) (void)xb_add(&bar[XB_XCNT(b.x)], 1u);
  return b;
}
DEVI void xcd_barrier_complete(unsigned* bar, unsigned x, unsigned& nloc, unsigned& nx) {
  const unsigned G = gridDim.x * gridDim.y * gridDim.z;
  unsigned sum, cnt, mine, sp = 0u;
  for (;;) {
    sum = 0u; cnt = 0u; mine = 0u;
#pragma unroll
    for (unsigned j = 0; j < 16; ++j) { const unsigned c = xb_ld(&bar[XB_XCNT(j)]); sum += c; cnt += (c > 0u) ? 1u : 0u; mine = (j == x) ? c : mine; }
    if (sum == G) break;
    __builtin_amdgcn_s_sleep(1);
    if ((++sp & 255u) == 0u) { if (xb_ld(&bar[XB_TMO])) break; if (sp > XB_SPIN_CAP) { atomicAdd(&bar[XB_TMO], 1u); break; } }
  }
  nloc = mine > 0u ? mine : 1u; nx = cnt > 0u ? cnt : 1u;
}
DEVI void xcd_barrier(const XcdBarrier& b) {
  asm volatile("s_waitcnt vmcnt(0)" ::: "memory");
  __syncthreads();
  if (threadIdx.x == 0) {
    unsigned* bar = b.bar;
    __builtin_amdgcn_s_waitcnt(0);
    unsigned nloc = b.st[0], nx = b.st[1];
    if (nloc == 0u) { xcd_barrier_complete(bar, b.x, nloc, nx); b.st[0] = nloc; b.st[1] = nx; }
    const unsigned old = xb_add(&bar[XB_XSUB(b.x)], 1u);
    const unsigned gen = old / nloc;
    if (old + 1u == (gen + 1u) * nloc) {
      __builtin_amdgcn_fence(__ATOMIC_RELEASE, "agent");
      asm volatile("s_waitcnt vmcnt(0)" ::: "memory");
      const unsigned og = xb_add(&bar[XB_TOP], 1u);
      const unsigned tg = og / nx;
      if (og + 1u == (tg + 1u) * nx) xb_add(&bar[XB_TOPGEN], 1u);
      else XB_SPIN(xb_ld(&bar[XB_TOPGEN]) == tg, bar);
      __builtin_amdgcn_fence(__ATOMIC_ACQUIRE, "agent");
      xb_add(&bar[XB_XGEN(b.x)], 1u);
      asm volatile("s_waitcnt vmcnt(0)" ::: "memory");
    } else {
      XB_SPIN(xb_ld(&bar[XB_XGEN(b.x)]) == gen, bar);
      __builtin_amdgcn_fence(__ATOMIC_ACQUIRE, "agent");
      asm volatile("s_waitcnt vmcnt(0)" ::: "memory");
    }
  }
  __syncthreads();
}

__global__ void __launch_bounds__(512, 2) mega_fwd(Params P) {
  cg::grid_group grid = cg::this_grid();
  if (threadIdx.x == 0) *(uint4*)(smem + SM_XB) = make_uint4(0u, 0u, 0u, 0u);
  __syncthreads();
  XcdBarrier xb = xcd_barrier_post((unsigned*)(P.ws + OFF_BAR), (volatile LAS unsigned*)(smem + SM_XB));
  if (P.ph_hi > 1000) grid.sync();
#define BAR() xcd_barrier(xb)
#ifndef REP_S
#define REP_S -1
#endif
#define RUN(S_, CALL) { if (REP_S == (S_)) { const int do_at = 0; (void)do_at; CALL; BAR(); } { const int do_at = 1; (void)do_at; CALL; } BAR(); }
#define LAYER(l) \
  RUN(0, (norm_phase(P, l, 0), (l == 1 ? prep_phase(P, 1, false) : (void)0))) \
  RUN(1, (gemm_phase<MODE_INPROJ, false>(P, l))) \
  RUN(2, mixer1_phase(P, l)) \
  RUN(9, mixer2_phase(P, l)) \
  RUN(3, ssd_scan_phase(P)) \
  RUN(4, ssd_out_phase(P, l, do_at)) \
  RUN(5, (gemm_phase<MODE_RESID, true>(P, l))) \
  RUN(6, norm_phase(P, l, 1)) \
  RUN(7, (gemm_phase<MODE_SWIGLU, false>(P, l))) \
  RUN(8, (gemm_phase<MODE_RESID, false>(P, l)))
  prep_phase(P, 0, true); BAR();
  LAYER(0)
  LAYER(1)
  final_norm_phase(P);
}

extern "C" void kernel_launch(void* const* d_in, const int* in_sizes, int n_in, void* d_out, int out_size, void* d_ws, size_t ws_size, hipStream_t stream) {
  static int grid_blocks = 0;
  if (!grid_blocks) {
    int dev = 0, cus = 0, per_cu = 0;
    hipGetDevice(&dev);
    hipDeviceGetAttribute(&cus, hipDeviceAttributeMultiprocessorCount, dev);
    hipOccupancyMaxActiveBlocksPerMultiprocessor(&per_cu, mega_fwd, 512, 0);
    if (per_cu < 1) per_cu = 1;
    if (per_cu > 1) per_cu = 1;
    grid_blocks = cus * per_cu;
    if (ws_size < WS_END) fprintf(stderr, "kernel_launch: workspace too small: %zu < %zu\n", ws_size, (size_t)WS_END);
  }
  Params p{};
  const float** pp = (const float**)&p;
  for (int i = 0; i < 21; ++i) pp[i] = (const float*)d_in[i];
  p.out = (float*)d_out; p.ws = (unsigned char*)d_ws;
  hipMemsetAsync((unsigned char*)d_ws + OFF_MODS, 0, SZ_MODS + SZ_BAR, stream);
#if LAUNCH_PER_PHASE
  for (int ph = 0; ph < NPH; ++ph) {
    p.ph_lo = ph; p.ph_hi = ph + 1;
    hipLaunchKernelGGL(mega_fwd, dim3(grid_blocks), dim3(256), 0, stream, p);
  }
#else
  p.ph_lo = 0; p.ph_hi = NPH;
  void* args[] = {&p};
  hipError_t e = hipLaunchCooperativeKernel((void*)mega_fwd, dim3(grid_blocks), dim3(512), args, 0, stream);
  if (e != hipSuccess) fprintf(stderr, "cooperative launch failed: %s (grid %d)\n", hipGetErrorString(e), grid_blocks);
#endif
}
```

```cpp
#include <hip/hip_runtime.h>
#include <hip/hip_cooperative_groups.h>
#include <cstdio>
#include <cstdint>
namespace cg = cooperative_groups;

#ifndef LAUNCH_PER_PHASE
#define LAUNCH_PER_PHASE 0
#endif

typedef unsigned short bf16_t;
typedef short bf16x8 __attribute__((ext_vector_type(8)));
typedef float f32x4 __attribute__((ext_vector_type(4)));
typedef unsigned u32x4 __attribute__((ext_vector_type(4)));
typedef unsigned u32x2 __attribute__((ext_vector_type(2)));
#define DEVI __device__ __forceinline__

constexpr int T = 16384, TC = 1024, TT = T + TC;
constexpr int PW = 2816;
constexpr int NPH = 20;
constexpr float EPSN = 1e-6f;

constexpr size_t SZ_WIN = (size_t)2944 * 1024 * 2, SZ_WOUT = (size_t)1024 * 1024 * 2, SZ_WFI = (size_t)5632 * 1024 * 2, SZ_WFO = (size_t)1024 * 2816 * 2;
constexpr size_t OFF_WIN = 0;
constexpr size_t OFF_WOUT = OFF_WIN + SZ_WIN;
constexpr size_t OFF_WFI = OFF_WOUT + SZ_WOUT;
constexpr size_t OFF_WFO = OFF_WFI + SZ_WFI;
constexpr size_t OFF_H = OFF_WFO + SZ_WFO;
constexpr size_t OFF_PROJ = OFF_H + (size_t)TT * 1024 * 2;
constexpr size_t OFF_VT = OFF_PROJ + (size_t)TT * PW * 2;
constexpr size_t OFF_DT = OFF_VT + (size_t)384 * TT * 2;
constexpr size_t OFF_XC = OFF_DT + (size_t)TT * 16 * 4;
constexpr size_t OFF_MODS = OFF_XC + (size_t)TC * 1024 * 4;
constexpr size_t SZ_MODS = (size_t)2 * 5 * 6144 * 4;
constexpr size_t OFF_BAR = OFF_MODS + SZ_MODS;
constexpr size_t SZ_BAR = 3456 * 4;
constexpr size_t OFF_SSQ = OFF_BAR + SZ_BAR;
constexpr size_t OFF_ST = OFF_SSQ + (size_t)TT * 4;
constexpr size_t OFF_CD = OFF_ST + (size_t)64 * 34 * 8192 * 2;
constexpr size_t OFF_ROPE = OFF_CD + (size_t)64 * 34 * 4;
constexpr size_t OFF_XN = OFF_ROPE + 2 * 1024 * 4;
constexpr size_t OFF_XTX = OFF_XN + (size_t)TT * 512 * 2;
constexpr size_t OFF_XTB = OFF_XTX + (size_t)512 * TT * 2;
constexpr size_t WS_END = OFF_XTB + (size_t)256 * TT * 2;
static_assert(WS_END <= (size_t)256 * 1024 * 1024, "workspace map exceeds 256 MiB");

struct Params {
  const float *x, *c, *ctx, *c_ctx, *w_mod, *b_mod, *g_mix, *w_in, *wa_sink, *na_rpb, *conv_w, *conv_b, *dt_bias, *a_log, *ssm_d, *ssm_g, *w_out, *g_ffn, *w_ffn_in, *w_ffn_out, *g_final;
  float* out; unsigned char* ws; int ph_lo, ph_hi;
};

constexpr int HSTR = 73728, SM_XB = 2 * HSTR, SMEM_BYTES = 2 * HSTR + 16;
__shared__ __attribute__((aligned(16))) unsigned char smem[SMEM_BYTES];
#define NOINL __device__ __forceinline__

typedef __bf16 bf16x2_t __attribute__((ext_vector_type(2)));
typedef float f32x2_t __attribute__((ext_vector_type(2)));
DEVI unsigned cvt_pk(float lo, float hi) { f32x2_t v = {lo, hi}; bf16x2_t b = __builtin_convertvector(v, bf16x2_t); return __builtin_bit_cast(unsigned, b); }
DEVI float bflo(unsigned u) { return __uint_as_float(u << 16); }
DEVI float bfhi(unsigned u) { return __uint_as_float(u & 0xffff0000u); }
DEVI float bf2f(bf16_t h) { return __uint_as_float((unsigned)h << 16); }
DEVI float silu_f(float v) { return v * __builtin_amdgcn_rcpf(1.f + __expf(-v)); }
DEVI float softplus_f(float v) { const float e = __expf(v); return v > 20.f ? v : (e < 1e-3f ? e * (1.f - 0.5f * e) : __logf(1.f + e)); }
DEVI float wave_sum(float v) {
#pragma unroll
  for (int o = 32; o > 0; o >>= 1) v += __shfl_xor(v, o);
  return v;
}
DEVI float wave_incl_scan(float v, int lane) {
#pragma unroll
  for (int o = 1; o < 64; o <<= 1) { const float u = __shfl_up(v, o); if (lane >= o) v += u; }
  return v;
}
DEVI f32x4 mfma16(bf16x8 a, bf16x8 b, f32x4 c) { return __builtin_amdgcn_mfma_f32_16x16x32_bf16(a, b, c, 0, 0, 0); }
DEVI bf16x8 as_bf16x8(u32x4 v) { union { u32x4 u; bf16x8 b; } x; x.u = v; return x.b; }

DEVI u32x4 scale8(u32x4 v, float s) {
  u32x4 o;
  o.x = cvt_pk(bflo(v.x) * s, bfhi(v.x) * s); o.y = cvt_pk(bflo(v.y) * s, bfhi(v.y) * s);
  o.z = cvt_pk(bflo(v.z) * s, bfhi(v.z) * s); o.w = cvt_pk(bflo(v.w) * s, bfhi(v.w) * s);
  return o;
}
DEVI int tid_opq() { int t; asm volatile("v_mov_b32 %0, %1" : "=v"(t) : "v"((int)(threadIdx.x & 255))); return t; }
DEVI int half_id() { return __builtin_amdgcn_readfirstlane((int)(threadIdx.x >> 8)); }
#define VB (blockIdx.x * 2 + half_id())
#define VG (gridDim.x * 2)
DEVI int ufy(int v) { return __builtin_amdgcn_readfirstlane(v); }

NOINL void prep_phase(const Params& P, int wl, bool full) {
  unsigned char* const smh = smem + half_id() * HSTR;
  float* tile = (float*)smh;
  const int t = tid_opq();
  constexpr int I_IN = 46 * 16, I_OUT = 16 * 16, I_FI = 88 * 16, I_FO = 16 * 44, I_L = I_IN + I_OUT + I_FI + I_FO;
  constexpr int I_MOD = 2 * 16 * 24;
  const int total = I_L + (full ? I_MOD + 1 : 0);
  for (int it = VB; it < total; it += VG) {
    if (it < I_L) {
      const int l = wl; int r = it;
      const float* W; bf16_t* Wt; int K, N, kind, nt_, kt_;
      if (r < I_IN) { kind = 0; W = P.w_in + (size_t)l * 1024 * 2832; N = 2832; K = 1024; Wt = (bf16_t*)(P.ws + OFF_WIN); nt_ = r / 16; kt_ = r % 16; }
      else if (r < I_IN + I_OUT) { r -= I_IN; kind = 1; W = P.w_out + (size_t)l * 1024 * 1024; N = 1024; K = 1024; Wt = (bf16_t*)(P.ws + OFF_WOUT); nt_ = r / 16; kt_ = r % 16; }
      else if (r < I_IN + I_OUT + I_FI) { r -= I_IN + I_OUT; kind = 2; W = P.w_ffn_in + (size_t)l * 1024 * 5632; N = 5632; K = 1024; Wt = (bf16_t*)(P.ws + OFF_WFI); nt_ = r / 16; kt_ = r % 16; }
      else { r -= I_IN + I_OUT + I_FI; kind = 3; W = P.w_ffn_out + (size_t)l * 2816 * 1024; N = 1024; K = 2816; Wt = (bf16_t*)(P.ws + OFF_WFO); nt_ = r / 44; kt_ = r % 44; }
      {
        const int n4 = (t & 15) * 4, np = nt_ * 64 + n4;
        int col;
        if (kind == 0) {
          const int cb_ = np & ~127, w_ = np & 127;
          const bool plain_ = np < 2816 && !(cb_ < 256 || cb_ == 1024 || cb_ == 1152 || cb_ == 1536 || cb_ == 1664);
          col = np < 2832 ? (plain_ ? cb_ + (w_ >> 5) * 32 + ((w_ >> 2) & 3) * 8 + ((w_ >> 4) & 1) * 4 + (w_ & 3) : np) : -1;
        }
        else if (kind == 2) { const int w_ = np & 255;
          col = ((w_ >> 4) & 1) * 2816 + (np >> 8) * 128 + ((w_ >> 5) & 3) * 32 + ((w_ >> 2) & 3) * 8 + (w_ >> 7) * 4 + (w_ & 3); }
        else col = np;
#pragma unroll
        for (int i = 0; i < 4; ++i) {
          const int kk = i * 16 + (t >> 4);
          f32x4 v = (f32x4){0.f, 0.f, 0.f, 0.f};
          const int ksrc = kind == 1 ? ((kt_ * 64 + kk + 512) & 1023) : (kt_ * 64 + kk);
          if (col >= 0) v = *(const f32x4*)(W + (size_t)ksrc * N + col);
          tile[kk * 65 + n4] = v[0]; tile[kk * 65 + n4 + 1] = v[1]; tile[kk * 65 + n4 + 2] = v[2]; tile[kk * 65 + n4 + 3] = v[3];
        }
      }
      __syncthreads();
      {
        const int n = t >> 2, kc = (t & 3) * 16;
        u32x4 o0, o1;
        o0.x = cvt_pk(tile[(kc + 0) * 65 + n], tile[(kc + 1) * 65 + n]); o0.y = cvt_pk(tile[(kc + 2) * 65 + n], tile[(kc + 3) * 65 + n]);
        o0.z = cvt_pk(tile[(kc + 4) * 65 + n], tile[(kc + 5) * 65 + n]); o0.w = cvt_pk(tile[(kc + 6) * 65 + n], tile[(kc + 7) * 65 + n]);
        o1.x = cvt_pk(tile[(kc + 8) * 65 + n], tile[(kc + 9) * 65 + n]); o1.y = cvt_pk(tile[(kc + 10) * 65 + n], tile[(kc + 11) * 65 + n]);
        o1.z = cvt_pk(tile[(kc + 12) * 65 + n], tile[(kc + 13) * 65 + n]); o1.w = cvt_pk(tile[(kc + 14) * 65 + n], tile[(kc + 15) * 65 + n]);
        bf16_t* dst = Wt + (size_t)(nt_ * 64 + n) * K + kt_ * 64 + kc;
        *(u32x4*)dst = o0; *(u32x4*)(dst + 8) = o1;
      }
      __syncthreads();
    } else if (it < I_L + I_MOD) {
      const int m = it - I_L; const int l = m / 384, rem = m % 384, kc = rem / 24, cb = rem % 24;
      float* sv = (float*)smh;
      for (int e = t; e < 320; e += 256) { const int r = e >> 6, k = kc * 64 + (e & 63); const float v = r < 4 ? P.c[r * 1024 + k] : P.c_ctx[k]; sv[e] = v / (1.f + __expf(-v)); }
      __syncthreads();
      const int n = cb * 256 + t;
      float a0 = 0.f, a1 = 0.f, a2 = 0.f, a3 = 0.f, a4 = 0.f;
      const float* wp = P.w_mod + ((size_t)l * 1024 + kc * 64) * 6144 + n;
#pragma unroll 8
      for (int kk = 0; kk < 64; ++kk) { const float w = wp[(size_t)kk * 6144]; a0 += sv[kk] * w; a1 += sv[64 + kk] * w; a2 += sv[128 + kk] * w; a3 += sv[192 + kk] * w; a4 += sv[256 + kk] * w; }
      if (kc == 0) { const float bb = P.b_mod[l * 6144 + n]; a0 += bb; a1 += bb; a2 += bb; a3 += bb; a4 += bb; }
      float* md = (float*)(P.ws + OFF_MODS) + (size_t)l * 5 * 6144 + n;
      atomicAdd(md, a0); atomicAdd(md + 6144, a1); atomicAdd(md + 2 * 6144, a2); atomicAdd(md + 3 * 6144, a3); atomicAdd(md + 4 * 6144, a4);
      __syncthreads();
    } else {
      float* rc = (float*)(P.ws + OFF_ROPE);
      for (int e = t; e < 1024; e += 256) { const int pos = e >> 4, i = e & 15; const float inv = __builtin_amdgcn_exp2f(-(float)i * (13.287712379549449f / 16.f)); float xr = (float)pos * inv * 0.15915494309189535f; xr -= floorf(xr); rc[e] = __builtin_amdgcn_cosf(xr); rc[1024 + e] = __builtin_amdgcn_sinf(xr); }
    }
  }
}

NOINL void norm_phase(const Params& P, int layer, int which) {
  const float* src_lat = (layer == 0 && which == 0) ? P.x : P.out; const float* src_ctx = (layer == 0 && which == 0) ? P.ctx : (const float*)(P.ws + OFF_XC);
  const int M = (which == 0 || layer == 0) ? TT : T;
  const int t_ = tid_opq(); const int lane = t_ & 63, wv = t_ >> 6;
  const int gw = VB * 4 + wv, nw = VG * 4;
  const float* g = (which == 0 ? P.g_mix : P.g_ffn) + layer * 1024;
  bf16_t* H = (bf16_t*)(P.ws + OFF_H);
  float* ssq = (float*)(P.ws + OFF_SSQ);
  for (int row = gw; row < M; row += nw) {
    const float* xr = row < T ? src_lat + (size_t)row * 1024 : src_ctx + (size_t)(row - T) * 1024;
    const int mr = row < T ? (row >> 12) : 4;
    const float* md = (const float*)(P.ws + OFF_MODS) + (size_t)(layer * 5 + mr) * 6144 + which * 3072;
    f32x4 v[4]; float s = 0.f;
#pragma unroll
    for (int j = 0; j < 4; ++j) { v[j] = *(const f32x4*)(xr + 4 * (lane + 64 * j)); s += v[j][0] * v[j][0] + v[j][1] * v[j][1] + v[j][2] * v[j][2] + v[j][3] * v[j][3]; }
    s = wave_sum(s);
    const float rstd = rsqrtf(s * (1.f / 1024.f) + EPSN);
    f32x4 ggv[4], shv[4], scv[4];
#pragma unroll
    for (int j = 0; j < 4; ++j) { const int k = 4 * (lane + 64 * j); ggv[j] = *(const f32x4*)(g + k); shv[j] = *(const f32x4*)(md + k); scv[j] = *(const f32x4*)(md + 1024 + k); }
#pragma unroll
    for (int j = 0; j < 4; ++j) {
      const int k = 4 * (lane + 64 * j);
      const f32x4 gg = ggv[j], sh = shv[j], sc = scv[j];
      f32x4 h;
#pragma unroll
      for (int e = 0; e < 4; ++e) h[e] = v[j][e] * rstd * gg[e] * (1.f + sc[e]) + sh[e];
      u32x2 o; o.x = cvt_pk(h[0], h[1]); o.y = cvt_pk(h[2], h[3]);
      *(u32x2*)(H + (size_t)row * 1024 + k) = o;
    }
    if (which == 0 && lane == 0) ssq[row] = 0.f;
  }
}

NOINL void final_norm_phase(const Params& P) {
  const int t_ = tid_opq(); const int lane = t_ & 63, wv = t_ >> 6;
  const int gw = VB * 4 + wv, nw = VG * 4;
  for (int row = gw; row < T; row += nw) {
    float* xr = P.out + (size_t)row * 1024;
    f32x4 v[4]; float s = 0.f;
#pragma unroll
    for (int j = 0; j < 4; ++j) { v[j] = *(const f32x4*)(xr + 4 * (lane + 64 * j)); s += v[j][0] * v[j][0] + v[j][1] * v[j][1] + v[j][2] * v[j][2] + v[j][3] * v[j][3]; }
    s = wave_sum(s);
    const float rstd = rsqrtf(s * (1.f / 1024.f) + EPSN);
#pragma unroll
    for (int j = 0; j < 4; ++j) {
      const int k = 4 * (lane + 64 * j);
      const f32x4 gg = *(const f32x4*)(P.g_final + k);
      f32x4 h;
#pragma unroll
      for (int e = 0; e < 4; ++e) h[e] = v[j][e] * rstd * gg[e];
      *(f32x4*)(xr + k) = h;
    }
  }
}

namespace pg8 {
#define PG8_LAS __attribute__((address_space(3)))
typedef unsigned short bf16_t;
typedef short bf16x8 __attribute__((ext_vector_type(8)));
typedef float f32x4 __attribute__((ext_vector_type(4)));
typedef unsigned u32x4 __attribute__((ext_vector_type(4)));
constexpr int BM = 256, BK = 64, HALF = 128, HTB = HALF * BK * 2  , STAGE_BYTES = 8 * HTB, NXCD = 8, WGM = 8;

__host__ __device__ __forceinline__ int lds_byte(int r, int c) { const int st = (r >> 4) * 2 + (c >> 5), rr = r & 15, cc = c & 31, ob = rr * 64 + cc * 2; return st * 1024 + (ob ^ (((ob >> 9) & 1) << 5)); }
__host__ __device__ __forceinline__ void stage_rc(int b, int& R, int& C) { const int st = b / 1024, sb = b % 1024, swz = sb ^ (((sb >> 9) & 1) << 5); R = (st >> 1) * 16 + swz / 64; C = (st & 1) * 32 + (swz % 64) / 2; }
__host__ __device__ __forceinline__ int perm32(int rho) { const int n = rho >> 4, i = rho & 15; return 8 * (i >> 2) + 4 * n + (i & 3); }

struct Unit { int pm, pn; };
struct Gemm { const bf16_t* A; const bf16_t* Bt; int M, N, K; };

struct StaticOrder {
    int nM, nN, nwg, G, c;
    __host__ __device__ void init(int M, int N, int G_, int c_) { nM = M / BM; nN = N / BM; nwg = nM * nN; G = G_; c = c_; }
    __host__ __device__ bool next(int i, Unit& u) const {
        const long L = (long)i * G + c; if (L >= nwg) return false;
        int wgid = (int)L; { const int q = nwg / NXCD, r = nwg % NXCD, xcd = wgid % NXCD, off = wgid / NXCD; wgid = (xcd < r ? xcd * (q + 1) : r * (q + 1) + (xcd - r) * q) + off; }
        const int nig = WGM * nN, gid = wgid / nig, fm = gid * WGM, gsz = (nM - fm) < WGM ? (nM - fm) : WGM;
        u.pm = fm + ((wgid % nig) % gsz); u.pn = (wgid % nig) / gsz; return true;
    }
    __device__ __forceinline__ void a_ready(const Unit&) const {}
    __device__ __forceinline__ void done(const Unit&) const {}
};

template <class Epi, class Sched, bool ALIGN_EPI = false, bool SP2 = false>
__device__ __forceinline__ void gemm_phase(PG8_LAS unsigned char* lds, const Gemm g, const Sched& S, const Epi& E) {
    int tid_; asm volatile("v_mov_b32 %0, %1" : "=v"(tid_) : "v"((int)threadIdx.x)); const int tid = tid_, wid = __builtin_amdgcn_readfirstlane(tid >> 6), lane = tid & 63, wr = wid >> 2, wc = wid & 3, fr = lane & 15, fq = lane >> 4;
    const int K = g.K, nt = K / BK;
    unsigned voffA[2], voffB[2];
#pragma unroll
    for (int i = 0; i < 2; ++i) { int R, C; stage_rc(tid * 16 + i * 8192, R, C); const int Rb = Epi::PERM ? ((R & ~31) + perm32(R & 31)) : R;
        voffA[i] = (unsigned)(R * K + C) * 2u; voffB[i] = (unsigned)(Rb * K + C) * 2u; }
    const size_t kstep = (size_t)(BK * 2);
    const size_t hstep = (size_t)HALF * K * 2;
    const size_t tstep = 2 * hstep;
    const unsigned ldsw = (unsigned)wid * 1024u;
    const int aoff = lds_byte(wr * 64 + fr, fq * 8), boff = lds_byte(wc * 32 + fr, fq * 8);
#define PG8_SA(b, h) (((b) * 2 + (h)) * HTB)
#define PG8_SB(b, h) ((4 + (b) * 2 + (h)) * HTB)
#define PG8_STAGE(bufoff, gbase, voff) do { _Pragma("unroll") for (int _i = 0; _i < 2; ++_i) \
        __builtin_amdgcn_global_load_lds((const unsigned*)((const char*)(gbase) + (voff)[_i]), (PG8_LAS unsigned*)(lds + (bufoff) + ldsw + _i * 8192), 16, 0, 0); } while (0)
#define PG8_LDA(dst, b, h) do { _Pragma("unroll") for (int m = 0; m < 4; ++m) _Pragma("unroll") for (int k = 0; k < 2; ++k) dst[m][k] = *(const PG8_LAS bf16x8*)(lds + PG8_SA(b, h) + aoff + m * 2048 + k * 1024); } while (0)
#define PG8_LDB(dst, b, h) do { _Pragma("unroll") for (int n = 0; n < 2; ++n) _Pragma("unroll") for (int k = 0; k < 2; ++k) dst[n][k] = *(const PG8_LAS bf16x8*)(lds + PG8_SB(b, h) + boff + n * 2048 + k * 1024); } while (0)
#define PG8_MMA(ai, bj, At, Bt) do { __builtin_amdgcn_s_setprio(1); _Pragma("unroll") for (int m = 0; m < 4; ++m) _Pragma("unroll") for (int n = 0; n < 2; ++n) _Pragma("unroll") for (int k = 0; k < 2; ++k) \
        acc[ai][bj][m][n] = __builtin_amdgcn_mfma_f32_16x16x32_bf16(Bt[n][k], At[m][k], acc[ai][bj][m][n], 0, 0, 0); __builtin_amdgcn_s_setprio(0); } while (0)
#define PG8_WAIT_V(n) asm volatile("s_waitcnt vmcnt(" #n ")" ::: "memory")
#define PG8_WAIT_L(n) asm volatile("s_waitcnt lgkmcnt(" #n ")" ::: "memory")
#define PG8_BAR __builtin_amdgcn_s_barrier()
#define PG8_SCHED __builtin_amdgcn_sched_barrier(0)
    Unit cur, nxt; int ui = 0;
    if (!S.next(0, cur)) return;
    f32x4 acc[2][2][4][2];
#pragma unroll
    for (int a = 0; a < 2; ++a)
#pragma unroll
        for (int b = 0; b < 2; ++b)
#pragma unroll
            for (int m = 0; m < 4; ++m)
#pragma unroll
                for (int n = 0; n < 2; ++n) acc[a][b][m][n] = (f32x4){0.f, 0.f, 0.f, 0.f};
    bf16x8 At[4][2], B0[2][2], B1[2][2];
    const char* cA = (const char*)g.A + (size_t)cur.pm * tstep; const char* cB = (const char*)g.Bt + (size_t)cur.pn * tstep;
    S.a_ready(cur);
    if constexpr (SP2) {
        PG8_STAGE(PG8_SB(0, 0), cB, voffB); PG8_STAGE(PG8_SB(0, 1), cB + hstep, voffB); PG8_STAGE(PG8_SA(0, 0), cA, voffA); PG8_STAGE(PG8_SA(0, 1), cA + hstep, voffA);
        if (wr == 1) PG8_BAR;
        PG8_WAIT_V(2); PG8_BAR;
        PG8_STAGE(PG8_SB(1, 0), cB + kstep, voffB); PG8_STAGE(PG8_SA(1, 0), cA + kstep, voffA); PG8_STAGE(PG8_SB(1, 1), cB + hstep + kstep, voffB);
        PG8_WAIT_V(6); PG8_BAR;
    } else {
        PG8_STAGE(PG8_SB(0, 0), cB, voffB); PG8_STAGE(PG8_SA(0, 0), cA, voffA); PG8_STAGE(PG8_SB(0, 1), cB + hstep, voffB); PG8_STAGE(PG8_SA(0, 1), cA + hstep, voffA);
        if (wr == 1) PG8_BAR;
        PG8_WAIT_V(4); PG8_BAR;
        PG8_STAGE(PG8_SB(1, 0), cB + kstep, voffB); PG8_STAGE(PG8_SA(1, 0), cA + kstep, voffA); PG8_STAGE(PG8_SB(1, 1), cB + hstep + kstep, voffB);
        PG8_WAIT_V(6); PG8_BAR;
    }
    for (;;) {
        const bool has_next = S.next(ui + 1, nxt);
        const char* nA = has_next ? (const char*)g.A + (size_t)nxt.pm * tstep : cA; const char* nB = has_next ? (const char*)g.Bt + (size_t)nxt.pn * tstep : cB;
        for (int t = 0; t < nt; t += 2) {
            if constexpr (Epi::MIDSCALE) { if (t == 8) E.midscale(acc, cur, wr, fr); }
            const bool last = (t == nt - 2);
            const char* a1 = cA + (size_t)(t + 1) * kstep;
            const char* a2 = last ? nA : cA + (size_t)(t + 2) * kstep; const char* b2 = last ? nB : cB + (size_t)(t + 2) * kstep;
            const char* a3 = a2 + kstep; const char* b3 = b2 + kstep;
            if (last && has_next) S.a_ready(nxt);
            if constexpr (SP2) {
            PG8_LDB(B0, 0, 0); PG8_LDB(B1, 0, 1); PG8_SCHED; PG8_LDA(At, 0, 0); PG8_STAGE(PG8_SA(1, 1), a1 + hstep, voffA);
            PG8_WAIT_V(8); PG8_WAIT_L(0); PG8_BAR; PG8_MMA(0, 0, At, B0); PG8_MMA(0, 1, At, B1); PG8_BAR; PG8_SCHED;
            PG8_LDA(At, 0, 1); PG8_STAGE(PG8_SB(0, 0), b2, voffB); PG8_STAGE(PG8_SB(0, 1), b2 + hstep, voffB); PG8_STAGE(PG8_SA(0, 0), a2, voffA);
            PG8_WAIT_V(8); PG8_WAIT_L(0); PG8_BAR; PG8_MMA(1, 0, At, B0); PG8_MMA(1, 1, At, B1); PG8_BAR; PG8_SCHED;
            PG8_LDB(B0, 1, 0); PG8_LDB(B1, 1, 1); PG8_SCHED; PG8_LDA(At, 1, 0); PG8_STAGE(PG8_SA(0, 1), a2 + hstep, voffA);
            PG8_WAIT_V(8); PG8_WAIT_L(0); PG8_BAR; PG8_MMA(0, 0, At, B0); PG8_MMA(0, 1, At, B1); PG8_BAR; PG8_SCHED;
            PG8_LDA(At, 1, 1); PG8_STAGE(PG8_SB(1, 0), b3, voffB); PG8_STAGE(PG8_SB(1, 1), b3 + hstep, voffB); PG8_STAGE(PG8_SA(1, 0), a3, voffA);
            PG8_WAIT_V(8); PG8_WAIT_L(0); PG8_BAR; PG8_MMA(1, 0, At, B0); PG8_MMA(1, 1, At, B1); PG8_BAR; PG8_SCHED;
            } else {
            PG8_LDB(B0, 0, 0); PG8_SCHED; PG8_LDA(At, 0, 0); PG8_STAGE(PG8_SA(1, 1), a1 + hstep, voffA);
            PG8_WAIT_L(8); PG8_BAR; PG8_WAIT_L(0); PG8_MMA(0, 0, At, B0); PG8_BAR; PG8_SCHED;
            PG8_LDB(B1, 0, 1); PG8_STAGE(PG8_SB(0, 0), b2, voffB);
            PG8_BAR; PG8_WAIT_L(0); PG8_MMA(0, 1, At, B1); PG8_BAR;
            PG8_LDA(At, 0, 1); PG8_STAGE(PG8_SA(0, 0), a2, voffA);
            PG8_BAR; PG8_WAIT_L(0); PG8_MMA(1, 0, At, B0); PG8_BAR; PG8_SCHED;
            PG8_STAGE(PG8_SB(0, 1), b2 + hstep, voffB);
            PG8_WAIT_V(6); PG8_BAR; PG8_MMA(1, 1, At, B1); PG8_BAR;
            PG8_LDB(B0, 1, 0); PG8_SCHED; PG8_LDA(At, 1, 0); PG8_STAGE(PG8_SA(0, 1), a2 + hstep, voffA);
            PG8_WAIT_L(8); PG8_BAR; PG8_WAIT_L(0); PG8_MMA(0, 0, At, B0); PG8_BAR; PG8_SCHED;
            PG8_LDB(B1, 1, 1); PG8_STAGE(PG8_SB(1, 0), b3, voffB);
            PG8_BAR; PG8_WAIT_L(0); PG8_MMA(0, 1, At, B1); PG8_BAR;
            PG8_LDA(At, 1, 1); PG8_STAGE(PG8_SA(1, 0), a3, voffA);
            PG8_BAR; PG8_WAIT_L(0); PG8_MMA(1, 0, At, B0); PG8_BAR; PG8_SCHED;
            PG8_STAGE(PG8_SB(1, 1), b3 + hstep, voffB);
            PG8_WAIT_V(6); PG8_BAR; PG8_MMA(1, 1, At, B1); PG8_BAR;
            }
        }
        if constexpr (ALIGN_EPI) { if (wr == 0) PG8_BAR; }
        if constexpr (!Epi::AFTER_DRAIN) { E(acc, cur, wr, wc, fr, fq); S.done(cur); }
        if (!has_next) break;
#pragma unroll
        for (int a = 0; a < 2; ++a)
#pragma unroll
            for (int b = 0; b < 2; ++b)
#pragma unroll
                for (int m = 0; m < 4; ++m)
#pragma unroll
                    for (int n = 0; n < 2; ++n) acc[a][b][m][n] = (f32x4){0.f, 0.f, 0.f, 0.f};
        cur = nxt; cA = nA; cB = nB; ++ui;
        if constexpr (ALIGN_EPI) { if (wr == 1) PG8_BAR; }
    }
    PG8_WAIT_V(0);
    if constexpr (!ALIGN_EPI) { if (wr == 0) PG8_BAR; }
    PG8_BAR;
    if constexpr (Epi::AFTER_DRAIN) { E.fused(acc, cur, wr, wc, fr, fq, lds, wid, lane); S.done(cur); }
#undef PG8_SA
#undef PG8_SB
#undef PG8_STAGE
#undef PG8_LDA
#undef PG8_LDB
#undef PG8_MMA
#undef PG8_WAIT_V
#undef PG8_WAIT_L
#undef PG8_BAR
#undef PG8_SCHED
}
}

struct EpiInProj {
  static constexpr bool PERM = false, AFTER_DRAIN = false, MIDSCALE = false;
  unsigned char* ws;
  DEVI void operator()(const f32x4 (&acc)[2][2][4][2], const pg8::Unit& u, int wr, int wc, int fr, int fq) const {
    bf16_t* PROJ = (bf16_t*)(ws + OFF_PROJ); bf16_t* VT = (bf16_t*)(ws + OFF_VT); const float* rc = (const float*)(ws + OFF_ROPE);
    const int rowb = u.pm * 256 + wr * 64 + fr;
#pragma unroll
    for (int bj = 0; bj < 2; ++bj) {
      const int cb = u.pn * 256 + bj * 128;
      const bool isv = (cb == 1152) || (cb == 1536) || (cb == 1664);
      const bool do_rope = (cb < 256) || (cb == 1024);
      const float qs = cb < 512 ? 0.125f : 1.f;
      const int vchb = (cb == 1152 ? 0 : 128 + (cb - 1536)) + 32 * wc + 4 * fq;
#pragma unroll
      for (int ai = 0; ai < 2; ++ai)
#pragma unroll
        for (int m = 0; m < 4; ++m) {
          const int row = rowb + 128 * ai + 16 * m;
          f32x4 v0 = acc[ai][bj][m][0], v1 = acc[ai][bj][m][1];
          if (isv) {
#pragma unroll
            for (int e = 0; e < 4; ++e) { VT[(unsigned)((vchb + e) * TT + row)] = (bf16_t)(cvt_pk(v0[e], 0.f) & 0xffffu); VT[(unsigned)((vchb + 16 + e) * TT + row)] = (bf16_t)(cvt_pk(v1[e], 0.f) & 0xffffu); }
          } else {
            if (do_rope && row < T) {
              const int pos = row & 4095, pp = (wc & 1) ? (pos & 63) : (pos >> 6);
              const f32x4 cs = *(const f32x4*)(rc + pp * 16 + 4 * fq), sn = *(const f32x4*)(rc + 1024 + pp * 16 + 4 * fq);
#pragma unroll
              for (int e = 0; e < 4; ++e) { const float x1 = v0[e], x2 = v1[e]; v0[e] = x1 * cs[e] - x2 * sn[e]; v1[e] = x2 * cs[e] + x1 * sn[e]; }
            }
            u32x2 o0, o1; o0.x = cvt_pk(v0[0] * qs, v0[1] * qs); o0.y = cvt_pk(v0[2] * qs, v0[3] * qs); o1.x = cvt_pk(v1[0] * qs, v1[1] * qs); o1.y = cvt_pk(v1[2] * qs, v1[3] * qs);
            if (do_rope) {
              bf16_t* dst = PROJ + (unsigned)(row * PW + cb + 32 * wc + 4 * fq);
              *(u32x2*)dst = o0; *(u32x2*)(dst + 16) = o1;
            } else {
              *(u32x4*)(PROJ + (unsigned)(row * PW + cb + 32 * wc + 8 * fq)) = (u32x4){o0.x, o0.y, o1.x, o1.y};
            }
          }
        }
    }
  }
};
struct EpiSwiglu {
  static constexpr bool PERM = false, AFTER_DRAIN = false, MIDSCALE = false;
  unsigned char* ws;
  DEVI void operator()(const f32x4 (&acc)[2][2][4][2], const pg8::Unit& u, int wr, int wc, int fr, int fq) const {
    bf16_t* G = (bf16_t*)(ws + OFF_PROJ);
    const int rowb = u.pm * 256 + wr * 64 + fr;
#pragma unroll
    for (int ai = 0; ai < 2; ++ai)
#pragma unroll
      for (int m = 0; m < 4; ++m) {
        const int row = rowb + 128 * ai + 16 * m;
        float o0[4], o1[4];
#pragma unroll
        for (int e = 0; e < 4; ++e) { o0[e] = silu_f(acc[ai][0][m][0][e]) * acc[ai][0][m][1][e]; o1[e] = silu_f(acc[ai][1][m][0][e]) * acc[ai][1][m][1][e]; }
        u32x4 ov; ov.x = cvt_pk(o0[0], o0[1]); ov.y = cvt_pk(o0[2], o0[3]); ov.z = cvt_pk(o1[0], o1[1]); ov.w = cvt_pk(o1[2], o1[3]);
        *(u32x4*)(G + (unsigned)(row * 2816 + u.pn * 128 + wc * 32 + 8 * fq)) = ov;
      }
  }
};
template <bool MID>
struct EpiResid {
  static constexpr bool PERM = false, AFTER_DRAIN = false, MIDSCALE = MID;
  unsigned char* ws; const float* rin_lat; const float* rin_ctx; float* rout_lat; float* rout_ctx; int layer, gate_idx;
  DEVI void midscale(f32x4 (&acc)[2][2][4][2], const pg8::Unit& u, int wr, int fr) const {
    const float* ssq = (const float*)(ws + OFF_SSQ) + u.pm * 256 + wr * 64 + fr;
    float sq[8];
#pragma unroll
    for (int k = 0; k < 8; ++k) sq[k] = ssq[128 * (k >> 2) + 16 * (k & 3)];
#pragma unroll
    for (int ai = 0; ai < 2; ++ai)
#pragma unroll
      for (int m = 0; m < 4; ++m) {
        const float rs = rsqrtf(sq[ai * 4 + m] * (1.f / 512.f) + EPSN);
#pragma unroll
        for (int bj = 0; bj < 2; ++bj) { acc[ai][bj][m][0] = acc[ai][bj][m][0] * rs; acc[ai][bj][m][1] = acc[ai][bj][m][1] * rs; }
      }
  }
  DEVI void operator()(const f32x4 (&acc)[2][2][4][2], const pg8::Unit& u, int wr, int wc, int fr, int fq) const {
    const bool lat = u.pm < T / 256;
    const int mr = lat ? (u.pm >> 4) : 4;
    const float* gpb = (const float*)(ws + OFF_MODS) + (size_t)(layer * 5 + mr) * 6144 + gate_idx * 1024;
    const float* rinb = lat ? rin_lat : rin_ctx; float* routb = lat ? rout_lat : rout_ctx;
    const int col0 = u.pn * 256 + wc * 32 + 4 * fq;
    const unsigned off0 = (unsigned)(((lat ? u.pm : u.pm - T / 256) * 256 + wr * 64 + fr) * 1024 + col0);
#pragma unroll
    for (int bj = 0; bj < 2; ++bj)
#pragma unroll
      for (int n = 0; n < 2; ++n) {
        const f32x4 gv = *(const f32x4*)(gpb + col0 + 128 * bj + 16 * n);
        f32x4 rv[8];
#pragma unroll
        for (int k = 0; k < 8; ++k) rv[k] = *(const f32x4*)(rinb + off0 + (unsigned)((128 * (k >> 2) + 16 * (k & 3)) * 1024 + 128 * bj + 16 * n));
#pragma unroll
        for (int ai = 0; ai < 2; ++ai)
#pragma unroll
          for (int m = 0; m < 4; ++m) {
            const unsigned off = off0 + (unsigned)((128 * ai + 16 * m) * 1024 + 128 * bj + 16 * n);
            f32x4 o;
#pragma unroll
            for (int e = 0; e < 4; ++e) o[e] = rv[ai * 4 + m][e] + gv[e] * acc[ai][bj][m][n][e];
            *(f32x4*)(routb + off) = o;
          }
      }
  }
};
constexpr int MODE_INPROJ = 0, MODE_RESID = 1, MODE_SWIGLU = 2;
template <int MODE, bool ASCALE>
DEVI void gemm_phase(const Params& P, int layer) {
  constexpr int K = (MODE == MODE_RESID && !ASCALE) ? 2816 : 1024;
  constexpr int N = MODE == MODE_INPROJ ? 2816 : (MODE == MODE_SWIGLU ? 5632 : 1024);
  const int M = (MODE == MODE_INPROJ || (layer == 0 && MODE != MODE_RESID)) ? TT : T;
  const bf16_t* A = (const bf16_t*)(P.ws + ((MODE == MODE_RESID && !ASCALE) ? OFF_PROJ : OFF_H));
  const bf16_t* Wt = (const bf16_t*)(P.ws + (MODE == MODE_INPROJ ? OFF_WIN : MODE == MODE_SWIGLU ? OFF_WFI : ASCALE ? OFF_WOUT : OFF_WFO));
  pg8::Gemm g{A, Wt, M, N, K}; pg8::StaticOrder S; S.init(M, N, (int)gridDim.x, (int)blockIdx.x);
  PG8_LAS unsigned char* lds = (PG8_LAS unsigned char*)smem;
  if constexpr (MODE == MODE_INPROJ) {
    EpiInProj E{P.ws};
    pg8::gemm_phase<EpiInProj, pg8::StaticOrder, true, true>(lds, g, S, E);
    const int lane = threadIdx.x & 63, r = lane & 15, q = lane >> 4;
    const bf16_t* Wd = Wt + (size_t)(2816 + r) * 1024 + 8 * q;
    float* DTb = (float*)(P.ws + OFF_DT);
    for (int tile = blockIdx.x * 8 + (threadIdx.x >> 6); tile < TT / 16; tile += gridDim.x * 8) {
      const bf16_t* Ar = A + (size_t)(16 * tile + r) * 1024 + 8 * q;
      f32x4 acc = (f32x4){0.f, 0.f, 0.f, 0.f};
#pragma unroll 8
      for (int s2 = 0; s2 < 32; ++s2) acc = mfma16(*(const bf16x8*)(Ar + 32 * s2), *(const bf16x8*)(Wd + 32 * s2), acc);
#pragma unroll
      for (int e = 0; e < 4; ++e) DTb[(size_t)(16 * tile + 4 * q + e) * 16 + r] = acc[e];
    }
  } else if constexpr (MODE == MODE_SWIGLU) {
    EpiSwiglu E{P.ws};
    pg8::gemm_phase<EpiSwiglu, pg8::StaticOrder, true, true>(lds, g, S, E);
  } else {
    float* XCp = (float*)(P.ws + OFF_XC);
    EpiResid<ASCALE> E{P.ws, (ASCALE && layer == 0) ? P.x : P.out, (ASCALE && layer == 0) ? P.ctx : XCp, P.out, XCp, layer, ASCALE ? 2 : 5};
    pg8::gemm_phase<EpiResid<ASCALE>, pg8::StaticOrder, true, true>(lds, g, S, E);
    if (layer == 0) {
      const int lane = threadIdx.x & 63, r = lane & 15, q = lane >> 4, w8 = threadIdx.x >> 6;
      const float* gpb = (const float*)(P.ws + OFF_MODS) + (size_t)(layer * 5 + 4) * 6144 + (ASCALE ? 2 : 5) * 1024;
      const float* rinb = ASCALE ? P.ctx : XCp;
      const float* ssq = (const float*)(P.ws + OFF_SSQ) + T;
      constexpr int PER = K / 32 / 8;
      float* part = (float*)smem;
      for (int tl = blockIdx.x; tl < 256; tl += gridDim.x) {
        const int r0 = (tl >> 4) * 64, n0 = (tl & 15) * 64;
        const bf16_t* Ar = A + (size_t)(T + r0 + r) * K + w8 * PER * 32 + 8 * q;
        const bf16_t* Br = Wt + (size_t)(n0 + r) * K + w8 * PER * 32 + 8 * q;
        f32x4 acc[4][4];
#pragma unroll
        for (int i = 0; i < 4; ++i)
#pragma unroll
          for (int j = 0; j < 4; ++j) acc[i][j] = (f32x4){0.f, 0.f, 0.f, 0.f};
#pragma unroll 2
        for (int s2 = 0; s2 < PER; ++s2) {
          bf16x8 af[4], bfr[4];
#pragma unroll
          for (int i = 0; i < 4; ++i) { af[i] = *(const bf16x8*)(Ar + (size_t)(16 * i) * K + 32 * s2); bfr[i] = *(const bf16x8*)(Br + (size_t)(16 * i) * K + 32 * s2); }
#pragma unroll
          for (int i = 0; i < 4; ++i)
#pragma unroll
            for (int j = 0; j < 4; ++j) acc[i][j] = mfma16(af[i], bfr[j], acc[i][j]);
        }
        const bool sc = ASCALE && w8 < 4;
        float sqv[16];
#pragma unroll
        for (int k = 0; k < 16; ++k) sqv[k] = ssq[r0 + 16 * (k >> 2) + 4 * q + (k & 3)];
#pragma unroll
        for (int i = 0; i < 4; ++i)
#pragma unroll
          for (int e = 0; e < 4; ++e) {
            const float rs = sc ? rsqrtf(sqv[i * 4 + e] * (1.f / 512.f) + EPSN) : 1.f;
#pragma unroll
            for (int j = 0; j < 4; ++j) part[w8 * 4096 + (16 * i + 4 * q + e) * 64 + 16 * j + r] = acc[i][j][e] * rs;
          }
        __syncthreads();
        float rres[8], gres[8];
#pragma unroll
        for (int k = 0; k < 8; ++k) { const int o = (int)threadIdx.x + 512 * k; rres[k] = rinb[(unsigned)((r0 + (o >> 6)) * 1024 + n0 + (o & 63))]; gres[k] = gpb[n0 + (o & 63)]; }
#pragma unroll
        for (int k = 0; k < 8; ++k) {
          const int o = (int)threadIdx.x + 512 * k, row = o >> 6, col = o & 63;
          float sum = 0.f;
#pragma unroll
          for (int pw = 0; pw < 8; ++pw) sum += part[pw * 4096 + o];
          XCp[(unsigned)((r0 + row) * 1024 + n0 + col)] = rres[k] + gres[k] * sum;
        }
        __syncthreads();
      }
    }
  }
}

template <int KIND>
NOINL void attn_item(const Params& P, int layer, int b, int i1, int i2, int isctx_) {
  unsigned char* const smh = smem + half_id() * HSTR;
  const bool isctx = isctx_ != 0;
  constexpr int NQT = (KIND == 1) ? 1 : 2;
  const int t = tid_opq(), lane = t & 63, w = t >> 6, r = lane & 15, q = lane >> 4, r7 = r & 7;
  const bf16_t* PROJ = (const bf16_t*)(P.ws + OFF_PROJ);
  const bf16_t* VT = (const bf16_t*)(P.ws + OFF_VT);
  bf16_t* MIX = (bf16_t*)(P.ws + OFF_H);
  constexpr bool DBL = (KIND == 1);
  constexpr int VSTR = DBL ? 272 : 136;
  unsigned char* Ks = smh; unsigned char* Vs = smh + (DBL ? 16384 : 8192); float* rpb = (float*)(smh + 33792);
  const int col0 = w == 0 ? 0 : (w == 1 ? 8 : (w == 2 ? 24 : 32));
  int qrow[NQT]; int qcol, kcol, vch, ocol, ntile; bool has_sink = false; float sinkv = 0.f;
  int r0g = 0;
  if (KIND == 0 && !isctx) {
    const int n = i1, head = i2;
#pragma unroll
    for (int qt = 0; qt < NQT; ++qt) qrow[qt] = b * 4096 + 128 * n + 32 * w + 16 * qt + r;
    qcol = head * 64; kcol = 1024 + (head >> 1) * 64; vch = (head >> 1) * 64; ocol = 512 + head * 64; ntile = 10; has_sink = true; sinkv = P.wa_sink[layer * 4 + head];
  } else if (KIND == 1) {
    const int gr = i1, h = i2;
    qrow[0] = b * 4096 + gr * 64 + 16 * w + r;
    qcol = 256 + 64 * h; kcol = 1280 + 64 * h; vch = 128 + 64 * h; ocol = 768 + 64 * h; ntile = 8;
    r0g = gr - 4 < 0 ? 0 : (gr - 4 > 56 ? 56 : gr - 4);
    __syncthreads();
    for (int e = t; e < 465; e += 256) rpb[e] = P.na_rpb[(size_t)(layer * 4 + h) * 465 + e];
  } else {
    const int qb = i1, hh = i2;
#pragma unroll
    for (int qt = 0; qt < NQT; ++qt) qrow[qt] = T + b * 256 + 128 * qb + 32 * w + 16 * qt + r;
    ntile = 4;
    if (hh < 4) { qcol = hh * 64; kcol = 1024 + (hh >> 1) * 64; vch = (hh >> 1) * 64; ocol = 512 + hh * 64; has_sink = true; sinkv = P.wa_sink[layer * 4 + hh]; }
    else { const int h = hh - 4; qcol = 256 + 64 * h; kcol = 1280 + 64 * h; vch = 128 + 64 * h; ocol = 768 + 64 * h; }
  }
  bf16x8 qf[NQT][2];
#pragma unroll
  for (int qt = 0; qt < NQT; ++qt)
#pragma unroll
    for (int s = 0; s < 2; ++s) qf[qt][s] = *(const bf16x8*)(PROJ + (size_t)qrow[qt] * PW + qcol + 32 * s + 8 * q);
  f32x4 o[4][NQT]; float mrun[NQT], lrun[NQT];
#pragma unroll
  for (int qt = 0; qt < NQT; ++qt) { mrun[qt] = -1e30f; lrun[qt] = 0.f;
#pragma unroll
    for (int dt = 0; dt < 4; ++dt) o[dt][qt] = (f32x4){0.f, 0.f, 0.f, 0.f}; }

  const int skip = (KIND == 0 && !isctx && i1 == 0) ? 2 : 0;
  const int nvalid = ntile - skip - ((KIND == 0 && !isctx && i1 == 31) ? 2 : 0);
  const int skey = t >> 2, sc0 = (t & 3) * 2;
  u32x4 pk0, pk1, pv0, pv1, pk2, pk3, pv2, pv3;
#define KV_ROW0(IDX, TI, KROW0) const int TI = (IDX) < 4 ? (IDX) : (IDX) + skip; \
    const int KROW0 = TI < 4 ? T + b * 256 + 64 * TI : (KIND == 1 ? b * 4096 + (r0g + 2 * (TI - 4)) * 64 : b * 4096 + 128 * (i1 - 1) + 64 * (TI - 4));
#define KV_LOAD(IDX) { KV_ROW0(IDX, ti_, kr0_) \
    const bf16_t* kp = PROJ + (size_t)(kr0_ + skey) * PW + kcol + sc0 * 8; pk0 = *(const u32x4*)kp; pk1 = *(const u32x4*)(kp + 8); \
    const bf16_t* vp = VT + (size_t)(vch + skey) * TT + kr0_ + sc0 * 8; pv0 = *(const u32x4*)vp; pv1 = *(const u32x4*)(vp + 8); \
    if (DBL && ti_ >= 4) { pk2 = *(const u32x4*)(kp + 64 * PW); pk3 = *(const u32x4*)(kp + 64 * PW + 8); pv2 = *(const u32x4*)(vp + 64); pv3 = *(const u32x4*)(vp + 72); } }
  KV_LOAD(0);
#pragma unroll 1
  for (int idx = 0; idx < nvalid; ++idx) {
    KV_ROW0(idx, ti, krow0)
    (void)krow0;
    const int kbase = 128 * (i1 - 1) + 64 * (ti - 4); const int kr = r0g + 2 * (ti - 4);
    const bool local2 = DBL && ti >= 4;
    __syncthreads();
    {
      *(u32x4*)(Ks + skey * 128 + ((sc0 ^ (skey & 7)) << 4)) = pk0; *(u32x4*)(Ks + skey * 128 + (((sc0 + 1) ^ (skey & 7)) << 4)) = pk1;
      u32x2* dst = (u32x2*)(Vs + skey * VSTR + sc0 * 16);
      dst[0] = (u32x2){pv0.x, pv0.y}; dst[1] = (u32x2){pv0.z, pv0.w}; dst[2] = (u32x2){pv1.x, pv1.y}; dst[3] = (u32x2){pv1.z, pv1.w};
      if (local2) {
        *(u32x4*)(Ks + (skey + 64) * 128 + ((sc0 ^ (skey & 7)) << 4)) = pk2; *(u32x4*)(Ks + (skey + 64) * 128 + (((sc0 + 1) ^ (skey & 7)) << 4)) = pk3;
        u32x2* dst2 = (u32x2*)(Vs + skey * VSTR + 128 + sc0 * 16);
        dst2[0] = (u32x2){pv2.x, pv2.y}; dst2[1] = (u32x2){pv2.z, pv2.w}; dst2[2] = (u32x2){pv3.x, pv3.y}; dst2[3] = (u32x2){pv3.z, pv3.w};
      }
    }
    __syncthreads();
    if (idx + 1 < nvalid) KV_LOAD(idx + 1);
    f32x4 sc[4][NQT];
#pragma unroll
    for (int kt = 0; kt < 4; ++kt) {
      const int krow = (local2 ? (kt >> 1) * 64 + col0 + 16 * (kt & 1) : 16 * kt) + r;
      const bf16x8 kf0 = *(const bf16x8*)(Ks + krow * 128 + ((q ^ r7) << 4));
      const bf16x8 kf1 = *(const bf16x8*)(Ks + krow * 128 + (((4 + q) ^ r7) << 4));
#pragma unroll
      for (int qt = 0; qt < NQT; ++qt) { sc[kt][qt] = mfma16(kf0, qf[qt][0], (f32x4){0.f, 0.f, 0.f, 0.f}); sc[kt][qt] = mfma16(kf1, qf[qt][1], sc[kt][qt]); }
    }
    if (ti >= 4) {
      if (KIND == 0) {
#pragma unroll
        for (int qt = 0; qt < NQT; ++qt) { const int qpos = 128 * i1 + 32 * w + 16 * qt + r;
#pragma unroll
          for (int kt = 0; kt < 4; ++kt)
#pragma unroll
            for (int e = 0; e < 4; ++e) { const int d = qpos - (kbase + 16 * kt + 4 * q + e); if (d > 128 || d < -128) sc[kt][qt][e] = -1e30f; } }
      } else if (KIND == 1) {
        const int qc = 16 * w + r; const int cs = qc - 8 < 0 ? 0 : (qc - 8 > 48 ? 48 : qc - 8);
#pragma unroll
        for (int kt = 0; kt < 4; ++kt) {
          const int dy = kr + (kt >> 1) - i1 + 7;
#pragma unroll
          for (int e = 0; e < 4; ++e) { const int kc = col0 + 16 * (kt & 1) + 4 * q + e; const bool ok = (kc >= cs) && (kc < cs + 16);
            int dx = kc - qc + 15; dx = dx < 0 ? 0 : (dx > 30 ? 30 : dx);
            sc[kt][0][e] = ok ? sc[kt][0][e] + rpb[dy * 31 + dx] : -1e30f; }
        }
      }
    }
    bf16x8 pf[2][NQT];
#pragma unroll
    for (int qt = 0; qt < NQT; ++qt) {
      float mx = -1e30f;
#pragma unroll
      for (int kt = 0; kt < 4; ++kt)
#pragma unroll
        for (int e = 0; e < 4; ++e) mx = fmaxf(mx, sc[kt][qt][e]);
      mx = fmaxf(mx, __shfl_xor(mx, 16)); mx = fmaxf(mx, __shfl_xor(mx, 32));
      const float mn = fmaxf(mrun[qt], mx); const float alpha = __expf(mrun[qt] - mn); mrun[qt] = mn;
      float ls = 0.f;
#pragma unroll
      for (int kt = 0; kt < 4; ++kt)
#pragma unroll
        for (int e = 0; e < 4; ++e) { const float p = __expf(sc[kt][qt][e] - mn); sc[kt][qt][e] = p; ls += p; }
      lrun[qt] = lrun[qt] * alpha + ls;
#pragma unroll
      for (int dt = 0; dt < 4; ++dt) o[dt][qt] = o[dt][qt] * alpha;
#pragma unroll
      for (int s = 0; s < 2; ++s) {
        u32x4 pk; pk.x = cvt_pk(sc[2 * s][qt][0], sc[2 * s][qt][1]); pk.y = cvt_pk(sc[2 * s][qt][2], sc[2 * s][qt][3]);
        pk.z = cvt_pk(sc[2 * s + 1][qt][0], sc[2 * s + 1][qt][1]); pk.w = cvt_pk(sc[2 * s + 1][qt][2], sc[2 * s + 1][qt][3]);
        pf[s][qt] = as_bf16x8(pk);
      }
    }
#pragma unroll
    for (int s = 0; s < 2; ++s)
#pragma unroll
      for (int dt = 0; dt < 4; ++dt) {
        const int vkb = local2 ? 64 * s + col0 : 32 * s;
        const u32x2 lo = *(const u32x2*)(Vs + (16 * dt + r) * VSTR + (vkb + 4 * q) * 2);
        const u32x2 hi = *(const u32x2*)(Vs + (16 * dt + r) * VSTR + (vkb + 16 + 4 * q) * 2);
        const bf16x8 vf = as_bf16x8((u32x4){lo.x, lo.y, hi.x, hi.y});
#pragma unroll
        for (int qt = 0; qt < NQT; ++qt) o[dt][qt] = mfma16(vf, pf[s][qt], o[dt][qt]);
      }
  }
#pragma unroll
  for (int qt = 0; qt < NQT; ++qt) {
    float l = lrun[qt]; l += __shfl_xor(l, 16); l += __shfl_xor(l, 32);
    float mf = mrun[qt]; float scale;
    if (has_sink) { const float m2 = fmaxf(mf, sinkv); const float a = __expf(mf - m2); l = l * a + __expf(sinkv - m2); scale = a / l; }
    else scale = 1.f / l;
#pragma unroll
    for (int dt = 0; dt < 4; ++dt) {
      u32x2 ov; ov.x = cvt_pk(o[dt][qt][0] * scale, o[dt][qt][1] * scale); ov.y = cvt_pk(o[dt][qt][2] * scale, o[dt][qt][3] * scale);
      *(u32x2*)(MIX + (size_t)qrow[qt] * 1024 + ocol + 16 * dt + 4 * q) = ov;
    }
  }
}

DEVI void ssd_load_raw(unsigned char* raw, const bf16_t* PROJ, int rowbase, int lo, int hi, int col0) {
  for (int e = tid_opq(); e < 134 * 8; e += 256) {
    const int rr = e >> 3, ch = e & 7; const int row = rowbase - 3 + rr;
    u32x4 v = (u32x4){0u, 0u, 0u, 0u};
    if (row >= lo && row < hi) v = *(const u32x4*)(PROJ + (size_t)row * PW + col0 + ch * 8);
    *(u32x4*)(raw + rr * 128 + ch * 16) = v;
  }
}

template <bool TRANSP, bool WEIGHTED>
DEVI void ssd_conv(const unsigned char* raw, const float* cw  , const float* cb, unsigned char* out1, unsigned char* out2, const float* wt1, const float* wt2) {
  const int t_ = tid_opq(); const int c = t_ & 63, tq = t_ >> 6;
  float wj[7];
#pragma unroll
  for (int j = 0; j < 7; ++j) wj[j] = cw[j * 1024 + c];
  const float bias = cb[c];
  const bf16_t* rp = (const bf16_t*)raw + c;
  float w0 = bf2f(rp[(32 * tq + 0) * 64]), w1 = bf2f(rp[(32 * tq + 1) * 64]), w2 = bf2f(rp[(32 * tq + 2) * 64]), w3 = bf2f(rp[(32 * tq + 3) * 64]), w4 = bf2f(rp[(32 * tq + 4) * 64]), w5 = bf2f(rp[(32 * tq + 5) * 64]);
  float hold1[4], hold2[4];
#pragma unroll 1
  for (int tg = 0; tg < 8; ++tg) {
#pragma unroll
    for (int t4 = 0; t4 < 4; ++t4) {
      const int tok = 32 * tq + 4 * tg + t4;
      const float w6 = bf2f(rp[(tok + 6) * 64]);
      float v = bias + wj[0] * w0 + wj[1] * w1 + wj[2] * w2 + wj[3] * w3 + wj[4] * w4 + wj[5] * w5 + wj[6] * w6;
      v = silu_f(v);
      w0 = w1; w1 = w2; w2 = w3; w3 = w4; w4 = w5; w5 = w6;
      if (TRANSP) {
        hold1[t4] = WEIGHTED ? v * wt1[tok] : v;
        if (WEIGHTED) hold2[t4] = v * wt2[tok];
        if (t4 == 3) {
          u32x2 o; o.x = cvt_pk(hold1[0], hold1[1]); o.y = cvt_pk(hold1[2], hold1[3]);
          *(u32x2*)(out1 + c * 272 + (tok - 3) * 2) = o;
          if (WEIGHTED) { u32x2 o2; o2.x = cvt_pk(hold2[0], hold2[1]); o2.y = cvt_pk(hold2[2], hold2[3]); *(u32x2*)(out2 + c * 272 + (tok - 3) * 2) = o2; }
        }
      } else {
        *(bf16_t*)(out1 + tok * 128 + (((c >> 3) ^ (tok & 7)) << 4) + (c & 7) * 2) = (bf16_t)(cvt_pk(v, 0.f) & 0xffffu);
      }
    }
  }
}

constexpr int SM_RAW = 0, SM_X1 = 17152, SM_X2 = 34560, SM_BT = 51968, SM_SMALL = 69376;
constexpr int SM_XT = 17152, SM_BN = 34560, SM_CN = 50944;

NOINL void conv_item(const Params& P, int layer, int b, int cidx, int slab) {
  unsigned char* const smh = smem + half_id() * HSTR;
  const int t = tid_opq(), c = t & 63, tq = t >> 6;
  const bf16_t* PROJ = (const bf16_t*)(P.ws + OFF_PROJ);
  bf16_t* XN = (bf16_t*)(P.ws + OFF_XN);
  int rowbase, lo, hi;
  if (cidx < 2) { lo = T + b * 256; hi = lo + 256; rowbase = lo + cidx * 128; } else { lo = b * 4096; hi = lo + 4096; rowbase = lo + (cidx - 2) * 128; }
  __syncthreads();
  ssd_load_raw(smh + SM_RAW, PROJ, rowbase, lo, hi, 1792 + slab * 64);
  __syncthreads();
  const float* cw = P.conv_w + (size_t)layer * 7 * 1024 + slab * 64 + c;
  float wj[7];
#pragma unroll
  for (int j = 0; j < 7; ++j) wj[j] = cw[j * 1024];
  const float bias = P.conv_b[layer * 1024 + slab * 64 + c];
  const bf16_t* rp = (const bf16_t*)(smh + SM_RAW) + c;
  float w0 = bf2f(rp[(32 * tq + 0) * 64]), w1 = bf2f(rp[(32 * tq + 1) * 64]), w2 = bf2f(rp[(32 * tq + 2) * 64]), w3 = bf2f(rp[(32 * tq + 3) * 64]), w4 = bf2f(rp[(32 * tq + 4) * 64]), w5 = bf2f(rp[(32 * tq + 5) * 64]);
  const bool nat = slab >= 8, tr = slab < 12;
  bf16_t* trp = slab < 8 ? (bf16_t*)(P.ws + OFF_XTX) + (size_t)(slab * 64 + c) * TT : (bf16_t*)(P.ws + OFF_XTB) + (size_t)((slab - 8) * 64 + c) * TT;
#pragma unroll 1
  for (int tg = 0; tg < 4; ++tg) {
    float hold[8];
#pragma unroll
    for (int t8 = 0; t8 < 8; ++t8) {
      const int tok = 32 * tq + 8 * tg + t8;
      const float w6 = bf2f(rp[(tok + 6) * 64]);
      float v = bias + wj[0] * w0 + wj[1] * w1 + wj[2] * w2 + wj[3] * w3 + wj[4] * w4 + wj[5] * w5 + wj[6] * w6;
      v = silu_f(v);
      w0 = w1; w1 = w2; w2 = w3; w3 = w4; w4 = w5; w5 = w6;
      hold[t8] = v;
      if (nat) XN[(size_t)(rowbase + tok) * 512 + (slab - 8) * 64 + c] = (bf16_t)(cvt_pk(v, 0.f) & 0xffffu);
    }
    if (tr) {
      u32x4 o; o.x = cvt_pk(hold[0], hold[1]); o.y = cvt_pk(hold[2], hold[3]); o.z = cvt_pk(hold[4], hold[5]); o.w = cvt_pk(hold[6], hold[7]);
      *(u32x4*)(trp + rowbase + 32 * tq + 8 * tg) = o;
    }
  }
}

NOINL void ssd_state_item(const Params& P, int layer, int b, int cidx, int h) {
  unsigned char* const smh = smem + half_id() * HSTR;
  const int t = tid_opq(), lane = t & 63, w = t >> 6, r = lane & 15, q = lane >> 4;
  const bf16_t* PROJ = (const bf16_t*)(P.ws + OFF_PROJ);
  const float* DTb = (const float*)(P.ws + OFF_DT);
  bf16_t* ST = (bf16_t*)(P.ws + OFF_ST);
  float* CD = (float*)(P.ws + OFF_CD);
  float* sm = (float*)(smh + SM_SMALL);
  int rowbase, lo, hi;
  if (cidx < 2) { lo = T + b * 256; hi = lo + 256; rowbase = lo + cidx * 128; } else { lo = b * 4096; hi = lo + 4096; rowbase = lo + (cidx - 2) * 128; }
  const int g = h >> 2;
  const float Af = -__expf(P.a_log[layer * 16 + h]), Ab = -__expf(P.a_log[layer * 16 + 8 + h]);
  __syncthreads();
  float inf_ = 0.f, inb_ = 0.f, ab_ = 0.f;
  if (t < 128) {
    const float df = softplus_f(DTb[(size_t)(rowbase + t) * 16 + h] + P.dt_bias[layer * 16 + h]);
    const float db = softplus_f(DTb[(size_t)(rowbase + t) * 16 + 8 + h] + P.dt_bias[layer * 16 + 8 + h]);
    sm[256 + t] = df; sm[384 + t] = db;
    ab_ = db * Ab; inf_ = wave_incl_scan(df * Af, lane); inb_ = wave_incl_scan(ab_, lane);
    if (lane == 63) { sm[772 + w] = inf_; sm[774 + w] = inb_; }
  }
  __syncthreads();
  if (t < 128) {
    const float acf = inf_ + (w == 1 ? sm[772] : 0.f), totf = sm[772] + sm[773];
    const float preb = inb_ - ab_ + (w == 1 ? sm[774] : 0.f), totb = sm[774] + sm[775];
    sm[512 + t] = __expf(totf - acf) * sm[256 + t];
    sm[640 + t] = __expf(preb) * sm[384 + t];
    if (t == 0) { const int seq = (b * 8 + h) * 2; CD[seq * 34 + cidx] = __expf(totf); CD[(seq + 1) * 34 + cidx] = __expf(totb); }
  }
  __syncthreads();
  {
    const bf16_t* XTX = (const bf16_t*)(P.ws + OFF_XTX);
#pragma unroll
    for (int k = 0; k < 4; ++k) {
      const int e = t + 256 * k, p = e >> 4, c16 = e & 15;
      const u32x4 v = *(const u32x4*)(XTX + (size_t)(h * 64 + p) * TT + rowbase + c16 * 8);
      const float* wf = sm + 512 + c16 * 8; const float* wb = sm + 640 + c16 * 8;
      u32x4 of, ob;
      of.x = cvt_pk(bflo(v.x) * wf[0], bfhi(v.x) * wf[1]); of.y = cvt_pk(bflo(v.y) * wf[2], bfhi(v.y) * wf[3]); of.z = cvt_pk(bflo(v.z) * wf[4], bfhi(v.z) * wf[5]); of.w = cvt_pk(bflo(v.w) * wf[6], bfhi(v.w) * wf[7]);
      ob.x = cvt_pk(bflo(v.x) * wb[0], bfhi(v.x) * wb[1]); ob.y = cvt_pk(bflo(v.y) * wb[2], bfhi(v.y) * wb[3]); ob.z = cvt_pk(bflo(v.z) * wb[4], bfhi(v.z) * wb[5]); ob.w = cvt_pk(bflo(v.w) * wb[6], bfhi(v.w) * wb[7]);
      *(u32x4*)(smh + SM_X1 + p * 272 + c16 * 16) = of; *(u32x4*)(smh + SM_X2 + p * 272 + c16 * 16) = ob;
    }
  }
#pragma unroll 1
  for (int nh = 0; nh < 2; ++nh) {
    {
      const bf16_t* XTB = (const bf16_t*)(P.ws + OFF_XTB);
#pragma unroll
      for (int k = 0; k < 4; ++k) {
        const int e = t + 256 * k, n = e >> 4, c16 = e & 15;
        *(u32x4*)(smh + SM_BT + n * 272 + c16 * 16) = *(const u32x4*)(XTB + (size_t)(g * 128 + nh * 64 + n) * TT + rowbase + c16 * 8);
      }
    }
    __syncthreads();
    f32x4 acc[4][2];
#pragma unroll
    for (int nt = 0; nt < 4; ++nt) { acc[nt][0] = (f32x4){0.f, 0.f, 0.f, 0.f}; acc[nt][1] = (f32x4){0.f, 0.f, 0.f, 0.f}; }
#pragma unroll
    for (int s = 0; s < 4; ++s) {
      const bf16x8 xf = *(const bf16x8*)(smh + SM_X1 + (16 * w + r) * 272 + (32 * s + 8 * q) * 2);
      const bf16x8 xb = *(const bf16x8*)(smh + SM_X2 + (16 * w + r) * 272 + (32 * s + 8 * q) * 2);
#pragma unroll
      for (int nt = 0; nt < 4; ++nt) {
        const bf16x8 bt = *(const bf16x8*)(smh + SM_BT + (16 * nt + r) * 272 + (32 * s + 8 * q) * 2);
        acc[nt][0] = mfma16(bt, xf, acc[nt][0]); acc[nt][1] = mfma16(bt, xb, acc[nt][1]);
      }
    }
#pragma unroll
    for (int dir = 0; dir < 2; ++dir) {
      bf16_t* sp = ST + ((size_t)(((b * 8 + h) * 2 + dir) * 34 + cidx)) * 8192 + (16 * w + r) * 128 + nh * 64 + 4 * q;
#pragma unroll
      for (int nt = 0; nt < 4; ++nt) { u32x2 ov; ov.x = cvt_pk(acc[nt][dir][0], acc[nt][dir][1]); ov.y = cvt_pk(acc[nt][dir][2], acc[nt][dir][3]); *(u32x2*)(sp + 16 * nt) = ov; }
    }
    __syncthreads();
  }
}

NOINL void ssd_scan_phase(const Params& P) {
  bf16_t* ST = (bf16_t*)(P.ws + OFF_ST);
  const float* CD = (const float*)(P.ws + OFF_CD);
  const int total = 64 * 2048;
  for (int gidx = VB * 256 + tid_opq(); gidx < total; gidx += VG * 256) {
    const int seq = gidx >> 11, e = gidx & 2047, dir = seq & 1;
    bf16_t* base = ST + (size_t)seq * 34 * 8192 + e * 4;
    const float* cd = CD + seq * 34;
    u32x2 v[34];
#pragma unroll
    for (int k = 0; k < 34; ++k) { const int ci = dir == 0 ? k : (k == 0 ? 1 : (k == 1 ? 0 : 35 - k)); v[k] = *(const u32x2*)(base + (size_t)ci * 8192); }
    float dk[34];
#pragma unroll
    for (int k = 0; k < 34; ++k) { const int ci = dir == 0 ? k : (k == 0 ? 1 : (k == 1 ? 0 : 35 - k)); dk[k] = cd[ci]; }
    float h0 = 0.f, h1 = 0.f, h2 = 0.f, h3 = 0.f;
#pragma unroll
    for (int k = 0; k < 34; ++k) {
      const int ci = dir == 0 ? k : (k == 0 ? 1 : (k == 1 ? 0 : 35 - k));
      u32x2 ov; ov.x = cvt_pk(h0, h1); ov.y = cvt_pk(h2, h3);
      *(u32x2*)(base + (size_t)ci * 8192) = ov;
      const float d = dk[k];
      h0 = h0 * d + bflo(v[k].x); h1 = h1 * d + bfhi(v[k].x); h2 = h2 * d + bflo(v[k].y); h3 = h3 * d + bfhi(v[k].y);
    }
  }
}

NOINL void ssd_out_item(const Params& P, int layer, int b, int cidx, int h, int do_atomic) {
  unsigned char* const smh = smem + half_id() * HSTR;
  const int t = tid_opq(), lane = t & 63, w = t >> 6, r = lane & 15, q = lane >> 4, r7 = r & 7;
  const bf16_t* PROJ = (const bf16_t*)(P.ws + OFF_PROJ);
  const float* DTb = (const float*)(P.ws + OFF_DT);
  const bf16_t* ST = (const bf16_t*)(P.ws + OFF_ST);
  bf16_t* MIX = (bf16_t*)(P.ws + OFF_H);
  float* SSQ = (float*)(P.ws + OFF_SSQ);
  float* sm = (float*)(smh + SM_SMALL);
  int rowbase, lo, hi;
  if (cidx < 2) { lo = T + b * 256; hi = lo + 256; rowbase = lo + cidx * 128; } else { lo = b * 4096; hi = lo + 4096; rowbase = lo + (cidx - 2) * 128; }
  const int g = h >> 2;
  const float Af = -__expf(P.a_log[layer * 16 + h]), Ab = -__expf(P.a_log[layer * 16 + 8 + h]);
  __syncthreads();
  float inf_ = 0.f, inb_ = 0.f, ab_ = 0.f;
  if (t < 128) {
    const float df = softplus_f(DTb[(size_t)(rowbase + t) * 16 + h] + P.dt_bias[layer * 16 + h]);
    const float db = softplus_f(DTb[(size_t)(rowbase + t) * 16 + 8 + h] + P.dt_bias[layer * 16 + 8 + h]);
    sm[256 + t] = df; sm[384 + t] = db;
    ab_ = db * Ab; inf_ = wave_incl_scan(df * Af, lane); inb_ = wave_incl_scan(ab_, lane);
    if (lane == 63) { sm[772 + w] = inf_; sm[774 + w] = inb_; }
  }
  {
    const bf16_t* XTX = (const bf16_t*)(P.ws + OFF_XTX);
#pragma unroll
    for (int k = 0; k < 4; ++k) {
      const int e = t + 256 * k, p = e >> 4, c16 = e & 15;
      *(u32x4*)(smh + SM_XT + p * 272 + c16 * 16) = *(const u32x4*)(XTX + (size_t)(h * 64 + p) * TT + rowbase + c16 * 8);
    }
  }
  __syncthreads();
  if (t < 128) {
    const float acf = inf_ + (w == 1 ? sm[772] : 0.f);
    const float preb = inb_ - ab_ + (w == 1 ? sm[774] : 0.f), totb = sm[774] + sm[775];
    sm[512 + t] = acf; sm[640 + t] = preb;
    if (t == 0) sm[768] = totb;
  }
  __syncthreads();
  f32x4 G[8][2], y[4][2];
#pragma unroll
  for (int jt = 0; jt < 8; ++jt) { G[jt][0] = (f32x4){0.f, 0.f, 0.f, 0.f}; G[jt][1] = (f32x4){0.f, 0.f, 0.f, 0.f}; }
#pragma unroll
  for (int pt = 0; pt < 4; ++pt) { y[pt][0] = (f32x4){0.f, 0.f, 0.f, 0.f}; y[pt][1] = (f32x4){0.f, 0.f, 0.f, 0.f}; }
  float acfi[2], prebi[2], efi[2][2];
#pragma unroll
  for (int it = 0; it < 2; ++it) {
    const int i = 32 * w + 16 * it + r;
    acfi[it] = sm[512 + i]; prebi[it] = sm[640 + i];
    efi[0][it] = __expf(acfi[it]); efi[1][it] = __expf(sm[768] - prebi[it]);
  }
#pragma unroll 1
  for (int nh = 0; nh < 2; ++nh) {
    {
      const bf16_t* XN = (const bf16_t*)(P.ws + OFF_XN);
#pragma unroll
      for (int k = 0; k < 4; ++k) {
        const int e = t + 256 * k, tok = e >> 3, ch = e & 7;
        const bf16_t* src = XN + (size_t)(rowbase + tok) * 512 + g * 128 + nh * 64 + ch * 8;
        *(u32x4*)(smh + SM_BN + tok * 128 + ((ch ^ (tok & 7)) << 4)) = *(const u32x4*)src;
        *(u32x4*)(smh + SM_CN + tok * 128 + ((ch ^ (tok & 7)) << 4)) = *(const u32x4*)(src + 256);
      }
      const int hp_ = t >> 2, hc_ = (t & 3) * 2;
#pragma unroll
      for (int d = 0; d < 2; ++d) {
        const bf16_t* hsrc = ST + ((size_t)(((b * 8 + h) * 2 + d) * 34 + cidx)) * 8192 + hp_ * 128 + nh * 64 + hc_ * 8;
        *(u32x4*)(smh + SM_RAW + d * 8192 + hp_ * 128 + ((hc_ ^ (hp_ & 7)) << 4)) = *(const u32x4*)hsrc;
        *(u32x4*)(smh + SM_RAW + d * 8192 + hp_ * 128 + (((hc_ + 1) ^ (hp_ & 7)) << 4)) = *(const u32x4*)(hsrc + 8);
      }
    }
    __syncthreads();
    bf16x8 cf[2][2];
#pragma unroll
    for (int it = 0; it < 2; ++it)
#pragma unroll
      for (int s = 0; s < 2; ++s) cf[it][s] = *(const bf16x8*)(smh + SM_CN + (32 * w + 16 * it + r) * 128 + (((4 * s + q) ^ r7) << 4));
#pragma unroll
    for (int jt = 0; jt < 8; ++jt)
#pragma unroll
      for (int s = 0; s < 2; ++s) {
        const bf16x8 bfr = *(const bf16x8*)(smh + SM_BN + (16 * jt + r) * 128 + (((4 * s + q) ^ r7) << 4));
        G[jt][0] = mfma16(bfr, cf[0][s], G[jt][0]); G[jt][1] = mfma16(bfr, cf[1][s], G[jt][1]);
      }
#pragma unroll
    for (int d = 0; d < 2; ++d) {
#pragma unroll
      for (int s = 0; s < 2; ++s) {
        union { bf16x8 b; u32x4 u; } c0, c1; c0.b = cf[0][s]; c1.b = cf[1][s];
        const bf16x8 cs0 = as_bf16x8(scale8(c0.u, efi[d][0])), cs1 = as_bf16x8(scale8(c1.u, efi[d][1]));
#pragma unroll
        for (int pt = 0; pt < 4; ++pt) {
          const bf16x8 hf = *(const bf16x8*)(smh + SM_RAW + d * 8192 + (16 * pt + r) * 128 + (((4 * s + q) ^ r7) << 4));
          y[pt][0] = mfma16(hf, cs0, y[pt][0]); y[pt][1] = mfma16(hf, cs1, y[pt][1]);
        }
      }
    }
    __syncthreads();
  }
#pragma unroll
  for (int s = 0; s < 4; ++s) {
    asm volatile("" ::: "memory");
    bf16x8 mf[2];
    const int wu = __builtin_amdgcn_readfirstlane(w);
    if (s < wu) {
      float aj[8], dfj[8];
#pragma unroll
      for (int jj = 0; jj < 8; ++jj) { const int j = 32 * s + (jj < 4 ? 4 * q + jj : 16 + 4 * q + jj - 4); aj[jj] = sm[512 + j]; dfj[jj] = sm[256 + j]; }
#pragma unroll
      for (int it = 0; it < 2; ++it) {
        float mv[8];
#pragma unroll
        for (int jj = 0; jj < 8; ++jj) mv[jj] = G[2 * s + (jj >> 2)][it][jj & 3] * __expf(acfi[it] - aj[jj]) * dfj[jj];
        u32x4 pk; pk.x = cvt_pk(mv[0], mv[1]); pk.y = cvt_pk(mv[2], mv[3]); pk.z = cvt_pk(mv[4], mv[5]); pk.w = cvt_pk(mv[6], mv[7]);
        mf[it] = as_bf16x8(pk);
      }
    } else if (s > wu) {
      float pj[8], dbj[8];
#pragma unroll
      for (int jj = 0; jj < 8; ++jj) { const int j = 32 * s + (jj < 4 ? 4 * q + jj : 16 + 4 * q + jj - 4); pj[jj] = sm[640 + j]; dbj[jj] = sm[384 + j]; }
#pragma unroll
      for (int it = 0; it < 2; ++it) {
        float mv[8];
#pragma unroll
        for (int jj = 0; jj < 8; ++jj) mv[jj] = G[2 * s + (jj >> 2)][it][jj & 3] * __expf(pj[jj] - prebi[it]) * dbj[jj];
        u32x4 pk; pk.x = cvt_pk(mv[0], mv[1]); pk.y = cvt_pk(mv[2], mv[3]); pk.z = cvt_pk(mv[4], mv[5]); pk.w = cvt_pk(mv[6], mv[7]);
        mf[it] = as_bf16x8(pk);
      }
    } else {
    float aj[8], pj[8], dfj[8], dbj[8];
#pragma unroll
    for (int jj = 0; jj < 8; ++jj) { const int j = 32 * s + (jj < 4 ? 4 * q + jj : 16 + 4 * q + jj - 4); aj[jj] = sm[512 + j]; pj[jj] = sm[640 + j]; dfj[jj] = sm[256 + j]; dbj[jj] = sm[384 + j]; }
#pragma unroll
    for (int it = 0; it < 2; ++it) {
      const int i = 32 * w + 16 * it + r;
      float mv[8];
#pragma unroll
      for (int jj = 0; jj < 8; ++jj) {
        const int j = 32 * s + (jj < 4 ? 4 * q + jj : 16 + 4 * q + jj - 4);
        const float gv = G[2 * s + (jj >> 2)][it][jj & 3];
        float m;
        if (j < i) m = gv * __expf(acfi[it] - aj[jj]) * dfj[jj];
        else if (j > i) m = gv * __expf(pj[jj] - prebi[it]) * dbj[jj];
        else m = gv * (dfj[jj] + dbj[jj]);
        mv[jj] = m;
      }
      u32x4 pk; pk.x = cvt_pk(mv[0], mv[1]); pk.y = cvt_pk(mv[2], mv[3]); pk.z = cvt_pk(mv[4], mv[5]); pk.w = cvt_pk(mv[6], mv[7]);
      mf[it] = as_bf16x8(pk);
    }
    }
#pragma unroll
    for (int pt = 0; pt < 4; ++pt) {
      const u32x2 lo2 = *(const u32x2*)(smh + SM_XT + (16 * pt + r) * 272 + (32 * s + 4 * q) * 2);
      const u32x2 hi2 = *(const u32x2*)(smh + SM_XT + (16 * pt + r) * 272 + (32 * s + 16 + 4 * q) * 2);
      const bf16x8 xf = as_bf16x8((u32x4){lo2.x, lo2.y, hi2.x, hi2.y});
      y[pt][0] = mfma16(xf, mf[0], y[pt][0]); y[pt][1] = mfma16(xf, mf[1], y[pt][1]);
    }
  }
  const float dsk = P.ssm_d[layer * 8 + h];
  const bf16_t* XT = (const bf16_t*)(smh + SM_XT);
  u32x2 zq[2][4]; f32x4 gq[4];
#pragma unroll
  for (int pt = 0; pt < 4; ++pt) {
    gq[pt] = *(const f32x4*)(P.ssm_g + layer * 512 + h * 64 + 16 * pt + 4 * q);
#pragma unroll
    for (int it = 0; it < 2; ++it) zq[it][pt] = *(const u32x2*)(PROJ + (size_t)(rowbase + 32 * w + 16 * it + r) * PW + 512 + h * 64 + 16 * pt + 4 * q);
  }
#pragma unroll
  for (int it = 0; it < 2; ++it) {
    const int i = 32 * w + 16 * it + r; const int row = rowbase + i;
    float ss = 0.f;
#pragma unroll
    for (int pt = 0; pt < 4; ++pt) {
      const int p0 = 16 * pt + 4 * q;
      const u32x2 zz = zq[it][pt];
      const f32x4 gg = gq[pt];
      const float zv[4] = {bflo(zz.x), bfhi(zz.x), bflo(zz.y), bfhi(zz.y)};
      float ov[4];
#pragma unroll
      for (int e = 0; e < 4; ++e) {
        const float xs = bf2f(XT[(p0 + e) * 136 + i]);
        const float yz = (y[pt][it][e] + dsk * xs) * silu_f(zv[e]);
        ss += yz * yz; ov[e] = yz * gg[e];
      }
      u32x2 o; o.x = cvt_pk(ov[0], ov[1]); o.y = cvt_pk(ov[2], ov[3]);
      *(u32x2*)(MIX + (size_t)row * 1024 + h * 64 + p0) = o;
    }
    ss += __shfl_xor(ss, 16); ss += __shfl_xor(ss, 32);
    if (q == 0 && do_atomic) atomicAdd(SSQ + row, ss);
  }
}

DEVI void mixer1_phase(const Params& P, int layer) {
  const int nA = 512, nV = 4 * 34 * 16, nC = (layer == 0) ? 64 : 0;
  const int total = nA + nV + nC;
#pragma unroll 1
  for (int it = VB; it < total; it += VG) {
    if (it < nA || it >= nA + nV) {
      int b, i1, i2; bool isctx = it >= nA;
      if (!isctx) { b = it >> 7; i1 = (it >> 2) & 31; i2 = it & 3; }
      else { const int e = it - nA - nV; b = e >> 4; i1 = (e >> 3) & 1; i2 = e & 7; }
      attn_item<0>(P, layer, b, i1, i2, isctx ? 1 : 0);
    } else { const int e = it - nA; const int b = e / 544, rem = e % 544; conv_item(P, layer, b, rem >> 4, rem & 15); }
  }
}
DEVI void mixer2_phase(const Params& P, int layer) {
  const int nB = 1024, nS = 4 * 34 * 8;
  const int total = nB + nS;
#pragma unroll 1
  for (int it = VB; it < total; it += VG) {
    if (it < nB) { const int b = it >> 8, gr = (it >> 2) & 63, h = it & 3; attn_item<1>(P, layer, b, gr, h, 0); }
    else { const int e = it - nB; const int b = e / 272, rem = e % 272; ssd_state_item(P, layer, b, rem >> 3, rem & 7); }
  }
}

DEVI void ssd_out_phase(const Params& P, int layer, int do_atomic = 1) {
  const int c0 = (layer == 0) ? 0 : 2;
  const int nc = 34 - c0;
  const int total = 4 * nc * 8;
#pragma unroll 1
  for (int it = VB; it < total; it += VG) {
    const int b = it / (nc * 8), rem = it % (nc * 8);
    ssd_out_item(P, layer, b, c0 + (rem >> 3), rem & 7, do_atomic);
  }
}


#define XB_TMO      128
#define XB_XCNT(j)  (256  + 64 * (j))
#define XB_XSUB(j)  (1280 + 64 * (j))
#define XB_XGEN(j)  (2304 + 64 * (j))
#define XB_TOP      3328
#define XB_TOPGEN   3392
#define XB_SPIN_CAP (1u << 18)
#define LAS __attribute__((address_space(3)))
DEVI unsigned xb_ld(unsigned* p)              { return __hip_atomic_load(p, __ATOMIC_RELAXED, __HIP_MEMORY_SCOPE_AGENT); }
DEVI unsigned xb_add(unsigned* p, unsigned v) { return __hip_atomic_fetch_add(p, v, __ATOMIC_RELAXED, __HIP_MEMORY_SCOPE_AGENT); }
DEVI unsigned xb_xcc_id() { return (unsigned)__builtin_amdgcn_s_getreg((3 << 11) | 20) & 0xFu; }
#define XB_SPIN(cond, bar) do { unsigned _sp = 0; while (cond) { __builtin_amdgcn_s_sleep(1); \
    if ((++_sp & 255u) == 0u) { if (xb_ld(&(bar)[XB_TMO])) break; if (_sp > XB_SPIN_CAP) { atomicAdd(&(bar)[XB_TMO], 1u); break; } } } } while (0)
struct XcdBarrier { unsigned* bar; unsigned x; volatile LAS unsigned* st; };
DEVI XcdBarrier xcd_barrier_post(unsigned* bar, volatile LAS unsigned* st) {
  XcdBarrier b; b.bar = bar; b.x = xb_xcc_id(); b.st = st;
  if (threadIdx.x == 0) (void)xb_add(&bar[XB_XCNT(b.x)], 1u);
  return b;
}
DEVI void xcd_barrier_complete(unsigned* bar, unsigned x, unsigned& nloc, unsigned& nx) {
  const unsigned G = gridDim.x * gridDim.y * gridDim.z;
  unsigned sum, cnt, mine, sp = 0u;
  for (;;) {
    sum = 0u; cnt = 0u; mine = 0u;
#pragma unroll
    for (unsigned j = 0; j < 16; ++j) { const unsigned c = xb_ld(&bar[XB_XCNT(j)]); sum += c; cnt += (c > 0u) ? 1u : 0u; mine = (j == x) ? c : mine; }
    if (sum == G) break;
    __builtin_amdgcn_s_sleep(1);
    if ((++sp & 255u) == 0u) { if (xb_ld(&bar[XB_TMO])) break; if (sp > XB_SPIN_CAP) { atomicAdd(&bar[XB_TMO], 1u); break; } }
  }
  nloc = mine > 0u ? mine : 1u; nx = cnt > 0u ? cnt : 1u;
}
DEVI void xcd_barrier(const XcdBarrier& b) {
  asm volatile("s_waitcnt vmcnt(0)" ::: "memory");
  __syncthreads();
  if (threadIdx.x == 0) {
    unsigned* bar = b.bar;
    __builtin_amdgcn_s_waitcnt(0);
    unsigned nloc = b.st[0], nx = b.st[1];
    if (nloc == 0u) { xcd_barrier_complete(bar, b.x, nloc, nx); b.st[0] = nloc; b.st[1] = nx; }
    const unsigned old = xb_add(&bar[XB_XSUB(b.x)], 1u);
    const unsigned gen = old / nloc;
    if (old + 1u == (gen + 1u) * nloc) {
      __builtin_amdgcn_fence(__ATOMIC_RELEASE, "agent");
      asm volatile("s_waitcnt vmcnt(0)" ::: "memory");
      const unsigned og = xb_add(&bar[XB_TOP], 1u);
      const unsigned tg = og / nx;
      if (og + 1u == (tg + 1u) * nx) xb_add(&bar[XB_TOPGEN], 1u);
      else XB_SPIN(xb_ld(&bar[XB_TOPGEN]) == tg, bar);
      __builtin_amdgcn_fence(__ATOMIC_ACQUIRE, "agent");
      xb_add(&bar[XB_XGEN(b.x)], 1u);
      asm volatile("s_waitcnt vmcnt(0)" ::: "memory");
    } else {
      XB_SPIN(xb_ld(&bar[XB_XGEN(b.x)]) == gen, bar);
      __builtin_amdgcn_fence(__ATOMIC_ACQUIRE, "agent");
      asm volatile("s_waitcnt vmcnt(0)" ::: "memory");
    }
  }
  __syncthreads();
}

__global__ void __launch_bounds__(512, 2) mega_fwd(Params P) {
  cg::grid_group grid = cg::this_grid();
  if (threadIdx.x == 0) *(uint4*)(smem + SM_XB) = make_uint4(0u, 0u, 0u, 0u);
  __syncthreads();
  XcdBarrier xb = xcd_barrier_post((unsigned*)(P.ws + OFF_BAR), (volatile LAS unsigned*)(smem + SM_XB));
  if (P.ph_hi > 1000) grid.sync();
#define BAR() xcd_barrier(xb)
#ifndef REP_S
#define REP_S -1
#endif
#define RUN(S_, CALL) { if (REP_S == (S_)) { const int do_at = 0; (void)do_at; CALL; BAR(); } { const int do_at = 1; (void)do_at; CALL; } BAR(); }
#define LAYER(l) \
  RUN(0, (norm_phase(P, l, 0), (l == 1 ? prep_phase(P, 1, false) : (void)0))) \
  RUN(1, (gemm_phase<MODE_INPROJ, false>(P, l))) \
  RUN(2, mixer1_phase(P, l)) \
  RUN(9, mixer2_phase(P, l)) \
  RUN(3, ssd_scan_phase(P)) \
  RUN(4, ssd_out_phase(P, l, do_at)) \
  RUN(5, (gemm_phase<MODE_RESID, true>(P, l))) \
  RUN(6, norm_phase(P, l, 1)) \
  RUN(7, (gemm_phase<MODE_SWIGLU, false>(P, l))) \
  RUN(8, (gemm_phase<MODE_RESID, false>(P, l)))
  prep_phase(P, 0, true); BAR();
  LAYER(0)
  LAYER(1)
  final_norm_phase(P);
}

extern "C" void kernel_launch(void* const* d_in, const int* in_sizes, int n_in, void* d_out, int out_size, void* d_ws, size_t ws_size, hipStream_t stream) {
  static int grid_blocks = 0;
  if (!grid_blocks) {
    int dev = 0, cus = 0, per_cu = 0;
    hipGetDevice(&dev);
    hipDeviceGetAttribute(&cus, hipDeviceAttributeMultiprocessorCount, dev);
    hipOccupancyMaxActiveBlocksPerMultiprocessor(&per_cu, mega_fwd, 512, 0);
    if (per_cu < 1) per_cu = 1;
    if (per_cu > 1) per_cu = 1;
    grid_blocks = cus * per_cu;
    if (ws_size < WS_END) fprintf(stderr, "kernel_launch: workspace too small: %zu < %zu\n", ws_size, (size_t)WS_END);
  }
  Params p{};
  const float** pp = (const float**)&p;
  for (int i = 0; i < 21; ++i) pp[i] = (const float*)d_in[i];
  p.out = (float*)d_out; p.ws = (unsigned char*)d_ws;
  hipMemsetAsync((unsigned char*)d_ws + OFF_MODS, 0, SZ_MODS + SZ_BAR, stream);
#if LAUNCH_PER_PHASE
  for (int ph = 0; ph < NPH; ++ph) {
    p.ph_lo = ph; p.ph_hi = ph + 1;
    hipLaunchKernelGGL(mega_fwd, dim3(grid_blocks), dim3(256), 0, stream, p);
  }
#else
  p.ph_lo = 0; p.ph_hi = NPH;
  void* args[] = {&p};
  hipError_t e = hipLaunchCooperativeKernel((void*)mega_fwd, dim3(grid_blocks), dim3(512), args, 0, stream);
  if (e != hipSuccess) fprintf(stderr, "cooperative launch failed: %s (grid %d)\n", hipGetErrorString(e), grid_blocks);
#endif
}
```

```cpp
#include <hip/hip_runtime.h>
#include <hip/hip_cooperative_groups.h>
#include <cstdio>
#include <cstdint>
namespace cg = cooperative_groups;

#ifndef LAUNCH_PER_PHASE
#define LAUNCH_PER_PHASE 0
#endif

typedef unsigned short bf16_t;
typedef short bf16x8 __attribute__((ext_vector_type(8)));
typedef float f32x4 __attribute__((ext_vector_type(4)));
typedef unsigned u32x4 __attribute__((ext_vector_type(4)));
typedef unsigned u32x2 __attribute__((ext_vector_type(2)));
#define DEVI __device__ __forceinline__

constexpr int T = 16384, TC = 1024, TT = T + TC;
constexpr int PW = 2816;
constexpr int NPH = 20;
constexpr float EPSN = 1e-6f;

constexpr size_t SZ_WIN = (size_t)2944 * 1024 * 2, SZ_WOUT = (size_t)1024 * 1024 * 2, SZ_WFI = (size_t)5632 * 1024 * 2, SZ_WFO = (size_t)1024 * 2816 * 2;
constexpr size_t OFF_WIN = 0;
constexpr size_t OFF_WOUT = OFF_WIN + SZ_WIN;
constexpr size_t OFF_WFI = OFF_WOUT + SZ_WOUT;
constexpr size_t OFF_WFO = OFF_WFI + SZ_WFI;
constexpr size_t OFF_H = OFF_WFO + SZ_WFO;
constexpr size_t OFF_PROJ = OFF_H + (size_t)TT * 1024 * 2;
constexpr size_t OFF_VT = OFF_PROJ + (size_t)TT * PW * 2;
constexpr size_t OFF_DT = OFF_VT + (size_t)384 * TT * 2;
constexpr size_t OFF_XC = OFF_DT + (size_t)TT * 16 * 4;
constexpr size_t OFF_MODS = OFF_XC + (size_t)TC * 1024 * 4;
constexpr size_t SZ_MODS = (size_t)2 * 5 * 6144 * 4;
constexpr size_t OFF_BAR = OFF_MODS + SZ_MODS;
constexpr size_t SZ_BAR = 3456 * 4;
constexpr size_t OFF_SSQ = OFF_BAR + SZ_BAR;
constexpr size_t OFF_ST = OFF_SSQ + (size_t)TT * 4;
constexpr size_t OFF_CD = OFF_ST + (size_t)64 * 34 * 8192 * 2;
constexpr size_t OFF_ROPE = OFF_CD + (size_t)64 * 34 * 4;
constexpr size_t OFF_XN = OFF_ROPE + 2 * 1024 * 4;
constexpr size_t OFF_XTX = OFF_XN + (size_t)TT * 512 * 2;
constexpr size_t OFF_XTB = OFF_XTX + (size_t)512 * TT * 2;
constexpr size_t WS_END = OFF_XTB + (size_t)256 * TT * 2;
static_assert(WS_END <= (size_t)256 * 1024 * 1024, "workspace map exceeds 256 MiB");

struct Params {
  const float *x, *c, *ctx, *c_ctx, *w_mod, *b_mod, *g_mix, *w_in, *wa_sink, *na_rpb, *conv_w, *conv_b, *dt_bias, *a_log, *ssm_d, *ssm_g, *w_out, *g_ffn, *w_ffn_in, *w_ffn_out, *g_final;
  float* out; unsigned char* ws; int ph_lo, ph_hi;
};

constexpr int HSTR = 73728, SM_XB = 2 * HSTR, SMEM_BYTES = 2 * HSTR + 16;
__shared__ __attribute__((aligned(16))) unsigned char smem[SMEM_BYTES];
#define NOINL __device__ __forceinline__

typedef __bf16 bf16x2_t __attribute__((ext_vector_type(2)));
typedef float f32x2_t __attribute__((ext_vector_type(2)));
DEVI unsigned cvt_pk(float lo, float hi) { f32x2_t v = {lo, hi}; bf16x2_t b = __builtin_convertvector(v, bf16x2_t); return __builtin_bit_cast(unsigned, b); }
DEVI float bflo(unsigned u) { return __uint_as_float(u << 16); }
DEVI float bfhi(unsigned u) { return __uint_as_float(u & 0xffff0000u); }
DEVI float bf2f(bf16_t h) { return __uint_as_float((unsigned)h << 16); }
DEVI float silu_f(float v) { return v * __builtin_amdgcn_rcpf(1.f + __expf(-v)); }
DEVI float softplus_f(float v) { const float e = __expf(v); return v > 20.f ? v : (e < 1e-3f ? e * (1.f - 0.5f * e) : __logf(1.f + e)); }
DEVI float wave_sum(float v) {
#pragma unroll
  for (int o = 32; o > 0; o >>= 1) v += __shfl_xor(v, o);
  return v;
}
DEVI float wave_incl_scan(float v, int lane) {
#pragma unroll
  for (int o = 1; o < 64; o <<= 1) { const float u = __shfl_up(v, o); if (lane >= o) v += u; }
  return v;
}
DEVI f32x4 mfma16(bf16x8 a, bf16x8 b, f32x4 c) { return __builtin_amdgcn_mfma_f32_16x16x32_bf16(a, b, c, 0, 0, 0); }
DEVI bf16x8 as_bf16x8(u32x4 v) { union { u32x4 u; bf16x8 b; } x; x.u = v; return x.b; }

DEVI u32x4 scale8(u32x4 v, float s) {
  u32x4 o;
  o.x = cvt_pk(bflo(v.x) * s, bfhi(v.x) * s); o.y = cvt_pk(bflo(v.y) * s, bfhi(v.y) * s);
  o.z = cvt_pk(bflo(v.z) * s, bfhi(v.z) * s); o.w = cvt_pk(bflo(v.w) * s, bfhi(v.w) * s);
  return o;
}
DEVI int tid_opq() { int t; asm volatile("v_mov_b32 %0, %1" : "=v"(t) : "v"((int)(threadIdx.x & 255))); return t; }
DEVI int half_id() { return __builtin_amdgcn_readfirstlane((int)(threadIdx.x >> 8)); }
#define VB (blockIdx.x * 2 + half_id())
#define VG (gridDim.x * 2)
DEVI int ufy(int v) { return __builtin_amdgcn_readfirstlane(v); }

NOINL void prep_phase(const Params& P, int wl, bool full) {
  unsigned char* const smh = smem + half_id() * HSTR;
  float* tile = (float*)smh;
  const int t = tid_opq();
  constexpr int I_IN = 46 * 16, I_OUT = 16 * 16, I_FI = 88 * 16, I_FO = 16 * 44, I_L = I_IN + I_OUT + I_FI + I_FO;
  constexpr int I_MOD = 2 * 16 * 24;
  const int total = I_L + (full ? I_MOD + 1 : 0);
  for (int it = VB; it < total; it += VG) {
    if (it < I_L) {
      const int l = wl; int r = it;
      const float* W; bf16_t* Wt; int K, N, kind, nt_, kt_;
      if (r < I_IN) { kind = 0; W = P.w_in + (size_t)l * 1024 * 2832; N = 2832; K = 1024; Wt = (bf16_t*)(P.ws + OFF_WIN); nt_ = r / 16; kt_ = r % 16; }
      else if (r < I_IN + I_OUT) { r -= I_IN; kind = 1; W = P.w_out + (size_t)l * 1024 * 1024; N = 1024; K = 1024; Wt = (bf16_t*)(P.ws + OFF_WOUT); nt_ = r / 16; kt_ = r % 16; }
      else if (r < I_IN + I_OUT + I_FI) { r -= I_IN + I_OUT; kind = 2; W = P.w_ffn_in + (size_t)l * 1024 * 5632; N = 5632; K = 1024; Wt = (bf16_t*)(P.ws + OFF_WFI); nt_ = r / 16; kt_ = r % 16; }
      else { r -= I_IN + I_OUT + I_FI; kind = 3; W = P.w_ffn_out + (size_t)l * 2816 * 1024; N = 1024; K = 2816; Wt = (bf16_t*)(P.ws + OFF_WFO); nt_ = r / 44; kt_ = r % 44; }
      {
        const int n4 = (t & 15) * 4, np = nt_ * 64 + n4;
        int col;
        if (kind == 0) {
          const int cb_ = np & ~127, w_ = np & 127;
          const bool plain_ = np < 2816 && !(cb_ < 256 || cb_ == 1024 || cb_ == 1152 || cb_ == 1536 || cb_ == 1664);
          col = np < 2832 ? (plain_ ? cb_ + (w_ >> 5) * 32 + ((w_ >> 2) & 3) * 8 + ((w_ >> 4) & 1) * 4 + (w_ & 3) : np) : -1;
        }
        else if (kind == 2) { const int w_ = np & 255;
          col = ((w_ >> 4) & 1) * 2816 + (np >> 8) * 128 + ((w_ >> 5) & 3) * 32 + ((w_ >> 2) & 3) * 8 + (w_ >> 7) * 4 + (w_ & 3); }
        else col = np;
#pragma unroll
        for (int i = 0; i < 4; ++i) {
          const int kk = i * 16 + (t >> 4);
          f32x4 v = (f32x4){0.f, 0.f, 0.f, 0.f};
          const int ksrc = kind == 1 ? ((kt_ * 64 + kk + 512) & 1023) : (kt_ * 64 + kk);
          if (col >= 0) v = *(const f32x4*)(W + (size_t)ksrc * N + col);
          tile[kk * 65 + n4] = v[0]; tile[kk * 65 + n4 + 1] = v[1]; tile[kk * 65 + n4 + 2] = v[2]; tile[kk * 65 + n4 + 3] = v[3];
        }
      }
      __syncthreads();
      {
        const int n = t >> 2, kc = (t & 3) * 16;
        u32x4 o0, o1;
        o0.x = cvt_pk(tile[(kc + 0) * 65 + n], tile[(kc + 1) * 65 + n]); o0.y = cvt_pk(tile[(kc + 2) * 65 + n], tile[(kc + 3) * 65 + n]);
        o0.z = cvt_pk(tile[(kc + 4) * 65 + n], tile[(kc + 5) * 65 + n]); o0.w = cvt_pk(tile[(kc + 6) * 65 + n], tile[(kc + 7) * 65 + n]);
        o1.x = cvt_pk(tile[(kc + 8) * 65 + n], tile[(kc + 9) * 65 + n]); o1.y = cvt_pk(tile[(kc + 10) * 65 + n], tile[(kc + 11) * 65 + n]);
        o1.z = cvt_pk(tile[(kc + 12) * 65 + n], tile[(kc + 13) * 65 + n]); o1.w = cvt_pk(tile[(kc + 14) * 65 + n], tile[(kc + 15) * 65 + n]);
        bf16_t* dst = Wt + (size_t)(nt_ * 64 + n) * K + kt_ * 64 + kc;
        *(u32x4*)dst = o0; *(u32x4*)(dst + 8) = o1;
      }
      __syncthreads();
    } else if (it < I_L + I_MOD) {
      const int m = it - I_L; const int l = m / 384, rem = m % 384, kc = rem / 24, cb = rem % 24;
      float* sv = (float*)smh;
      for (int e = t; e < 320; e += 256) { const int r = e >> 6, k = kc * 64 + (e & 63); const float v = r < 4 ? P.c[r * 1024 + k] : P.c_ctx[k]; sv[e] = v / (1.f + __expf(-v)); }
      __syncthreads();
      const int n = cb * 256 + t;
      float a0 = 0.f, a1 = 0.f, a2 = 0.f, a3 = 0.f, a4 = 0.f;
      const float* wp = P.w_mod + ((size_t)l * 1024 + kc * 64) * 6144 + n;
#pragma unroll 8
      for (int kk = 0; kk < 64; ++kk) { const float w = wp[(size_t)kk * 6144]; a0 += sv[kk] * w; a1 += sv[64 + kk] * w; a2 += sv[128 + kk] * w; a3 += sv[192 + kk] * w; a4 += sv[256 + kk] * w; }
      if (kc == 0) { const float bb = P.b_mod[l * 6144 + n]; a0 += bb; a1 += bb; a2 += bb; a3 += bb; a4 += bb; }
      float* md = (float*)(P.ws + OFF_MODS) + (size_t)l * 5 * 6144 + n;
      atomicAdd(md, a0); atomicAdd(md + 6144, a1); atomicAdd(md + 2 * 6144, a2); atomicAdd(md + 3 * 6144, a3); atomicAdd(md + 4 * 6144, a4);
      __syncthreads();
    } else {
      float* rc = (float*)(P.ws + OFF_ROPE);
      for (int e = t; e < 1024; e += 256) { const int pos = e >> 4, i = e & 15; const float inv = __builtin_amdgcn_exp2f(-(float)i * (13.287712379549449f / 16.f)); float xr = (float)pos * inv * 0.15915494309189535f; xr -= floorf(xr); rc[e] = __builtin_amdgcn_cosf(xr); rc[1024 + e] = __builtin_amdgcn_sinf(xr); }
    }
  }
}

NOINL void norm_phase(const Params& P, int layer, int which) {
  const float* src_lat = (layer == 0 && which == 0) ? P.x : P.out; const float* src_ctx = (layer == 0 && which == 0) ? P.ctx : (const float*)(P.ws + OFF_XC);
  const int M = (which == 0 || layer == 0) ? TT : T;
  const int t_ = tid_opq(); const int lane = t_ & 63, wv = t_ >> 6;
  const int gw = VB * 4 + wv, nw = VG * 4;
  const float* g = (which == 0 ? P.g_mix : P.g_ffn) + layer * 1024;
  bf16_t* H = (bf16_t*)(P.ws + OFF_H);
  float* ssq = (float*)(P.ws + OFF_SSQ);
  for (int row = gw; row < M; row += nw) {
    const float* xr = row < T ? src_lat + (size_t)row * 1024 : src_ctx + (size_t)(row - T) * 1024;
    const int mr = row < T ? (row >> 12) : 4;
    const float* md = (const float*)(P.ws + OFF_MODS) + (size_t)(layer * 5 + mr) * 6144 + which * 3072;
    f32x4 v[4]; float s = 0.f;
#pragma unroll
    for (int j = 0; j < 4; ++j) { v[j] = *(const f32x4*)(xr + 4 * (lane + 64 * j)); s += v[j][0] * v[j][0] + v[j][1] * v[j][1] + v[j][2] * v[j][2] + v[j][3] * v[j][3]; }
    s = wave_sum(s);
    const float rstd = rsqrtf(s * (1.f / 1024.f) + EPSN);
    f32x4 ggv[4], shv[4], scv[4];
#pragma unroll
    for (int j = 0; j < 4; ++j) { const int k = 4 * (lane + 64 * j); ggv[j] = *(const f32x4*)(g + k); shv[j] = *(const f32x4*)(md + k); scv[j] = *(const f32x4*)(md + 1024 + k); }
#pragma unroll
    for (int j = 0; j < 4; ++j) {
      const int k = 4 * (lane + 64 * j);
      const f32x4 gg = ggv[j], sh = shv[j], sc = scv[j];
      f32x4 h;
#pragma unroll
      for (int e = 0; e < 4; ++e) h[e] = v[j][e] * rstd * gg[e] * (1.f + sc[e]) + sh[e];
      u32x2 o; o.x = cvt_pk(h[0], h[1]); o.y = cvt_pk(h[2], h[3]);
      *(u32x2*)(H + (size_t)row * 1024 + k) = o;
    }
    if (which == 0 && lane == 0) ssq[row] = 0.f;
  }
}

NOINL void final_norm_phase(const Params& P) {
  const int t_ = tid_opq(); const int lane = t_ & 63, wv = t_ >> 6;
  const int gw = VB * 4 + wv, nw = VG * 4;
  for (int row = gw; row < T; row += nw) {
    float* xr = P.out + (size_t)row * 1024;
    f32x4 v[4]; float s = 0.f;
#pragma unroll
    for (int j = 0; j < 4; ++j) { v[j] = *(const f32x4*)(xr + 4 * (lane + 64 * j)); s += v[j][0] * v[j][0] + v[j][1] * v[j][1] + v[j][2] * v[j][2] + v[j][3] * v[j][3]; }
    s = wave_sum(s);
    const float rstd = rsqrtf(s * (1.f / 1024.f) + EPSN);
#pragma unroll
    for (int j = 0; j < 4; ++j) {
      const int k = 4 * (lane + 64 * j);
      const f32x4 gg = *(const f32x4*)(P.g_final + k);
      f32x4 h;
#pragma unroll
      for (int e = 0; e < 4; ++e) h[e] = v[j][e] * rstd * gg[e];
      *(f32x4*)(xr + k) = h;
    }
  }
}

namespace pg8 {
#define PG8_LAS __attribute__((address_space(3)))
typedef unsigned short bf16_t;
typedef short bf16x8 __attribute__((ext_vector_type(8)));
typedef float f32x4 __attribute__((ext_vector_type(4)));
typedef unsigned u32x4 __attribute__((ext_vector_type(4)));
constexpr int BM = 256, BK = 64, HALF = 128, HTB = HALF * BK * 2  , STAGE_BYTES = 8 * HTB, NXCD = 8, WGM = 8;

__host__ __device__ __forceinline__ int lds_byte(int r, int c) { const int st = (r >> 4) * 2 + (c >> 5), rr = r & 15, cc = c & 31, ob = rr * 64 + cc * 2; return st * 1024 + (ob ^ (((ob >> 9) & 1) << 5)); }
__host__ __device__ __forceinline__ void stage_rc(int b, int& R, int& C) { const int st = b / 1024, sb = b % 1024, swz = sb ^ (((sb >> 9) & 1) << 5); R = (st >> 1) * 16 + swz / 64; C = (st & 1) * 32 + (swz % 64) / 2; }
__host__ __device__ __forceinline__ int perm32(int rho) { const int n = rho >> 4, i = rho & 15; return 8 * (i >> 2) + 4 * n + (i & 3); }

struct Unit { int pm, pn; };
struct Gemm { const bf16_t* A; const bf16_t* Bt; int M, N, K; };

struct StaticOrder {
    int nM, nN, nwg, G, c;
    __host__ __device__ void init(int M, int N, int G_, int c_) { nM = M / BM; nN = N / BM; nwg = nM * nN; G = G_; c = c_; }
    __host__ __device__ bool next(int i, Unit& u) const {
        const long L = (long)i * G + c; if (L >= nwg) return false;
        int wgid = (int)L; { const int q = nwg / NXCD, r = nwg % NXCD, xcd = wgid % NXCD, off = wgid / NXCD; wgid = (xcd < r ? xcd * (q + 1) : r * (q + 1) + (xcd - r) * q) + off; }
        const int nig = WGM * nN, gid = wgid / nig, fm = gid * WGM, gsz = (nM - fm) < WGM ? (nM - fm) : WGM;
        u.pm = fm + ((wgid % nig) % gsz); u.pn = (wgid % nig) / gsz; return true;
    }
    __device__ __forceinline__ void a_ready(const Unit&) const {}
    __device__ __forceinline__ void done(const Unit&) const {}
};

template <class Epi, class Sched, bool ALIGN_EPI = false, bool SP2 = false>
__device__ __forceinline__ void gemm_phase(PG8_LAS unsigned char* lds, const Gemm g, const Sched& S, const Epi& E) {
    int tid_; asm volatile("v_mov_b32 %0, %1" : "=v"(tid_) : "v"((int)threadIdx.x)); const int tid = tid_, wid = __builtin_amdgcn_readfirstlane(tid >> 6), lane = tid & 63, wr = wid >> 2, wc = wid & 3, fr = lane & 15, fq = lane >> 4;
    const int K = g.K, nt = K / BK;
    unsigned voffA[2], voffB[2];
#pragma unroll
    for (int i = 0; i < 2; ++i) { int R, C; stage_rc(tid * 16 + i * 8192, R, C); const int Rb = Epi::PERM ? ((R & ~31) + perm32(R & 31)) : R;
        voffA[i] = (unsigned)(R * K + C) * 2u; voffB[i] = (unsigned)(Rb * K + C) * 2u; }
    const size_t kstep = (size_t)(BK * 2);
    const size_t hstep = (size_t)HALF * K * 2;
    const size_t tstep = 2 * hstep;
    const unsigned ldsw = (unsigned)wid * 1024u;
    const int aoff = lds_byte(wr * 64 + fr, fq * 8), boff = lds_byte(wc * 32 + fr, fq * 8);
#define PG8_SA(b, h) (((b) * 2 + (h)) * HTB)
#define PG8_SB(b, h) ((4 + (b) * 2 + (h)) * HTB)
#define PG8_STAGE(bufoff, gbase, voff) do { _Pragma("unroll") for (int _i = 0; _i < 2; ++_i) \
        __builtin_amdgcn_global_load_lds((const unsigned*)((const char*)(gbase) + (voff)[_i]), (PG8_LAS unsigned*)(lds + (bufoff) + ldsw + _i * 8192), 16, 0, 0); } while (0)
#define PG8_LDA(dst, b, h) do { _Pragma("unroll") for (int m = 0; m < 4; ++m) _Pragma("unroll") for (int k = 0; k < 2; ++k) dst[m][k] = *(const PG8_LAS bf16x8*)(lds + PG8_SA(b, h) + aoff + m * 2048 + k * 1024); } while (0)
#define PG8_LDB(dst, b, h) do { _Pragma("unroll") for (int n = 0; n < 2; ++n) _Pragma("unroll") for (int k = 0; k < 2; ++k) dst[n][k] = *(const PG8_LAS bf16x8*)(lds + PG8_SB(b, h) + boff + n * 2048 + k * 1024); } while (0)
#define PG8_MMA(ai, bj, At, Bt) do { __builtin_amdgcn_s_setprio(1); _Pragma("unroll") for (int m = 0; m < 4; ++m) _Pragma("unroll") for (int n = 0; n < 2; ++n) _Pragma("unroll") for (int k = 0; k < 2; ++k) \
        acc[ai][bj][m][n] = __builtin_amdgcn_mfma_f32_16x16x32_bf16(Bt[n][k], At[m][k], acc[ai][bj][m][n], 0, 0, 0); __builtin_amdgcn_s_setprio(0); } while (0)
#define PG8_WAIT_V(n) asm volatile("s_waitcnt vmcnt(" #n ")" ::: "memory")
#define PG8_WAIT_L(n) asm volatile("s_waitcnt lgkmcnt(" #n ")" ::: "memory")
#define PG8_BAR __builtin_amdgcn_s_barrier()
#define PG8_SCHED __builtin_amdgcn_sched_barrier(0)
    Unit cur, nxt; int ui = 0;
    if (!S.next(0, cur)) return;
    f32x4 acc[2][2][4][2];
#pragma unroll
    for (int a = 0; a < 2; ++a)
#pragma unroll
        for (int b = 0; b < 2; ++b)
#pragma unroll
            for (int m = 0; m < 4; ++m)
#pragma unroll
                for (int n = 0; n < 2; ++n) acc[a][b][m][n] = (f32x4){0.f, 0.f, 0.f, 0.f};
    bf16x8 At[4][2], B0[2][2], B1[2][2];
    const char* cA = (const char*)g.A + (size_t)cur.pm * tstep; const char* cB = (const char*)g.Bt + (size_t)cur.pn * tstep;
    S.a_ready(cur);
    if constexpr (SP2) {
        PG8_STAGE(PG8_SB(0, 0), cB, voffB); PG8_STAGE(PG8_SB(0, 1), cB + hstep, voffB); PG8_STAGE(PG8_SA(0, 0), cA, voffA); PG8_STAGE(PG8_SA(0, 1), cA + hstep, voffA);
        if (wr == 1) PG8_BAR;
        PG8_WAIT_V(2); PG8_BAR;
        PG8_STAGE(PG8_SB(1, 0), cB + kstep, voffB); PG8_STAGE(PG8_SA(1, 0), cA + kstep, voffA); PG8_STAGE(PG8_SB(1, 1), cB + hstep + kstep, voffB);
        PG8_WAIT_V(6); PG8_BAR;
    } else {
        PG8_STAGE(PG8_SB(0, 0), cB, voffB); PG8_STAGE(PG8_SA(0, 0), cA, voffA); PG8_STAGE(PG8_SB(0, 1), cB + hstep, voffB); PG8_STAGE(PG8_SA(0, 1), cA + hstep, voffA);
        if (wr == 1) PG8_BAR;
        PG8_WAIT_V(4); PG8_BAR;
        PG8_STAGE(PG8_SB(1, 0), cB + kstep, voffB); PG8_STAGE(PG8_SA(1, 0), cA + kstep, voffA); PG8_STAGE(PG8_SB(1, 1), cB + hstep + kstep, voffB);
        PG8_WAIT_V(6); PG8_BAR;
    }
    for (;;) {
        const bool has_next = S.next(ui + 1, nxt);
        const char* nA = has_next ? (const char*)g.A + (size_t)nxt.pm * tstep : cA; const char* nB = has_next ? (const char*)g.Bt + (size_t)nxt.pn * tstep : cB;
        for (int t = 0; t < nt; t += 2) {
            if constexpr (Epi::MIDSCALE) { if (t == 8) E.midscale(acc, cur, wr, fr); }
            const bool last = (t == nt - 2);
            const char* a1 = cA + (size_t)(t + 1) * kstep;
            const char* a2 = last ? nA : cA + (size_t)(t + 2) * kstep; const char* b2 = last ? nB : cB + (size_t)(t + 2) * kstep;
            const char* a3 = a2 + kstep; const char* b3 = b2 + kstep;
            if (last && has_next) S.a_ready(nxt);
            if constexpr (SP2) {
            PG8_LDB(B0, 0, 0); PG8_LDB(B1, 0, 1); PG8_SCHED; PG8_LDA(At, 0, 0); PG8_STAGE(PG8_SA(1, 1), a1 + hstep, voffA);
            PG8_WAIT_V(8); PG8_WAIT_L(0); PG8_BAR; PG8_MMA(0, 0, At, B0); PG8_MMA(0, 1, At, B1); PG8_BAR; PG8_SCHED;
            PG8_LDA(At, 0, 1); PG8_STAGE(PG8_SB(0, 0), b2, voffB); PG8_STAGE(PG8_SB(0, 1), b2 + hstep, voffB); PG8_STAGE(PG8_SA(0, 0), a2, voffA);
            PG8_WAIT_V(8); PG8_WAIT_L(0); PG8_BAR; PG8_MMA(1, 0, At, B0); PG8_MMA(1, 1, At, B1); PG8_BAR; PG8_SCHED;
            PG8_LDB(B0, 1, 0); PG8_LDB(B1, 1, 1); PG8_SCHED; PG8_LDA(At, 1, 0); PG8_STAGE(PG8_SA(0, 1), a2 + hstep, voffA);
            PG8_WAIT_V(8); PG8_WAIT_L(0); PG8_BAR; PG8_MMA(0, 0, At, B0); PG8_MMA(0, 1, At, B1); PG8_BAR; PG8_SCHED;
            PG8_LDA(At, 1, 1); PG8_STAGE(PG8_SB(1, 0), b3, voffB); PG8_STAGE(PG8_SB(1, 1), b3 + hstep, voffB); PG8_STAGE(PG8_SA(1, 0), a3, voffA);
            PG8_WAIT_V(8); PG8_WAIT_L(0); PG8_BAR; PG8_MMA(1, 0, At, B0); PG8_MMA(1, 1, At, B1); PG8_BAR; PG8_SCHED;
            } else {
            PG8_LDB(B0, 0, 0); PG8_SCHED; PG8_LDA(At, 0, 0); PG8_STAGE(PG8_SA(1, 1), a1 + hstep, voffA);
            PG8_WAIT_L(8); PG8_BAR; PG8_WAIT_L(0); PG8_MMA(0, 0, At, B0); PG8_BAR; PG8_SCHED;
            PG8_LDB(B1, 0, 1); PG8_STAGE(PG8_SB(0, 0), b2, voffB);
            PG8_BAR; PG8_WAIT_L(0); PG8_MMA(0, 1, At, B1); PG8_BAR;
            PG8_LDA(At, 0, 1); PG8_STAGE(PG8_SA(0, 0), a2, voffA);
            PG8_BAR; PG8_WAIT_L(0); PG8_MMA(1, 0, At, B0); PG8_BAR; PG8_SCHED;
            PG8_STAGE(PG8_SB(0, 1), b2 + hstep, voffB);
            PG8_WAIT_V(6); PG8_BAR; PG8_MMA(1, 1, At, B1); PG8_BAR;
            PG8_LDB(B0, 1, 0); PG8_SCHED; PG8_LDA(At, 1, 0); PG8_STAGE(PG8_SA(0, 1), a2 + hstep, voffA);
            PG8_WAIT_L(8); PG8_BAR; PG8_WAIT_L(0); PG8_MMA(0, 0, At, B0); PG8_BAR; PG8_SCHED;
            PG8_LDB(B1, 1, 1); PG8_STAGE(PG8_SB(1, 0), b3, voffB);
            PG8_BAR; PG8_WAIT_L(0); PG8_MMA(0, 1, At, B1); PG8_BAR;
            PG8_LDA(At, 1, 1); PG8_STAGE(PG8_SA(1, 0), a3, voffA);
            PG8_BAR; PG8_WAIT_L(0); PG8_MMA(1, 0, At, B0); PG8_BAR; PG8_SCHED;
            PG8_STAGE(PG8_SB(1, 1), b3 + hstep, voffB);
            PG8_WAIT_V(6); PG8_BAR; PG8_MMA(1, 1, At, B1); PG8_BAR;
            }
        }
        if constexpr (ALIGN_EPI) { if (wr == 0) PG8_BAR; }
        if constexpr (!Epi::AFTER_DRAIN) { E(acc, cur, wr, wc, fr, fq); S.done(cur); }
        if (!has_next) break;
#pragma unroll
        for (int a = 0; a < 2; ++a)
#pragma unroll
            for (int b = 0; b < 2; ++b)
#pragma unroll
                for (int m = 0; m < 4; ++m)
#pragma unroll
                    for (int n = 0; n < 2; ++n) acc[a][b][m][n] = (f32x4){0.f, 0.f, 0.f, 0.f};
        cur = nxt; cA = nA; cB = nB; ++ui;
        if constexpr (ALIGN_EPI) { if (wr == 1) PG8_BAR; }
    }
    PG8_WAIT_V(0);
    if constexpr (!ALIGN_EPI) { if (wr == 0) PG8_BAR; }
    PG8_BAR;
    if constexpr (Epi::AFTER_DRAIN) { E.fused(acc, cur, wr, wc, fr, fq, lds, wid, lane); S.done(cur); }
#undef PG8_SA
#undef PG8_SB
#undef PG8_STAGE
#undef PG8_LDA
#undef PG8_LDB
#undef PG8_MMA
#undef PG8_WAIT_V
#undef PG8_WAIT_L
#undef PG8_BAR
#undef PG8_SCHED
}
}

struct EpiInProj {
  static constexpr bool PERM = false, AFTER_DRAIN = false, MIDSCALE = false;
  unsigned char* ws;
  DEVI void operator()(const f32x4 (&acc)[2][2][4][2], const pg8::Unit& u, int wr, int wc, int fr, int fq) const {
    bf16_t* PROJ = (bf16_t*)(ws + OFF_PROJ); bf16_t* VT = (bf16_t*)(ws + OFF_VT); const float* rc = (const float*)(ws + OFF_ROPE);
    const int rowb = u.pm * 256 + wr * 64 + fr;
#pragma unroll
    for (int bj = 0; bj < 2; ++bj) {
      const int cb = u.pn * 256 + bj * 128;
      const bool isv = (cb == 1152) || (cb == 1536) || (cb == 1664);
      const bool do_rope = (cb < 256) || (cb == 1024);
      const float qs = cb < 512 ? 0.125f : 1.f;
      const int vchb = (cb == 1152 ? 0 : 128 + (cb - 1536)) + 32 * wc + 4 * fq;
#pragma unroll
      for (int ai = 0; ai < 2; ++ai)
#pragma unroll
        for (int m = 0; m < 4; ++m) {
          const int row = rowb + 128 * ai + 16 * m;
          f32x4 v0 = acc[ai][bj][m][0], v1 = acc[ai][bj][m][1];
          if (isv) {
#pragma unroll
            for (int e = 0; e < 4; ++e) { VT[(unsigned)((vchb + e) * TT + row)] = (bf16_t)(cvt_pk(v0[e], 0.f) & 0xffffu); VT[(unsigned)((vchb + 16 + e) * TT + row)] = (bf16_t)(cvt_pk(v1[e], 0.f) & 0xffffu); }
          } else {
            if (do_rope && row < T) {
              const int pos = row & 4095, pp = (wc & 1) ? (pos & 63) : (pos >> 6);
              const f32x4 cs = *(const f32x4*)(rc + pp * 16 + 4 * fq), sn = *(const f32x4*)(rc + 1024 + pp * 16 + 4 * fq);
#pragma unroll
              for (int e = 0; e < 4; ++e) { const float x1 = v0[e], x2 = v1[e]; v0[e] = x1 * cs[e] - x2 * sn[e]; v1[e] = x2 * cs[e] + x1 * sn[e]; }
            }
            u32x2 o0, o1; o0.x = cvt_pk(v0[0] * qs, v0[1] * qs); o0.y = cvt_pk(v0[2] * qs, v0[3] * qs); o1.x = cvt_pk(v1[0] * qs, v1[1] * qs); o1.y = cvt_pk(v1[2] * qs, v1[3] * qs);
            *(u32x4*)(PROJ + (unsigned)(row * PW + cb + 32 * wc + 8 * fq)) = (u32x4){o0.x, o0.y, o1.x, o1.y};
          }
        }
    }
  }
};
struct EpiSwiglu {
  static constexpr bool PERM = false, AFTER_DRAIN = false, MIDSCALE = false;
  unsigned char* ws;
  DEVI void operator()(const f32x4 (&acc)[2][2][4][2], const pg8::Unit& u, int wr, int wc, int fr, int fq) const {
    bf16_t* G = (bf16_t*)(ws + OFF_PROJ);
    const int rowb = u.pm * 256 + wr * 64 + fr;
#pragma unroll
    for (int ai = 0; ai < 2; ++ai)
#pragma unroll
      for (int m = 0; m < 4; ++m) {
        const int row = rowb + 128 * ai + 16 * m;
        float o0[4], o1[4];
#pragma unroll
        for (int e = 0; e < 4; ++e) { o0[e] = silu_f(acc[ai][0][m][0][e]) * acc[ai][0][m][1][e]; o1[e] = silu_f(acc[ai][1][m][0][e]) * acc[ai][1][m][1][e]; }
        u32x4 ov; ov.x = cvt_pk(o0[0], o0[1]); ov.y = cvt_pk(o0[2], o0[3]); ov.z = cvt_pk(o1[0], o1[1]); ov.w = cvt_pk(o1[2], o1[3]);
        *(u32x4*)(G + (unsigned)(row * 2816 + u.pn * 128 + wc * 32 + 8 * fq)) = ov;
      }
  }
};
template <bool MID>
struct EpiResid {
  static constexpr bool PERM = false, AFTER_DRAIN = false, MIDSCALE = MID;
  unsigned char* ws; const float* rin_lat; const float* rin_ctx; float* rout_lat; float* rout_ctx; int layer, gate_idx;
  DEVI void midscale(f32x4 (&acc)[2][2][4][2], const pg8::Unit& u, int wr, int fr) const {
    const float* ssq = (const float*)(ws + OFF_SSQ) + u.pm * 256 + wr * 64 + fr;
    float sq[8];
#pragma unroll
    for (int k = 0; k < 8; ++k) sq[k] = ssq[128 * (k >> 2) + 16 * (k & 3)];
#pragma unroll
    for (int ai = 0; ai < 2; ++ai)
#pragma unroll
      for (int m = 0; m < 4; ++m) {
        const float rs = rsqrtf(sq[ai * 4 + m] * (1.f / 512.f) + EPSN);
#pragma unroll
        for (int bj = 0; bj < 2; ++bj) { acc[ai][bj][m][0] = acc[ai][bj][m][0] * rs; acc[ai][bj][m][1] = acc[ai][bj][m][1] * rs; }
      }
  }
  DEVI void operator()(const f32x4 (&acc)[2][2][4][2], const pg8::Unit& u, int wr, int wc, int fr, int fq) const {
    const bool lat = u.pm < T / 256;
    const int mr = lat ? (u.pm >> 4) : 4;
    const float* gpb = (const float*)(ws + OFF_MODS) + (size_t)(layer * 5 + mr) * 6144 + gate_idx * 1024;
    const float* rinb = lat ? rin_lat : rin_ctx; float* routb = lat ? rout_lat : rout_ctx;
    const int col0 = u.pn * 256 + wc * 32 + 4 * fq;
    const unsigned off0 = (unsigned)(((lat ? u.pm : u.pm - T / 256) * 256 + wr * 64 + fr) * 1024 + col0);
#pragma unroll
    for (int bj = 0; bj < 2; ++bj)
#pragma unroll
      for (int n = 0; n < 2; ++n) {
        const f32x4 gv = *(const f32x4*)(gpb + col0 + 128 * bj + 16 * n);
        f32x4 rv[8];
#pragma unroll
        for (int k = 0; k < 8; ++k) rv[k] = *(const f32x4*)(rinb + off0 + (unsigned)((128 * (k >> 2) + 16 * (k & 3)) * 1024 + 128 * bj + 16 * n));
#pragma unroll
        for (int ai = 0; ai < 2; ++ai)
#pragma unroll
          for (int m = 0; m < 4; ++m) {
            const unsigned off = off0 + (unsigned)((128 * ai + 16 * m) * 1024 + 128 * bj + 16 * n);
            f32x4 o;
#pragma unroll
            for (int e = 0; e < 4; ++e) o[e] = rv[ai * 4 + m][e] + gv[e] * acc[ai][bj][m][n][e];
            *(f32x4*)(routb + off) = o;
          }
      }
  }
};
constexpr int MODE_INPROJ = 0, MODE_RESID = 1, MODE_SWIGLU = 2;
template <int MODE, bool ASCALE>
DEVI void gemm_phase(const Params& P, int layer) {
  constexpr int K = (MODE == MODE_RESID && !ASCALE) ? 2816 : 1024;
  constexpr int N = MODE == MODE_INPROJ ? 2816 : (MODE == MODE_SWIGLU ? 5632 : 1024);
  const int M = (MODE == MODE_INPROJ || (layer == 0 && MODE != MODE_RESID)) ? TT : T;
  const bf16_t* A = (const bf16_t*)(P.ws + ((MODE == MODE_RESID && !ASCALE) ? OFF_PROJ : OFF_H));
  const bf16_t* Wt = (const bf16_t*)(P.ws + (MODE == MODE_INPROJ ? OFF_WIN : MODE == MODE_SWIGLU ? OFF_WFI : ASCALE ? OFF_WOUT : OFF_WFO));
  pg8::Gemm g{A, Wt, M, N, K}; pg8::StaticOrder S; S.init(M, N, (int)gridDim.x, (int)blockIdx.x);
  PG8_LAS unsigned char* lds = (PG8_LAS unsigned char*)smem;
  if constexpr (MODE == MODE_INPROJ) {
    EpiInProj E{P.ws};
    pg8::gemm_phase<EpiInProj, pg8::StaticOrder, true, true>(lds, g, S, E);
    const int lane = threadIdx.x & 63, r = lane & 15, q = lane >> 4;
    const bf16_t* Wd = Wt + (size_t)(2816 + r) * 1024 + 8 * q;
    float* DTb = (float*)(P.ws + OFF_DT);
    for (int tile = blockIdx.x * 8 + (threadIdx.x >> 6); tile < TT / 16; tile += gridDim.x * 8) {
      const bf16_t* Ar = A + (size_t)(16 * tile + r) * 1024 + 8 * q;
      f32x4 acc = (f32x4){0.f, 0.f, 0.f, 0.f};
#pragma unroll 8
      for (int s2 = 0; s2 < 32; ++s2) acc = mfma16(*(const bf16x8*)(Ar + 32 * s2), *(const bf16x8*)(Wd + 32 * s2), acc);
#pragma unroll
      for (int e = 0; e < 4; ++e) DTb[(size_t)(16 * tile + 4 * q + e) * 16 + r] = acc[e];
    }
  } else if constexpr (MODE == MODE_SWIGLU) {
    EpiSwiglu E{P.ws};
    pg8::gemm_phase<EpiSwiglu, pg8::StaticOrder, true, true>(lds, g, S, E);
  } else {
    float* XCp = (float*)(P.ws + OFF_XC);
    EpiResid<ASCALE> E{P.ws, (ASCALE && layer == 0) ? P.x : P.out, (ASCALE && layer == 0) ? P.ctx : XCp, P.out, XCp, layer, ASCALE ? 2 : 5};
    pg8::gemm_phase<EpiResid<ASCALE>, pg8::StaticOrder, true, true>(lds, g, S, E);
    if (layer == 0) {
      const int lane = threadIdx.x & 63, r = lane & 15, q = lane >> 4, w8 = threadIdx.x >> 6;
      const float* gpb = (const float*)(P.ws + OFF_MODS) + (size_t)(layer * 5 + 4) * 6144 + (ASCALE ? 2 : 5) * 1024;
      const float* rinb = ASCALE ? P.ctx : XCp;
      const float* ssq = (const float*)(P.ws + OFF_SSQ) + T;
      constexpr int PER = K / 32 / 8;
      float* part = (float*)smem;
      for (int tl = blockIdx.x; tl < 256; tl += gridDim.x) {
        const int r0 = (tl >> 4) * 64, n0 = (tl & 15) * 64;
        const bf16_t* Ar = A + (size_t)(T + r0 + r) * K + w8 * PER * 32 + 8 * q;
        const bf16_t* Br = Wt + (size_t)(n0 + r) * K + w8 * PER * 32 + 8 * q;
        f32x4 acc[4][4];
#pragma unroll
        for (int i = 0; i < 4; ++i)
#pragma unroll
          for (int j = 0; j < 4; ++j) acc[i][j] = (f32x4){0.f, 0.f, 0.f, 0.f};
#pragma unroll 2
        for (int s2 = 0; s2 < PER; ++s2) {
          bf16x8 af[4], bfr[4];
#pragma unroll
          for (int i = 0; i < 4; ++i) { af[i] = *(const bf16x8*)(Ar + (size_t)(16 * i) * K + 32 * s2); bfr[i] = *(const bf16x8*)(Br + (size_t)(16 * i) * K + 32 * s2); }
#pragma unroll
          for (int i = 0; i < 4; ++i)
#pragma unroll
            for (int j = 0; j < 4; ++j) acc[i][j] = mfma16(af[i], bfr[j], acc[i][j]);
        }
        const bool sc = ASCALE && w8 < 4;
        float sqv[16];
#pragma unroll
        for (int k = 0; k < 16; ++k) sqv[k] = ssq[r0 + 16 * (k >> 2) + 4 * q + (k & 3)];
#pragma unroll
        for (int i = 0; i < 4; ++i)
#pragma unroll
          for (int e = 0; e < 4; ++e) {
            const float rs = sc ? rsqrtf(sqv[i * 4 + e] * (1.f / 512.f) + EPSN) : 1.f;
#pragma unroll
            for (int j = 0; j < 4; ++j) part[w8 * 4096 + (16 * i + 4 * q + e) * 64 + 16 * j + r] = acc[i][j][e] * rs;
          }
        __syncthreads();
        float rres[8], gres[8];
#pragma unroll
        for (int k = 0; k < 8; ++k) { const int o = (int)threadIdx.x + 512 * k; rres[k] = rinb[(unsigned)((r0 + (o >> 6)) * 1024 + n0 + (o & 63))]; gres[k] = gpb[n0 + (o & 63)]; }
#pragma unroll
        for (int k = 0; k < 8; ++k) {
          const int o = (int)threadIdx.x + 512 * k, row = o >> 6, col = o & 63;
          float sum = 0.f;
#pragma unroll
          for (int pw = 0; pw < 8; ++pw) sum += part[pw * 4096 + o];
          XCp[(unsigned)((r0 + row) * 1024 + n0 + col)] = rres[k] + gres[k] * sum;
        }
        __syncthreads();
      }
    }
  }
}

template <int KIND>
NOINL void attn_item(const Params& P, int layer, int b, int i1, int i2, int isctx_) {
  unsigned char* const smh = smem + half_id() * HSTR;
  const bool isctx = isctx_ != 0;
  constexpr int NQT = (KIND == 1) ? 1 : 2;
  const int t = tid_opq(), lane = t & 63, w = t >> 6, r = lane & 15, q = lane >> 4, r7 = r & 7;
  const bf16_t* PROJ = (const bf16_t*)(P.ws + OFF_PROJ);
  const bf16_t* VT = (const bf16_t*)(P.ws + OFF_VT);
  bf16_t* MIX = (bf16_t*)(P.ws + OFF_H);
  constexpr bool DBL = (KIND == 1);
  constexpr int VSTR = DBL ? 272 : 136;
  unsigned char* Ks = smh; unsigned char* Vs = smh + (DBL ? 16384 : 8192); float* rpb = (float*)(smh + 33792);
  const int col0 = w == 0 ? 0 : (w == 1 ? 8 : (w == 2 ? 24 : 32));
  int qrow[NQT]; int qcol, kcol, vch, ocol, ntile; bool has_sink = false; float sinkv = 0.f;
  int r0g = 0;
  if (KIND == 0 && !isctx) {
    const int n = i1, head = i2;
#pragma unroll
    for (int qt = 0; qt < NQT; ++qt) qrow[qt] = b * 4096 + 128 * n + 32 * w + 16 * qt + r;
    qcol = head * 64; kcol = 1024 + (head >> 1) * 64; vch = (head >> 1) * 64; ocol = 512 + head * 64; ntile = 10; has_sink = true; sinkv = P.wa_sink[layer * 4 + head];
  } else if (KIND == 1) {
    const int gr = i1, h = i2;
    qrow[0] = b * 4096 + gr * 64 + 16 * w + r;
    qcol = 256 + 64 * h; kcol = 1280 + 64 * h; vch = 128 + 64 * h; ocol = 768 + 64 * h; ntile = 8;
    r0g = gr - 4 < 0 ? 0 : (gr - 4 > 56 ? 56 : gr - 4);
    __syncthreads();
    for (int e = t; e < 465; e += 256) rpb[e] = P.na_rpb[(size_t)(layer * 4 + h) * 465 + e];
  } else {
    const int qb = i1, hh = i2;
#pragma unroll
    for (int qt = 0; qt < NQT; ++qt) qrow[qt] = T + b * 256 + 128 * qb + 32 * w + 16 * qt + r;
    ntile = 4;
    if (hh < 4) { qcol = hh * 64; kcol = 1024 + (hh >> 1) * 64; vch = (hh >> 1) * 64; ocol = 512 + hh * 64; has_sink = true; sinkv = P.wa_sink[layer * 4 + hh]; }
    else { const int h = hh - 4; qcol = 256 + 64 * h; kcol = 1280 + 64 * h; vch = 128 + 64 * h; ocol = 768 + 64 * h; }
  }
  bf16x8 qf[NQT][2];
#pragma unroll
  for (int qt = 0; qt < NQT; ++qt)
#pragma unroll
    for (int s = 0; s < 2; ++s) qf[qt][s] = *(const bf16x8*)(PROJ + (size_t)qrow[qt] * PW + qcol + 32 * s + 8 * q);
  f32x4 o[4][NQT]; float mrun[NQT], lrun[NQT];
#pragma unroll
  for (int qt = 0; qt < NQT; ++qt) { mrun[qt] = -1e30f; lrun[qt] = 0.f;
#pragma unroll
    for (int dt = 0; dt < 4; ++dt) o[dt][qt] = (f32x4){0.f, 0.f, 0.f, 0.f}; }

  const int skip = (KIND == 0 && !isctx && i1 == 0) ? 2 : 0;
  const int nvalid = ntile - skip - ((KIND == 0 && !isctx && i1 == 31) ? 2 : 0);
  const int skey = t >> 2, sc0 = (t & 3) * 2;
  u32x4 pk0, pk1, pv0, pv1, pk2, pk3, pv2, pv3;
#define KV_ROW0(IDX, TI, KROW0) const int TI = (IDX) < 4 ? (IDX) : (IDX) + skip; \
    const int KROW0 = TI < 4 ? T + b * 256 + 64 * TI : (KIND == 1 ? b * 4096 + (r0g + 2 * (TI - 4)) * 64 : b * 4096 + 128 * (i1 - 1) + 64 * (TI - 4));
#define KV_LOAD(IDX) { KV_ROW0(IDX, ti_, kr0_) \
    const bf16_t* kp = PROJ + (size_t)(kr0_ + skey) * PW + kcol + sc0 * 8; pk0 = *(const u32x4*)kp; pk1 = *(const u32x4*)(kp + 8); \
    const bf16_t* vp = VT + (size_t)(vch + skey) * TT + kr0_ + sc0 * 8; pv0 = *(const u32x4*)vp; pv1 = *(const u32x4*)(vp + 8); \
    if (DBL && ti_ >= 4) { pk2 = *(const u32x4*)(kp + 64 * PW); pk3 = *(const u32x4*)(kp + 64 * PW + 8); pv2 = *(const u32x4*)(vp + 64); pv3 = *(const u32x4*)(vp + 72); } }
  KV_LOAD(0);
#pragma unroll 1
  for (int idx = 0; idx < nvalid; ++idx) {
    KV_ROW0(idx, ti, krow0)
    (void)krow0;
    const int kbase = 128 * (i1 - 1) + 64 * (ti - 4); const int kr = r0g + 2 * (ti - 4);
    const bool local2 = DBL && ti >= 4;
    __syncthreads();
    {
      *(u32x4*)(Ks + skey * 128 + ((sc0 ^ (skey & 7)) << 4)) = pk0; *(u32x4*)(Ks + skey * 128 + (((sc0 + 1) ^ (skey & 7)) << 4)) = pk1;
      u32x2* dst = (u32x2*)(Vs + skey * VSTR + sc0 * 16);
      dst[0] = (u32x2){pv0.x, pv0.y}; dst[1] = (u32x2){pv0.z, pv0.w}; dst[2] = (u32x2){pv1.x, pv1.y}; dst[3] = (u32x2){pv1.z, pv1.w};
      if (local2) {
        *(u32x4*)(Ks + (skey + 64) * 128 + ((sc0 ^ (skey & 7)) << 4)) = pk2; *(u32x4*)(Ks + (skey + 64) * 128 + (((sc0 + 1) ^ (skey & 7)) << 4)) = pk3;
        u32x2* dst2 = (u32x2*)(Vs + skey * VSTR + 128 + sc0 * 16);
        dst2[0] = (u32x2){pv2.x, pv2.y}; dst2[1] = (u32x2){pv2.z, pv2.w}; dst2[2] = (u32x2){pv3.x, pv3.y}; dst2[3] = (u32x2){pv3.z, pv3.w};
      }
    }
    __syncthreads();
    if (idx + 1 < nvalid) KV_LOAD(idx + 1);
    f32x4 sc[4][NQT];
#pragma unroll
    for (int kt = 0; kt < 4; ++kt) {
      const int krow = (local2 ? (kt >> 1) * 64 + col0 + 16 * (kt & 1) : 16 * kt) + r;
      const bf16x8 kf0 = *(const bf16x8*)(Ks + krow * 128 + ((q ^ r7) << 4));
      const bf16x8 kf1 = *(const bf16x8*)(Ks + krow * 128 + (((4 + q) ^ r7) << 4));
#pragma unroll
      for (int qt = 0; qt < NQT; ++qt) { sc[kt][qt] = mfma16(kf0, qf[qt][0], (f32x4){0.f, 0.f, 0.f, 0.f}); sc[kt][qt] = mfma16(kf1, qf[qt][1], sc[kt][qt]); }
    }
    if (ti >= 4) {
      if (KIND == 0) {
#pragma unroll
        for (int qt = 0; qt < NQT; ++qt) { const int qpos = 128 * i1 + 32 * w + 16 * qt + r;
#pragma unroll
          for (int kt = 0; kt < 4; ++kt)
#pragma unroll
            for (int e = 0; e < 4; ++e) { const int d = qpos - (kbase + 16 * kt + 4 * q + e); if (d > 128 || d < -128) sc[kt][qt][e] = -1e30f; } }
      } else if (KIND == 1) {
        const int qc = 16 * w + r; const int cs = qc - 8 < 0 ? 0 : (qc - 8 > 48 ? 48 : qc - 8);
#pragma unroll
        for (int kt = 0; kt < 4; ++kt) {
          const int dy = kr + (kt >> 1) - i1 + 7;
#pragma unroll
          for (int e = 0; e < 4; ++e) { const int kc = col0 + 16 * (kt & 1) + 4 * q + e; const bool ok = (kc >= cs) && (kc < cs + 16);
            int dx = kc - qc + 15; dx = dx < 0 ? 0 : (dx > 30 ? 30 : dx);
            sc[kt][0][e] = ok ? sc[kt][0][e] + rpb[dy * 31 + dx] : -1e30f; }
        }
      }
    }
    bf16x8 pf[2][NQT];
#pragma unroll
    for (int qt = 0; qt < NQT; ++qt) {
      float mx = -1e30f;
#pragma unroll
      for (int kt = 0; kt < 4; ++kt)
#pragma unroll
        for (int e = 0; e < 4; ++e) mx = fmaxf(mx, sc[kt][qt][e]);
      mx = fmaxf(mx, __shfl_xor(mx, 16)); mx = fmaxf(mx, __shfl_xor(mx, 32));
      const float mn = fmaxf(mrun[qt], mx); const float alpha = __expf(mrun[qt] - mn); mrun[qt] = mn;
      float ls = 0.f;
#pragma unroll
      for (int kt = 0; kt < 4; ++kt)
#pragma unroll
        for (int e = 0; e < 4; ++e) { const float p = __expf(sc[kt][qt][e] - mn); sc[kt][qt][e] = p; ls += p; }
      lrun[qt] = lrun[qt] * alpha + ls;
#pragma unroll
      for (int dt = 0; dt < 4; ++dt) o[dt][qt] = o[dt][qt] * alpha;
#pragma unroll
      for (int s = 0; s < 2; ++s) {
        u32x4 pk; pk.x = cvt_pk(sc[2 * s][qt][0], sc[2 * s][qt][1]); pk.y = cvt_pk(sc[2 * s][qt][2], sc[2 * s][qt][3]);
        pk.z = cvt_pk(sc[2 * s + 1][qt][0], sc[2 * s + 1][qt][1]); pk.w = cvt_pk(sc[2 * s + 1][qt][2], sc[2 * s + 1][qt][3]);
        pf[s][qt] = as_bf16x8(pk);
      }
    }
#pragma unroll
    for (int s = 0; s < 2; ++s)
#pragma unroll
      for (int dt = 0; dt < 4; ++dt) {
        const int vkb = local2 ? 64 * s + col0 : 32 * s;
        const u32x2 lo = *(const u32x2*)(Vs + (16 * dt + r) * VSTR + (vkb + 4 * q) * 2);
        const u32x2 hi = *(const u32x2*)(Vs + (16 * dt + r) * VSTR + (vkb + 16 + 4 * q) * 2);
        const bf16x8 vf = as_bf16x8((u32x4){lo.x, lo.y, hi.x, hi.y});
#pragma unroll
        for (int qt = 0; qt < NQT; ++qt) o[dt][qt] = mfma16(vf, pf[s][qt], o[dt][qt]);
      }
  }
#pragma unroll
  for (int qt = 0; qt < NQT; ++qt) {
    float l = lrun[qt]; l += __shfl_xor(l, 16); l += __shfl_xor(l, 32);
    float mf = mrun[qt]; float scale;
    if (has_sink) { const float m2 = fmaxf(mf, sinkv); const float a = __expf(mf - m2); l = l * a + __expf(sinkv - m2); scale = a / l; }
    else scale = 1.f / l;
#pragma unroll
    for (int dt = 0; dt < 4; ++dt) {
      u32x2 ov; ov.x = cvt_pk(o[dt][qt][0] * scale, o[dt][qt][1] * scale); ov.y = cvt_pk(o[dt][qt][2] * scale, o[dt][qt][3] * scale);
      *(u32x2*)(MIX + (size_t)qrow[qt] * 1024 + ocol + 16 * dt + 4 * q) = ov;
    }
  }
}

DEVI void ssd_load_raw(unsigned char* raw, const bf16_t* PROJ, int rowbase, int lo, int hi, int col0) {
  for (int e = tid_opq(); e < 134 * 8; e += 256) {
    const int rr = e >> 3, ch = e & 7; const int row = rowbase - 3 + rr;
    u32x4 v = (u32x4){0u, 0u, 0u, 0u};
    if (row >= lo && row < hi) v = *(const u32x4*)(PROJ + (size_t)row * PW + col0 + ch * 8);
    *(u32x4*)(raw + rr * 128 + ch * 16) = v;
  }
}

template <bool TRANSP, bool WEIGHTED>
DEVI void ssd_conv(const unsigned char* raw, const float* cw  , const float* cb, unsigned char* out1, unsigned char* out2, const float* wt1, const float* wt2) {
  const int t_ = tid_opq(); const int c = t_ & 63, tq = t_ >> 6;
  float wj[7];
#pragma unroll
  for (int j = 0; j < 7; ++j) wj[j] = cw[j * 1024 + c];
  const float bias = cb[c];
  const bf16_t* rp = (const bf16_t*)raw + c;
  float w0 = bf2f(rp[(32 * tq + 0) * 64]), w1 = bf2f(rp[(32 * tq + 1) * 64]), w2 = bf2f(rp[(32 * tq + 2) * 64]), w3 = bf2f(rp[(32 * tq + 3) * 64]), w4 = bf2f(rp[(32 * tq + 4) * 64]), w5 = bf2f(rp[(32 * tq + 5) * 64]);
  float hold1[4], hold2[4];
#pragma unroll 1
  for (int tg = 0; tg < 8; ++tg) {
#pragma unroll
    for (int t4 = 0; t4 < 4; ++t4) {
      const int tok = 32 * tq + 4 * tg + t4;
      const float w6 = bf2f(rp[(tok + 6) * 64]);
      float v = bias + wj[0] * w0 + wj[1] * w1 + wj[2] * w2 + wj[3] * w3 + wj[4] * w4 + wj[5] * w5 + wj[6] * w6;
      v = silu_f(v);
      w0 = w1; w1 = w2; w2 = w3; w3 = w4; w4 = w5; w5 = w6;
      if (TRANSP) {
        hold1[t4] = WEIGHTED ? v * wt1[tok] : v;
        if (WEIGHTED) hold2[t4] = v * wt2[tok];
        if (t4 == 3) {
          u32x2 o; o.x = cvt_pk(hold1[0], hold1[1]); o.y = cvt_pk(hold1[2], hold1[3]);
          *(u32x2*)(out1 + c * 272 + (tok - 3) * 2) = o;
          if (WEIGHTED) { u32x2 o2; o2.x = cvt_pk(hold2[0], hold2[1]); o2.y = cvt_pk(hold2[2], hold2[3]); *(u32x2*)(out2 + c * 272 + (tok - 3) * 2) = o2; }
        }
      } else {
        *(bf16_t*)(out1 + tok * 128 + (((c >> 3) ^ (tok & 7)) << 4) + (c & 7) * 2) = (bf16_t)(cvt_pk(v, 0.f) & 0xffffu);
      }
    }
  }
}

constexpr int SM_RAW = 0, SM_X1 = 17152, SM_X2 = 34560, SM_BT = 51968, SM_SMALL = 69376;
constexpr int SM_XT = 17152, SM_BN = 34560, SM_CN = 50944;

NOINL void conv_item(const Params& P, int layer, int b, int cidx, int slab) {
  unsigned char* const smh = smem + half_id() * HSTR;
  const int t = tid_opq(), c = t & 63, tq = t >> 6;
  const bf16_t* PROJ = (const bf16_t*)(P.ws + OFF_PROJ);
  bf16_t* XN = (bf16_t*)(P.ws + OFF_XN);
  int rowbase, lo, hi;
  if (cidx < 2) { lo = T + b * 256; hi = lo + 256; rowbase = lo + cidx * 128; } else { lo = b * 4096; hi = lo + 4096; rowbase = lo + (cidx - 2) * 128; }
  __syncthreads();
  ssd_load_raw(smh + SM_RAW, PROJ, rowbase, lo, hi, 1792 + slab * 64);
  __syncthreads();
  const float* cw = P.conv_w + (size_t)layer * 7 * 1024 + slab * 64 + c;
  float wj[7];
#pragma unroll
  for (int j = 0; j < 7; ++j) wj[j] = cw[j * 1024];
  const float bias = P.conv_b[layer * 1024 + slab * 64 + c];
  const bf16_t* rp = (const bf16_t*)(smh + SM_RAW) + c;
  float w0 = bf2f(rp[(32 * tq + 0) * 64]), w1 = bf2f(rp[(32 * tq + 1) * 64]), w2 = bf2f(rp[(32 * tq + 2) * 64]), w3 = bf2f(rp[(32 * tq + 3) * 64]), w4 = bf2f(rp[(32 * tq + 4) * 64]), w5 = bf2f(rp[(32 * tq + 5) * 64]);
  const bool nat = slab >= 8, tr = slab < 12;
  bf16_t* trp = slab < 8 ? (bf16_t*)(P.ws + OFF_XTX) + (size_t)(slab * 64 + c) * TT : (bf16_t*)(P.ws + OFF_XTB) + (size_t)((slab - 8) * 64 + c) * TT;
#pragma unroll 1
  for (int tg = 0; tg < 4; ++tg) {
    float hold[8];
#pragma unroll
    for (int t8 = 0; t8 < 8; ++t8) {
      const int tok = 32 * tq + 8 * tg + t8;
      const float w6 = bf2f(rp[(tok + 6) * 64]);
      float v = bias + wj[0] * w0 + wj[1] * w1 + wj[2] * w2 + wj[3] * w3 + wj[4] * w4 + wj[5] * w5 + wj[6] * w6;
      v = silu_f(v);
      w0 = w1; w1 = w2; w2 = w3; w3 = w4; w4 = w5; w5 = w6;
      hold[t8] = v;
      if (nat) XN[(size_t)(rowbase + tok) * 512 + (slab - 8) * 64 + c] = (bf16_t)(cvt_pk(v, 0.f) & 0xffffu);
    }
    if (tr) {
      u32x4 o; o.x = cvt_pk(hold[0], hold[1]); o.y = cvt_pk(hold[2], hold[3]); o.z = cvt_pk(hold[4], hold[5]); o.w = cvt_pk(hold[6], hold[7]);
      *(u32x4*)(trp + rowbase + 32 * tq + 8 * tg) = o;
    }
  }
}

NOINL void ssd_state_item(const Params& P, int layer, int b, int cidx, int h) {
  unsigned char* const smh = smem + half_id() * HSTR;
  const int t = tid_opq(), lane = t & 63, w = t >> 6, r = lane & 15, q = lane >> 4;
  const bf16_t* PROJ = (const bf16_t*)(P.ws + OFF_PROJ);
  const float* DTb = (const float*)(P.ws + OFF_DT);
  bf16_t* ST = (bf16_t*)(P.ws + OFF_ST);
  float* CD = (float*)(P.ws + OFF_CD);
  float* sm = (float*)(smh + SM_SMALL);
  int rowbase, lo, hi;
  if (cidx < 2) { lo = T + b * 256; hi = lo + 256; rowbase = lo + cidx * 128; } else { lo = b * 4096; hi = lo + 4096; rowbase = lo + (cidx - 2) * 128; }
  const int g = h >> 2;
  const float Af = -__expf(P.a_log[layer * 16 + h]), Ab = -__expf(P.a_log[layer * 16 + 8 + h]);
  __syncthreads();
  float inf_ = 0.f, inb_ = 0.f, ab_ = 0.f;
  if (t < 128) {
    const float df = softplus_f(DTb[(size_t)(rowbase + t) * 16 + h] + P.dt_bias[layer * 16 + h]);
    const float db = softplus_f(DTb[(size_t)(rowbase + t) * 16 + 8 + h] + P.dt_bias[layer * 16 + 8 + h]);
    sm[256 + t] = df; sm[384 + t] = db;
    ab_ = db * Ab; inf_ = wave_incl_scan(df * Af, lane); inb_ = wave_incl_scan(ab_, lane);
    if (lane == 63) { sm[772 + w] = inf_; sm[774 + w] = inb_; }
  }
  __syncthreads();
  if (t < 128) {
    const float acf = inf_ + (w == 1 ? sm[772] : 0.f), totf = sm[772] + sm[773];
    const float preb = inb_ - ab_ + (w == 1 ? sm[774] : 0.f), totb = sm[774] + sm[775];
    sm[512 + t] = __expf(totf - acf) * sm[256 + t];
    sm[640 + t] = __expf(preb) * sm[384 + t];
    if (t == 0) { const int seq = (b * 8 + h) * 2; CD[seq * 34 + cidx] = __expf(totf); CD[(seq + 1) * 34 + cidx] = __expf(totb); }
  }
  __syncthreads();
  {
    const bf16_t* XTX = (const bf16_t*)(P.ws + OFF_XTX);
#pragma unroll
    for (int k = 0; k < 4; ++k) {
      const int e = t + 256 * k, p = e >> 4, c16 = e & 15;
      const u32x4 v = *(const u32x4*)(XTX + (size_t)(h * 64 + p) * TT + rowbase + c16 * 8);
      const float* wf = sm + 512 + c16 * 8; const float* wb = sm + 640 + c16 * 8;
      u32x4 of, ob;
      of.x = cvt_pk(bflo(v.x) * wf[0], bfhi(v.x) * wf[1]); of.y = cvt_pk(bflo(v.y) * wf[2], bfhi(v.y) * wf[3]); of.z = cvt_pk(bflo(v.z) * wf[4], bfhi(v.z) * wf[5]); of.w = cvt_pk(bflo(v.w) * wf[6], bfhi(v.w) * wf[7]);
      ob.x = cvt_pk(bflo(v.x) * wb[0], bfhi(v.x) * wb[1]); ob.y = cvt_pk(bflo(v.y) * wb[2], bfhi(v.y) * wb[3]); ob.z = cvt_pk(bflo(v.z) * wb[4], bfhi(v.z) * wb[5]); ob.w = cvt_pk(bflo(v.w) * wb[6], bfhi(v.w) * wb[7]);
      *(u32x4*)(smh + SM_X1 + p * 272 + c16 * 16) = of; *(u32x4*)(smh + SM_X2 + p * 272 + c16 * 16) = ob;
    }
  }
#pragma unroll 1
  for (int nh = 0; nh < 2; ++nh) {
    {
      const bf16_t* XTB = (const bf16_t*)(P.ws + OFF_XTB);
#pragma unroll
      for (int k = 0; k < 4; ++k) {
        const int e = t + 256 * k, n = e >> 4, c16 = e & 15;
        *(u32x4*)(smh + SM_BT + n * 272 + c16 * 16) = *(const u32x4*)(XTB + (size_t)(g * 128 + nh * 64 + n) * TT + rowbase + c16 * 8);
      }
    }
    __syncthreads();
    f32x4 acc[4][2];
#pragma unroll
    for (int nt = 0; nt < 4; ++nt) { acc[nt][0] = (f32x4){0.f, 0.f, 0.f, 0.f}; acc[nt][1] = (f32x4){0.f, 0.f, 0.f, 0.f}; }
#pragma unroll
    for (int s = 0; s < 4; ++s) {
      const bf16x8 xf = *(const bf16x8*)(smh + SM_X1 + (16 * w + r) * 272 + (32 * s + 8 * q) * 2);
      const bf16x8 xb = *(const bf16x8*)(smh + SM_X2 + (16 * w + r) * 272 + (32 * s + 8 * q) * 2);
#pragma unroll
      for (int nt = 0; nt < 4; ++nt) {
        const bf16x8 bt = *(const bf16x8*)(smh + SM_BT + (16 * nt + r) * 272 + (32 * s + 8 * q) * 2);
        acc[nt][0] = mfma16(bt, xf, acc[nt][0]); acc[nt][1] = mfma16(bt, xb, acc[nt][1]);
      }
    }
#pragma unroll
    for (int dir = 0; dir < 2; ++dir) {
      bf16_t* sp = ST + ((size_t)(((b * 8 + h) * 2 + dir) * 34 + cidx)) * 8192 + (16 * w + r) * 128 + nh * 64 + 4 * q;
#pragma unroll
      for (int nt = 0; nt < 4; ++nt) { u32x2 ov; ov.x = cvt_pk(acc[nt][dir][0], acc[nt][dir][1]); ov.y = cvt_pk(acc[nt][dir][2], acc[nt][dir][3]); *(u32x2*)(sp + 16 * nt) = ov; }
    }
    __syncthreads();
  }
}

NOINL void ssd_scan_phase(const Params& P) {
  bf16_t* ST = (bf16_t*)(P.ws + OFF_ST);
  const float* CD = (const float*)(P.ws + OFF_CD);
  const int total = 64 * 2048;
  for (int gidx = VB * 256 + tid_opq(); gidx < total; gidx += VG * 256) {
    const int seq = gidx >> 11, e = gidx & 2047, dir = seq & 1;
    bf16_t* base = ST + (size_t)seq * 34 * 8192 + e * 4;
    const float* cd = CD + seq * 34;
    u32x2 v[34];
#pragma unroll
    for (int k = 0; k < 34; ++k) { const int ci = dir == 0 ? k : (k == 0 ? 1 : (k == 1 ? 0 : 35 - k)); v[k] = *(const u32x2*)(base + (size_t)ci * 8192); }
    float dk[34];
#pragma unroll
    for (int k = 0; k < 34; ++k) { const int ci = dir == 0 ? k : (k == 0 ? 1 : (k == 1 ? 0 : 35 - k)); dk[k] = cd[ci]; }
    float h0 = 0.f, h1 = 0.f, h2 = 0.f, h3 = 0.f;
#pragma unroll
    for (int k = 0; k < 34; ++k) {
      const int ci = dir == 0 ? k : (k == 0 ? 1 : (k == 1 ? 0 : 35 - k));
      u32x2 ov; ov.x = cvt_pk(h0, h1); ov.y = cvt_pk(h2, h3);
      *(u32x2*)(base + (size_t)ci * 8192) = ov;
      const float d = dk[k];
      h0 = h0 * d + bflo(v[k].x); h1 = h1 * d + bfhi(v[k].x); h2 = h2 * d + bflo(v[k].y); h3 = h3 * d + bfhi(v[k].y);
    }
  }
}

NOINL void ssd_out_item(const Params& P, int layer, int b, int cidx, int h, int do_atomic) {
  unsigned char* const smh = smem + half_id() * HSTR;
  const int t = tid_opq(), lane = t & 63, w = t >> 6, r = lane & 15, q = lane >> 4, r7 = r & 7;
  const bf16_t* PROJ = (const bf16_t*)(P.ws + OFF_PROJ);
  const float* DTb = (const float*)(P.ws + OFF_DT);
  const bf16_t* ST = (const bf16_t*)(P.ws + OFF_ST);
  bf16_t* MIX = (bf16_t*)(P.ws + OFF_H);
  float* SSQ = (float*)(P.ws + OFF_SSQ);
  float* sm = (float*)(smh + SM_SMALL);
  int rowbase, lo, hi;
  if (cidx < 2) { lo = T + b * 256; hi = lo + 256; rowbase = lo + cidx * 128; } else { lo = b * 4096; hi = lo + 4096; rowbase = lo + (cidx - 2) * 128; }
  const int g = h >> 2;
  const float Af = -__expf(P.a_log[layer * 16 + h]), Ab = -__expf(P.a_log[layer * 16 + 8 + h]);
  __syncthreads();
  float inf_ = 0.f, inb_ = 0.f, ab_ = 0.f;
  if (t < 128) {
    const float df = softplus_f(DTb[(size_t)(rowbase + t) * 16 + h] + P.dt_bias[layer * 16 + h]);
    const float db = softplus_f(DTb[(size_t)(rowbase + t) * 16 + 8 + h] + P.dt_bias[layer * 16 + 8 + h]);
    sm[256 + t] = df; sm[384 + t] = db;
    ab_ = db * Ab; inf_ = wave_incl_scan(df * Af, lane); inb_ = wave_incl_scan(ab_, lane);
    if (lane == 63) { sm[772 + w] = inf_; sm[774 + w] = inb_; }
  }
  {
    const bf16_t* XTX = (const bf16_t*)(P.ws + OFF_XTX);
#pragma unroll
    for (int k = 0; k < 4; ++k) {
      const int e = t + 256 * k, p = e >> 4, c16 = e & 15;
      *(u32x4*)(smh + SM_XT + p * 272 + c16 * 16) = *(const u32x4*)(XTX + (size_t)(h * 64 + p) * TT + rowbase + c16 * 8);
    }
  }
  __syncthreads();
  if (t < 128) {
    const float acf = inf_ + (w == 1 ? sm[772] : 0.f);
    const float preb = inb_ - ab_ + (w == 1 ? sm[774] : 0.f), totb = sm[774] + sm[775];
    sm[512 + t] = acf; sm[640 + t] = preb;
    if (t == 0) sm[768] = totb;
  }
  __syncthreads();
  f32x4 G[8][2], y[4][2];
#pragma unroll
  for (int jt = 0; jt < 8; ++jt) { G[jt][0] = (f32x4){0.f, 0.f, 0.f, 0.f}; G[jt][1] = (f32x4){0.f, 0.f, 0.f, 0.f}; }
#pragma unroll
  for (int pt = 0; pt < 4; ++pt) { y[pt][0] = (f32x4){0.f, 0.f, 0.f, 0.f}; y[pt][1] = (f32x4){0.f, 0.f, 0.f, 0.f}; }
  float acfi[2], prebi[2], efi[2][2];
#pragma unroll
  for (int it = 0; it < 2; ++it) {
    const int i = 32 * w + 16 * it + r;
    acfi[it] = sm[512 + i]; prebi[it] = sm[640 + i];
    efi[0][it] = __expf(acfi[it]); efi[1][it] = __expf(sm[768] - prebi[it]);
  }
#pragma unroll 1
  for (int nh = 0; nh < 2; ++nh) {
    {
      const bf16_t* XN = (const bf16_t*)(P.ws + OFF_XN);
#pragma unroll
      for (int k = 0; k < 4; ++k) {
        const int e = t + 256 * k, tok = e >> 3, ch = e & 7;
        const bf16_t* src = XN + (size_t)(rowbase + tok) * 512 + g * 128 + nh * 64 + ch * 8;
        *(u32x4*)(smh + SM_BN + tok * 128 + ((ch ^ (tok & 7)) << 4)) = *(const u32x4*)src;
        *(u32x4*)(smh + SM_CN + tok * 128 + ((ch ^ (tok & 7)) << 4)) = *(const u32x4*)(src + 256);
      }
      const int hp_ = t >> 2, hc_ = (t & 3) * 2;
#pragma unroll
      for (int d = 0; d < 2; ++d) {
        const bf16_t* hsrc = ST + ((size_t)(((b * 8 + h) * 2 + d) * 34 + cidx)) * 8192 + hp_ * 128 + nh * 64 + hc_ * 8;
        *(u32x4*)(smh + SM_RAW + d * 8192 + hp_ * 128 + ((hc_ ^ (hp_ & 7)) << 4)) = *(const u32x4*)hsrc;
        *(u32x4*)(smh + SM_RAW + d * 8192 + hp_ * 128 + (((hc_ + 1) ^ (hp_ & 7)) << 4)) = *(const u32x4*)(hsrc + 8);
      }
    }
    __syncthreads();
    bf16x8 cf[2][2];
#pragma unroll
    for (int it = 0; it < 2; ++it)
#pragma unroll
      for (int s = 0; s < 2; ++s) cf[it][s] = *(const bf16x8*)(smh + SM_CN + (32 * w + 16 * it + r) * 128 + (((4 * s + q) ^ r7) << 4));
#pragma unroll
    for (int jt = 0; jt < 8; ++jt)
#pragma unroll
      for (int s = 0; s < 2; ++s) {
        const bf16x8 bfr = *(const bf16x8*)(smh + SM_BN + (16 * jt + r) * 128 + (((4 * s + q) ^ r7) << 4));
        G[jt][0] = mfma16(bfr, cf[0][s], G[jt][0]); G[jt][1] = mfma16(bfr, cf[1][s], G[jt][1]);
      }
#pragma unroll
    for (int d = 0; d < 2; ++d) {
#pragma unroll
      for (int s = 0; s < 2; ++s) {
        union { bf16x8 b; u32x4 u; } c0, c1; c0.b = cf[0][s]; c1.b = cf[1][s];
        const bf16x8 cs0 = as_bf16x8(scale8(c0.u, efi[d][0])), cs1 = as_bf16x8(scale8(c1.u, efi[d][1]));
#pragma unroll
        for (int pt = 0; pt < 4; ++pt) {
          const bf16x8 hf = *(const bf16x8*)(smh + SM_RAW + d * 8192 + (16 * pt + r) * 128 + (((4 * s + q) ^ r7) << 4));
          y[pt][0] = mfma16(hf, cs0, y[pt][0]); y[pt][1] = mfma16(hf, cs1, y[pt][1]);
        }
      }
    }
    __syncthreads();
  }
#pragma unroll
  for (int s = 0; s < 4; ++s) {
    asm volatile("" ::: "memory");
    bf16x8 mf[2];
    const int wu = __builtin_amdgcn_readfirstlane(w);
    if (s < wu) {
      float aj[8], dfj[8];
#pragma unroll
      for (int jj = 0; jj < 8; ++jj) { const int j = 32 * s + (jj < 4 ? 4 * q + jj : 16 + 4 * q + jj - 4); aj[jj] = sm[512 + j]; dfj[jj] = sm[256 + j]; }
#pragma unroll
      for (int it = 0; it < 2; ++it) {
        float mv[8];
#pragma unroll
        for (int jj = 0; jj < 8; ++jj) mv[jj] = G[2 * s + (jj >> 2)][it][jj & 3] * __expf(acfi[it] - aj[jj]) * dfj[jj];
        u32x4 pk; pk.x = cvt_pk(mv[0], mv[1]); pk.y = cvt_pk(mv[2], mv[3]); pk.z = cvt_pk(mv[4], mv[5]); pk.w = cvt_pk(mv[6], mv[7]);
        mf[it] = as_bf16x8(pk);
      }
    } else if (s > wu) {
      float pj[8], dbj[8];
#pragma unroll
      for (int jj = 0; jj < 8; ++jj) { const int j = 32 * s + (jj < 4 ? 4 * q + jj : 16 + 4 * q + jj - 4); pj[jj] = sm[640 + j]; dbj[jj] = sm[384 + j]; }
#pragma unroll
      for (int it = 0; it < 2; ++it) {
        float mv[8];
#pragma unroll
        for (int jj = 0; jj < 8; ++jj) mv[jj] = G[2 * s + (jj >> 2)][it][jj & 3] * __expf(pj[jj] - prebi[it]) * dbj[jj];
        u32x4 pk; pk.x = cvt_pk(mv[0], mv[1]); pk.y = cvt_pk(mv[2], mv[3]); pk.z = cvt_pk(mv[4], mv[5]); pk.w = cvt_pk(mv[6], mv[7]);
        mf[it] = as_bf16x8(pk);
      }
    } else {
    float aj[8], pj[8], dfj[8], dbj[8];
#pragma unroll
    for (int jj = 0; jj < 8; ++jj) { const int j = 32 * s + (jj < 4 ? 4 * q + jj : 16 + 4 * q + jj - 4); aj[jj] = sm[512 + j]; pj[jj] = sm[640 + j]; dfj[jj] = sm[256 + j]; dbj[jj] = sm[384 + j]; }
#pragma unroll
    for (int it = 0; it < 2; ++it) {
      const int i = 32 * w + 16 * it + r;
      float mv[8];
#pragma unroll
      for (int jj = 0; jj < 8; ++jj) {
        const int j = 32 * s + (jj < 4 ? 4 * q + jj : 16 + 4 * q + jj - 4);
        const float gv = G[2 * s + (jj >> 2)][it][jj & 3];
        float m;
        if (j < i) m = gv * __expf(acfi[it] - aj[jj]) * dfj[jj];
        else if (j > i) m = gv * __expf(pj[jj] - prebi[it]) * dbj[jj];
        else m = gv * (dfj[jj] + dbj[jj]);
        mv[jj] = m;
      }
      u32x4 pk; pk.x = cvt_pk(mv[0], mv[1]); pk.y = cvt_pk(mv[2], mv[3]); pk.z = cvt_pk(mv[4], mv[5]); pk.w = cvt_pk(mv[6], mv[7]);
      mf[it] = as_bf16x8(pk);
    }
    }
#pragma unroll
    for (int pt = 0; pt < 4; ++pt) {
      const u32x2 lo2 = *(const u32x2*)(smh + SM_XT + (16 * pt + r) * 272 + (32 * s + 4 * q) * 2);
      const u32x2 hi2 = *(const u32x2*)(smh + SM_XT + (16 * pt + r) * 272 + (32 * s + 16 + 4 * q) * 2);
      const bf16x8 xf = as_bf16x8((u32x4){lo2.x, lo2.y, hi2.x, hi2.y});
      y[pt][0] = mfma16(xf, mf[0], y[pt][0]); y[pt][1] = mfma16(xf, mf[1], y[pt][1]);
    }
  }
  const float dsk = P.ssm_d[layer * 8 + h];
  const bf16_t* XT = (const bf16_t*)(smh + SM_XT);
  u32x2 zq[2][4]; f32x4 gq[4];
#pragma unroll
  for (int pt = 0; pt < 4; ++pt) {
    gq[pt] = *(const f32x4*)(P.ssm_g + layer * 512 + h * 64 + 16 * pt + 4 * q);
#pragma unroll
    for (int it = 0; it < 2; ++it) zq[it][pt] = *(const u32x2*)(PROJ + (size_t)(rowbase + 32 * w + 16 * it + r) * PW + 512 + h * 64 + 16 * pt + 4 * q);
  }
#pragma unroll
  for (int it = 0; it < 2; ++it) {
    const int i = 32 * w + 16 * it + r; const int row = rowbase + i;
    float ss = 0.f;
#pragma unroll
    for (int pt = 0; pt < 4; ++pt) {
      const int p0 = 16 * pt + 4 * q;
      const u32x2 zz = zq[it][pt];
      const f32x4 gg = gq[pt];
      const float zv[4] = {bflo(zz.x), bfhi(zz.x), bflo(zz.y), bfhi(zz.y)};
      float ov[4];
#pragma unroll
      for (int e = 0; e < 4; ++e) {
        const float xs = bf2f(XT[(p0 + e) * 136 + i]);
        const float yz = (y[pt][it][e] + dsk * xs) * silu_f(zv[e]);
        ss += yz * yz; ov[e] = yz * gg[e];
      }
      u32x2 o; o.x = cvt_pk(ov[0], ov[1]); o.y = cvt_pk(ov[2], ov[3]);
      *(u32x2*)(MIX + (size_t)row * 1024 + h * 64 + p0) = o;
    }
    ss += __shfl_xor(ss, 16); ss += __shfl_xor(ss, 32);
    if (q == 0 && do_atomic) atomicAdd(SSQ + row, ss);
  }
}

DEVI void mixer1_phase(const Params& P, int layer) {
  const int nA = 512, nV = 4 * 34 * 16, nC = (layer == 0) ? 64 : 0;
  const int total = nA + nV + nC;
#pragma unroll 1
  for (int it = VB; it < total; it += VG) {
    if (it < nA || it >= nA + nV) {
      int b, i1, i2; bool isctx = it >= nA;
      if (!isctx) { b = it >> 7; i1 = (it >> 2) & 31; i2 = it & 3; }
      else { const int e = it - nA - nV; b = e >> 4; i1 = (e >> 3) & 1; i2 = e & 7; }
      attn_item<0>(P, layer, b, i1, i2, isctx ? 1 : 0);
    } else { const int e = it - nA; const int b = e / 544, rem = e % 544; conv_item(P, layer, b, rem >> 4, rem & 15); }
  }
}
DEVI void mixer2_phase(const Params& P, int layer) {
  const int nB = 1024, nS = 4 * 34 * 8;
  const int total = nB + nS;
#pragma unroll 1
  for (int it = VB; it < total; it += VG) {
    if (it < nB) { const int b = it >> 8, gr = (it >> 2) & 63, h = it & 3; attn_item<1>(P, layer, b, gr, h, 0); }
    else { const int e = it - nB; const int b = e / 272, rem = e % 272; ssd_state_item(P, layer, b, rem >> 3, rem & 7); }
  }
}

DEVI void ssd_out_phase(const Params& P, int layer, int do_atomic = 1) {
  const int c0 = (layer == 0) ? 0 : 2;
  const int nc = 34 - c0;
  const int total = 4 * nc * 8;
#pragma unroll 1
  for (int it = VB; it < total; it += VG) {
    const int b = it / (nc * 8), rem = it % (nc * 8);
    ssd_out_item(P, layer, b, c0 + (rem >> 3), rem & 7, do_atomic);
  }
}


#define XB_TMO      128
#define XB_XCNT(j)  (256  + 64 * (j))
#define XB_XSUB(j)  (1280 + 64 * (j))
#define XB_XGEN(j)  (2304 + 64 * (j))
#define XB_TOP      3328
#define XB_TOPGEN   3392
#define XB_SPIN_CAP (1u << 18)
#define LAS __attribute__((address_space(3)))
DEVI unsigned xb_ld(unsigned* p)              { return __hip_atomic_load(p, __ATOMIC_RELAXED, __HIP_MEMORY_SCOPE_AGENT); }
DEVI unsigned xb_add(unsigned* p, unsigned v) { return __hip_atomic_fetch_add(p, v, __ATOMIC_RELAXED, __HIP_MEMORY_SCOPE_AGENT); }
DEVI unsigned xb_xcc_id() { return (unsigned)__builtin_amdgcn_s_getreg((3 << 11) | 20) & 0xFu; }
#define XB_SPIN(cond, bar) do { unsigned _sp = 0; while (cond) { __builtin_amdgcn_s_sleep(1); \
    if ((++_sp & 255u) == 0u) { if (xb_ld(&(bar)[XB_TMO])) break; if (_sp > XB_SPIN_CAP) { atomicAdd(&(bar)[XB_TMO], 1u); break; } } } } while (0)
struct XcdBarrier { unsigned* bar; unsigned x; volatile LAS unsigned* st; };
DEVI XcdBarrier xcd_barrier_post(unsigned* bar, volatile LAS unsigned* st) {
  XcdBarrier b; b.bar = bar; b.x = xb_xcc_id(); b.st = st;
  if (threadIdx.x == 0) (void)xb_add(&bar[XB_XCNT(b.x)], 1u);
  return b;
}
DEVI void xcd_barrier_complete(unsigned* bar, unsigned x, unsigned& nloc, unsigned& nx) {
  const unsigned G = gridDim.x * gridDim.y * gridDim.z;
  unsigned sum, cnt, mine, sp = 0u;
  for (;;) {
    sum = 0u; cnt = 0u; mine = 0u;
#pragma unroll
    for (unsigned j = 0; j < 16; ++j) { const unsigned c = xb_ld(&bar[XB_XCNT(j)]); sum += c; cnt += (c > 0u) ? 1u : 0u; mine = (j == x) ? c : mine; }
    if (sum == G) break;
    __builtin_amdgcn_s_sleep(1);
    if ((++sp & 255u) == 0u) { if (xb_ld(&bar[XB_TMO])) break; if (sp > XB_SPIN_CAP) { atomicAdd(&bar[XB_TMO], 1u); break; } }
  }
  nloc = mine > 0u ? mine : 1u; nx = cnt > 0u ? cnt : 1u;
}
DEVI void xcd_barrier(const XcdBarrier& b) {
  asm volatile("s_waitcnt vmcnt(0)" ::: "memory");
  __syncthreads();
  if (threadIdx.x == 0) {
    unsigned* bar = b.bar;
    __builtin_amdgcn_s_waitcnt(0);
    unsigned nloc = b.st[0], nx = b.st[1];
    if (nloc == 0u) { xcd_barrier_complete(bar, b.x, nloc, nx); b.st[0] = nloc; b.st[1] = nx; }
    const unsigned old = xb_add(&bar[XB_XSUB(b.x)], 1u);
    const unsigned gen = old / nloc;
    if (old + 1u == (gen + 1u) * nloc) {
      __builtin_amdgcn_fence(__ATOMIC_RELEASE, "agent");
      asm volatile("s_waitcnt vmcnt(0)" ::: "memory");
      const unsigned og = xb_add(&bar[XB_TOP], 1u);
      const unsigned tg = og / nx;
      if (og + 1u == (tg + 1u) * nx) xb_add(&bar[XB_TOPGEN], 1u);
      else XB_SPIN(xb_ld(&bar[XB_TOPGEN]) == tg, bar);
      __builtin_amdgcn_fence(__ATOMIC_ACQUIRE, "agent");
      xb_add(&bar[XB_XGEN(b.x)], 1u);
      asm volatile("s_waitcnt vmcnt(0)" ::: "memory");
    } else {
      XB_SPIN(xb_ld(&bar[XB_XGEN(b.x)]) == gen, bar);
      __builtin_amdgcn_fence(__ATOMIC_ACQUIRE, "agent");
      asm volatile("s_waitcnt vmcnt(0)" ::: "memory");
    }
  }
  __syncthreads();
}

__global__ void __launch_bounds__(512, 2) mega_fwd(Params P) {
  cg::grid_group grid = cg::this_grid();
  if (threadIdx.x == 0) *(uint4*)(smem + SM_XB) = make_uint4(0u, 0u, 0u, 0u);
  __syncthreads();
  XcdBarrier xb = xcd_barrier_post((unsigned*)(P.ws + OFF_BAR), (volatile LAS unsigned*)(smem + SM_XB));
  if (P.ph_hi > 1000) grid.sync();
#define BAR() xcd_barrier(xb)
#ifndef REP_S
#define REP_S -1
#endif
#define RUN(S_, CALL) { if (REP_S == (S_)) { const int do_at = 0; (void)do_at; CALL; BAR(); } { const int do_at = 1; (void)do_at; CALL; } BAR(); }
#define LAYER(l) \
  RUN(0, (norm_phase(P, l, 0), (l == 1 ? prep_phase(P, 1, false) : (void)0))) \
  RUN(1, (gemm_phase<MODE_INPROJ, false>(P, l))) \
  RUN(2, mixer1_phase(P, l)) \
  RUN(9, mixer2_phase(P, l)) \
  RUN(3, ssd_scan_phase(P)) \
  RUN(4, ssd_out_phase(P, l, do_at)) \
  RUN(5, (gemm_phase<MODE_RESID, true>(P, l))) \
  RUN(6, norm_phase(P, l, 1)) \
  RUN(7, (gemm_phase<MODE_SWIGLU, false>(P, l))) \
  RUN(8, (gemm_phase<MODE_RESID, false>(P, l)))
  prep_phase(P, 0, true); BAR();
  LAYER(0)
  LAYER(1)
  final_norm_phase(P);
}

extern "C" void kernel_launch(void* const* d_in, const int* in_sizes, int n_in, void* d_out, int out_size, void* d_ws, size_t ws_size, hipStream_t stream) {
  static int grid_blocks = 0;
  if (!grid_blocks) {
    int dev = 0, cus = 0, per_cu = 0;
    hipGetDevice(&dev);
    hipDeviceGetAttribute(&cus, hipDeviceAttributeMultiprocessorCount, dev);
    hipOccupancyMaxActiveBlocksPerMultiprocessor(&per_cu, mega_fwd, 512, 0);
    if (per_cu < 1) per_cu = 1;
    if (per_cu > 1) per_cu = 1;
    grid_blocks = cus * per_cu;
    if (ws_size < WS_END) fprintf(stderr, "kernel_launch: workspace too small: %zu < %zu\n", ws_size, (size_t)WS_END);
  }
  Params p{};
  const float** pp = (const float**)&p;
  for (int i = 0; i < 21; ++i) pp[i] = (const float*)d_in[i];
  p.out = (float*)d_out; p.ws = (unsigned char*)d_ws;
  hipMemsetAsync((unsigned char*)d_ws + OFF_MODS, 0, SZ_MODS + SZ_BAR, stream);
#if LAUNCH_PER_PHASE
  for (int ph = 0; ph < NPH; ++ph) {
    p.ph_lo = ph; p.ph_hi = ph + 1;
    hipLaunchKernelGGL(mega_fwd, dim3(grid_blocks), dim3(256), 0, stream, p);
  }
#else
  p.ph_lo = 0; p.ph_hi = NPH;
  void* args[] = {&p};
  hipError_t e = hipLaunchCooperativeKernel((void*)mega_fwd, dim3(grid_blocks), dim3(512), args, 0, stream);
  if (e != hipSuccess) fprintf(stderr, "cooperative launch failed: %s (grid %d)\n", hipGetErrorString(e), grid_blocks);
#endif
}
```

```cpp
#include <hip/hip_runtime.h>
#include <hip/hip_cooperative_groups.h>
#include <cstdio>
#include <cstdint>
namespace cg = cooperative_groups;

#ifndef LAUNCH_PER_PHASE
#define LAUNCH_PER_PHASE 0
#endif

typedef unsigned short bf16_t;
typedef short bf16x8 __attribute__((ext_vector_type(8)));
typedef float f32x4 __attribute__((ext_vector_type(4)));
typedef unsigned u32x4 __attribute__((ext_vector_type(4)));
typedef unsigned u32x2 __attribute__((ext_vector_type(2)));
#define DEVI __device__ __forceinline__

constexpr int T = 16384, TC = 1024, TT = T + TC;
constexpr int PW = 2816;
constexpr int NPH = 20;
constexpr float EPSN = 1e-6f;

constexpr size_t SZ_WIN = (size_t)2944 * 1024 * 2, SZ_WOUT = (size_t)1024 * 1024 * 2, SZ_WFI = (size_t)5632 * 1024 * 2, SZ_WFO = (size_t)1024 * 2816 * 2;
constexpr size_t OFF_WIN = 0;
constexpr size_t OFF_WOUT = OFF_WIN + SZ_WIN;
constexpr size_t OFF_WFI = OFF_WOUT + SZ_WOUT;
constexpr size_t OFF_WFO = OFF_WFI + SZ_WFI;
constexpr size_t OFF_H = OFF_WFO + SZ_WFO;
constexpr size_t OFF_PROJ = OFF_H + (size_t)TT * 1024 * 2;
constexpr size_t OFF_VT = OFF_PROJ + (size_t)TT * PW * 2;
constexpr size_t OFF_DT = OFF_VT + (size_t)384 * TT * 2;
constexpr size_t OFF_XC = OFF_DT + (size_t)TT * 16 * 4;
constexpr size_t OFF_MODS = OFF_XC + (size_t)TC * 1024 * 4;
constexpr size_t SZ_MODS = (size_t)2 * 5 * 6144 * 4;
constexpr size_t OFF_BAR = OFF_MODS + SZ_MODS;
constexpr size_t SZ_BAR = 3456 * 4;
constexpr size_t OFF_SSQ = OFF_BAR + SZ_BAR;
constexpr size_t OFF_ST = OFF_SSQ + (size_t)TT * 4;
constexpr size_t OFF_CD = OFF_ST + (size_t)64 * 34 * 8192 * 2;
constexpr size_t OFF_ROPE = OFF_CD + (size_t)64 * 34 * 4;
constexpr size_t OFF_XN = OFF_ROPE + 2 * 1024 * 4;
constexpr size_t OFF_XTX = OFF_XN + (size_t)TT * 512 * 2;
constexpr size_t OFF_XTB = OFF_XTX + (size_t)512 * TT * 2;
constexpr size_t WS_END = OFF_XTB + (size_t)256 * TT * 2;
static_assert(WS_END <= (size_t)256 * 1024 * 1024, "workspace map exceeds 256 MiB");

struct Params {
  const float *x, *c, *ctx, *c_ctx, *w_mod, *b_mod, *g_mix, *w_in, *wa_sink, *na_rpb, *conv_w, *conv_b, *dt_bias, *a_log, *ssm_d, *ssm_g, *w_out, *g_ffn, *w_ffn_in, *w_ffn_out, *g_final;
  float* out; unsigned char* ws; int ph_lo, ph_hi;
};

constexpr int HSTR = 73728, SM_XB = 2 * HSTR, SMEM_BYTES = 2 * HSTR + 16;
__shared__ __attribute__((aligned(16))) unsigned char smem[SMEM_BYTES];
#define NOINL __device__ __forceinline__

typedef __bf16 bf16x2_t __attribute__((ext_vector_type(2)));
typedef float f32x2_t __attribute__((ext_vector_type(2)));
DEVI unsigned cvt_pk(float lo, float hi) { f32x2_t v = {lo, hi}; bf16x2_t b = __builtin_convertvector(v, bf16x2_t); return __builtin_bit_cast(unsigned, b); }
DEVI float bflo(unsigned u) { return __uint_as_float(u << 16); }
DEVI float bfhi(unsigned u) { return __uint_as_float(u & 0xffff0000u); }
DEVI float bf2f(bf16_t h) { return __uint_as_float((unsigned)h << 16); }
DEVI float silu_f(float v) { return v * __builtin_amdgcn_rcpf(1.f + __expf(-v)); }
DEVI float softplus_f(float v) { const float e = __expf(v); return v > 20.f ? v : (e < 1e-3f ? e * (1.f - 0.5f * e) : __logf(1.f + e)); }
DEVI float wave_sum(float v) {
#pragma unroll
  for (int o = 32; o > 0; o >>= 1) v += __shfl_xor(v, o);
  return v;
}
DEVI float wave_incl_scan(float v, int lane) {
#pragma unroll
  for (int o = 1; o < 64; o <<= 1) { const float u = __shfl_up(v, o); if (lane >= o) v += u; }
  return v;
}
DEVI f32x4 mfma16(bf16x8 a, bf16x8 b, f32x4 c) { return __builtin_amdgcn_mfma_f32_16x16x32_bf16(a, b, c, 0, 0, 0); }
DEVI bf16x8 as_bf16x8(u32x4 v) { union { u32x4 u; bf16x8 b; } x; x.u = v; return x.b; }

DEVI u32x4 scale8(u32x4 v, float s) {
  u32x4 o;
  o.x = cvt_pk(bflo(v.x) * s, bfhi(v.x) * s); o.y = cvt_pk(bflo(v.y) * s, bfhi(v.y) * s);
  o.z = cvt_pk(bflo(v.z) * s, bfhi(v.z) * s); o.w = cvt_pk(bflo(v.w) * s, bfhi(v.w) * s);
  return o;
}
DEVI int tid_opq() { int t; asm volatile("v_mov_b32 %0, %1" : "=v"(t) : "v"((int)(threadIdx.x & 255))); return t; }
DEVI int half_id() { return __builtin_amdgcn_readfirstlane((int)(threadIdx.x >> 8)); }
#define VB (blockIdx.x * 2 + half_id())
#define VG (gridDim.x * 2)
DEVI int ufy(int v) { return __builtin_amdgcn_readfirstlane(v); }

NOINL void prep_phase(const Params& P, int wl, bool full) {
  unsigned char* const smh = smem + half_id() * HSTR;
  float* tile = (float*)smh;
  const int t = tid_opq();
  constexpr int I_IN = 46 * 16, I_OUT = 16 * 16, I_FI = 88 * 16, I_FO = 16 * 44, I_L = I_IN + I_OUT + I_FI + I_FO;
  constexpr int I_MOD = 2 * 16 * 24;
  const int total = I_L + (full ? I_MOD + 1 : 0);
  for (int it = VB; it < total; it += VG) {
    if (it < I_L) {
      const int l = wl; int r = it;
      const float* W; bf16_t* Wt; int K, N, kind, nt_, kt_;
      if (r < I_IN) { kind = 0; W = P.w_in + (size_t)l * 1024 * 2832; N = 2832; K = 1024; Wt = (bf16_t*)(P.ws + OFF_WIN); nt_ = r / 16; kt_ = r % 16; }
      else if (r < I_IN + I_OUT) { r -= I_IN; kind = 1; W = P.w_out + (size_t)l * 1024 * 1024; N = 1024; K = 1024; Wt = (bf16_t*)(P.ws + OFF_WOUT); nt_ = r / 16; kt_ = r % 16; }
      else if (r < I_IN + I_OUT + I_FI) { r -= I_IN + I_OUT; kind = 2; W = P.w_ffn_in + (size_t)l * 1024 * 5632; N = 5632; K = 1024; Wt = (bf16_t*)(P.ws + OFF_WFI); nt_ = r / 16; kt_ = r % 16; }
      else { r -= I_IN + I_OUT + I_FI; kind = 3; W = P.w_ffn_out + (size_t)l * 2816 * 1024; N = 1024; K = 2816; Wt = (bf16_t*)(P.ws + OFF_WFO); nt_ = r / 44; kt_ = r % 44; }
      {
        const int n4 = (t & 15) * 4, np = nt_ * 64 + n4;
        int col;
        if (kind == 0) {
          const int cb_ = np & ~127, w_ = np & 127;
          const bool plain_ = np < 2816 && !(cb_ < 256 || cb_ == 1024 || cb_ == 1152 || cb_ == 1536 || cb_ == 1664);
          col = np < 2832 ? (plain_ ? cb_ + (w_ >> 5) * 32 + ((w_ >> 2) & 3) * 8 + ((w_ >> 4) & 1) * 4 + (w_ & 3) : np) : -1;
        }
        else if (kind == 2) { const int w_ = np & 255;
          col = ((w_ >> 4) & 1) * 2816 + (np >> 8) * 128 + ((w_ >> 5) & 3) * 32 + ((w_ >> 2) & 3) * 8 + (w_ >> 7) * 4 + (w_ & 3); }
        else col = np;
#pragma unroll
        for (int i = 0; i < 4; ++i) {
          const int kk = i * 16 + (t >> 4);
          f32x4 v = (f32x4){0.f, 0.f, 0.f, 0.f};
          const int ksrc = kind == 1 ? ((kt_ * 64 + kk + 512) & 1023) : (kt_ * 64 + kk);
          if (col >= 0) v = *(const f32x4*)(W + (size_t)ksrc * N + col);
          tile[kk * 65 + n4] = v[0]; tile[kk * 65 + n4 + 1] = v[1]; tile[kk * 65 + n4 + 2] = v[2]; tile[kk * 65 + n4 + 3] = v[3];
        }
      }
      __syncthreads();
      {
        const int n = t >> 2, kc = (t & 3) * 16;
        u32x4 o0, o1;
        o0.x = cvt_pk(tile[(kc + 0) * 65 + n], tile[(kc + 1) * 65 + n]); o0.y = cvt_pk(tile[(kc + 2) * 65 + n], tile[(kc + 3) * 65 + n]);
        o0.z = cvt_pk(tile[(kc + 4) * 65 + n], tile[(kc + 5) * 65 + n]); o0.w = cvt_pk(tile[(kc + 6) * 65 + n], tile[(kc + 7) * 65 + n]);
        o1.x = cvt_pk(tile[(kc + 8) * 65 + n], tile[(kc + 9) * 65 + n]); o1.y = cvt_pk(tile[(kc + 10) * 65 + n], tile[(kc + 11) * 65 + n]);
        o1.z = cvt_pk(tile[(kc + 12) * 65 + n], tile[(kc + 13) * 65 + n]); o1.w = cvt_pk(tile[(kc + 14) * 65 + n], tile[(kc + 15) * 65 + n]);
        bf16_t* dst = Wt + (size_t)(nt_ * 64 + n) * K + kt_ * 64 + kc;
        *(u32x4*)dst = o0; *(u32x4*)(dst + 8) = o1;
      }
      __syncthreads();
    } else if (it < I_L + I_MOD) {
      const int m = it - I_L; const int l = m / 384, rem = m % 384, kc = rem / 24, cb = rem % 24;
      float* sv = (float*)smh;
      for (int e = t; e < 320; e += 256) { const int r = e >> 6, k = kc * 64 + (e & 63); const float v = r < 4 ? P.c[r * 1024 + k] : P.c_ctx[k]; sv[e] = v / (1.f + __expf(-v)); }
      __syncthreads();
      const int n = cb * 256 + t;
      float a0 = 0.f, a1 = 0.f, a2 = 0.f, a3 = 0.f, a4 = 0.f;
      const float* wp = P.w_mod + ((size_t)l * 1024 + kc * 64) * 6144 + n;
#pragma unroll 8
      for (int kk = 0; kk < 64; ++kk) { const float w = wp[(size_t)kk * 6144]; a0 += sv[kk] * w; a1 += sv[64 + kk] * w; a2 += sv[128 + kk] * w; a3 += sv[192 + kk] * w; a4 += sv[256 + kk] * w; }
      if (kc == 0) { const float bb = P.b_mod[l * 6144 + n]; a0 += bb; a1 += bb; a2 += bb; a3 += bb; a4 += bb; }
      float* md = (float*)(P.ws + OFF_MODS) + (size_t)l * 5 * 6144 + n;
      atomicAdd(md, a0); atomicAdd(md + 6144, a1); atomicAdd(md + 2 * 6144, a2); atomicAdd(md + 3 * 6144, a3); atomicAdd(md + 4 * 6144, a4);
      __syncthreads();
    } else {
      float* rc = (float*)(P.ws + OFF_ROPE);
      for (int e = t; e < 1024; e += 256) { const int pos = e >> 4, i = e & 15; const float inv = __builtin_amdgcn_exp2f(-(float)i * (13.287712379549449f / 16.f)); float xr = (float)pos * inv * 0.15915494309189535f; xr -= floorf(xr); rc[e] = __builtin_amdgcn_cosf(xr); rc[1024 + e] = __builtin_amdgcn_sinf(xr); }
    }
  }
}

NOINL void norm_phase(const Params& P, int layer, int which) {
  const float* src_lat = (layer == 0 && which == 0) ? P.x : P.out; const float* src_ctx = (layer == 0 && which == 0) ? P.ctx : (const float*)(P.ws + OFF_XC);
  const int M = (which == 0 || layer == 0) ? TT : T;
  const int t_ = tid_opq(); const int lane = t_ & 63, wv = t_ >> 6;
  const int gw = VB * 4 + wv, nw = VG * 4;
  const float* g = (which == 0 ? P.g_mix : P.g_ffn) + layer * 1024;
  bf16_t* H = (bf16_t*)(P.ws + OFF_H);
  float* ssq = (float*)(P.ws + OFF_SSQ);
  for (int row = gw; row < M; row += nw) {
    const float* xr = row < T ? src_lat + (size_t)row * 1024 : src_ctx + (size_t)(row - T) * 1024;
    const int mr = row < T ? (row >> 12) : 4;
    const float* md = (const float*)(P.ws + OFF_MODS) + (size_t)(layer * 5 + mr) * 6144 + which * 3072;
    f32x4 v[4]; float s = 0.f;
#pragma unroll
    for (int j = 0; j < 4; ++j) { v[j] = *(const f32x4*)(xr + 4 * (lane + 64 * j)); s += v[j][0] * v[j][0] + v[j][1] * v[j][1] + v[j][2] * v[j][2] + v[j][3] * v[j][3]; }
    s = wave_sum(s);
    const float rstd = rsqrtf(s * (1.f / 1024.f) + EPSN);
    f32x4 ggv[4], shv[4], scv[4];
#pragma unroll
    for (int j = 0; j < 4; ++j) { const int k = 4 * (lane + 64 * j); ggv[j] = *(const f32x4*)(g + k); shv[j] = *(const f32x4*)(md + k); scv[j] = *(const f32x4*)(md + 1024 + k); }
#pragma unroll
    for (int j = 0; j < 4; ++j) {
      const int k = 4 * (lane + 64 * j);
      const f32x4 gg = ggv[j], sh = shv[j], sc = scv[j];
      f32x4 h;
#pragma unroll
      for (int e = 0; e < 4; ++e) h[e] = v[j][e] * rstd * gg[e] * (1.f + sc[e]) + sh[e];
      u32x2 o; o.x = cvt_pk(h[0], h[1]); o.y = cvt_pk(h[2], h[3]);
      *(u32x2*)(H + (size_t)row * 1024 + k) = o;
    }
    if (which == 0 && lane == 0) ssq[row] = 0.f;
  }
}

NOINL void final_norm_phase(const Params& P) {
  const int t_ = tid_opq(); const int lane = t_ & 63, wv = t_ >> 6;
  const int gw = VB * 4 + wv, nw = VG * 4;
  for (int row = gw; row < T; row += nw) {
    float* xr = P.out + (size_t)row * 1024;
    f32x4 v[4]; float s = 0.f;
#pragma unroll
    for (int j = 0; j < 4; ++j) { v[j] = *(const f32x4*)(xr + 4 * (lane + 64 * j)); s += v[j][0] * v[j][0] + v[j][1] * v[j][1] + v[j][2] * v[j][2] + v[j][3] * v[j][3]; }
    s = wave_sum(s);
    const float rstd = rsqrtf(s * (1.f / 1024.f) + EPSN);
#pragma unroll
    for (int j = 0; j < 4; ++j) {
      const int k = 4 * (lane + 64 * j);
      const f32x4 gg = *(const f32x4*)(P.g_final + k);
      f32x4 h;
#pragma unroll
      for (int e = 0; e < 4; ++e) h[e] = v[j][e] * rstd * gg[e];
      *(f32x4*)(xr + k) = h;
    }
  }
}

namespace pg8 {
#define PG8_LAS __attribute__((address_space(3)))
typedef unsigned short bf16_t;
typedef short bf16x8 __attribute__((ext_vector_type(8)));
typedef float f32x4 __attribute__((ext_vector_type(4)));
typedef unsigned u32x4 __attribute__((ext_vector_type(4)));
constexpr int BM = 256, BK = 64, HALF = 128, HTB = HALF * BK * 2  , STAGE_BYTES = 8 * HTB, NXCD = 8, WGM = 8;

__host__ __device__ __forceinline__ int lds_byte(int r, int c) { const int st = (r >> 4) * 2 + (c >> 5), rr = r & 15, cc = c & 31, ob = rr * 64 + cc * 2; return st * 1024 + (ob ^ (((ob >> 9) & 1) << 5)); }
__host__ __device__ __forceinline__ void stage_rc(int b, int& R, int& C) { const int st = b / 1024, sb = b % 1024, swz = sb ^ (((sb >> 9) & 1) << 5); R = (st >> 1) * 16 + swz / 64; C = (st & 1) * 32 + (swz % 64) / 2; }
__host__ __device__ __forceinline__ int perm32(int rho) { const int n = rho >> 4, i = rho & 15; return 8 * (i >> 2) + 4 * n + (i & 3); }

struct Unit { int pm, pn; };
struct Gemm { const bf16_t* A; const bf16_t* Bt; int M, N, K; };

struct StaticOrder {
    int nM, nN, nwg, G, c;
    __host__ __device__ void init(int M, int N, int G_, int c_) { nM = M / BM; nN = N / BM; nwg = nM * nN; G = G_; c = c_; }
    __host__ __device__ bool next(int i, Unit& u) const {
        const long L = (long)i * G + c; if (L >= nwg) return false;
        int wgid = (int)L; { const int q = nwg / NXCD, r = nwg % NXCD, xcd = wgid % NXCD, off = wgid / NXCD; wgid = (xcd < r ? xcd * (q + 1) : r * (q + 1) + (xcd - r) * q) + off; }
        const int nig = WGM * nN, gid = wgid / nig, fm = gid * WGM, gsz = (nM - fm) < WGM ? (nM - fm) : WGM;
        u.pm = fm + ((wgid % nig) % gsz); u.pn = (wgid % nig) / gsz; return true;
    }
    __device__ __forceinline__ void a_ready(const Unit&) const {}
    __device__ __forceinline__ void done(const Unit&) const {}
};

template <class Epi, class Sched, bool ALIGN_EPI = false, bool SP2 = false>
__device__ __forceinline__ void gemm_phase(PG8_LAS unsigned char* lds, const Gemm g, const Sched& S, const Epi& E) {
    int tid_; asm volatile("v_mov_b32 %0, %1" : "=v"(tid_) : "v"((int)threadIdx.x)); const int tid = tid_, wid = __builtin_amdgcn_readfirstlane(tid >> 6), lane = tid & 63, wr = wid >> 2, wc = wid & 3, fr = lane & 15, fq = lane >> 4;
    const int K = g.K, nt = K / BK;
    unsigned voffA[2], voffB[2];
#pragma unroll
    for (int i = 0; i < 2; ++i) { int R, C; stage_rc(tid * 16 + i * 8192, R, C); const int Rb = Epi::PERM ? ((R & ~31) + perm32(R & 31)) : R;
        voffA[i] = (unsigned)(R * K + C) * 2u; voffB[i] = (unsigned)(Rb * K + C) * 2u; }
    const size_t kstep = (size_t)(BK * 2);
    const size_t hstep = (size_t)HALF * K * 2;
    const size_t tstep = 2 * hstep;
    const unsigned ldsw = (unsigned)wid * 1024u;
    const int aoff = lds_byte(wr * 64 + fr, fq * 8), boff = lds_byte(wc * 32 + fr, fq * 8);
#define PG8_SA(b, h) (((b) * 2 + (h)) * HTB)
#define PG8_SB(b, h) ((4 + (b) * 2 + (h)) * HTB)
#define PG8_STAGE(bufoff, gbase, voff) do { _Pragma("unroll") for (int _i = 0; _i < 2; ++_i) \
        __builtin_amdgcn_global_load_lds((const unsigned*)((const char*)(gbase) + (voff)[_i]), (PG8_LAS unsigned*)(lds + (bufoff) + ldsw + _i * 8192), 16, 0, 0); } while (0)
#define PG8_LDA(dst, b, h) do { _Pragma("unroll") for (int m = 0; m < 4; ++m) _Pragma("unroll") for (int k = 0; k < 2; ++k) dst[m][k] = *(const PG8_LAS bf16x8*)(lds + PG8_SA(b, h) + aoff + m * 2048 + k * 1024); } while (0)
#define PG8_LDB(dst, b, h) do { _Pragma("unroll") for (int n = 0; n < 2; ++n) _Pragma("unroll") for (int k = 0; k < 2; ++k) dst[n][k] = *(const PG8_LAS bf16x8*)(lds + PG8_SB(b, h) + boff + n * 2048 + k * 1024); } while (0)
#define PG8_MMA(ai, bj, At, Bt) do { __builtin_amdgcn_s_setprio(1); _Pragma("unroll") for (int m = 0; m < 4; ++m) _Pragma("unroll") for (int n = 0; n < 2; ++n) _Pragma("unroll") for (int k = 0; k < 2; ++k) \
        acc[ai][bj][m][n] = __builtin_amdgcn_mfma_f32_16x16x32_bf16(Bt[n][k], At[m][k], acc[ai][bj][m][n], 0, 0, 0); __builtin_amdgcn_s_setprio(0); } while (0)
#define PG8_WAIT_V(n) asm volatile("s_waitcnt vmcnt(" #n ")" ::: "memory")
#define PG8_WAIT_L(n) asm volatile("s_waitcnt lgkmcnt(" #n ")" ::: "memory")
#define PG8_BAR __builtin_amdgcn_s_barrier()
#define PG8_SCHED __builtin_amdgcn_sched_barrier(0)
    Unit cur, nxt; int ui = 0;
    if (!S.next(0, cur)) return;
    f32x4 acc[2][2][4][2];
#pragma unroll
    for (int a = 0; a < 2; ++a)
#pragma unroll
        for (int b = 0; b < 2; ++b)
#pragma unroll
            for (int m = 0; m < 4; ++m)
#pragma unroll
                for (int n = 0; n < 2; ++n) acc[a][b][m][n] = (f32x4){0.f, 0.f, 0.f, 0.f};
    bf16x8 At[4][2], B0[2][2], B1[2][2];
    const char* cA = (const char*)g.A + (size_t)cur.pm * tstep; const char* cB = (const char*)g.Bt + (size_t)cur.pn * tstep;
    S.a_ready(cur);
    if constexpr (SP2) {
        PG8_STAGE(PG8_SB(0, 0), cB, voffB); PG8_STAGE(PG8_SB(0, 1), cB + hstep, voffB); PG8_STAGE(PG8_SA(0, 0), cA, voffA); PG8_STAGE(PG8_SA(0, 1), cA + hstep, voffA);
        if (wr == 1) PG8_BAR;
        PG8_WAIT_V(2); PG8_BAR;
        PG8_STAGE(PG8_SB(1, 0), cB + kstep, voffB); PG8_STAGE(PG8_SA(1, 0), cA + kstep, voffA); PG8_STAGE(PG8_SB(1, 1), cB + hstep + kstep, voffB);
        PG8_WAIT_V(6); PG8_BAR;
    } else {
        PG8_STAGE(PG8_SB(0, 0), cB, voffB); PG8_STAGE(PG8_SA(0, 0), cA, voffA); PG8_STAGE(PG8_SB(0, 1), cB + hstep, voffB); PG8_STAGE(PG8_SA(0, 1), cA + hstep, voffA);
        if (wr == 1) PG8_BAR;
        PG8_WAIT_V(4); PG8_BAR;
        PG8_STAGE(PG8_SB(1, 0), cB + kstep, voffB); PG8_STAGE(PG8_SA(1, 0), cA + kstep, voffA); PG8_STAGE(PG8_SB(1, 1), cB + hstep + kstep, voffB);
        PG8_WAIT_V(6); PG8_BAR;
    }
    for (;;) {
        const bool has_next = S.next(ui + 1, nxt);
        const char* nA = has_next ? (const char*)g.A + (size_t)nxt.pm * tstep : cA; const char* nB = has_next ? (const char*)g.Bt + (size_t)nxt.pn * tstep : cB;
        for (int t = 0; t < nt; t += 2) {
            if constexpr (Epi::MIDSCALE) { if (t == 8) E.midscale(acc, cur, wr, fr); }
            const bool last = (t == nt - 2);
            const char* a1 = cA + (size_t)(t + 1) * kstep;
            const char* a2 = last ? nA : cA + (size_t)(t + 2) * kstep; const char* b2 = last ? nB : cB + (size_t)(t + 2) * kstep;
            const char* a3 = a2 + kstep; const char* b3 = b2 + kstep;
            if (last && has_next) S.a_ready(nxt);
            if constexpr (SP2) {
            PG8_LDB(B0, 0, 0); PG8_LDB(B1, 0, 1); PG8_SCHED; PG8_LDA(At, 0, 0); PG8_STAGE(PG8_SA(1, 1), a1 + hstep, voffA);
            PG8_WAIT_V(8); PG8_WAIT_L(0); PG8_BAR; PG8_MMA(0, 0, At, B0); PG8_MMA(0, 1, At, B1); PG8_BAR; PG8_SCHED;
            PG8_LDA(At, 0, 1); PG8_STAGE(PG8_SB(0, 0), b2, voffB); PG8_STAGE(PG8_SB(0, 1), b2 + hstep, voffB); PG8_STAGE(PG8_SA(0, 0), a2, voffA);
            PG8_WAIT_V(8); PG8_WAIT_L(0); PG8_BAR; PG8_MMA(1, 0, At, B0); PG8_MMA(1, 1, At, B1); PG8_BAR; PG8_SCHED;
            PG8_LDB(B0, 1, 0); PG8_LDB(B1, 1, 1); PG8_SCHED; PG8_LDA(At, 1, 0); PG8_STAGE(PG8_SA(0, 1), a2 + hstep, voffA);
            PG8_WAIT_V(8); PG8_WAIT_L(0); PG8_BAR; PG8_MMA(0, 0, At, B0); PG8_MMA(0, 1, At, B1); PG8_BAR; PG8_SCHED;
            PG8_LDA(At, 1, 1); PG8_STAGE(PG8_SB(1, 0), b3, voffB); PG8_STAGE(PG8_SB(1, 1), b3 + hstep, voffB); PG8_STAGE(PG8_SA(1, 0), a3, voffA);
            PG8_WAIT_V(8); PG8_WAIT_L(0); PG8_BAR; PG8_MMA(1, 0, At, B0); PG8_MMA(1, 1, At, B1); PG8_BAR; PG8_SCHED;
            } else {
            PG8_LDB(B0, 0, 0); PG8_SCHED; PG8_LDA(At, 0, 0); PG8_STAGE(PG8_SA(1, 1), a1 + hstep, voffA);
            PG8_WAIT_L(8); PG8_BAR; PG8_WAIT_L(0); PG8_MMA(0, 0, At, B0); PG8_BAR; PG8_SCHED;
            PG8_LDB(B1, 0, 1); PG8_STAGE(PG8_SB(0, 0), b2, voffB);
            PG8_BAR; PG8_WAIT_L(0); PG8_MMA(0, 1, At, B1); PG8_BAR;
            PG8_LDA(At, 0, 1); PG8_STAGE(PG8_SA(0, 0), a2, voffA);
            PG8_BAR; PG8_WAIT_L(0); PG8_MMA(1, 0, At, B0); PG8_BAR; PG8_SCHED;
            PG8_STAGE(PG8_SB(0, 1), b2 + hstep, voffB);
            PG8_WAIT_V(6); PG8_BAR; PG8_MMA(1, 1, At, B1); PG8_BAR;
            PG8_LDB(B0, 1, 0); PG8_SCHED; PG8_LDA(At, 1, 0); PG8_STAGE(PG8_SA(0, 1), a2 + hstep, voffA);
            PG8_WAIT_L(8); PG8_BAR; PG8_WAIT_L(0); PG8_MMA(0, 0, At, B0); PG8_BAR; PG8_SCHED;
            PG8_LDB(B1, 1, 1); PG8_STAGE(PG8_SB(1, 0), b3, voffB);
            PG8_BAR; PG8_WAIT_L(0); PG8_MMA(0, 1, At, B1); PG8_BAR;
            PG8_LDA(At, 1, 1); PG8_STAGE(PG8_SA(1, 0), a3, voffA);
            PG8_BAR; PG8_WAIT_L(0); PG8_MMA(1, 0, At, B0); PG8_BAR; PG8_SCHED;
            PG8_STAGE(PG8_SB(1, 1), b3 + hstep, voffB);
            PG8_WAIT_V(6); PG8_BAR; PG8_MMA(1, 1, At, B1); PG8_BAR;
            }
        }
        if constexpr (ALIGN_EPI) { if (wr == 0) PG8_BAR; }
        if constexpr (!Epi::AFTER_DRAIN) { E(acc, cur, wr, wc, fr, fq); S.done(cur); }
        if (!has_next) break;
#pragma unroll
        for (int a = 0; a < 2; ++a)
#pragma unroll
            for (int b = 0; b < 2; ++b)
#pragma unroll
                for (int m = 0; m < 4; ++m)
#pragma unroll
                    for (int n = 0; n < 2; ++n) acc[a][b][m][n] = (f32x4){0.f, 0.f, 0.f, 0.f};
        cur = nxt; cA = nA; cB = nB; ++ui;
        if constexpr (ALIGN_EPI) { if (wr == 1) PG8_BAR; }
    }
    PG8_WAIT_V(0);
    if constexpr (!ALIGN_EPI) { if (wr == 0) PG8_BAR; }
    PG8_BAR;
    if constexpr (Epi::AFTER_DRAIN) { E.fused(acc, cur, wr, wc, fr, fq, lds, wid, lane); S.done(cur); }
#undef PG8_SA
#undef PG8_SB
#undef PG8_STAGE
#undef PG8_LDA
#undef PG8_LDB
#undef PG8_MMA
#undef PG8_WAIT_V
#undef PG8_WAIT_L
#undef PG8_BAR
#undef PG8_SCHED
}
}

struct EpiInProj {
  static constexpr bool PERM = false, AFTER_DRAIN = false, MIDSCALE = false;
  unsigned char* ws;
  DEVI void operator()(const f32x4 (&acc)[2][2][4][2], const pg8::Unit& u, int wr, int wc, int fr, int fq) const {
    bf16_t* PROJ = (bf16_t*)(ws + OFF_PROJ); bf16_t* VT = (bf16_t*)(ws + OFF_VT); const float* rc = (const float*)(ws + OFF_ROPE);
    const int rowb = u.pm * 256 + wr * 64 + fr;
#pragma unroll
    for (int bj = 0; bj < 2; ++bj) {
      const int cb = u.pn * 256 + bj * 128;
      const bool isv = (cb == 1152) || (cb == 1536) || (cb == 1664);
      const bool do_rope = (cb < 256) || (cb == 1024);
      const float qs = cb < 512 ? 0.125f : 1.f;
      const int vchb = (cb == 1152 ? 0 : 128 + (cb - 1536)) + 32 * wc + 4 * fq;
#pragma unroll
      for (int ai = 0; ai < 2; ++ai)
#pragma unroll
        for (int m = 0; m < 4; ++m) {
          const int row = rowb + 128 * ai + 16 * m;
          f32x4 v0 = acc[ai][bj][m][0], v1 = acc[ai][bj][m][1];
          if (isv) {
#pragma unroll
            for (int e = 0; e < 4; ++e) { VT[(unsigned)((vchb + e) * TT + row)] = (bf16_t)(cvt_pk(v0[e], 0.f) & 0xffffu); VT[(unsigned)((vchb + 16 + e) * TT + row)] = (bf16_t)(cvt_pk(v1[e], 0.f) & 0xffffu); }
          } else {
            if (do_rope && row < T) {
              const int pos = row & 4095, pp = (wc & 1) ? (pos & 63) : (pos >> 6);
              const f32x4 cs = *(const f32x4*)(rc + pp * 16 + 4 * fq), sn = *(const f32x4*)(rc + 1024 + pp * 16 + 4 * fq);
#pragma unroll
              for (int e = 0; e < 4; ++e) { const float x1 = v0[e], x2 = v1[e]; v0[e] = x1 * cs[e] - x2 * sn[e]; v1[e] = x2 * cs[e] + x1 * sn[e]; }
            }
            u32x2 o0, o1; o0.x = cvt_pk(v0[0] * qs, v0[1] * qs); o0.y = cvt_pk(v0[2] * qs, v0[3] * qs); o1.x = cvt_pk(v1[0] * qs, v1[1] * qs); o1.y = cvt_pk(v1[2] * qs, v1[3] * qs);
            *(u32x4*)(PROJ + (unsigned)(row * PW + cb + 32 * wc + 8 * fq)) = (u32x4){o0.x, o0.y, o1.x, o1.y};
          }
        }
    }
  }
};
struct EpiSwiglu {
  static constexpr bool PERM = false, AFTER_DRAIN = false, MIDSCALE = false;
  unsigned char* ws;
  DEVI void operator()(const f32x4 (&acc)[2][2][4][2], const pg8::Unit& u, int wr, int wc, int fr, int fq) const {
    bf16_t* G = (bf16_t*)(ws + OFF_PROJ);
    const int rowb = u.pm * 256 + wr * 64 + fr;
#pragma unroll
    for (int ai = 0; ai < 2; ++ai)
#pragma unroll
      for (int m = 0; m < 4; ++m) {
        const int row = rowb + 128 * ai + 16 * m;
        float o0[4], o1[4];
#pragma unroll
        for (int e = 0; e < 4; ++e) { o0[e] = silu_f(acc[ai][0][m][0][e]) * acc[ai][0][m][1][e]; o1[e] = silu_f(acc[ai][1][m][0][e]) * acc[ai][1][m][1][e]; }
        u32x4 ov; ov.x = cvt_pk(o0[0], o0[1]); ov.y = cvt_pk(o0[2], o0[3]); ov.z = cvt_pk(o1[0], o1[1]); ov.w = cvt_pk(o1[2], o1[3]);
        *(u32x4*)(G + (unsigned)(row * 2816 + u.pn * 128 + wc * 32 + 8 * fq)) = ov;
      }
  }
};
template <bool MID>
struct EpiResid {
  static constexpr bool PERM = false, AFTER_DRAIN = false, MIDSCALE = MID;
  unsigned char* ws; const float* rin_lat; const float* rin_ctx; float* rout_lat; float* rout_ctx; int layer, gate_idx;
  DEVI void midscale(f32x4 (&acc)[2][2][4][2], const pg8::Unit& u, int wr, int fr) const {
    const float* ssq = (const float*)(ws + OFF_SSQ) + u.pm * 256 + wr * 64 + fr;
    float sq[8];
#pragma unroll
    for (int k = 0; k < 8; ++k) sq[k] = ssq[128 * (k >> 2) + 16 * (k & 3)];
#pragma unroll
    for (int ai = 0; ai < 2; ++ai)
#pragma unroll
      for (int m = 0; m < 4; ++m) {
        const float rs = rsqrtf(sq[ai * 4 + m] * (1.f / 512.f) + EPSN);
#pragma unroll
        for (int bj = 0; bj < 2; ++bj) { acc[ai][bj][m][0] = acc[ai][bj][m][0] * rs; acc[ai][bj][m][1] = acc[ai][bj][m][1] * rs; }
      }
  }
  DEVI void operator()(const f32x4 (&acc)[2][2][4][2], const pg8::Unit& u, int wr, int wc, int fr, int fq) const {
    const bool lat = u.pm < T / 256;
    const int mr = lat ? (u.pm >> 4) : 4;
    const float* gpb = (const float*)(ws + OFF_MODS) + (size_t)(layer * 5 + mr) * 6144 + gate_idx * 1024;
    const float* rinb = lat ? rin_lat : rin_ctx; float* routb = lat ? rout_lat : rout_ctx;
    const int col0 = u.pn * 256 + wc * 32 + 4 * fq;
    const unsigned off0 = (unsigned)(((lat ? u.pm : u.pm - T / 256) * 256 + wr * 64 + fr) * 1024 + col0);
#pragma unroll
    for (int bj = 0; bj < 2; ++bj)
#pragma unroll
      for (int n = 0; n < 2; ++n) {
        const f32x4 gv = *(const f32x4*)(gpb + col0 + 128 * bj + 16 * n);
        f32x4 rv[8];
#pragma unroll
        for (int k = 0; k < 8; ++k) rv[k] = *(const f32x4*)(rinb + off0 + (unsigned)((128 * (k >> 2) + 16 * (k & 3)) * 1024 + 128 * bj + 16 * n));
#pragma unroll
        for (int ai = 0; ai < 2; ++ai)
#pragma unroll
          for (int m = 0; m < 4; ++m) {
            const unsigned off = off0 + (unsigned)((128 * ai + 16 * m) * 1024 + 128 * bj + 16 * n);
            f32x4 o;
#pragma unroll
            for (int e = 0; e < 4; ++e) o[e] = rv[ai * 4 + m][e] + gv[e] * acc[ai][bj][m][n][e];
            *(f32x4*)(routb + off) = o;
          }
      }
  }
};
constexpr int MODE_INPROJ = 0, MODE_RESID = 1, MODE_SWIGLU = 2;
template <int MODE, bool ASCALE>
DEVI void gemm_phase(const Params& P, int layer) {
  constexpr int K = (MODE == MODE_RESID && !ASCALE) ? 2816 : 1024;
  constexpr int N = MODE == MODE_INPROJ ? 2816 : (MODE == MODE_SWIGLU ? 5632 : 1024);
  const int M = (MODE == MODE_INPROJ || (layer == 0 && MODE != MODE_RESID)) ? TT : T;
  const bf16_t* A = (const bf16_t*)(P.ws + ((MODE == MODE_RESID && !ASCALE) ? OFF_PROJ : OFF_H));
  const bf16_t* Wt = (const bf16_t*)(P.ws + (MODE == MODE_INPROJ ? OFF_WIN : MODE == MODE_SWIGLU ? OFF_WFI : ASCALE ? OFF_WOUT : OFF_WFO));
  pg8::Gemm g{A, Wt, M, N, K}; pg8::StaticOrder S; S.init(M, N, (int)gridDim.x, (int)blockIdx.x);
  PG8_LAS unsigned char* lds = (PG8_LAS unsigned char*)smem;
  if constexpr (MODE == MODE_INPROJ) {
    EpiInProj E{P.ws};
    pg8::gemm_phase<EpiInProj, pg8::StaticOrder, true, true>(lds, g, S, E);
    const int lane = threadIdx.x & 63, r = lane & 15, q = lane >> 4;
    const bf16_t* Wd = Wt + (size_t)(2816 + r) * 1024 + 8 * q;
    float* DTb = (float*)(P.ws + OFF_DT);
    for (int tile = blockIdx.x * 8 + (threadIdx.x >> 6); tile < TT / 16; tile += gridDim.x * 8) {
      const bf16_t* Ar = A + (size_t)(16 * tile + r) * 1024 + 8 * q;
      f32x4 acc = (f32x4){0.f, 0.f, 0.f, 0.f};
#pragma unroll 8
      for (int s2 = 0; s2 < 32; ++s2) acc = mfma16(*(const bf16x8*)(Ar + 32 * s2), *(const bf16x8*)(Wd + 32 * s2), acc);
#pragma unroll
      for (int e = 0; e < 4; ++e) DTb[(size_t)(16 * tile + 4 * q + e) * 16 + r] = acc[e];
    }
  } else if constexpr (MODE == MODE_SWIGLU) {
    EpiSwiglu E{P.ws};
    pg8::gemm_phase<EpiSwiglu, pg8::StaticOrder, true, true>(lds, g, S, E);
  } else {
    float* XCp = (float*)(P.ws + OFF_XC);
    EpiResid<ASCALE> E{P.ws, (ASCALE && layer == 0) ? P.x : P.out, (ASCALE && layer == 0) ? P.ctx : XCp, P.out, XCp, layer, ASCALE ? 2 : 5};
    pg8::gemm_phase<EpiResid<ASCALE>, pg8::StaticOrder, false, true>(lds, g, S, E);
    if (layer == 0) {
      const int lane = threadIdx.x & 63, r = lane & 15, q = lane >> 4, w8 = threadIdx.x >> 6;
      const float* gpb = (const float*)(P.ws + OFF_MODS) + (size_t)(layer * 5 + 4) * 6144 + (ASCALE ? 2 : 5) * 1024;
      const float* rinb = ASCALE ? P.ctx : XCp;
      const float* ssq = (const float*)(P.ws + OFF_SSQ) + T;
      constexpr int PER = K / 32 / 8;
      float* part = (float*)smem;
      for (int tl = blockIdx.x; tl < 256; tl += gridDim.x) {
        const int r0 = (tl >> 4) * 64, n0 = (tl & 15) * 64;
        const bf16_t* Ar = A + (size_t)(T + r0 + r) * K + w8 * PER * 32 + 8 * q;
        const bf16_t* Br = Wt + (size_t)(n0 + r) * K + w8 * PER * 32 + 8 * q;
        f32x4 acc[4][4];
#pragma unroll
        for (int i = 0; i < 4; ++i)
#pragma unroll
          for (int j = 0; j < 4; ++j) acc[i][j] = (f32x4){0.f, 0.f, 0.f, 0.f};
#pragma unroll 2
        for (int s2 = 0; s2 < PER; ++s2) {
          bf16x8 af[4], bfr[4];
#pragma unroll
          for (int i = 0; i < 4; ++i) { af[i] = *(const bf16x8*)(Ar + (size_t)(16 * i) * K + 32 * s2); bfr[i] = *(const bf16x8*)(Br + (size_t)(16 * i) * K + 32 * s2); }
#pragma unroll
          for (int i = 0; i < 4; ++i)
#pragma unroll
            for (int j = 0; j < 4; ++j) acc[i][j] = mfma16(af[i], bfr[j], acc[i][j]);
        }
        const bool sc = ASCALE && w8 < 4;
        float sqv[16];
#pragma unroll
        for (int k = 0; k < 16; ++k) sqv[k] = ssq[r0 + 16 * (k >> 2) + 4 * q + (k & 3)];
#pragma unroll
        for (int i = 0; i < 4; ++i)
#pragma unroll
          for (int e = 0; e < 4; ++e) {
            const float rs = sc ? rsqrtf(sqv[i * 4 + e] * (1.f / 512.f) + EPSN) : 1.f;
#pragma unroll
            for (int j = 0; j < 4; ++j) part[w8 * 4096 + (16 * i + 4 * q + e) * 64 + 16 * j + r] = acc[i][j][e] * rs;
          }
        __syncthreads();
        float rres[8], gres[8];
#pragma unroll
        for (int k = 0; k < 8; ++k) { const int o = (int)threadIdx.x + 512 * k; rres[k] = rinb[(unsigned)((r0 + (o >> 6)) * 1024 + n0 + (o & 63))]; gres[k] = gpb[n0 + (o & 63)]; }
#pragma unroll
        for (int k = 0; k < 8; ++k) {
          const int o = (int)threadIdx.x + 512 * k, row = o >> 6, col = o & 63;
          float sum = 0.f;
#pragma unroll
          for (int pw = 0; pw < 8; ++pw) sum += part[pw * 4096 + o];
          XCp[(unsigned)((r0 + row) * 1024 + n0 + col)] = rres[k] + gres[k] * sum;
        }
        __syncthreads();
      }
    }
  }
}

template <int KIND>
NOINL void attn_item(const Params& P, int layer, int b, int i1, int i2, int isctx_) {
  unsigned char* const smh = smem + half_id() * HSTR;
  const bool isctx = isctx_ != 0;
  constexpr int NQT = (KIND == 1) ? 1 : 2;
  const int t = tid_opq(), lane = t & 63, w = t >> 6, r = lane & 15, q = lane >> 4, r7 = r & 7;
  const bf16_t* PROJ = (const bf16_t*)(P.ws + OFF_PROJ);
  const bf16_t* VT = (const bf16_t*)(P.ws + OFF_VT);
  bf16_t* MIX = (bf16_t*)(P.ws + OFF_H);
  constexpr bool DBL = (KIND == 1);
  constexpr int VSTR = DBL ? 272 : 136;
  unsigned char* Ks = smh; unsigned char* Vs = smh + (DBL ? 16384 : 8192); float* rpb = (float*)(smh + 33792);
  const int col0 = w == 0 ? 0 : (w == 1 ? 8 : (w == 2 ? 24 : 32));
  int qrow[NQT]; int qcol, kcol, vch, ocol, ntile; bool has_sink = false; float sinkv = 0.f;
  int r0g = 0;
  if (KIND == 0 && !isctx) {
    const int n = i1, head = i2;
#pragma unroll
    for (int qt = 0; qt < NQT; ++qt) qrow[qt] = b * 4096 + 128 * n + 32 * w + 16 * qt + r;
    qcol = head * 64; kcol = 1024 + (head >> 1) * 64; vch = (head >> 1) * 64; ocol = 512 + head * 64; ntile = 10; has_sink = true; sinkv = P.wa_sink[layer * 4 + head];
  } else if (KIND == 1) {
    const int gr = i1, h = i2;
    qrow[0] = b * 4096 + gr * 64 + 16 * w + r;
    qcol = 256 + 64 * h; kcol = 1280 + 64 * h; vch = 128 + 64 * h; ocol = 768 + 64 * h; ntile = 8;
    r0g = gr - 4 < 0 ? 0 : (gr - 4 > 56 ? 56 : gr - 4);
    __syncthreads();
    for (int e = t; e < 465; e += 256) rpb[e] = P.na_rpb[(size_t)(layer * 4 + h) * 465 + e];
  } else {
    const int qb = i1, hh = i2;
#pragma unroll
    for (int qt = 0; qt < NQT; ++qt) qrow[qt] = T + b * 256 + 128 * qb + 32 * w + 16 * qt + r;
    ntile = 4;
    if (hh < 4) { qcol = hh * 64; kcol = 1024 + (hh >> 1) * 64; vch = (hh >> 1) * 64; ocol = 512 + hh * 64; has_sink = true; sinkv = P.wa_sink[layer * 4 + hh]; }
    else { const int h = hh - 4; qcol = 256 + 64 * h; kcol = 1280 + 64 * h; vch = 128 + 64 * h; ocol = 768 + 64 * h; }
  }
  bf16x8 qf[NQT][2];
#pragma unroll
  for (int qt = 0; qt < NQT; ++qt)
#pragma unroll
    for (int s = 0; s < 2; ++s) qf[qt][s] = *(const bf16x8*)(PROJ + (size_t)qrow[qt] * PW + qcol + 32 * s + 8 * q);
  f32x4 o[4][NQT]; float mrun[NQT], lrun[NQT];
#pragma unroll
  for (int qt = 0; qt < NQT; ++qt) { mrun[qt] = -1e30f; lrun[qt] = 0.f;
#pragma unroll
    for (int dt = 0; dt < 4; ++dt) o[dt][qt] = (f32x4){0.f, 0.f, 0.f, 0.f}; }

  const int skip = (KIND == 0 && !isctx && i1 == 0) ? 2 : 0;
  const int nvalid = ntile - skip - ((KIND == 0 && !isctx && i1 == 31) ? 2 : 0);
  const int skey = t >> 2, sc0 = (t & 3) * 2;
  u32x4 pk0, pk1, pv0, pv1, pk2, pk3, pv2, pv3;
#define KV_ROW0(IDX, TI, KROW0) const int TI = (IDX) < 4 ? (IDX) : (IDX) + skip; \
    const int KROW0 = TI < 4 ? T + b * 256 + 64 * TI : (KIND == 1 ? b * 4096 + (r0g + 2 * (TI - 4)) * 64 : b * 4096 + 128 * (i1 - 1) + 64 * (TI - 4));
#define KV_LOAD(IDX) { KV_ROW0(IDX, ti_, kr0_) \
    const bf16_t* kp = PROJ + (size_t)(kr0_ + skey) * PW + kcol + sc0 * 8; pk0 = *(const u32x4*)kp; pk1 = *(const u32x4*)(kp + 8); \
    const bf16_t* vp = VT + (size_t)(vch + skey) * TT + kr0_ + sc0 * 8; pv0 = *(const u32x4*)vp; pv1 = *(const u32x4*)(vp + 8); \
    if (DBL && ti_ >= 4) { pk2 = *(const u32x4*)(kp + 64 * PW); pk3 = *(const u32x4*)(kp + 64 * PW + 8); pv2 = *(const u32x4*)(vp + 64); pv3 = *(const u32x4*)(vp + 72); } }
  KV_LOAD(0);
#pragma unroll 1
  for (int idx = 0; idx < nvalid; ++idx) {
    KV_ROW0(idx, ti, krow0)
    (void)krow0;
    const int kbase = 128 * (i1 - 1) + 64 * (ti - 4); const int kr = r0g + 2 * (ti - 4);
    const bool local2 = DBL && ti >= 4;
    __syncthreads();
    {
      *(u32x4*)(Ks + skey * 128 + ((sc0 ^ (skey & 7)) << 4)) = pk0; *(u32x4*)(Ks + skey * 128 + (((sc0 + 1) ^ (skey & 7)) << 4)) = pk1;
      u32x2* dst = (u32x2*)(Vs + skey * VSTR + sc0 * 16);
      dst[0] = (u32x2){pv0.x, pv0.y}; dst[1] = (u32x2){pv0.z, pv0.w}; dst[2] = (u32x2){pv1.x, pv1.y}; dst[3] = (u32x2){pv1.z, pv1.w};
      if (local2) {
        *(u32x4*)(Ks + (skey + 64) * 128 + ((sc0 ^ (skey & 7)) << 4)) = pk2; *(u32x4*)(Ks + (skey + 64) * 128 + (((sc0 + 1) ^ (skey & 7)) << 4)) = pk3;
        u32x2* dst2 = (u32x2*)(Vs + skey * VSTR + 128 + sc0 * 16);
        dst2[0] = (u32x2){pv2.x, pv2.y}; dst2[1] = (u32x2){pv2.z, pv2.w}; dst2[2] = (u32x2){pv3.x, pv3.y}; dst2[3] = (u32x2){pv3.z, pv3.w};
      }
    }
    __syncthreads();
    if (idx + 1 < nvalid) KV_LOAD(idx + 1);
    f32x4 sc[4][NQT];
#pragma unroll
    for (int kt = 0; kt < 4; ++kt) {
      const int krow = (local2 ? (kt >> 1) * 64 + col0 + 16 * (kt & 1) : 16 * kt) + r;
      const bf16x8 kf0 = *(const bf16x8*)(Ks + krow * 128 + ((q ^ r7) << 4));
      const bf16x8 kf1 = *(const bf16x8*)(Ks + krow * 128 + (((4 + q) ^ r7) << 4));
#pragma unroll
      for (int qt = 0; qt < NQT; ++qt) { sc[kt][qt] = mfma16(kf0, qf[qt][0], (f32x4){0.f, 0.f, 0.f, 0.f}); sc[kt][qt] = mfma16(kf1, qf[qt][1], sc[kt][qt]); }
    }
    if (ti >= 4) {
      if (KIND == 0) {
#pragma unroll
        for (int qt = 0; qt < NQT; ++qt) { const int qpos = 128 * i1 + 32 * w + 16 * qt + r;
#pragma unroll
          for (int kt = 0; kt < 4; ++kt)
#pragma unroll
            for (int e = 0; e < 4; ++e) { const int d = qpos - (kbase + 16 * kt + 4 * q + e); if (d > 128 || d < -128) sc[kt][qt][e] = -1e30f; } }
      } else if (KIND == 1) {
        const int qc = 16 * w + r; const int cs = qc - 8 < 0 ? 0 : (qc - 8 > 48 ? 48 : qc - 8);
#pragma unroll
        for (int kt = 0; kt < 4; ++kt) {
          const int dy = kr + (kt >> 1) - i1 + 7;
#pragma unroll
          for (int e = 0; e < 4; ++e) { const int kc = col0 + 16 * (kt & 1) + 4 * q + e; const bool ok = (kc >= cs) && (kc < cs + 16);
            int dx = kc - qc + 15; dx = dx < 0 ? 0 : (dx > 30 ? 30 : dx);
            sc[kt][0][e] = ok ? sc[kt][0][e] + rpb[dy * 31 + dx] : -1e30f; }
        }
      }
    }
    bf16x8 pf[2][NQT];
#pragma unroll
    for (int qt = 0; qt < NQT; ++qt) {
      float mx = -1e30f;
#pragma unroll
      for (int kt = 0; kt < 4; ++kt)
#pragma unroll
        for (int e = 0; e < 4; ++e) mx = fmaxf(mx, sc[kt][qt][e]);
      mx = fmaxf(mx, __shfl_xor(mx, 16)); mx = fmaxf(mx, __shfl_xor(mx, 32));
      const float mn = fmaxf(mrun[qt], mx); const float alpha = __expf(mrun[qt] - mn); mrun[qt] = mn;
      float ls = 0.f;
#pragma unroll
      for (int kt = 0; kt < 4; ++kt)
#pragma unroll
        for (int e = 0; e < 4; ++e) { const float p = __expf(sc[kt][qt][e] - mn); sc[kt][qt][e] = p; ls += p; }
      lrun[qt] = lrun[qt] * alpha + ls;
#pragma unroll
      for (int dt = 0; dt < 4; ++dt) o[dt][qt] = o[dt][qt] * alpha;
#pragma unroll
      for (int s = 0; s < 2; ++s) {
        u32x4 pk; pk.x = cvt_pk(sc[2 * s][qt][0], sc[2 * s][qt][1]); pk.y = cvt_pk(sc[2 * s][qt][2], sc[2 * s][qt][3]);
        pk.z = cvt_pk(sc[2 * s + 1][qt][0], sc[2 * s + 1][qt][1]); pk.w = cvt_pk(sc[2 * s + 1][qt][2], sc[2 * s + 1][qt][3]);
        pf[s][qt] = as_bf16x8(pk);
      }
    }
#pragma unroll
    for (int s = 0; s < 2; ++s)
#pragma unroll
      for (int dt = 0; dt < 4; ++dt) {
        const int vkb = local2 ? 64 * s + col0 : 32 * s;
        const u32x2 lo = *(const u32x2*)(Vs + (16 * dt + r) * VSTR + (vkb + 4 * q) * 2);
        const u32x2 hi = *(const u32x2*)(Vs + (16 * dt + r) * VSTR + (vkb + 16 + 4 * q) * 2);
        const bf16x8 vf = as_bf16x8((u32x4){lo.x, lo.y, hi.x, hi.y});
#pragma unroll
        for (int qt = 0; qt < NQT; ++qt) o[dt][qt] = mfma16(vf, pf[s][qt], o[dt][qt]);
      }
  }
#pragma unroll
  for (int qt = 0; qt < NQT; ++qt) {
    float l = lrun[qt]; l += __shfl_xor(l, 16); l += __shfl_xor(l, 32);
    float mf = mrun[qt]; float scale;
    if (has_sink) { const float m2 = fmaxf(mf, sinkv); const float a = __expf(mf - m2); l = l * a + __expf(sinkv - m2); scale = a / l; }
    else scale = 1.f / l;
#pragma unroll
    for (int dt = 0; dt < 4; ++dt) {
      u32x2 ov; ov.x = cvt_pk(o[dt][qt][0] * scale, o[dt][qt][1] * scale); ov.y = cvt_pk(o[dt][qt][2] * scale, o[dt][qt][3] * scale);
      *(u32x2*)(MIX + (size_t)qrow[qt] * 1024 + ocol + 16 * dt + 4 * q) = ov;
    }
  }
}

DEVI void ssd_load_raw(unsigned char* raw, const bf16_t* PROJ, int rowbase, int lo, int hi, int col0) {
  for (int e = tid_opq(); e < 134 * 8; e += 256) {
    const int rr = e >> 3, ch = e & 7; const int row = rowbase - 3 + rr;
    u32x4 v = (u32x4){0u, 0u, 0u, 0u};
    if (row >= lo && row < hi) v = *(const u32x4*)(PROJ + (size_t)row * PW + col0 + ch * 8);
    *(u32x4*)(raw + rr * 128 + ch * 16) = v;
  }
}

template <bool TRANSP, bool WEIGHTED>
DEVI void ssd_conv(const unsigned char* raw, const float* cw  , const float* cb, unsigned char* out1, unsigned char* out2, const float* wt1, const float* wt2) {
  const int t_ = tid_opq(); const int c = t_ & 63, tq = t_ >> 6;
  float wj[7];
#pragma unroll
  for (int j = 0; j < 7; ++j) wj[j] = cw[j * 1024 + c];
  const float bias = cb[c];
  const bf16_t* rp = (const bf16_t*)raw + c;
  float w0 = bf2f(rp[(32 * tq + 0) * 64]), w1 = bf2f(rp[(32 * tq + 1) * 64]), w2 = bf2f(rp[(32 * tq + 2) * 64]), w3 = bf2f(rp[(32 * tq + 3) * 64]), w4 = bf2f(rp[(32 * tq + 4) * 64]), w5 = bf2f(rp[(32 * tq + 5) * 64]);
  float hold1[4], hold2[4];
#pragma unroll 1
  for (int tg = 0; tg < 8; ++tg) {
#pragma unroll
    for (int t4 = 0; t4 < 4; ++t4) {
      const int tok = 32 * tq + 4 * tg + t4;
      const float w6 = bf2f(rp[(tok + 6) * 64]);
      float v = bias + wj[0] * w0 + wj[1] * w1 + wj[2] * w2 + wj[3] * w3 + wj[4] * w4 + wj[5] * w5 + wj[6] * w6;
      v = silu_f(v);
      w0 = w1; w1 = w2; w2 = w3; w3 = w4; w4 = w5; w5 = w6;
      if (TRANSP) {
        hold1[t4] = WEIGHTED ? v * wt1[tok] : v;
        if (WEIGHTED) hold2[t4] = v * wt2[tok];
        if (t4 == 3) {
          u32x2 o; o.x = cvt_pk(hold1[0], hold1[1]); o.y = cvt_pk(hold1[2], hold1[3]);
          *(u32x2*)(out1 + c * 272 + (tok - 3) * 2) = o;
          if (WEIGHTED) { u32x2 o2; o2.x = cvt_pk(hold2[0], hold2[1]); o2.y = cvt_pk(hold2[2], hold2[3]); *(u32x2*)(out2 + c * 272 + (tok - 3) * 2) = o2; }
        }
      } else {
        *(bf16_t*)(out1 + tok * 128 + (((c >> 3) ^ (tok & 7)) << 4) + (c & 7) * 2) = (bf16_t)(cvt_pk(v, 0.f) & 0xffffu);
      }
    }
  }
}

constexpr int SM_RAW = 0, SM_X1 = 17152, SM_X2 = 34560, SM_BT = 51968, SM_SMALL = 69376;
constexpr int SM_XT = 17152, SM_BN = 34560, SM_CN = 50944;

NOINL void conv_item(const Params& P, int layer, int b, int cidx, int slab) {
  unsigned char* const smh = smem + half_id() * HSTR;
  const int t = tid_opq(), c = t & 63, tq = t >> 6;
  const bf16_t* PROJ = (const bf16_t*)(P.ws + OFF_PROJ);
  bf16_t* XN = (bf16_t*)(P.ws + OFF_XN);
  int rowbase, lo, hi;
  if (cidx < 2) { lo = T + b * 256; hi = lo + 256; rowbase = lo + cidx * 128; } else { lo = b * 4096; hi = lo + 4096; rowbase = lo + (cidx - 2) * 128; }
  __syncthreads();
  ssd_load_raw(smh + SM_RAW, PROJ, rowbase, lo, hi, 1792 + slab * 64);
  __syncthreads();
  const float* cw = P.conv_w + (size_t)layer * 7 * 1024 + slab * 64 + c;
  float wj[7];
#pragma unroll
  for (int j = 0; j < 7; ++j) wj[j] = cw[j * 1024];
  const float bias = P.conv_b[layer * 1024 + slab * 64 + c];
  const bf16_t* rp = (const bf16_t*)(smh + SM_RAW) + c;
  float w0 = bf2f(rp[(32 * tq + 0) * 64]), w1 = bf2f(rp[(32 * tq + 1) * 64]), w2 = bf2f(rp[(32 * tq + 2) * 64]), w3 = bf2f(rp[(32 * tq + 3) * 64]), w4 = bf2f(rp[(32 * tq + 4) * 64]), w5 = bf2f(rp[(32 * tq + 5) * 64]);
  const bool nat = slab >= 8, tr = slab < 12;
  bf16_t* trp = slab < 8 ? (bf16_t*)(P.ws + OFF_XTX) + (size_t)(slab * 64 + c) * TT : (bf16_t*)(P.ws + OFF_XTB) + (size_t)((slab - 8) * 64 + c) * TT;
#pragma unroll 1
  for (int tg = 0; tg < 4; ++tg) {
    float hold[8];
#pragma unroll
    for (int t8 = 0; t8 < 8; ++t8) {
      const int tok = 32 * tq + 8 * tg + t8;
      const float w6 = bf2f(rp[(tok + 6) * 64]);
      float v = bias + wj[0] * w0 + wj[1] * w1 + wj[2] * w2 + wj[3] * w3 + wj[4] * w4 + wj[5] * w5 + wj[6] * w6;
      v = silu_f(v);
      w0 = w1; w1 = w2; w2 = w3; w3 = w4; w4 = w5; w5 = w6;
      hold[t8] = v;
      if (nat) XN[(size_t)(rowbase + tok) * 512 + (slab - 8) * 64 + c] = (bf16_t)(cvt_pk(v, 0.f) & 0xffffu);
    }
    if (tr) {
      u32x4 o; o.x = cvt_pk(hold[0], hold[1]); o.y = cvt_pk(hold[2], hold[3]); o.z = cvt_pk(hold[4], hold[5]); o.w = cvt_pk(hold[6], hold[7]);
      *(u32x4*)(trp + rowbase + 32 * tq + 8 * tg) = o;
    }
  }
}

NOINL void ssd_state_item(const Params& P, int layer, int b, int cidx, int h) {
  unsigned char* const smh = smem + half_id() * HSTR;
  const int t = tid_opq(), lane = t & 63, w = t >> 6, r = lane & 15, q = lane >> 4;
  const bf16_t* PROJ = (const bf16_t*)(P.ws + OFF_PROJ);
  const float* DTb = (const float*)(P.ws + OFF_DT);
  bf16_t* ST = (bf16_t*)(P.ws + OFF_ST);
  float* CD = (float*)(P.ws + OFF_CD);
  float* sm = (float*)(smh + SM_SMALL);
  int rowbase, lo, hi;
  if (cidx < 2) { lo = T + b * 256; hi = lo + 256; rowbase = lo + cidx * 128; } else { lo = b * 4096; hi = lo + 4096; rowbase = lo + (cidx - 2) * 128; }
  const int g = h >> 2;
  const float Af = -__expf(P.a_log[layer * 16 + h]), Ab = -__expf(P.a_log[layer * 16 + 8 + h]);
  __syncthreads();
  float inf_ = 0.f, inb_ = 0.f, ab_ = 0.f;
  if (t < 128) {
    const float df = softplus_f(DTb[(size_t)(rowbase + t) * 16 + h] + P.dt_bias[layer * 16 + h]);
    const float db = softplus_f(DTb[(size_t)(rowbase + t) * 16 + 8 + h] + P.dt_bias[layer * 16 + 8 + h]);
    sm[256 + t] = df; sm[384 + t] = db;
    ab_ = db * Ab; inf_ = wave_incl_scan(df * Af, lane); inb_ = wave_incl_scan(ab_, lane);
    if (lane == 63) { sm[772 + w] = inf_; sm[774 + w] = inb_; }
  }
  __syncthreads();
  if (t < 128) {
    const float acf = inf_ + (w == 1 ? sm[772] : 0.f), totf = sm[772] + sm[773];
    const float preb = inb_ - ab_ + (w == 1 ? sm[774] : 0.f), totb = sm[774] + sm[775];
    sm[512 + t] = __expf(totf - acf) * sm[256 + t];
    sm[640 + t] = __expf(preb) * sm[384 + t];
    if (t == 0) { const int seq = (b * 8 + h) * 2; CD[seq * 34 + cidx] = __expf(totf); CD[(seq + 1) * 34 + cidx] = __expf(totb); }
  }
  __syncthreads();
  {
    const bf16_t* XTX = (const bf16_t*)(P.ws + OFF_XTX);
#pragma unroll
    for (int k = 0; k < 4; ++k) {
      const int e = t + 256 * k, p = e >> 4, c16 = e & 15;
      const u32x4 v = *(const u32x4*)(XTX + (size_t)(h * 64 + p) * TT + rowbase + c16 * 8);
      const float* wf = sm + 512 + c16 * 8; const float* wb = sm + 640 + c16 * 8;
      u32x4 of, ob;
      of.x = cvt_pk(bflo(v.x) * wf[0], bfhi(v.x) * wf[1]); of.y = cvt_pk(bflo(v.y) * wf[2], bfhi(v.y) * wf[3]); of.z = cvt_pk(bflo(v.z) * wf[4], bfhi(v.z) * wf[5]); of.w = cvt_pk(bflo(v.w) * wf[6], bfhi(v.w) * wf[7]);
      ob.x = cvt_pk(bflo(v.x) * wb[0], bfhi(v.x) * wb[1]); ob.y = cvt_pk(bflo(v.y) * wb[2], bfhi(v.y) * wb[3]); ob.z = cvt_pk(bflo(v.z) * wb[4], bfhi(v.z) * wb[5]); ob.w = cvt_pk(bflo(v.w) * wb[6], bfhi(v.w) * wb[7]);
      *(u32x4*)(smh + SM_X1 + p * 272 + c16 * 16) = of; *(u32x4*)(smh + SM_X2 + p * 272 + c16 * 16) = ob;
    }
  }
#pragma unroll 1
  for (int nh = 0; nh < 2; ++nh) {
    {
      const bf16_t* XTB = (const bf16_t*)(P.ws + OFF_XTB);
#pragma unroll
      for (int k = 0; k < 4; ++k) {
        const int e = t + 256 * k, n = e >> 4, c16 = e & 15;
        *(u32x4*)(smh + SM_BT + n * 272 + c16 * 16) = *(const u32x4*)(XTB + (size_t)(g * 128 + nh * 64 + n) * TT + rowbase + c16 * 8);
      }
    }
    __syncthreads();
    f32x4 acc[4][2];
#pragma unroll
    for (int nt = 0; nt < 4; ++nt) { acc[nt][0] = (f32x4){0.f, 0.f, 0.f, 0.f}; acc[nt][1] = (f32x4){0.f, 0.f, 0.f, 0.f}; }
#pragma unroll
    for (int s = 0; s < 4; ++s) {
      const bf16x8 xf = *(const bf16x8*)(smh + SM_X1 + (16 * w + r) * 272 + (32 * s + 8 * q) * 2);
      const bf16x8 xb = *(const bf16x8*)(smh + SM_X2 + (16 * w + r) * 272 + (32 * s + 8 * q) * 2);
#pragma unroll
      for (int nt = 0; nt < 4; ++nt) {
        const bf16x8 bt = *(const bf16x8*)(smh + SM_BT + (16 * nt + r) * 272 + (32 * s + 8 * q) * 2);
        acc[nt][0] = mfma16(bt, xf, acc[nt][0]); acc[nt][1] = mfma16(bt, xb, acc[nt][1]);
      }
    }
#pragma unroll
    for (int dir = 0; dir < 2; ++dir) {
      bf16_t* sp = ST + ((size_t)(((b * 8 + h) * 2 + dir) * 34 + cidx)) * 8192 + (16 * w + r) * 128 + nh * 64 + 4 * q;
#pragma unroll
      for (int nt = 0; nt < 4; ++nt) { u32x2 ov; ov.x = cvt_pk(acc[nt][dir][0], acc[nt][dir][1]); ov.y = cvt_pk(acc[nt][dir][2], acc[nt][dir][3]); *(u32x2*)(sp + 16 * nt) = ov; }
    }
    __syncthreads();
  }
}

NOINL void ssd_scan_phase(const Params& P) {
  bf16_t* ST = (bf16_t*)(P.ws + OFF_ST);
  const float* CD = (const float*)(P.ws + OFF_CD);
  const int total = 64 * 2048;
  for (int gidx = VB * 256 + tid_opq(); gidx < total; gidx += VG * 256) {
    const int seq = gidx >> 11, e = gidx & 2047, dir = seq & 1;
    bf16_t* base = ST + (size_t)seq * 34 * 8192 + e * 4;
    const float* cd = CD + seq * 34;
    u32x2 v[34];
#pragma unroll
    for (int k = 0; k < 34; ++k) { const int ci = dir == 0 ? k : (k == 0 ? 1 : (k == 1 ? 0 : 35 - k)); v[k] = *(const u32x2*)(base + (size_t)ci * 8192); }
    float dk[34];
#pragma unroll
    for (int k = 0; k < 34; ++k) { const int ci = dir == 0 ? k : (k == 0 ? 1 : (k == 1 ? 0 : 35 - k)); dk[k] = cd[ci]; }
    float h0 = 0.f, h1 = 0.f, h2 = 0.f, h3 = 0.f;
#pragma unroll
    for (int k = 0; k < 34; ++k) {
      const int ci = dir == 0 ? k : (k == 0 ? 1 : (k == 1 ? 0 : 35 - k));
      u32x2 ov; ov.x = cvt_pk(h0, h1); ov.y = cvt_pk(h2, h3);
      *(u32x2*)(base + (size_t)ci * 8192) = ov;
      const float d = dk[k];
      h0 = h0 * d + bflo(v[k].x); h1 = h1 * d + bfhi(v[k].x); h2 = h2 * d + bflo(v[k].y); h3 = h3 * d + bfhi(v[k].y);
    }
  }
}

NOINL void ssd_out_item(const Params& P, int layer, int b, int cidx, int h, int do_atomic) {
  unsigned char* const smh = smem + half_id() * HSTR;
  const int t = tid_opq(), lane = t & 63, w = t >> 6, r = lane & 15, q = lane >> 4, r7 = r & 7;
  const bf16_t* PROJ = (const bf16_t*)(P.ws + OFF_PROJ);
  const float* DTb = (const float*)(P.ws + OFF_DT);
  const bf16_t* ST = (const bf16_t*)(P.ws + OFF_ST);
  bf16_t* MIX = (bf16_t*)(P.ws + OFF_H);
  float* SSQ = (float*)(P.ws + OFF_SSQ);
  float* sm = (float*)(smh + SM_SMALL);
  int rowbase, lo, hi;
  if (cidx < 2) { lo = T + b * 256; hi = lo + 256; rowbase = lo + cidx * 128; } else { lo = b * 4096; hi = lo + 4096; rowbase = lo + (cidx - 2) * 128; }
  const int g = h >> 2;
  const float Af = -__expf(P.a_log[layer * 16 + h]), Ab = -__expf(P.a_log[layer * 16 + 8 + h]);
  __syncthreads();
  float inf_ = 0.f, inb_ = 0.f, ab_ = 0.f;
  if (t < 128) {
    const float df = softplus_f(DTb[(size_t)(rowbase + t) * 16 + h] + P.dt_bias[layer * 16 + h]);
    const float db = softplus_f(DTb[(size_t)(rowbase + t) * 16 + 8 + h] + P.dt_bias[layer * 16 + 8 + h]);
    sm[256 + t] = df; sm[384 + t] = db;
    ab_ = db * Ab; inf_ = wave_incl_scan(df * Af, lane); inb_ = wave_incl_scan(ab_, lane);
    if (lane == 63) { sm[772 + w] = inf_; sm[774 + w] = inb_; }
  }
  {
    const bf16_t* XTX = (const bf16_t*)(P.ws + OFF_XTX);
#pragma unroll
    for (int k = 0; k < 4; ++k) {
      const int e = t + 256 * k, p = e >> 4, c16 = e & 15;
      *(u32x4*)(smh + SM_XT + p * 272 + c16 * 16) = *(const u32x4*)(XTX + (size_t)(h * 64 + p) * TT + rowbase + c16 * 8);
    }
  }
  __syncthreads();
  if (t < 128) {
    const float acf = inf_ + (w == 1 ? sm[772] : 0.f);
    const float preb = inb_ - ab_ + (w == 1 ? sm[774] : 0.f), totb = sm[774] + sm[775];
    sm[512 + t] = acf; sm[640 + t] = preb;
    if (t == 0) sm[768] = totb;
  }
  __syncthreads();
  f32x4 G[8][2], y[4][2];
#pragma unroll
  for (int jt = 0; jt < 8; ++jt) { G[jt][0] = (f32x4){0.f, 0.f, 0.f, 0.f}; G[jt][1] = (f32x4){0.f, 0.f, 0.f, 0.f}; }
#pragma unroll
  for (int pt = 0; pt < 4; ++pt) { y[pt][0] = (f32x4){0.f, 0.f, 0.f, 0.f}; y[pt][1] = (f32x4){0.f, 0.f, 0.f, 0.f}; }
  float acfi[2], prebi[2], efi[2][2];
#pragma unroll
  for (int it = 0; it < 2; ++it) {
    const int i = 32 * w + 16 * it + r;
    acfi[it] = sm[512 + i]; prebi[it] = sm[640 + i];
    efi[0][it] = __expf(acfi[it]); efi[1][it] = __expf(sm[768] - prebi[it]);
  }
#pragma unroll 1
  for (int nh = 0; nh < 2; ++nh) {
    {
      const bf16_t* XN = (const bf16_t*)(P.ws + OFF_XN);
#pragma unroll
      for (int k = 0; k < 4; ++k) {
        const int e = t + 256 * k, tok = e >> 3, ch = e & 7;
        const bf16_t* src = XN + (size_t)(rowbase + tok) * 512 + g * 128 + nh * 64 + ch * 8;
        *(u32x4*)(smh + SM_BN + tok * 128 + ((ch ^ (tok & 7)) << 4)) = *(const u32x4*)src;
        *(u32x4*)(smh + SM_CN + tok * 128 + ((ch ^ (tok & 7)) << 4)) = *(const u32x4*)(src + 256);
      }
      const int hp_ = t >> 2, hc_ = (t & 3) * 2;
#pragma unroll
      for (int d = 0; d < 2; ++d) {
        const bf16_t* hsrc = ST + ((size_t)(((b * 8 + h) * 2 + d) * 34 + cidx)) * 8192 + hp_ * 128 + nh * 64 + hc_ * 8;
        *(u32x4*)(smh + SM_RAW + d * 8192 + hp_ * 128 + ((hc_ ^ (hp_ & 7)) << 4)) = *(const u32x4*)hsrc;
        *(u32x4*)(smh + SM_RAW + d * 8192 + hp_ * 128 + (((hc_ + 1) ^ (hp_ & 7)) << 4)) = *(const u32x4*)(hsrc + 8);
      }
    }
    __syncthreads();
    bf16x8 cf[2][2];
#pragma unroll
    for (int it = 0; it < 2; ++it)
#pragma unroll
      for (int s = 0; s < 2; ++s) cf[it][s] = *(const bf16x8*)(smh + SM_CN + (32 * w + 16 * it + r) * 128 + (((4 * s + q) ^ r7) << 4));
#pragma unroll
    for (int jt = 0; jt < 8; ++jt)
#pragma unroll
      for (int s = 0; s < 2; ++s) {
        const bf16x8 bfr = *(const bf16x8*)(smh + SM_BN + (16 * jt + r) * 128 + (((4 * s + q) ^ r7) << 4));
        G[jt][0] = mfma16(bfr, cf[0][s], G[jt][0]); G[jt][1] = mfma16(bfr, cf[1][s], G[jt][1]);
      }
#pragma unroll
    for (int d = 0; d < 2; ++d) {
#pragma unroll
      for (int s = 0; s < 2; ++s) {
        union { bf16x8 b; u32x4 u; } c0, c1; c0.b = cf[0][s]; c1.b = cf[1][s];
        const bf16x8 cs0 = as_bf16x8(scale8(c0.u, efi[d][0])), cs1 = as_bf16x8(scale8(c1.u, efi[d][1]));
#pragma unroll
        for (int pt = 0; pt < 4; ++pt) {
          const bf16x8 hf = *(const bf16x8*)(smh + SM_RAW + d * 8192 + (16 * pt + r) * 128 + (((4 * s + q) ^ r7) << 4));
          y[pt][0] = mfma16(hf, cs0, y[pt][0]); y[pt][1] = mfma16(hf, cs1, y[pt][1]);
        }
      }
    }
    __syncthreads();
  }
#pragma unroll
  for (int s = 0; s < 4; ++s) {
    asm volatile("" ::: "memory");
    bf16x8 mf[2];
    const int wu = __builtin_amdgcn_readfirstlane(w);
    if (s < wu) {
      float aj[8], dfj[8];
#pragma unroll
      for (int jj = 0; jj < 8; ++jj) { const int j = 32 * s + (jj < 4 ? 4 * q + jj : 16 + 4 * q + jj - 4); aj[jj] = sm[512 + j]; dfj[jj] = sm[256 + j]; }
#pragma unroll
      for (int it = 0; it < 2; ++it) {
        float mv[8];
#pragma unroll
        for (int jj = 0; jj < 8; ++jj) mv[jj] = G[2 * s + (jj >> 2)][it][jj & 3] * __expf(acfi[it] - aj[jj]) * dfj[jj];
        u32x4 pk; pk.x = cvt_pk(mv[0], mv[1]); pk.y = cvt_pk(mv[2], mv[3]); pk.z = cvt_pk(mv[4], mv[5]); pk.w = cvt_pk(mv[6], mv[7]);
        mf[it] = as_bf16x8(pk);
      }
    } else if (s > wu) {
      float pj[8], dbj[8];
#pragma unroll
      for (int jj = 0; jj < 8; ++jj) { const int j = 32 * s + (jj < 4 ? 4 * q + jj : 16 + 4 * q + jj - 4); pj[jj] = sm[640 + j]; dbj[jj] = sm[384 + j]; }
#pragma unroll
      for (int it = 0; it < 2; ++it) {
        float mv[8];
#pragma unroll
        for (int jj = 0; jj < 8; ++jj) mv[jj] = G[2 * s + (jj >> 2)][it][jj & 3] * __expf(pj[jj] - prebi[it]) * dbj[jj];
        u32x4 pk; pk.x = cvt_pk(mv[0], mv[1]); pk.y = cvt_pk(mv[2], mv[3]); pk.z = cvt_pk(mv[4], mv[5]); pk.w = cvt_pk(mv[6], mv[7]);
        mf[it] = as_bf16x8(pk);
      }
    } else {
    float aj[8], pj[8], dfj[8], dbj[8];
#pragma unroll
    for (int jj = 0; jj < 8; ++jj) { const int j = 32 * s + (jj < 4 ? 4 * q + jj : 16 + 4 * q + jj - 4); aj[jj] = sm[512 + j]; pj[jj] = sm[640 + j]; dfj[jj] = sm[256 + j]; dbj[jj] = sm[384 + j]; }
#pragma unroll
    for (int it = 0; it < 2; ++it) {
      const int i = 32 * w + 16 * it + r;
      float mv[8];
#pragma unroll
      for (int jj = 0; jj < 8; ++jj) {
        const int j = 32 * s + (jj < 4 ? 4 * q + jj : 16 + 4 * q + jj - 4);
        const float gv = G[2 * s + (jj >> 2)][it][jj & 3];
        float m;
        if (j < i) m = gv * __expf(acfi[it] - aj[jj]) * dfj[jj];
        else if (j > i) m = gv * __expf(pj[jj] - prebi[it]) * dbj[jj];
        else m = gv * (dfj[jj] + dbj[jj]);
        mv[jj] = m;
      }
      u32x4 pk; pk.x = cvt_pk(mv[0], mv[1]); pk.y = cvt_pk(mv[2], mv[3]); pk.z = cvt_pk(mv[4], mv[5]); pk.w = cvt_pk(mv[6], mv[7]);
      mf[it] = as_bf16x8(pk);
    }
    }
#pragma unroll
    for (int pt = 0; pt < 4; ++pt) {
      const u32x2 lo2 = *(const u32x2*)(smh + SM_XT + (16 * pt + r) * 272 + (32 * s + 4 * q) * 2);
      const u32x2 hi2 = *(const u32x2*)(smh + SM_XT + (16 * pt + r) * 272 + (32 * s + 16 + 4 * q) * 2);
      const bf16x8 xf = as_bf16x8((u32x4){lo2.x, lo2.y, hi2.x, hi2.y});
      y[pt][0] = mfma16(xf, mf[0], y[pt][0]); y[pt][1] = mfma16(xf, mf[1], y[pt][1]);
    }
  }
  const float dsk = P.ssm_d[layer * 8 + h];
  const bf16_t* XT = (const bf16_t*)(smh + SM_XT);
  u32x2 zq[2][4]; f32x4 gq[4];
#pragma unroll
  for (int pt = 0; pt < 4; ++pt) {
    gq[pt] = *(const f32x4*)(P.ssm_g + layer * 512 + h * 64 + 16 * pt + 4 * q);
#pragma unroll
    for (int it = 0; it < 2; ++it) zq[it][pt] = *(const u32x2*)(PROJ + (size_t)(rowbase + 32 * w + 16 * it + r) * PW + 512 + h * 64 + 16 * pt + 4 * q);
  }
#pragma unroll
  for (int it = 0; it < 2; ++it) {
    const int i = 32 * w + 16 * it + r; const int row = rowbase + i;
    float ss = 0.f;
#pragma unroll
    for (int pt = 0; pt < 4; ++pt) {
      const int p0 = 16 * pt + 4 * q;
      const u32x2 zz = zq[it][pt];
      const f32x4 gg = gq[pt];
      const float zv[4] = {bflo(zz.x), bfhi(zz.x), bflo(zz.y), bfhi(zz.y)};
      float ov[4];
#pragma unroll
      for (int e = 0; e < 4; ++e) {
        const float xs = bf2f(XT[(p0 + e) * 136 + i]);
        const float yz = (y[pt][it][e] + dsk * xs) * silu_f(zv[e]);
        ss += yz * yz; ov[e] = yz * gg[e];
      }
      u32x2 o; o.x = cvt_pk(ov[0], ov[1]); o.y = cvt_pk(ov[2], ov[3]);
      *(u32x2*)(MIX + (size_t)row * 1024 + h * 64 + p0) = o;
    }
    ss += __shfl_xor(ss, 16); ss += __shfl_xor(ss, 32);
    if (q == 0 && do_atomic) atomicAdd(SSQ + row, ss);
  }
}

DEVI void mixer1_phase(const Params& P, int layer) {
  const int nA = 512, nV = 4 * 34 * 16, nC = (layer == 0) ? 64 : 0;
  const int total = nA + nV + nC;
#pragma unroll 1
  for (int it = VB; it < total; it += VG) {
    if (it < nA || it >= nA + nV) {
      int b, i1, i2; bool isctx = it >= nA;
      if (!isctx) { b = it >> 7; i1 = (it >> 2) & 31; i2 = it & 3; }
      else { const int e = it - nA - nV; b = e >> 4; i1 = (e >> 3) & 1; i2 = e & 7; }
      attn_item<0>(P, layer, b, i1, i2, isctx ? 1 : 0);
    } else { const int e = it - nA; const int b = e / 544, rem = e % 544; conv_item(P, layer, b, rem >> 4, rem & 15); }
  }
}
DEVI void mixer2_phase(const Params& P, int layer) {
  const int nB = 1024, nS = 4 * 34 * 8;
  const int total = nB + nS;
#pragma unroll 1
  for (int it = VB; it < total; it += VG) {
    if (it < nB) { const int b = it >> 8, gr = (it >> 2) & 63, h = it & 3; attn_item<1>(P, layer, b, gr, h, 0); }
    else { const int e = it - nB; const int b = e / 272, rem = e % 272; ssd_state_item(P, layer, b, rem >> 3, rem & 7); }
  }
}

DEVI void ssd_out_phase(const Params& P, int layer, int do_atomic = 1) {
  const int c0 = (layer == 0) ? 0 : 2;
  const int nc = 34 - c0;
  const int total = 4 * nc * 8;
#pragma unroll 1
  for (int it = VB; it < total; it += VG) {
    const int b = it / (nc * 8), rem = it % (nc * 8);
    ssd_out_item(P, layer, b, c0 + (rem >> 3), rem & 7, do_atomic);
  }
}


#define XB_TMO      128
#define XB_XCNT(j)  (256  + 64 * (j))
#define XB_XSUB(j)  (1280 + 64 * (j))
#define XB_XGEN(j)  (2304 + 64 * (j))
#define XB_TOP      3328
#define XB_TOPGEN   3392
#define XB_SPIN_CAP (1u << 18)
#define LAS __attribute__((address_space(3)))
DEVI unsigned xb_ld(unsigned* p)              { return __hip_atomic_load(p, __ATOMIC_RELAXED, __HIP_MEMORY_SCOPE_AGENT); }
DEVI unsigned xb_add(unsigned* p, unsigned v) { return __hip_atomic_fetch_add(p, v, __ATOMIC_RELAXED, __HIP_MEMORY_SCOPE_AGENT); }
DEVI unsigned xb_xcc_id() { return (unsigned)__builtin_amdgcn_s_getreg((3 << 11) | 20) & 0xFu; }
#define XB_SPIN(cond, bar) do { unsigned _sp = 0; while (cond) { __builtin_amdgcn_s_sleep(1); \
    if ((++_sp & 255u) == 0u) { if (xb_ld(&(bar)[XB_TMO])) break; if (_sp > XB_SPIN_CAP) { atomicAdd(&(bar)[XB_TMO], 1u); break; } } } } while (0)
struct XcdBarrier { unsigned* bar; unsigned x; volatile LAS unsigned* st; };
DEVI XcdBarrier xcd_barrier_post(unsigned* bar, volatile LAS unsigned* st) {
  XcdBarrier b; b.bar = bar; b.x = xb_xcc_id(); b.st = st;
  if (threadIdx.x == 0) (void)xb_add(&bar[XB_XCNT(b.x)], 1u);
  return b;
}
DEVI void xcd_barrier_complete(unsigned* bar, unsigned x, unsigned& nloc, unsigned& nx) {
  const unsigned G = gridDim.x * gridDim.y * gridDim.z;
  unsigned sum, cnt, mine, sp = 0u;
  for (;;) {
    sum = 0u; cnt = 0u; mine = 0u;
#pragma unroll
    for (unsigned j = 0; j < 16; ++j) { const unsigned c = xb_ld(&bar[XB_XCNT(j)]); sum += c; cnt += (c > 0u) ? 1u : 0u; mine = (j == x) ? c : mine; }
    if (sum == G) break;
    __builtin_amdgcn_s_sleep(1);
    if ((++sp & 255u) == 0u) { if (xb_ld(&bar[XB_TMO])) break; if (sp > XB_SPIN_CAP) { atomicAdd(&bar[XB_TMO], 1u); break; } }
  }
  nloc = mine > 0u ? mine : 1u; nx = cnt > 0u ? cnt : 1u;
}
DEVI void xcd_barrier(const XcdBarrier& b) {
  asm volatile("s_waitcnt vmcnt(0)" ::: "memory");
  __syncthreads();
  if (threadIdx.x == 0) {
    unsigned* bar = b.bar;
    __builtin_amdgcn_s_waitcnt(0);
    unsigned nloc = b.st[0], nx = b.st[1];
    if (nloc == 0u) { xcd_barrier_complete(bar, b.x, nloc, nx); b.st[0] = nloc; b.st[1] = nx; }
    const unsigned old = xb_add(&bar[XB_XSUB(b.x)], 1u);
    const unsigned gen = old / nloc;
    if (old + 1u == (gen + 1u) * nloc) {
      __builtin_amdgcn_fence(__ATOMIC_RELEASE, "agent");
      asm volatile("s_waitcnt vmcnt(0)" ::: "memory");
      const unsigned og = xb_add(&bar[XB_TOP], 1u);
      const unsigned tg = og / nx;
      if (og + 1u == (tg + 1u) * nx) xb_add(&bar[XB_TOPGEN], 1u);
      else XB_SPIN(xb_ld(&bar[XB_TOPGEN]) == tg, bar);
      __builtin_amdgcn_fence(__ATOMIC_ACQUIRE, "agent");
      xb_add(&bar[XB_XGEN(b.x)], 1u);
      asm volatile("s_waitcnt vmcnt(0)" ::: "memory");
    } else {
      XB_SPIN(xb_ld(&bar[XB_XGEN(b.x)]) == gen, bar);
      __builtin_amdgcn_fence(__ATOMIC_ACQUIRE, "agent");
      asm volatile("s_waitcnt vmcnt(0)" ::: "memory");
    }
  }
  __syncthreads();
}

__global__ void __launch_bounds__(512, 2) mega_fwd(Params P) {
  cg::grid_group grid = cg::this_grid();
  if (threadIdx.x == 0) *(uint4*)(smem + SM_XB) = make_uint4(0u, 0u, 0u, 0u);
  __syncthreads();
  XcdBarrier xb = xcd_barrier_post((unsigned*)(P.ws + OFF_BAR), (volatile LAS unsigned*)(smem + SM_XB));
  if (P.ph_hi > 1000) grid.sync();
#define BAR() xcd_barrier(xb)
#ifndef REP_S
#define REP_S -1
#endif
#define RUN(S_, CALL) { if (REP_S == (S_)) { const int do_at = 0; (void)do_at; CALL; BAR(); } { const int do_at = 1; (void)do_at; CALL; } BAR(); }
#define LAYER(l) \
  RUN(0, (norm_phase(P, l, 0), (l == 1 ? prep_phase(P, 1, false) : (void)0))) \
  RUN(1, (gemm_phase<MODE_INPROJ, false>(P, l))) \
  RUN(2, mixer1_phase(P, l)) \
  RUN(9, mixer2_phase(P, l)) \
  RUN(3, ssd_scan_phase(P)) \
  RUN(4, ssd_out_phase(P, l, do_at)) \
  RUN(5, (gemm_phase<MODE_RESID, true>(P, l))) \
  RUN(6, norm_phase(P, l, 1)) \
  RUN(7, (gemm_phase<MODE_SWIGLU, false>(P, l))) \
  RUN(8, (gemm_phase<MODE_RESID, false>(P, l)))
  prep_phase(P, 0, true); BAR();
  LAYER(0)
  LAYER(1)
  final_norm_phase(P);
}

extern "C" void kernel_launch(void* const* d_in, const int* in_sizes, int n_in, void* d_out, int out_size, void* d_ws, size_t ws_size, hipStream_t stream) {
  static int grid_blocks = 0;
  if (!grid_blocks) {
    int dev = 0, cus = 0, per_cu = 0;
    hipGetDevice(&dev);
    hipDeviceGetAttribute(&cus, hipDeviceAttributeMultiprocessorCount, dev);
    hipOccupancyMaxActiveBlocksPerMultiprocessor(&per_cu, mega_fwd, 512, 0);
    if (per_cu < 1) per_cu = 1;
    if (per_cu > 1) per_cu = 1;
    grid_blocks = cus * per_cu;
    if (ws_size < WS_END) fprintf(stderr, "kernel_launch: workspace too small: %zu < %zu\n", ws_size, (size_t)WS_END);
  }
  Params p{};
  const float** pp = (const float**)&p;
  for (int i = 0; i < 21; ++i) pp[i] = (const float*)d_in[i];
  p.out = (float*)d_out; p.ws = (unsigned char*)d_ws;
  hipMemsetAsync((unsigned char*)d_ws + OFF_MODS, 0, SZ_MODS + SZ_BAR, stream);
#if LAUNCH_PER_PHASE
  for (int ph = 0; ph < NPH; ++ph) {
    p.ph_lo = ph; p.ph_hi = ph + 1;
    hipLaunchKernelGGL(mega_fwd, dim3(grid_blocks), dim3(256), 0, stream, p);
  }
#else
  p.ph_lo = 0; p.ph_hi = NPH;
  void* args[] = {&p};
  hipError_t e = hipLaunchCooperativeKernel((void*)mega_fwd, dim3(grid_blocks), dim3(512), args, 0, stream);
  if (e != hipSuccess) fprintf(stderr, "cooperative launch failed: %s (grid %d)\n", hipGetErrorString(e), grid_blocks);
#endif
}
```
